# Optimizing an MI355X kernel written in HIP

```python
import jax, jax.numpy as jnp
from jax import lax
import numpy as np

D_MODEL = 2048
BATCH = 8
SEQ = 2048
DEPTH = 2

HEAD_DIM = 128
Q_BLOCK = 128
NEG = -1e30
FORCE = 1e9
EPS = 1e-6

MOBA_HEADS = 8
MOBA_BLOCK = 256
MOBA_TOPK = 3
MOBA_WIDTH = MOBA_HEADS * HEAD_DIM

NSA_HEADS = 8
NSA_KV_HEADS = 2
NSA_GROUP = NSA_HEADS // NSA_KV_HEADS
NSA_CMP_LEN = 32
NSA_CMP_STRIDE = 16
NSA_SLC_BLOCK = 64
NSA_TOPN = 8
NSA_WINDOW = 512
NSA_WIDTH = NSA_HEADS * HEAD_DIM
NSA_KV_WIDTH = NSA_KV_HEADS * HEAD_DIM

GLA_HEADS = 4
GLA_DK = 128
GLA_DV = 256
GLA_RANK = 16
GLA_TAU = 16.0
GLA_CHUNK = 64
GLA_KEY_WIDTH = GLA_HEADS * GLA_DK
GLA_WIDTH = GLA_HEADS * GLA_DV

N_BRANCH = 3
IN_SPLITS = (MOBA_WIDTH, MOBA_WIDTH, MOBA_WIDTH,
             NSA_WIDTH, 6 * NSA_KV_WIDTH, 3 * NSA_HEADS,
             GLA_KEY_WIDTH, GLA_KEY_WIDTH, GLA_WIDTH,
             GLA_RANK, GLA_WIDTH,
             N_BRANCH * D_MODEL)
IN_WIDTH = sum(IN_SPLITS)

MOE_GROUPS = 4
MOE_EXPERTS_PER_GROUP = 8
MOE_EXPERTS = MOE_GROUPS * MOE_EXPERTS_PER_GROUP
MOE_TOPK = 2
MOE_FF = D_MODEL // 4
MOE_ROW_BLOCK = 128

kernel_name = 'hybrid_moba_nsa_gla_hmoe_block'


def rmsnorm(x, g):
    xf = x.astype(jnp.float32)
    y = xf * lax.rsqrt(jnp.mean(xf * xf, axis=-1, keepdims=True) + EPS)
    return (y * g.astype(jnp.float32)).astype(x.dtype)


def moba_attention(q, k, v):
    B, S = q.shape[0], q.shape[1]
    Sp = -(-S // MOBA_BLOCK) * MOBA_BLOCK
    pad = ((0, 0), (0, Sp - S), (0, 0), (0, 0))
    q, k, v = jnp.pad(q, pad), jnp.pad(k, pad), jnp.pad(v, pad)
    nb = Sp // MOBA_BLOCK
    topk = min(MOBA_TOPK, nb)
    scale = HEAD_DIM ** -0.5
    heads = jnp.arange(MOBA_HEADS)[:, None, None]

    def per_example(args):
        qe, ke, ve = args
        qh = qe.transpose(1, 0, 2)
        kb = ke.transpose(1, 0, 2).reshape(MOBA_HEADS, nb, MOBA_BLOCK, HEAD_DIM)
        vb = ve.transpose(1, 0, 2).reshape(MOBA_HEADS, nb, MOBA_BLOCK, HEAD_DIM)
        kmean = jnp.mean(kb.astype(jnp.float32), axis=2)

        def per_qblock(i):
            start = i * Q_BLOCK
            qb = lax.dynamic_slice_in_dim(qh, start, Q_BLOCK, axis=1)
            pos = start + jnp.arange(Q_BLOCK)
            cur = start // MOBA_BLOCK
            gate = jnp.einsum('hqd,hnd->hqn', qb.astype(jnp.float32), kmean)
            gate = jnp.where(jnp.arange(nb) < cur, gate, NEG)
            _, sel = lax.top_k(gate, topk)
            k_sel = kb[heads, sel]
            v_sel = vb[heads, sel]
            k_own = lax.dynamic_index_in_dim(kb, cur, axis=1, keepdims=False)
            v_own = lax.dynamic_index_in_dim(vb, cur, axis=1, keepdims=False)
            s_sel = jnp.einsum('hqd,hqnkd->hqnk', qb, k_sel, preferred_element_type=jnp.float32) * scale
            s_sel = jnp.where((sel < cur)[..., None], s_sel, NEG)
            s_own = jnp.einsum('hqd,hkd->hqk', qb, k_own, preferred_element_type=jnp.float32) * scale
            own_pos = cur * MOBA_BLOCK + jnp.arange(MOBA_BLOCK)
            s_own = jnp.where(own_pos[None, None, :] <= pos[None, :, None], s_own, NEG)
            s = jnp.concatenate([s_sel.reshape(MOBA_HEADS, Q_BLOCK, topk * MOBA_BLOCK), s_own], axis=-1)
            p = jax.nn.softmax(s, axis=-1).astype(ve.dtype)
            p_sel = p[..., :topk * MOBA_BLOCK].reshape(MOBA_HEADS, Q_BLOCK, topk, MOBA_BLOCK)
            p_own = p[..., topk * MOBA_BLOCK:]
            return (jnp.einsum('hqnk,hqnkd->qhd', p_sel, v_sel)
                    + jnp.einsum('hqk,hkd->qhd', p_own, v_own))

        out = lax.map(per_qblock, jnp.arange(Sp // Q_BLOCK))
        return out.reshape(Sp, MOBA_HEADS, HEAD_DIM)

    out = lax.map(per_example, (q, k, v))
    return out[:, :S]


def nsa_attention(q, kv, gates, cmp_pe, cmp_w1, cmp_w2):
    B, S = q.shape[0], q.shape[1]
    G, R, dh = NSA_KV_HEADS, NSA_GROUP, HEAD_DIM
    scale = dh ** -0.5
    ncmp = (S - NSA_CMP_LEN) // NSA_CMP_STRIDE + 1
    win_idx = jnp.arange(ncmp)[:, None] * NSA_CMP_STRIDE + jnp.arange(NSA_CMP_LEN)[None, :]
    blocks = kv[:, :, 0:2][:, win_idx]
    blocks = blocks + cmp_pe.transpose(1, 0, 2)[None, None, :, :, None, :]
    flat = blocks.transpose(0, 1, 3, 4, 2, 5).reshape(B, ncmp, 2, G, NSA_CMP_LEN * dh)
    hid = jax.nn.silu(jnp.einsum('bncgi,cio->bncgo', flat, cmp_w1))
    kv_c = jnp.einsum('bncgi,cio->bncgo', hid, cmp_w2)
    k_c, v_c = kv_c[:, :, 0], kv_c[:, :, 1]
    cmp_start = jnp.arange(ncmp) * NSA_CMP_STRIDE
    cmp_end = cmp_start + NSA_CMP_LEN - 1
    nslc = S // NSA_SLC_BLOCK
    slc_start = jnp.arange(nslc) * NSA_SLC_BLOCK
    overlap = ((cmp_start[:, None] < slc_start[None, :] + NSA_SLC_BLOCK)
               & (cmp_end[:, None] >= slc_start[None, :])).astype(jnp.float32)
    topn = min(NSA_TOPN, nslc)
    groups = jnp.arange(G)[:, None, None]

    def per_example(args):
        qe, kve, ge, kce, vce = args
        qg = qe.reshape(S, G, R, dh).transpose(1, 2, 0, 3)
        pos = jnp.arange(S)
        s_c = jnp.einsum('grqd,ngd->grqn', qg, kce, preferred_element_type=jnp.float32) * scale
        cmask = cmp_end[None, :] <= pos[:, None]
        p_c = jax.nn.softmax(jnp.where(cmask, s_c, NEG), axis=-1) * cmask
        o_c = jnp.einsum('grqn,ngd->qgrd', p_c.astype(vce.dtype), vce)
        imp = jnp.einsum('gqn,nj->gqj', p_c.sum(axis=1), overlap)
        cur_blk = pos // NSA_SLC_BLOCK
        j = jnp.arange(nslc)[None, :]
        forced = (j == 0) | (j == cur_blk[:, None]) | (j == cur_blk[:, None] - 1)
        imp = jnp.where(forced, FORCE, imp)
        imp = jnp.where(j > cur_blk[:, None], NEG, imp)
        _, sel = lax.top_k(imp, topn)
        ksb = kve[:, 2].transpose(1, 0, 2).reshape(G, nslc, NSA_SLC_BLOCK, dh)
        vsb = kve[:, 3].transpose(1, 0, 2).reshape(G, nslc, NSA_SLC_BLOCK, dh)
        kw = jnp.pad(kve[:, 4], ((NSA_WINDOW, 0), (0, 0), (0, 0)))
        vw = jnp.pad(kve[:, 5], ((NSA_WINDOW, 0), (0, 0), (0, 0)))

        def per_qblock(i):
            start = i * Q_BLOCK
            qb = lax.dynamic_slice_in_dim(qg, start, Q_BLOCK, axis=2)
            qpos = start + jnp.arange(Q_BLOCK)
            selb = lax.dynamic_slice_in_dim(sel, start, Q_BLOCK, axis=1)
            k_sel = ksb[groups, selb]
            v_sel = vsb[groups, selb]
            s_s = jnp.einsum('grqd,gqnkd->grqnk', qb, k_sel, preferred_element_type=jnp.float32) * scale
            key_pos = selb[..., None] * NSA_SLC_BLOCK + jnp.arange(NSA_SLC_BLOCK)
            s_s = jnp.where((key_pos <= qpos[None, :, None, None])[:, None], s_s, NEG)
            p_s = jax.nn.softmax(s_s.reshape(G, R, Q_BLOCK, topn * NSA_SLC_BLOCK), axis=-1)
            p_s = p_s.reshape(G, R, Q_BLOCK, topn, NSA_SLC_BLOCK).astype(v_sel.dtype)
            o_s = jnp.einsum('grqnk,gqnkd->qgrd', p_s, v_sel)
            k_w = lax.dynamic_slice_in_dim(kw, start, NSA_WINDOW + Q_BLOCK, axis=0)
            v_w = lax.dynamic_slice_in_dim(vw, start, NSA_WINDOW + Q_BLOCK, axis=0)
            wpos = start - NSA_WINDOW + jnp.arange(NSA_WINDOW + Q_BLOCK)
            wmask = ((wpos[None, :] <= qpos[:, None]) & (wpos[None, :] > qpos[:, None] - NSA_WINDOW)
                     & (wpos[None, :] >= 0))
            s_w = jnp.einsum('grqd,kgd->grqk', qb, k_w, preferred_element_type=jnp.float32) * scale
            p_w = jax.nn.softmax(jnp.where(wmask, s_w, NEG), axis=-1).astype(v_w.dtype)
            o_w = jnp.einsum('grqk,kgd->qgrd', p_w, v_w)
            return o_s, o_w

        o_s, o_w = lax.map(per_qblock, jnp.arange(S // Q_BLOCK))
        o_s = o_s.reshape(S, G, R, dh)
        o_w = o_w.reshape(S, G, R, dh)
        gg = ge.reshape(S, G, R, 3)
        o = gg[..., 0:1] * o_c + gg[..., 1:2] * o_s + gg[..., 2:3] * o_w
        return o.reshape(S, NSA_HEADS, dh)

    return lax.map(per_example, (q, kv, gates, k_c, v_c))


def gla_attention(q, k, v, log_a):
    B, S, H = q.shape[0], q.shape[1], q.shape[2]
    nc = S // GLA_CHUNK

    def chunks(t):
        return t.reshape(B, nc, GLA_CHUNK, H, t.shape[-1]).transpose(1, 0, 3, 2, 4)

    qc, kc, vc, ac = chunks(q * (GLA_DK ** -0.5)), chunks(k), chunks(v), chunks(log_a)
    causal = jnp.tril(jnp.ones((GLA_CHUNK, GLA_CHUNK), dtype=bool))

    def step(state, inp):
        qi, ki, vi, ai = inp
        qf, kf, vf = qi.astype(jnp.float32), ki.astype(jnp.float32), vi.astype(jnp.float32)
        b = jnp.cumsum(ai.astype(jnp.float32), axis=2)
        diff = b[:, :, :, None, :] - b[:, :, None, :, :]
        decay = jnp.exp(jnp.where(causal[None, None, :, :, None], diff, -jnp.inf))
        attn = jnp.einsum('bhtd,bhsd,bhtsd->bhts', qf, kf, decay)
        o = (jnp.einsum('bhts,bhse->bhte', attn, vf)
             + jnp.einsum('bhtd,bhde->bhte', qf * jnp.exp(b), state))
        b_last = b[:, :, -1:, :]
        state = (jnp.exp(b_last[:, :, 0, :, None]) * state
                 + jnp.einsum('bhsd,bhse->bhde', kf * jnp.exp(b_last - b), vf))
        return state, o

    state0 = jnp.zeros((B, H, GLA_DK, GLA_DV), jnp.float32)
    _, o = lax.scan(step, state0, (qc, kc, vc, ac))
    return o.transpose(1, 0, 3, 2, 4).reshape(B, S, H, GLA_DV).astype(v.dtype)


def hier_moe(h, rg_w, rg_b, re_w, re_b, w_gate, w_up, w_down):
    B, S, D = h.shape
    T = B * S
    ht = h.reshape(T, D)
    g_logits = (ht @ rg_w).astype(jnp.float32) + rg_b.astype(jnp.float32)
    grp = jnp.argmax(g_logits, axis=-1)
    p_grp = jnp.take_along_axis(jax.nn.softmax(g_logits, axis=-1), grp[:, None], axis=1)[:, 0]
    e_logits = ((ht @ re_w).astype(jnp.float32) + re_b.astype(jnp.float32)).reshape(T, MOE_GROUPS, MOE_EXPERTS_PER_GROUP)
    e_in = jnp.take_along_axis(e_logits, grp[:, None, None], axis=1)[:, 0]
    top_v, top_i = lax.top_k(e_in, MOE_TOPK)
    w = jax.nn.softmax(top_v, axis=-1) * p_grp[:, None]
    expert = grp[:, None] * MOE_EXPERTS_PER_GROUP + top_i
    A = T * MOE_TOPK
    e_flat = expert.reshape(A)
    w_flat = w.reshape(A)
    tok = jnp.arange(A) // MOE_TOPK
    order = jnp.argsort(e_flat)
    e_sorted = e_flat[order]
    counts = jax.ops.segment_sum(jnp.ones((A,), jnp.int32), e_flat, num_segments=MOE_EXPERTS)
    starts = jnp.cumsum(counts) - counts
    padded = (counts + MOE_ROW_BLOCK - 1) // MOE_ROW_BLOCK * MOE_ROW_BLOCK
    pends = jnp.cumsum(padded)
    pstarts = pends - padded
    dest = pstarts[e_sorted] + (jnp.arange(A) - starts[e_sorted])
    P = (A + MOE_EXPERTS * (MOE_ROW_BLOCK - 1) + MOE_ROW_BLOCK - 1) // MOE_ROW_BLOCK * MOE_ROW_BLOCK
    nblk = P // MOE_ROW_BLOCK
    row_tok = jnp.zeros((P,), jnp.int32).at[dest].set(tok[order])
    row_w = jnp.zeros((P,), jnp.float32).at[dest].set(w_flat[order])
    blk_e = jnp.clip(jnp.searchsorted(pends, jnp.arange(nblk) * MOE_ROW_BLOCK, side='right'), 0, MOE_EXPERTS - 1)

    def expert_block(args):
        toks, e = args
        xb = ht[toks]
        return (jax.nn.silu(xb @ w_gate[e]) * (xb @ w_up[e])) @ w_down[e]

    y_rows = lax.map(expert_block, (row_tok.reshape(nblk, MOE_ROW_BLOCK), blk_e)).reshape(P, D)
    y_rows = y_rows * row_w[:, None].astype(y_rows.dtype)
    y = jax.ops.segment_sum(y_rows, row_tok, num_segments=T)
    return y.reshape(B, S, D)


def hybrid_layer(x, norm1_g, w_in, nsa_cmp_pe, nsa_cmp_w1, nsa_cmp_w2, gla_wa, gla_ba, gla_norm_g,
                 w_br_moba, w_br_nsa, w_br_gla, w_out, norm2_g, router_group_w, router_group_b,
                 router_expert_w, router_expert_b, expert_w_gate, expert_w_up, expert_w_down):
    B, S = x.shape[0], x.shape[1]
    h = rmsnorm(x, norm1_g)
    proj = h @ w_in
    offsets = [int(o) for o in np.cumsum(IN_SPLITS)[:-1]]
    (mq, mk, mv, nq, nkv, ng, gq, gk, gv, ga, gg, mg) = jnp.split(proj, offsets, axis=-1)
    o_m = moba_attention(mq.reshape(B, S, MOBA_HEADS, HEAD_DIM), mk.reshape(B, S, MOBA_HEADS, HEAD_DIM),
                         mv.reshape(B, S, MOBA_HEADS, HEAD_DIM)).reshape(B, S, MOBA_WIDTH)
    o_n = nsa_attention(nq.reshape(B, S, NSA_HEADS, HEAD_DIM), nkv.reshape(B, S, 6, NSA_KV_HEADS, HEAD_DIM),
                        jax.nn.sigmoid(ng.reshape(B, S, NSA_HEADS, 3)),
                        nsa_cmp_pe, nsa_cmp_w1, nsa_cmp_w2).reshape(B, S, NSA_WIDTH)
    log_a = jax.nn.log_sigmoid((ga @ gla_wa + gla_ba).astype(jnp.float32)) / GLA_TAU
    o_g = gla_attention(gq.reshape(B, S, GLA_HEADS, GLA_DK), gk.reshape(B, S, GLA_HEADS, GLA_DK),
                        gv.reshape(B, S, GLA_HEADS, GLA_DV), log_a.reshape(B, S, GLA_HEADS, GLA_DK))
    o_g = (rmsnorm(o_g, gla_norm_g) * jax.nn.silu(gg.reshape(B, S, GLA_HEADS, GLA_DV))).reshape(B, S, GLA_WIDTH)
    gates = jax.nn.sigmoid(mg.reshape(B, S, N_BRANCH, D_MODEL))
    merged = (gates[:, :, 0] * (o_m @ w_br_moba) + gates[:, :, 1] * (o_n @ w_br_nsa)
              + gates[:, :, 2] * (o_g @ w_br_gla))
    x = x + merged @ w_out
    x = x + hier_moe(rmsnorm(x, norm2_g), router_group_w, router_group_b, router_expert_w, router_expert_b,
                     expert_w_gate, expert_w_up, expert_w_down)
    return x


def setup_inputs(seed: int = 0) -> dict:
    key = jax.random.key(seed)
    ks = jax.random.split(key, 24)
    L = DEPTH

    def nrm(k, shape, scale):
        return jax.random.normal(k, shape, jnp.float32) * scale

    return {
        'x': nrm(ks[0], (BATCH, SEQ, D_MODEL), 1.0),
        'norm1_g': 1.0 + nrm(ks[1], (L, D_MODEL), 0.02),
        'w_in': nrm(ks[2], (L, D_MODEL, IN_WIDTH), D_MODEL ** -0.5),
        'nsa_cmp_pe': nrm(ks[3], (L, 2, NSA_CMP_LEN, HEAD_DIM), 0.1),
        'nsa_cmp_w1': nrm(ks[4], (L, 2, NSA_CMP_LEN * HEAD_DIM, HEAD_DIM), (NSA_CMP_LEN * HEAD_DIM) ** -0.5),
        'nsa_cmp_w2': nrm(ks[5], (L, 2, HEAD_DIM, HEAD_DIM), HEAD_DIM ** -0.5),
        'gla_wa': nrm(ks[6], (L, GLA_RANK, GLA_KEY_WIDTH), GLA_RANK ** -0.5),
        'gla_ba': nrm(ks[7], (L, GLA_KEY_WIDTH), 0.02),
        'gla_norm_g': 1.0 + nrm(ks[8], (L, GLA_DV), 0.02),
        'w_br_moba': nrm(ks[9], (L, MOBA_WIDTH, D_MODEL), MOBA_WIDTH ** -0.5),
        'w_br_nsa': nrm(ks[10], (L, NSA_WIDTH, D_MODEL), NSA_WIDTH ** -0.5),
        'w_br_gla': nrm(ks[11], (L, GLA_WIDTH, D_MODEL), GLA_WIDTH ** -0.5),
        'w_out': nrm(ks[12], (L, D_MODEL, D_MODEL), D_MODEL ** -0.5),
        'norm2_g': 1.0 + nrm(ks[13], (L, D_MODEL), 0.02),
        'router_group_w': nrm(ks[14], (L, D_MODEL, MOE_GROUPS), D_MODEL ** -0.5),
        'router_group_b': nrm(ks[15], (L, MOE_GROUPS), 0.01),
        'router_expert_w': nrm(ks[16], (L, D_MODEL, MOE_EXPERTS), D_MODEL ** -0.5),
        'router_expert_b': nrm(ks[17], (L, MOE_EXPERTS), 0.01),
        'expert_w_gate': nrm(ks[18], (L, MOE_EXPERTS, D_MODEL, MOE_FF), D_MODEL ** -0.5),
        'expert_w_up': nrm(ks[19], (L, MOE_EXPERTS, D_MODEL, MOE_FF), D_MODEL ** -0.5),
        'expert_w_down': nrm(ks[20], (L, MOE_EXPERTS, MOE_FF, D_MODEL), MOE_FF ** -0.5),
        'final_norm_g': 1.0 + nrm(ks[21], (D_MODEL,), 0.02),
    }


def reference(x, norm1_g, w_in, nsa_cmp_pe, nsa_cmp_w1, nsa_cmp_w2, gla_wa, gla_ba, gla_norm_g,
              w_br_moba, w_br_nsa, w_br_gla, w_out, norm2_g, router_group_w, router_group_b,
              router_expert_w, router_expert_b, expert_w_gate, expert_w_up, expert_w_down, final_norm_g):
    for l in range(DEPTH):
        x = hybrid_layer(x, norm1_g[l], w_in[l], nsa_cmp_pe[l], nsa_cmp_w1[l], nsa_cmp_w2[l],
                         gla_wa[l], gla_ba[l], gla_norm_g[l], w_br_moba[l], w_br_nsa[l], w_br_gla[l],
                         w_out[l], norm2_g[l], router_group_w[l], router_group_b[l],
                         router_expert_w[l], router_expert_b[l], expert_w_gate[l], expert_w_up[l],
                         expert_w_down[l])
    return rmsnorm(x, final_norm_g)
```

```cpp
#define MIX_SET 1
#include <hip/hip_runtime.h>
#include <hip/hip_bf16.h>
#include <stdint.h>
#include <math.h>

constexpr int D=2048, NB=8, S=2048, T=NB*S, NL=2;
constexpr int INW=14888;
constexpr int O_MQ=0,O_MK=1024,O_MV=2048,O_NQ=3072,O_NKV=4096,O_NG=5632,O_GQ=5656,O_GK=6168,O_GV=6680,O_GA=7704,O_GG=7720,O_MG=8744;
using f32x16 = __attribute__((ext_vector_type(16))) float;
using f32x4  = __attribute__((ext_vector_type(4))) float;
using bf16x8 = __attribute__((ext_vector_type(8))) short;
#define LAS __attribute__((address_space(3)))
typedef unsigned short bf16_t;
typedef unsigned u32x4 __attribute__((ext_vector_type(4)));
typedef unsigned u32x2 __attribute__((ext_vector_type(2)));
typedef float f32x2 __attribute__((ext_vector_type(2)));

__device__ __forceinline__ unsigned cvt_pk_bf16(float lo, float hi) { unsigned r; asm volatile("v_cvt_pk_bf16_f32 %0, %1, %2" : "=v"(r) : "v"(lo), "v"(hi)); return r; }
__device__ __forceinline__ float bf_lo(unsigned w) { return __uint_as_float(w << 16); }
__device__ __forceinline__ float bf_hi(unsigned w) { return __uint_as_float(w & 0xffff0000u); }
__device__ __forceinline__ float bf2f(bf16_t b) { return __uint_as_float(((unsigned)b) << 16); }
__device__ __forceinline__ bf16_t f2bf(float f) { unsigned u = __float_as_uint(f); u += 0x7FFFu + ((u >> 16) & 1u); return (bf16_t)(u >> 16); }
__device__ __forceinline__ float fast_sigmoid(float x) { return __builtin_amdgcn_rcpf(1.f + __builtin_amdgcn_exp2f(-1.4426950408889634f * x)); }
__device__ __forceinline__ float fast_silu(float x) { return x * fast_sigmoid(x); }

#ifndef GE_SP2_DEFAULT
#define GE_SP2_DEFAULT true
#endif
#ifndef GE_ALIGN_DEFAULT
#define GE_ALIGN_DEFAULT true
#endif
namespace ge {
constexpr int BM = 256, BK = 64, HALF = 128, HTB = HALF * BK * 2, STAGE_BYTES = 8 * HTB, NXCD = 8, WGM = 8;
__host__ __device__ __forceinline__ int lds_byte(int r, int c) { const int st = (r >> 4) * 2 + (c >> 5), rr = r & 15, cc = c & 31, ob = rr * 64 + cc * 2; return st * 1024 + (ob ^ (((ob >> 9) & 1) << 5)); }
__host__ __device__ __forceinline__ void stage_rc(int b, int& R, int& C) { const int st = b / 1024, sb = b % 1024, swz = sb ^ (((sb >> 9) & 1) << 5); R = (st >> 1) * 16 + swz / 64; C = (st & 1) * 32 + (swz % 64) / 2; }
__host__ __device__ __forceinline__ int perm32(int rho) { const int n = rho >> 4, i = rho & 15; return 8 * (i >> 2) + 4 * n + (i & 3); }

typedef int i32x8 __attribute__((ext_vector_type(8)));
typedef int i32x4 __attribute__((ext_vector_type(4)));
__device__ __forceinline__ i32x8 cat8(bf16x8 a, bf16x8 b) { const i32x4 x = *reinterpret_cast<i32x4*>(&a), y = *reinterpret_cast<i32x4*>(&b); return (i32x8){x[0], x[1], x[2], x[3], y[0], y[1], y[2], y[3]}; }
constexpr int F8_SCALE_A = 0x7B7B7B7B, F8_SCALE_B = 0x76767676;
struct Unit { const char* A; const char* B; int r0; int c0; int aux; int aux2; };

__device__ __forceinline__ bool static_tile(int i, int G, int c, int nM, int nN, int& pm, int& pn) {
    const int nwg = nM * nN; const long L = (long)i * G + c; if (L >= nwg) return false;
    int wgid = (int)L; { const int q = nwg / NXCD, r = nwg % NXCD, xcd = wgid % NXCD, off = wgid / NXCD; wgid = (xcd < r ? xcd * (q + 1) : r * (q + 1) + (xcd - r) * q) + off; }
    const int nig = WGM * nN, gid = wgid / nig, fm = gid * WGM, gsz = (nM - fm) < WGM ? (nM - fm) : WGM;
    pm = fm + ((wgid % nig) % gsz); pn = (wgid % nig) / gsz; return true;
}

template <class Epi, class Sched, int KMODE, bool F8 = false, bool SP2 = GE_SP2_DEFAULT, bool ALIGN_EPI = GE_ALIGN_DEFAULT>
__device__ __forceinline__ void gemm_phase(LAS unsigned char* lds, const int tid_in, const int K, const int kbig, const Sched& S, const Epi& E) {
    int tid_ = tid_in; asm volatile("" : "+v"(tid_));
    const int tid = tid_, wid = __builtin_amdgcn_readfirstlane(tid >> 6), lane = tid & 63, wr = wid >> 2, wc = wid & 3, fr = lane & 15, fq = lane >> 4;
    const int nt = F8 ? K / 128 : K / BK;
    unsigned voffB[2];
#pragma unroll
    for (int i = 0; i < 2; ++i) { int R, C; stage_rc(tid * 16 + i * 8192, R, C); const int Rb = Epi::PERM ? ((R & ~31) + perm32(R & 31)) : R; voffB[i] = F8 ? (unsigned)(Rb * K + C * 2) : (unsigned)(Rb * K + C) * 2u; }
    const size_t hstepB = F8 ? (size_t)HALF * K : (size_t)HALF * K * 2;
    const unsigned ldsw = (unsigned)wid * 1024u;
    const int aoff = F8 ? lds_byte(wr * 64 + fr, fq * 16) : lds_byte(wr * 64 + fr, fq * 8), boff = F8 ? lds_byte(wc * 32 + fr, fq * 16) : lds_byte(wc * 32 + fr, fq * 8);
    const int aoff1 = F8 ? lds_byte(wr * 64 + fr, fq * 16 + 8) - aoff : 1024, boff1 = F8 ? lds_byte(wc * 32 + fr, fq * 16 + 8) - boff : 1024;
#define GE_KOFF(t) (KMODE == 0 ? (size_t)(t) * 128 : (size_t)((t) >> 1) * (size_t)kbig + (size_t)((t) & 1) * 128)
#define GE_SA(b, h) (((b) * 2 + (h)) * HTB)
#define GE_SB(b, h) ((4 + (b) * 2 + (h)) * HTB)
#define GE_STAGE_B(bufoff, gbase) do { _Pragma("unroll") for (int _i = 0; _i < 2; ++_i) \
        __builtin_amdgcn_global_load_lds((const unsigned*)((const char*)(gbase) + voffB[_i]), (LAS unsigned*)(lds + (bufoff) + ldsw + _i * 8192), 16, 0, 0); } while (0)
#define GE_STAGE_A(bufoff, gbase, v0, v1) do { \
        __builtin_amdgcn_global_load_lds((const unsigned*)((const char*)(gbase) + (v0)), (LAS unsigned*)(lds + (bufoff) + ldsw), 16, 0, 0); \
        __builtin_amdgcn_global_load_lds((const unsigned*)((const char*)(gbase) + (v1)), (LAS unsigned*)(lds + (bufoff) + ldsw + 8192), 16, 0, 0); } while (0)
#define GE_LDA(dst, b, h) do { _Pragma("unroll") for (int m = 0; m < 4; ++m) _Pragma("unroll") for (int k = 0; k < 2; ++k) dst[m][k] = *(const LAS bf16x8*)(lds + GE_SA(b, h) + aoff + m * 2048 + k * aoff1); } while (0)
#define GE_LDB(dst, b, h) do { _Pragma("unroll") for (int n = 0; n < 2; ++n) _Pragma("unroll") for (int k = 0; k < 2; ++k) dst[n][k] = *(const LAS bf16x8*)(lds + GE_SB(b, h) + boff + n * 2048 + k * boff1); } while (0)
#define GE_MMA(ai, bj, At, Bt) do { __builtin_amdgcn_s_setprio(1); _Pragma("unroll") for (int m = 0; m < 4; ++m) _Pragma("unroll") for (int n = 0; n < 2; ++n) { \
        if constexpr (F8) { const i32x8 b8_ = ge::cat8(Bt[n][0], Bt[n][1]), a8_ = ge::cat8(At[m][0], At[m][1]); \
              \
            asm volatile("v_mfma_scale_f32_16x16x128_f8f6f4 %0, %1, %2, %0, %3, %4 op_sel_hi:[0,0,0]" : "+v"(acc[ai][bj][m][n]) : "v"(b8_), "v"(a8_), "v"(f8sb), "v"(f8sa)); } \
        else { _Pragma("unroll") for (int k = 0; k < 2; ++k) acc[ai][bj][m][n] = __builtin_amdgcn_mfma_f32_16x16x32_bf16(Bt[n][k], At[m][k], acc[ai][bj][m][n], 0, 0, 0); } } \
        if constexpr (F8) asm volatile("s_nop 7" ::: "memory"); \
        __builtin_amdgcn_s_setprio(0); } while (0)
#define GE_WAIT_V(n) asm volatile("s_waitcnt vmcnt(" #n ")" ::: "memory")
#define GE_WAIT_L(n) asm volatile("s_waitcnt lgkmcnt(" #n ")" ::: "memory")
#define GE_BAR __builtin_amdgcn_s_barrier()
#define GE_SCHED __builtin_amdgcn_sched_barrier(0)
    Unit cur, nxt; int ui = 0;
    if (!S.next(0, cur)) return;
    int f8sa = F8_SCALE_A, f8sb = F8_SCALE_B; if constexpr (F8) asm volatile("" : "+v"(f8sa), "+v"(f8sb));
    f32x4 acc[2][2][4][2];
#pragma unroll
    for (int a = 0; a < 2; ++a)
#pragma unroll
        for (int b = 0; b < 2; ++b)
#pragma unroll
            for (int m = 0; m < 4; ++m)
#pragma unroll
                for (int n = 0; n < 2; ++n) acc[a][b][m][n] = (f32x4){0.f, 0.f, 0.f, 0.f};
    bf16x8 At[4][2], B0[2][2], B1[2][2];
    unsigned va[2][2], vn[2][2];
    S.voffA(cur, tid, va);
    const char* cA = cur.A; const char* cB = cur.B;
    if constexpr (SP2) {
        GE_STAGE_B(GE_SB(0, 0), cB); GE_STAGE_B(GE_SB(0, 1), cB + hstepB); GE_STAGE_A(GE_SA(0, 0), cA, va[0][0], va[0][1]); GE_STAGE_A(GE_SA(0, 1), cA, va[1][0], va[1][1]);
        if (wr == 1) GE_BAR;
        GE_WAIT_V(2); GE_BAR;
        GE_STAGE_B(GE_SB(1, 0), cB + 128); GE_STAGE_A(GE_SA(1, 0), cA + GE_KOFF(1), va[0][0], va[0][1]); GE_STAGE_B(GE_SB(1, 1), cB + hstepB + 128);
        GE_WAIT_V(6); GE_BAR;
    } else {
    GE_STAGE_B(GE_SB(0, 0), cB); GE_STAGE_A(GE_SA(0, 0), cA, va[0][0], va[0][1]); GE_STAGE_B(GE_SB(0, 1), cB + hstepB); GE_STAGE_A(GE_SA(0, 1), cA, va[1][0], va[1][1]);
    if (wr == 1) GE_BAR;
    GE_WAIT_V(4); GE_BAR;
    GE_STAGE_B(GE_SB(1, 0), cB + 128); GE_STAGE_A(GE_SA(1, 0), cA + GE_KOFF(1), va[0][0], va[0][1]); GE_STAGE_B(GE_SB(1, 1), cB + hstepB + 128);
    GE_WAIT_V(6); GE_BAR;
    }
    for (;;) {
        const bool has_next = S.next(ui + 1, nxt);
        if constexpr (Sched::GATHER) { if (has_next) S.voffA(nxt, tid, vn); else { vn[0][0] = va[0][0]; vn[0][1] = va[0][1]; vn[1][0] = va[1][0]; vn[1][1] = va[1][1]; } }
        const char* nA = has_next ? nxt.A : cA; const char* nB = has_next ? nxt.B : cB;
        for (int t = 0; t < nt; t += 2) {
            const bool last = (t == nt - 2);
            const char* a1 = cA + GE_KOFF(t + 1);
            const char* a2 = last ? nA : cA + GE_KOFF(t + 2); const char* b2 = last ? nB : cB + (size_t)(t + 2) * 128;
            const char* a3 = last ? nA + GE_KOFF(1) : cA + GE_KOFF(t + 3); const char* b3 = b2 + 128;
            unsigned w00 = va[0][0], w01 = va[0][1], w10 = va[1][0], w11 = va[1][1];
            if constexpr (Sched::GATHER) { if (last) { w00 = vn[0][0]; w01 = vn[0][1]; w10 = vn[1][0]; w11 = vn[1][1]; } }
            if constexpr (SP2) {
            GE_LDB(B0, 0, 0); GE_LDB(B1, 0, 1); GE_SCHED; GE_LDA(At, 0, 0); GE_STAGE_A(GE_SA(1, 1), a1, va[1][0], va[1][1]);
            GE_WAIT_V(8); GE_WAIT_L(0); GE_BAR; GE_MMA(0, 0, At, B0); GE_MMA(0, 1, At, B1); GE_BAR; GE_SCHED;
            GE_LDA(At, 0, 1); GE_STAGE_B(GE_SB(0, 0), b2); GE_STAGE_B(GE_SB(0, 1), b2 + hstepB); GE_STAGE_A(GE_SA(0, 0), a2, w00, w01);
            GE_WAIT_V(8); GE_WAIT_L(0); GE_BAR; GE_MMA(1, 0, At, B0); GE_MMA(1, 1, At, B1); GE_BAR; GE_SCHED;
            GE_LDB(B0, 1, 0); GE_LDB(B1, 1, 1); GE_SCHED; GE_LDA(At, 1, 0); GE_STAGE_A(GE_SA(0, 1), a2, w10, w11);
            GE_WAIT_V(8); GE_WAIT_L(0); GE_BAR; GE_MMA(0, 0, At, B0); GE_MMA(0, 1, At, B1); GE_BAR; GE_SCHED;
            GE_LDA(At, 1, 1); GE_STAGE_B(GE_SB(1, 0), b3); GE_STAGE_B(GE_SB(1, 1), b3 + hstepB); GE_STAGE_A(GE_SA(1, 0), a3, w00, w01);
            GE_WAIT_V(8); GE_WAIT_L(0); GE_BAR; GE_MMA(1, 0, At, B0); GE_MMA(1, 1, At, B1); GE_BAR; GE_SCHED;
            } else {
            GE_LDB(B0, 0, 0); GE_SCHED; GE_LDA(At, 0, 0); GE_STAGE_A(GE_SA(1, 1), a1, va[1][0], va[1][1]);
            GE_WAIT_L(8); GE_BAR; GE_WAIT_L(0); GE_MMA(0, 0, At, B0); GE_BAR; GE_SCHED;
            GE_LDB(B1, 0, 1); GE_STAGE_B(GE_SB(0, 0), b2);
            GE_BAR; GE_WAIT_L(0); GE_MMA(0, 1, At, B1); GE_BAR;
            GE_LDA(At, 0, 1); GE_STAGE_A(GE_SA(0, 0), a2, w00, w01);
            GE_BAR; GE_WAIT_L(0); GE_MMA(1, 0, At, B0); GE_BAR; GE_SCHED;
            GE_STAGE_B(GE_SB(0, 1), b2 + hstepB);
            GE_WAIT_V(6); GE_BAR; GE_MMA(1, 1, At, B1); GE_BAR;
            GE_LDB(B0, 1, 0); GE_SCHED; GE_LDA(At, 1, 0); GE_STAGE_A(GE_SA(0, 1), a2, w10, w11);
            GE_WAIT_L(8); GE_BAR; GE_WAIT_L(0); GE_MMA(0, 0, At, B0); GE_BAR; GE_SCHED;
            GE_LDB(B1, 1, 1); GE_STAGE_B(GE_SB(1, 0), b3);
            GE_BAR; GE_WAIT_L(0); GE_MMA(0, 1, At, B1); GE_BAR;
            GE_LDA(At, 1, 1); GE_STAGE_A(GE_SA(1, 0), a3, w00, w01);
            GE_BAR; GE_WAIT_L(0); GE_MMA(1, 0, At, B0); GE_BAR; GE_SCHED;
            GE_STAGE_B(GE_SB(1, 1), b3 + hstepB);
            GE_WAIT_V(6); GE_BAR; GE_MMA(1, 1, At, B1); GE_BAR;
            }
        }
        if constexpr (ALIGN_EPI) { if (wr == 0) GE_BAR; }
        E(acc, cur, wr, wc, fr, fq);
        if (!has_next) break;
#pragma unroll
        for (int a = 0; a < 2; ++a)
#pragma unroll
            for (int b = 0; b < 2; ++b)
#pragma unroll
                for (int m = 0; m < 4; ++m)
#pragma unroll
                    for (int n = 0; n < 2; ++n) acc[a][b][m][n] = (f32x4){0.f, 0.f, 0.f, 0.f};
        cur = nxt; cA = nA; cB = nB; ++ui;
        if constexpr (Sched::GATHER) { va[0][0] = vn[0][0]; va[0][1] = vn[0][1]; va[1][0] = vn[1][0]; va[1][1] = vn[1][1]; }
        if constexpr (ALIGN_EPI) { if (wr == 1) GE_BAR; }
    }
    GE_WAIT_V(0);
    if constexpr (!ALIGN_EPI) { if (wr == 0) GE_BAR; }
    GE_BAR;
#undef GE_KOFF
#undef GE_SA
#undef GE_SB
#undef GE_STAGE_A
#undef GE_STAGE_B
#undef GE_LDA
#undef GE_LDB
#undef GE_MMA
#undef GE_WAIT_V
#undef GE_WAIT_L
#undef GE_BAR
#undef GE_SCHED
}

template <bool F8 = false>
__device__ __forceinline__ void dense_voffA(int lda, int tid, unsigned (&v)[2][2]) {
#pragma unroll
    for (int i = 0; i < 2; ++i) { int R, C; stage_rc(tid * 16 + i * 8192, R, C); v[0][i] = F8 ? (unsigned)(R * lda + C * 2) : (unsigned)(R * lda + C) * 2u; v[1][i] = F8 ? (unsigned)((R + HALF) * lda + C * 2) : (unsigned)((R + HALF) * lda + C) * 2u; }
}
}
#define XB_TMO      128
#define XB_XCNT(j)  (256  + 64 * (j))
#define XB_XSUB(j)  (1280 + 64 * (j))
#define XB_XGEN(j)  (2304 + 64 * (j))
#define XB_TOP      3328
#define XB_TOPGEN   3392
#define XCD_BAR_WORDS 3456
#define XB_SPIN_CAP (1u << 18)

__device__ __forceinline__ unsigned xb_ld(unsigned* p)              { return __hip_atomic_load(p, __ATOMIC_RELAXED, __HIP_MEMORY_SCOPE_AGENT); }
__device__ __forceinline__ unsigned xb_add(unsigned* p, unsigned v) { return __hip_atomic_fetch_add(p, v, __ATOMIC_RELAXED, __HIP_MEMORY_SCOPE_AGENT); }
__device__ __forceinline__ unsigned xb_xcc_id() { return (unsigned)__builtin_amdgcn_s_getreg((3 << 11) | 20) & 0xFu; }
#define XB_SPIN(cond, bar) do { unsigned _sp = 0; while (cond) { __builtin_amdgcn_s_sleep(1); \
    if ((++_sp & 255u) == 0u) { if (xb_ld(&(bar)[XB_TMO])) break; if (_sp > XB_SPIN_CAP) { atomicAdd(&(bar)[XB_TMO], 1u); break; } } } } while (0)

struct XcdBarrier {
    unsigned* bar; unsigned x;
    volatile LAS unsigned* st;
};

__device__ __forceinline__ XcdBarrier xcd_barrier_post(unsigned* bar, volatile LAS unsigned* st) {
    XcdBarrier b; b.bar = bar; b.x = xb_xcc_id(); b.st = st;
    if (threadIdx.x == 0) (void)xb_add(&bar[XB_XCNT(b.x)], 1u);
    return b;
}
__device__ __forceinline__ void xcd_barrier_complete(unsigned* bar, unsigned x, unsigned& nloc, unsigned& nx) {
    const unsigned G = gridDim.x * gridDim.y * gridDim.z;
    unsigned sum, cnt, mine, sp = 0u;
    for (;;) {
        sum = 0u; cnt = 0u; mine = 0u;
#pragma unroll
        for (unsigned j = 0; j < 16; ++j) { const unsigned c = xb_ld(&bar[XB_XCNT(j)]); sum += c; cnt += (c > 0u) ? 1u : 0u; mine = (j == x) ? c : mine; }
        if (sum == G) break;
        __builtin_amdgcn_s_sleep(1);
        if ((++sp & 255u) == 0u) { if (xb_ld(&bar[XB_TMO])) break; if (sp > XB_SPIN_CAP) { atomicAdd(&bar[XB_TMO], 1u); break; } }
    }
    nloc = mine > 0u ? mine : 1u; nx = cnt > 0u ? cnt : 1u;
}

__device__ __forceinline__ void xcd_barrier(const XcdBarrier& b) {
    asm volatile("s_waitcnt vmcnt(0)" ::: "memory");
    __syncthreads();
    if (threadIdx.x == 0) {
        unsigned* bar = b.bar;
        __builtin_amdgcn_s_waitcnt(0);
        unsigned nloc = b.st[0], nx = b.st[1];
        if (nloc == 0u) { xcd_barrier_complete(bar, b.x, nloc, nx); b.st[0] = nloc; b.st[1] = nx; }
        const unsigned old = xb_add(&bar[XB_XSUB(b.x)], 1u);
        const unsigned gen = old / nloc;
        if (old + 1u == (gen + 1u) * nloc) {
            __builtin_amdgcn_fence(__ATOMIC_RELEASE, "agent");
            asm volatile("s_waitcnt vmcnt(0)" ::: "memory");
            const unsigned og = xb_add(&bar[XB_TOP], 1u);
            const unsigned tg = og / nx;
            if (og + 1u == (tg + 1u) * nx) xb_add(&bar[XB_TOPGEN], 1u);
            else XB_SPIN(xb_ld(&bar[XB_TOPGEN]) == tg, bar);
            __builtin_amdgcn_fence(__ATOMIC_ACQUIRE, "agent");
            xb_add(&bar[XB_XGEN(b.x)], 1u);
            asm volatile("s_waitcnt vmcnt(0)" ::: "memory");
        } else {
            XB_SPIN(xb_ld(&bar[XB_XGEN(b.x)]) == gen, bar);
            __builtin_amdgcn_fence(__ATOMIC_ACQUIRE, "agent");
            asm volatile("s_waitcnt vmcnt(0)" ::: "memory");
        }
    }
    __syncthreads();
}

constexpr int LDP = 15104;
constexpr int P_MQ=0,P_MK=1024,P_MV=2048,P_NQ=3072,P_NKV=4096,P_GQ=5632,P_GK=6144,P_GV=6656,P_GG=7680,P_MG=8704,P_NG=14848,P_GA=14872;
constexpr int NTHR = 512;
#ifndef INPROJ_F8
#define INPROJ_F8 2
#endif
constexpr int LDS_BYTES = 147456;
constexpr int MOE_ROWS = 40960;
constexpr int MOE_TILES = MOE_ROWS / 256;

constexpr size_t al256(size_t x) { return (x + 255) & ~(size_t)255; }
constexpr size_t WS_CTL   = 0;
constexpr size_t CTL_BYTES = 65536;
constexpr size_t WS_WIN   = WS_CTL + CTL_BYTES;
constexpr size_t WS_WBR   = WS_WIN + al256((size_t)NL * LDP * 2048 * 2);
constexpr size_t WS_WOUT  = WS_WBR + al256((size_t)NL * 3 * 2048 * 1024 * 2);
constexpr size_t WS_WC1   = WS_WOUT + al256((size_t)NL * 2048 * 2048 * 2);
constexpr size_t WS_WC2   = WS_WC1 + al256((size_t)NL * 2 * 256 * 4096 * 2);
constexpr size_t WS_BIAS1 = WS_WC2 + al256((size_t)NL * 2 * 256 * 256 * 2);
constexpr size_t WS_WGU   = WS_BIAS1 + al256((size_t)NL * 2 * 256 * 4);
constexpr size_t WS_WD    = WS_WGU + al256((size_t)32 * 1024 * 2048 * 2);
constexpr size_t WS_H     = WS_WD + al256((size_t)32 * 2048 * 512 * 2);
constexpr size_t WS_PROJ  = WS_H + al256((size_t)T * 2048 * 2);
constexpr size_t WS_OM    = WS_PROJ + al256((size_t)T * LDP * 2);
constexpr size_t WS_ON    = WS_OM + al256((size_t)T * 1024 * 2);
constexpr size_t WS_OG    = WS_ON + al256((size_t)T * 1024 * 2);
constexpr size_t WS_MERGED= WS_OG + al256((size_t)T * 1024 * 2);
constexpr size_t WS_MISC  = WS_MERGED + al256((size_t)T * 2048 * 2);
constexpr size_t WS_KMEAN = WS_MISC;
constexpr size_t WS_KVC   = WS_KMEAN + al256((size_t)NB * 8 * 8 * 128 * 4);
constexpr size_t WS_DEC   = WS_KVC + al256((size_t)NB * 127 * 4 * 128 * 4);
constexpr size_t WS_OGRAW = WS_H;
constexpr size_t WS_ROUTE = WS_DEC + al256((size_t)T * 512 * 4);
constexpr size_t WS_ROWTOK= WS_ROUTE + al256((size_t)T * 8 * 4);
constexpr size_t WS_ROWW  = WS_ROWTOK + al256((size_t)MOE_ROWS * 4);
constexpr size_t WS_TILEE = WS_ROWW + al256((size_t)MOE_ROWS * 4);
constexpr size_t WS_END_SMALL = WS_TILEE + al256((size_t)(MOE_TILES + 64) * 4);
constexpr size_t WS_HID   = WS_PROJ;
constexpr size_t WS_YBUF  = WS_HID + al256((size_t)MOE_ROWS * 512 * 2);
static_assert(WS_YBUF + (size_t)MOE_ROWS * 2048 * 2 <= WS_OM, "MoE buffers must fit in the PROJ region");
constexpr size_t WS_TOTAL = WS_END_SMALL;

constexpr int CW_BAR = 0;
constexpr int CW_CNT = 4096;
constexpr int CW_CUR = 4096 + 64;
constexpr int CW_MISC = 4096 + 128;

constexpr size_t WS_H8 = (size_t)1152 * 1024 * 1024;
constexpr size_t WS_NEED = WS_H8 + (size_t)T * 2048;
#ifndef MIX_SET
#define MIX_SET 0
#endif
#if MIX_SET == 0
constexpr int NT16 = 24, NT8 = 35;
__host__ __device__ __forceinline__ int tile16(int p) { return p < 8 ? p : p < 12 ? p + 4 : p == 12 ? 16 : p == 13 ? 18 : p == 14 ? 20 : p < 19 ? p + 7 : p < 23 ? p + 11 : 58; }
__host__ __device__ __forceinline__ int tile8(int p) { return p < 4 ? p + 8 : p == 4 ? 17 : p == 5 ? 19 : p == 6 ? 21 : p < 11 ? p + 19 : p + 23; }
#else
constexpr int NT16 = 35, NT8 = 24;
__host__ __device__ __forceinline__ int tile16(int p) { return p < 34 ? p : 58; }
__host__ __device__ __forceinline__ int tile8(int p) { return p + 34; }
#endif
struct Args { const float* in[22]; float* out; unsigned char* ws; int ph_lo, ph_hi; };
constexpr int LDS_ARGS = 131072;
constexpr int LDS_XB = LDS_ARGS + 256;
constexpr int LDS_MISC = LDS_ARGS + 512;

struct Frame {
    LAS unsigned char* lds; int tid, lane, wave, G, c;
    unsigned char* ws;
    __device__ __forceinline__ const float* in(int k) const { const unsigned long long v = *(const volatile LAS unsigned long long*)(lds + LDS_ARGS + k * 8); return (const float*)(const __attribute__((address_space(1))) float*)(((unsigned long long)__builtin_amdgcn_readfirstlane((unsigned)(v >> 32)) << 32) | (unsigned)__builtin_amdgcn_readfirstlane((unsigned)v)); }
    __device__ __forceinline__ float* out() const { return (float*)in(22); }
};
template <class P> __device__ __forceinline__ P* opaque_ptr(P* p) {
    const unsigned long long v = (unsigned long long)p; unsigned lo = __builtin_amdgcn_readfirstlane((unsigned)v), hi = __builtin_amdgcn_readfirstlane((unsigned)(v >> 32));
    asm volatile("" : "+s"(lo), "+s"(hi)); return (P*)(__attribute__((address_space(1))) P*)(((unsigned long long)hi << 32) | lo);
}
__device__ __forceinline__ Frame phase_frame(const Frame& F0) {
    __syncthreads();
    Frame F = F0; F.ws = opaque_ptr(F0.ws);
    int t; asm volatile("v_mbcnt_lo_u32_b32 %0, -1, 0\n\tv_mbcnt_hi_u32_b32 %0, -1, %0" : "=v"(t)); t += F0.wave * 64; asm volatile("" : "+v"(t));
    F.tid = t; F.lane = t & 63; F.wave = __builtin_amdgcn_readfirstlane(t >> 6); return F;
}

__device__ __forceinline__ unsigned pack_fp8x4(float a, float b, float c, float d) { int w = __builtin_amdgcn_cvt_pk_fp8_f32(a, b, 0, false); w = __builtin_amdgcn_cvt_pk_fp8_f32(c, d, w, true); return (unsigned)w; }
template <bool F8, class Fn>
__device__ __forceinline__ void conv_t(const Frame& F, Fn colsrc, int ld, int K, int N, void* dstv, float scale = 1.f) {
    LAS float* tile = (LAS float*)F.lds;
    const int ntn = N / 256, ntk = K / 64, tot = ntn * ntk;
    for (int ti = F.c; ti < tot; ti += F.G) {
        const int tn = ti % ntn, tk = ti / ntn; const int n0 = tn * 256, k0 = tk * 64;
        const int n4 = (F.tid & 63) * 4, kq = F.tid >> 6;
        const float* sp = colsrc(n0 + n4);
        f32x4 v[8];
#pragma unroll
        for (int p = 0; p < 8; ++p) v[p] = sp ? *(const f32x4*)(sp + (size_t)(k0 + p * 8 + kq) * ld) : (f32x4){0.f, 0.f, 0.f, 0.f};
#pragma unroll
        for (int p = 0; p < 8; ++p) *(LAS f32x4*)(tile + (p * 8 + kq) * 260 + n4) = v[p];
        __syncthreads();
#pragma unroll
        for (int q = 0; q < 4; ++q) { const int idx = q * NTHR + F.tid; const int n = idx >> 3, k8 = (idx & 7) * 8;
            float t[8];
#pragma unroll
            for (int jj = 0; jj < 8; ++jj) t[jj] = tile[(k8 + jj) * 260 + n] * scale;
            if (F8) { u32x2 w = {pack_fp8x4(t[0], t[1], t[2], t[3]), pack_fp8x4(t[4], t[5], t[6], t[7])}; *(u32x2*)((unsigned char*)dstv + (size_t)(n0 + n) * K + k0 + k8) = w; }
            else { u32x4 w = {cvt_pk_bf16(t[0], t[1]), cvt_pk_bf16(t[2], t[3]), cvt_pk_bf16(t[4], t[5]), cvt_pk_bf16(t[6], t[7])}; *(u32x4*)((bf16_t*)dstv + (size_t)(n0 + n) * K + k0 + k8) = w; } }
        __syncthreads();
    }
}

__device__ __forceinline__ void p_conv_static(const Frame& F0) {
    const Frame F = phase_frame(F0);
    for (int l = 0; l < NL; ++l) {
        { const float* w = F.in(2) + (size_t)l * D * INW;
          auto srcpad = [=](int n) -> const float* { int s; if (n < 5632) s = n; else if (n < 7680) s = n + 24; else if (n < 14848) s = n + 40; else if (n < 14872) s = O_NG + (n - 14848); else if (n < 14888) s = O_GA + (n - 14872); else return nullptr; return w + s; };
#if INPROJ_F8 == 2
          conv_t<false>(F, [=](int n) -> const float* { return srcpad(tile16(n >> 8) * 256 + (n & 255)); }, INW, 2048, NT16 * 256, (bf16_t*)(F.ws + WS_WIN) + (size_t)l * NT16 * 256 * 2048);
          conv_t<true>(F, [=](int n) -> const float* { return srcpad(tile8(n >> 8) * 256 + (n & 255)); }, INW, 2048, NT8 * 256, F.ws + WS_WIN + (size_t)NL * NT16 * 256 * 2048 * 2 + (size_t)l * NT8 * 256 * 2048, 512.f);
#elif INPROJ_F8 == 1
          conv_t<true>(F, srcpad, INW, 2048, LDP, F.ws + WS_WIN + (size_t)l * LDP * 2048, 512.f);
#else
          conv_t<false>(F, srcpad, INW, 2048, LDP, (bf16_t*)(F.ws + WS_WIN) + (size_t)l * LDP * 2048);
#endif
        }
#define CONV_BR(b, idx) { const float* w = F.in(idx) + (size_t)l * 1024 * D; bf16_t* dst = (bf16_t*)(F.ws + WS_WBR) + ((size_t)l * 3 + b) * 2048 * 1024; \
          conv_t<false>(F, [=](int n) -> const float* { return w + n; }, D, 1024, 2048, dst); }
        CONV_BR(0, 9) CONV_BR(1, 10) CONV_BR(2, 11)
#undef CONV_BR
        { const float* w = F.in(12) + (size_t)l * D * D; bf16_t* dst = (bf16_t*)(F.ws + WS_WOUT) + (size_t)l * 2048 * 2048;
          conv_t<false>(F, [=](int n) -> const float* { return w + n; }, D, 2048, 2048, dst); }
        for (int c = 0; c < 2; ++c) { const float* w = F.in(4) + ((size_t)l * 2 + c) * 4096 * 128; bf16_t* dst = (bf16_t*)(F.ws + WS_WC1) + ((size_t)l * 2 + c) * 256 * 4096;
          conv_t<false>(F, [=](int n) -> const float* { return n < 128 ? w + n : nullptr; }, 128, 4096, 256, dst); }
    }
}
__device__ __forceinline__ void p_conv_experts(const Frame& F0, int l) {
    const Frame F = phase_frame(F0);
    const float* wg = F.in(18) + (size_t)l * 32 * D * 512; const float* wu = F.in(19) + (size_t)l * 32 * D * 512; const float* wd = F.in(20) + (size_t)l * 32 * 512 * D;
    conv_t<false>(F, [=](int n) -> const float* { const int e = n >> 10, r = n & 1023, j = r >> 8, wi = r & 255; const unsigned long long dlt = (unsigned long long)wu - (unsigned long long)wg; const float* base = (const float*)((unsigned long long)wg + (dlt & (0ull - (unsigned long long)(wi >> 7)))) + (size_t)e * D * 512; return base + j * 128 + (wi & 127); }, 512, 2048, 32 * 1024, (bf16_t*)(F.ws + WS_WGU));
    conv_t<false>(F, [=](int n) -> const float* { return wd + (size_t)(n >> 11) * 512 * D + (n & 2047); }, D, 512, 32 * 2048, (bf16_t*)(F.ws + WS_WD));
}

__device__ __forceinline__ void store_h4(unsigned char* ws, size_t idx, float a, float b, float c, float d) {
#if INPROJ_F8 >= 1
    *(unsigned*)(ws + (INPROJ_F8 == 2 ? WS_H8 : WS_H) + idx) = pack_fp8x4(a * 16.f, b * 16.f, c * 16.f, d * 16.f);
#endif
#if INPROJ_F8 != 1
    u32x2 w; w[0] = cvt_pk_bf16(a, b); w[1] = cvt_pk_bf16(c, d); *(u32x2*)((bf16_t*)(ws + WS_H) + idx) = w;
#endif
}
__device__ __forceinline__ void p_rmsnorm(const Frame& F0, int l) {
    const Frame F = phase_frame(F0);
    const float* x = (l == 0) ? F.in(0) : F.out(); const float* g = F.in(1) + l * D; unsigned char* h = F.ws;
    for (int row = F.c * 8 + F.wave; row < T; row += F.G * 8) {
        const float* xr = x + (size_t)row * D; f32x4 v[8]; float ss = 0.f;
#pragma unroll
        for (int i = 0; i < 8; ++i) { v[i] = *(const f32x4*)(xr + i * 256 + F.lane * 4); ss += v[i][0] * v[i][0] + v[i][1] * v[i][1] + v[i][2] * v[i][2] + v[i][3] * v[i][3]; }
#pragma unroll
        for (int o = 32; o > 0; o >>= 1) ss += __shfl_xor(ss, o);
        const float rstd = rsqrtf(ss * (1.f / D) + 1e-6f);
#pragma unroll
        for (int i = 0; i < 8; ++i) { const f32x4 gv = *(const f32x4*)(g + i * 256 + F.lane * 4);
            store_h4(h, (size_t)row * D + i * 256 + F.lane * 4, v[i][0] * rstd * gv[0], v[i][1] * rstd * gv[1], v[i][2] * rstd * gv[2], v[i][3] * rstd * gv[3]); }
    }
}

template <bool F8 = false>
struct SchedDenseT {
    static constexpr bool GATHER = false;
    const char* A; const char* B; int lda, K, nM, nN, G, c;
    __device__ __forceinline__ bool next(int i, ge::Unit& u) const { int pm, pn; if (!ge::static_tile(i, G, c, nM, nN, pm, pn)) return false;
        u.A = A + (size_t)pm * 256 * lda * (F8 ? 1 : 2); u.B = B + (size_t)pn * 256 * K * (F8 ? 1 : 2); u.r0 = pm * 256; u.c0 = pn * 256; u.aux = 0; u.aux2 = 0; return true; }
    __device__ __forceinline__ void voffA(const ge::Unit&, int tid, unsigned (&v)[2][2]) const { ge::dense_voffA<F8>(lda, tid, v); }
};
typedef SchedDenseT<false> SchedDense;
struct EpiStoreBf16 {
    static constexpr bool PERM = true; bf16_t* O; int ldc;
    __device__ __forceinline__ void operator()(const f32x4 (&acc)[2][2][4][2], const ge::Unit& u, int wr, int wc, int fr, int fq) const {
#pragma unroll
        for (int ai = 0; ai < 2; ++ai)
#pragma unroll
            for (int m = 0; m < 4; ++m) { bf16_t* rowp = O + (size_t)(u.r0 + ai * 128 + wr * 64 + m * 16 + fr) * ldc + u.c0 + wc * 32 + 8 * fq;
#pragma unroll
                for (int bj = 0; bj < 2; ++bj) { const f32x4 v0 = acc[ai][bj][m][0], v1 = acc[ai][bj][m][1]; u32x4 w = {cvt_pk_bf16(v0[0], v0[1]), cvt_pk_bf16(v0[2], v0[3]), cvt_pk_bf16(v1[0], v1[1]), cvt_pk_bf16(v1[2], v1[3])};
                    *(u32x4*)(rowp + bj * 128) = w; } }
    }
};
struct EpiNull {
    static constexpr bool PERM = true;
    __device__ __forceinline__ void operator()(const f32x4 (&acc)[2][2][4][2], const ge::Unit&, int, int, int, int) const {
#pragma unroll
        for (int ai = 0; ai < 2; ++ai)
#pragma unroll
            for (int bj = 0; bj < 2; ++bj)
#pragma unroll
                for (int m = 0; m < 4; ++m) asm volatile("" :: "v"(acc[ai][bj][m][0]), "v"(acc[ai][bj][m][1]));
    }
};
struct SchedSame {
    static constexpr bool GATHER = false; const char* A; const char* B; int n;
    __device__ __forceinline__ bool next(int i, ge::Unit& u) const { if (i >= n) return false; u.A = A; u.B = B; u.r0 = 0; u.c0 = 0; u.aux = 0; u.aux2 = 0; return true; }
    __device__ __forceinline__ void voffA(const ge::Unit&, int tid, unsigned (&v)[2][2]) const { ge::dense_voffA<false>(2048, tid, v); }
};
__device__ __forceinline__ void p_inproj_same(const Frame& F0, int l) {
    const Frame F = phase_frame(F0);
    EpiNull E{};
    SchedSame S{(const char*)(F.ws + WS_H), (const char*)(F.ws + WS_WIN) + (size_t)l * LDP * 2048 * 2, 15};
    ge::gemm_phase<EpiNull, SchedSame, 0>(F.lds, F.tid, 2048, 0, S, E);
}
__device__ __forceinline__ void p_inproj_longk(const Frame& F0, int l) {
    const Frame F = phase_frame(F0);
    EpiNull E{};
    SchedSame S{(const char*)(F.ws + WS_H), (const char*)(F.ws + WS_WIN) + (size_t)l * LDP * 2048 * 2, 1};
    ge::gemm_phase<EpiNull, SchedSame, 0>(F.lds, F.tid, 2048 * 15, 0, S, E);
}
__device__ __forceinline__ void p_inproj_null(const Frame& F0, int l) {
    const Frame F = phase_frame(F0);
    EpiNull E{};
    SchedDense S{(const char*)(F.ws + WS_H), (const char*)(F.ws + WS_WIN) + (size_t)l * LDP * 2048 * 2, 2048, 2048, T / 256, LDP / 256, F.G, F.c};
    ge::gemm_phase<EpiNull, SchedDense, 0>(F.lds, F.tid, 2048, 0, S, E);
}
#ifndef INPROJ_F8
#define INPROJ_F8 1
#endif
template <bool F8>
struct SchedInprojMix {
    static constexpr bool GATHER = false;
    const char* A; const char* B; int G, c;
    __device__ __forceinline__ bool next(int i, ge::Unit& u) const { int pm, pn; if (!ge::static_tile(i, G, c, T / 256, F8 ? NT8 : NT16, pm, pn)) return false;
        u.A = A + (size_t)pm * 256 * 2048 * (F8 ? 1 : 2); u.B = B + (size_t)pn * 256 * 2048 * (F8 ? 1 : 2); u.r0 = pm * 256; u.c0 = (F8 ? tile8(pn) : tile16(pn)) * 256; u.aux = 0; u.aux2 = 0; return true; }
    __device__ __forceinline__ void voffA(const ge::Unit&, int tid, unsigned (&v)[2][2]) const { ge::dense_voffA<F8>(2048, tid, v); }
};
__device__ __forceinline__ void p_inproj(const Frame& F0, int l) {
    const Frame F = phase_frame(F0);
    EpiStoreBf16 E{(bf16_t*)(F.ws + WS_PROJ), LDP};
#if INPROJ_F8 == 2
    { SchedInprojMix<false> S{(const char*)(F.ws + WS_H), (const char*)(F.ws + WS_WIN) + (size_t)l * NT16 * 256 * 2048 * 2, F.G, F.c};
      ge::gemm_phase<EpiStoreBf16, SchedInprojMix<false>, 0, false>(F.lds, F.tid, 2048, 0, S, E); }
    { const Frame F2 = phase_frame(F0);
      SchedInprojMix<true> S{(const char*)(F2.ws + WS_H8), (const char*)(F2.ws + WS_WIN) + (size_t)NL * NT16 * 256 * 2048 * 2 + (size_t)l * NT8 * 256 * 2048, F2.G, F2.c};
      EpiStoreBf16 E2{(bf16_t*)(F2.ws + WS_PROJ), LDP};
      ge::gemm_phase<EpiStoreBf16, SchedInprojMix<true>, 0, true>(F2.lds, F2.tid, 2048, 0, S, E2); }
#elif INPROJ_F8 == 1
    SchedDenseT<true> S{(const char*)(F.ws + WS_H), (const char*)(F.ws + WS_WIN) + (size_t)l * LDP * 2048, 2048, 2048, T / 256, LDP / 256, F.G, F.c};
    ge::gemm_phase<EpiStoreBf16, SchedDenseT<true>, 0, true>(F.lds, F.tid, 2048, 0, S, E);
#else
    SchedDense S{(const char*)(F.ws + WS_H), (const char*)(F.ws + WS_WIN) + (size_t)l * LDP * 2048 * 2, 2048, 2048, T / 256, LDP / 256, F.G, F.c};
    ge::gemm_phase<EpiStoreBf16, SchedDense, 0>(F.lds, F.tid, 2048, 0, S, E);
#endif
}

struct SchedMerge {
    static constexpr bool GATHER = false;
    const char* O3; const char* W; int G, c;
    __device__ __forceinline__ bool next(int i, ge::Unit& u) const { const int ti = i / 3, b = i - ti * 3; int pm, pn; if (!ge::static_tile(ti, G, c, T / 256, 8, pm, pn)) return false;
        u.A = O3 + (size_t)b * T * 1024 * 2 + (size_t)pm * 256 * 1024 * 2; u.B = W + (size_t)b * 2048 * 1024 * 2 + (size_t)pn * 256 * 1024 * 2; u.r0 = pm * 256; u.c0 = pn * 256; u.aux = b; u.aux2 = 0; return true; }
    __device__ __forceinline__ void voffA(const ge::Unit&, int tid, unsigned (&v)[2][2]) const { ge::dense_voffA(1024, tid, v); }
};
struct EpiMerge {
    static constexpr bool PERM = true; const bf16_t* proj; bf16_t* merged;
    __device__ __forceinline__ void operator()(const f32x4 (&acc)[2][2][4][2], const ge::Unit& u, int wr, int wc, int fr, int fq) const {
        const int col = u.c0 + wc * 32 + 8 * fq;
#pragma unroll
        for (int ai = 0; ai < 2; ++ai) {
            u32x4 gw[4][2], pw[4][2];
#pragma unroll
            for (int m = 0; m < 4; ++m) { const size_t row = (size_t)(u.r0 + ai * 128 + wr * 64 + m * 16 + fr);
#pragma unroll
                for (int bj = 0; bj < 2; ++bj) { gw[m][bj] = *(const u32x4*)(proj + row * LDP + P_MG + u.aux * 2048 + col + bj * 128);
                    if (u.aux > 0) pw[m][bj] = *(const u32x4*)(merged + row * 2048 + col + bj * 128); else pw[m][bj] = (u32x4){0u, 0u, 0u, 0u}; } }
#pragma unroll
            for (int m = 0; m < 4; ++m) { const size_t row = (size_t)(u.r0 + ai * 128 + wr * 64 + m * 16 + fr);
#pragma unroll
                for (int bj = 0; bj < 2; ++bj) { const u32x4 g = gw[m][bj], q = pw[m][bj]; const f32x4 v0 = acc[ai][bj][m][0], v1 = acc[ai][bj][m][1];
                    const float o0 = v0[0] * fast_sigmoid(bf_lo(g[0])) + bf_lo(q[0]), o1 = v0[1] * fast_sigmoid(bf_hi(g[0])) + bf_hi(q[0]), o2 = v0[2] * fast_sigmoid(bf_lo(g[1])) + bf_lo(q[1]), o3 = v0[3] * fast_sigmoid(bf_hi(g[1])) + bf_hi(q[1]);
                    const float o4 = v1[0] * fast_sigmoid(bf_lo(g[2])) + bf_lo(q[2]), o5 = v1[1] * fast_sigmoid(bf_hi(g[2])) + bf_hi(q[2]), o6 = v1[2] * fast_sigmoid(bf_lo(g[3])) + bf_lo(q[3]), o7 = v1[3] * fast_sigmoid(bf_hi(g[3])) + bf_hi(q[3]);
                    u32x4 w = {cvt_pk_bf16(o0, o1), cvt_pk_bf16(o2, o3), cvt_pk_bf16(o4, o5), cvt_pk_bf16(o6, o7)};
                    *(u32x4*)(merged + row * 2048 + col + bj * 128) = w; } }
        }
    }
};
__device__ __forceinline__ void p_merge(const Frame& F0, int l) {
    const Frame F = phase_frame(F0);
    SchedMerge S{(const char*)(F.ws + WS_OM), (const char*)(F.ws + WS_WBR) + (size_t)l * 3 * 2048 * 1024 * 2, F.G, F.c};
    EpiMerge E{(const bf16_t*)(F.ws + WS_PROJ), (bf16_t*)(F.ws + WS_MERGED)};
    ge::gemm_phase<EpiMerge, SchedMerge, 0>(F.lds, F.tid, 1024, 0, S, E);
}

struct EpiResF32 {
    static constexpr bool PERM = false; const float* R; float* C;
    __device__ __forceinline__ void operator()(const f32x4 (&acc)[2][2][4][2], const ge::Unit& u, int wr, int wc, int fr, int fq) const {
#pragma unroll
        for (int ai = 0; ai < 2; ++ai) {
            f32x4 r[4][2][2];
#pragma unroll
            for (int m = 0; m < 4; ++m) { const size_t off = (size_t)(u.r0 + ai * 128 + wr * 64 + m * 16 + fr) * D + u.c0 + wc * 32 + 4 * fq;
#pragma unroll
                for (int bj = 0; bj < 2; ++bj)
#pragma unroll
                    for (int n = 0; n < 2; ++n) r[m][bj][n] = *(const f32x4*)(R + off + bj * 128 + n * 16); }
#pragma unroll
            for (int m = 0; m < 4; ++m) { const size_t off = (size_t)(u.r0 + ai * 128 + wr * 64 + m * 16 + fr) * D + u.c0 + wc * 32 + 4 * fq;
#pragma unroll
                for (int bj = 0; bj < 2; ++bj)
#pragma unroll
                    for (int n = 0; n < 2; ++n) *(f32x4*)(C + off + bj * 128 + n * 16) = acc[ai][bj][m][n] + r[m][bj][n]; }
        }
    }
};
__device__ __forceinline__ void p_wout(const Frame& F0, int l) {
    const Frame F = phase_frame(F0);
    const float* xsrc = (l == 0) ? F.in(0) : F.out();
    SchedDense S{(const char*)(F.ws + WS_MERGED), (const char*)(F.ws + WS_WOUT) + (size_t)l * 2048 * 2048 * 2, 2048, 2048, T / 256, 8, F.G, F.c};
    EpiResF32 E{xsrc, F.out()};
    ge::gemm_phase<EpiResF32, SchedDense, 0>(F.lds, F.tid, 2048, 0, S, E);
}

constexpr size_t WS_WR = WS_END_SMALL;
constexpr size_t WS_END2 = WS_WR + al256((size_t)NL * 2048 * 64 * 4);

__device__ __forceinline__ void p_conv_router(const Frame& F0) {
    const Frame F = phase_frame(F0);
    float* wr = (float*)(F.ws + WS_WR);
    const float* g2 = F.in(13); const float* rgw = F.in(14); const float* rew = F.in(16);
    for (int i = F.c * NTHR + F.tid; i < NL * 2048 * 64; i += F.G * NTHR) {
        const int j = i & 63, d = (i >> 6) & 2047, l = i >> 17;
        float v = 0.f;
        if (j < 4) v = rgw[((size_t)l * 2048 + d) * 4 + j]; else if (j < 36) v = rew[((size_t)l * 2048 + d) * 32 + (j - 4)];
        wr[i] = v * g2[l * 2048 + d];
    }
}

__device__ __forceinline__ void p_route1(const Frame& F0, int l) {
    const Frame F = phase_frame(F0);
    const float* x = F.out();
    const float* wr = (const float*)(F.ws + WS_WR) + (size_t)l * 2048 * 64;
    const float* g2 = F.in(13) + l * D; const float* rgb = F.in(15) + l * 4; const float* reb = F.in(17) + l * 32;
    unsigned* ctl = (unsigned*)(F.ws + WS_CTL);
    int* rowtok = (int*)(F.ws + WS_ROWTOK); float* roww = (float*)(F.ws + WS_ROWW);
    for (int i = F.c * NTHR + F.tid; i < MOE_ROWS; i += F.G * NTHR) { rowtok[i] = 0; roww[i] = 0.f; }
    LAS float* part = (LAS float*)F.lds;
    LAS float* ssq = (LAS float*)(F.lds + 65536);
    LAS float* lg = (LAS float*)(F.lds + 65536 + 1024);
    LAS float* rstd_s = (LAS float*)(F.lds + 65536 + 1024 + 64 * 40 * 4);
    const int w = F.wave, lane = F.lane, rh = w >> 2, kq = w & 3, r32 = lane & 31, hi = lane >> 5;
    for (int rg = F.c; rg < T / 64; rg += F.G) {
        const int row0 = rg * 64;
        f32x16 acc0, acc1;
#pragma unroll
        for (int r = 0; r < 16; ++r) { acc0[r] = 0.f; acc1[r] = 0.f; }
        float ss = 0.f;
        const float* xr = x + (size_t)(row0 + rh * 32 + r32) * D + kq * 512 + 8 * hi;
        const float* wp = wr + (size_t)(kq * 512 + 8 * hi) * 64 + r32;
        for (int ks = 0; ks < 32; ++ks) {
            const f32x4 xa = *(const f32x4*)(xr + ks * 16), xb = *(const f32x4*)(xr + ks * 16 + 4);
            const float xv[8] = {xa[0], xa[1], xa[2], xa[3], xb[0], xb[1], xb[2], xb[3]};
#pragma unroll
            for (int j = 0; j < 8; ++j) {
                const float b0 = wp[(size_t)(ks * 16 + j) * 64], b1 = wp[(size_t)(ks * 16 + j) * 64 + 32];
                ss += xv[j] * xv[j];
                acc0 = __builtin_amdgcn_mfma_f32_32x32x2f32(xv[j], b0, acc0, 0, 0, 0);
                acc1 = __builtin_amdgcn_mfma_f32_32x32x2f32(xv[j], b1, acc1, 0, 0, 0);
            }
        }
        ss += __shfl_xor(ss, 32);
        if (hi == 0) ssq[w * 32 + r32] = ss;
#pragma unroll
        for (int r = 0; r < 16; ++r) { const int row = (r & 3) + 8 * (r >> 2) + 4 * hi; part[(w * 32 + row) * 64 + r32] = acc0[r]; part[(w * 32 + row) * 64 + 32 + r32] = acc1[r]; }
        __syncthreads();
        { const int row = F.tid >> 3, sub = F.tid & 7, rr = row & 31, rhh = row >> 5;
          float s2 = ssq[(rhh * 4 + 0) * 32 + rr] + ssq[(rhh * 4 + 1) * 32 + rr] + ssq[(rhh * 4 + 2) * 32 + rr] + ssq[(rhh * 4 + 3) * 32 + rr];
          const float rstd = rsqrtf(s2 * (1.f / D) + 1e-6f);
          if (sub == 0) rstd_s[row] = rstd;
#pragma unroll
          for (int q = 0; q < 5; ++q) { const int j = sub * 5 + q; if (j < 36) {
              float a = part[((rhh * 4 + 0) * 32 + rr) * 64 + j] + part[((rhh * 4 + 1) * 32 + rr) * 64 + j] + part[((rhh * 4 + 2) * 32 + rr) * 64 + j] + part[((rhh * 4 + 3) * 32 + rr) * 64 + j];
              lg[row * 40 + j] = a * rstd + (j < 4 ? rgb[j] : reb[j - 4]); } } }
        __syncthreads();
        if (F.tid < 64) {
            const int row = F.tid; const LAS float* L = lg + row * 40;
            int grp = 0; float gm = L[0];
#pragma unroll
            for (int j = 1; j < 4; ++j) if (L[j] > gm) { gm = L[j]; grp = j; }
            float den = 0.f;
#pragma unroll
            for (int j = 0; j < 4; ++j) den += expf(L[j] - gm);
            const float pg = 1.f / den;
            const LAS float* el = L + 4 + grp * 8;
            int i0 = 0; for (int j = 1; j < 8; ++j) if (el[j] > el[i0]) i0 = j;
            int i1 = -1; for (int j = 0; j < 8; ++j) { if (j == i0) continue; if (i1 < 0 || el[j] > el[i1]) i1 = j; }
            const float e1 = expf(el[i1] - el[i0]), d2 = 1.f + e1;
            const int ea = grp * 8 + i0, eb = grp * 8 + i1;
            const unsigned pa = atomicAdd(&ctl[CW_CNT + l * 32 + ea], 1u), pb = atomicAdd(&ctl[CW_CNT + l * 32 + eb], 1u);
            int* rt = (int*)(F.ws + WS_ROUTE) + (size_t)(row0 + row) * 8;
            rt[0] = ea; rt[1] = eb; ((float*)rt)[2] = pg / d2; ((float*)rt)[3] = pg * e1 / d2; rt[4] = (int)pa; rt[5] = (int)pb;
        }
        for (int q = 0; q < 8; ++q) { const int row = w * 8 + q; const float rstd = rstd_s[row];
            const float* xr2 = x + (size_t)(row0 + row) * D; bf16_t* hr = (bf16_t*)(F.ws + WS_H) + (size_t)(row0 + row) * D;
#pragma unroll
            for (int i = 0; i < 8; ++i) { const f32x4 v = *(const f32x4*)(xr2 + i * 256 + lane * 4); const f32x4 gv = *(const f32x4*)(g2 + i * 256 + lane * 4);
                u32x2 wv; wv[0] = cvt_pk_bf16(v[0] * rstd * gv[0], v[1] * rstd * gv[1]); wv[1] = cvt_pk_bf16(v[2] * rstd * gv[2], v[3] * rstd * gv[3]); *(u32x2*)(hr + i * 256 + lane * 4) = wv; } }
        __syncthreads();
    }
}

struct MoeTab { int ntiles; };
__device__ __forceinline__ int moe_build_tab(const Frame& F, int l, LAS int* tab  ) {
    unsigned* ctl = (unsigned*)(F.ws + WS_CTL);
    if (F.tid < 32) tab[32 + F.tid] = (int)__hip_atomic_load(&ctl[CW_CNT + l * 32 + F.tid], __ATOMIC_RELAXED, __HIP_MEMORY_SCOPE_AGENT);
    __syncthreads();
    if (F.tid == 0) { int off = 0, nt = 0;
#pragma nounroll
        for (int e = 0; e < 32; ++e) { tab[e] = off; const int n = (tab[32 + e] + 255) >> 8;
#pragma nounroll
            for (int k = 0; k < n; ++k) { tab[64 + nt] = e; tab[224 + nt] = off + k * 256; ++nt; } off += n * 256; } tab[384] = nt; }
    __syncthreads();
    return tab[384];
}
__device__ __forceinline__ void p_route2(const Frame& F0, int l) {
    const Frame F = phase_frame(F0);
    LAS int* tab = (LAS int*)(F.lds + LDS_MISC);
    moe_build_tab(F, l, tab);
    int* rowtok = (int*)(F.ws + WS_ROWTOK); float* roww = (float*)(F.ws + WS_ROWW);
    for (int t = F.c * NTHR + F.tid; t < T; t += F.G * NTHR) {
        int* rt = (int*)(F.ws + WS_ROUTE) + (size_t)t * 8;
        const int ea = rt[0], eb = rt[1]; const float wa = ((float*)rt)[2], wb = ((float*)rt)[3];
        const int ra = tab[ea] + rt[4], rb = tab[eb] + rt[5];
        rowtok[ra] = t; roww[ra] = wa; rowtok[rb] = t; roww[rb] = wb; rt[6] = ra; rt[7] = rb;
    }
}

struct SchedMoeGU {
    static constexpr bool GATHER = true;
    const char* H; const char* W; const int* rowtok; LAS int* tab; int G, c, ntiles;
    __device__ __forceinline__ bool next(int i, ge::Unit& u) const { const int L = i * G + c; if (L >= ntiles * 4) return false; const int ti = L >> 2, ct = L & 3; const int e = tab[64 + ti];
        u.A = H; u.B = W + ((size_t)e * 1024 + ct * 256) * 2048 * 2; u.r0 = tab[224 + ti]; u.c0 = ct * 128; u.aux = e; u.aux2 = 0; return true; }
    __device__ __forceinline__ void voffA(const ge::Unit& u, int tid, unsigned (&v)[2][2]) const {
#pragma unroll
        for (int i = 0; i < 2; ++i) { int R, C; ge::stage_rc(tid * 16 + i * 8192, R, C); const int t0 = rowtok[u.r0 + R], t1 = rowtok[u.r0 + 128 + R]; v[0][i] = (unsigned)(t0 * 2048 + C) * 2u; v[1][i] = (unsigned)(t1 * 2048 + C) * 2u; } }
};
struct EpiGU {
    static constexpr bool PERM = true; bf16_t* hid;
    __device__ __forceinline__ void operator()(const f32x4 (&acc)[2][2][4][2], const ge::Unit& u, int wr, int wc, int fr, int fq) const {
#pragma unroll
        for (int ai = 0; ai < 2; ++ai)
#pragma unroll
            for (int m = 0; m < 4; ++m) { const f32x4 g0 = acc[ai][0][m][0], g1 = acc[ai][0][m][1], u0 = acc[ai][1][m][0], u1 = acc[ai][1][m][1];
                u32x4 w = {cvt_pk_bf16(fast_silu(g0[0]) * u0[0], fast_silu(g0[1]) * u0[1]), cvt_pk_bf16(fast_silu(g0[2]) * u0[2], fast_silu(g0[3]) * u0[3]),
                           cvt_pk_bf16(fast_silu(g1[0]) * u1[0], fast_silu(g1[1]) * u1[1]), cvt_pk_bf16(fast_silu(g1[2]) * u1[2], fast_silu(g1[3]) * u1[3])};
                *(u32x4*)(hid + (size_t)(u.r0 + ai * 128 + wr * 64 + m * 16 + fr) * 512 + u.c0 + wc * 32 + 8 * fq) = w; }
    }
};
__device__ __forceinline__ void p_moe_gu(const Frame& F0, int l) {
    const Frame F = phase_frame(F0);
    LAS int* tab = (LAS int*)(F.lds + LDS_MISC);
    const int nt = moe_build_tab(F, l, tab);
    SchedMoeGU S{(const char*)(F.ws + WS_H), (const char*)(F.ws + WS_WGU), (const int*)(F.ws + WS_ROWTOK), tab, F.G, F.c, nt};
    EpiGU E{(bf16_t*)(F.ws + WS_HID)};
    ge::gemm_phase<EpiGU, SchedMoeGU, 0>(F.lds, F.tid, 2048, 0, S, E);
}
struct SchedMoeD {
    static constexpr bool GATHER = false;
    const char* HID; const char* W; LAS int* tab; int G, c, ntiles;
    __device__ __forceinline__ bool next(int i, ge::Unit& u) const { const int L = i * G + c; if (L >= ntiles * 8) return false; const int ti = L >> 3, ct = L & 7; const int e = tab[64 + ti];
        u.r0 = tab[224 + ti]; u.A = HID + (size_t)u.r0 * 512 * 2; u.B = W + ((size_t)e * 2048 + ct * 256) * 512 * 2; u.c0 = ct * 256; u.aux = e; u.aux2 = 0; return true; }
    __device__ __forceinline__ void voffA(const ge::Unit&, int tid, unsigned (&v)[2][2]) const { ge::dense_voffA(512, tid, v); }
};
struct EpiDown {
    static constexpr bool PERM = true; bf16_t* y; const float* roww;
    __device__ __forceinline__ void operator()(const f32x4 (&acc)[2][2][4][2], const ge::Unit& u, int wr, int wc, int fr, int fq) const {
#pragma unroll
        for (int ai = 0; ai < 2; ++ai)
#pragma unroll
            for (int m = 0; m < 4; ++m) { const int row = u.r0 + ai * 128 + wr * 64 + m * 16 + fr; const float s = roww[row]; bf16_t* rowp = y + (size_t)row * 2048 + u.c0 + wc * 32 + 8 * fq;
#pragma unroll
                for (int bj = 0; bj < 2; ++bj) { const f32x4 v0 = acc[ai][bj][m][0] * s, v1 = acc[ai][bj][m][1] * s; u32x4 w = {cvt_pk_bf16(v0[0], v0[1]), cvt_pk_bf16(v0[2], v0[3]), cvt_pk_bf16(v1[0], v1[1]), cvt_pk_bf16(v1[2], v1[3])};
                    *(u32x4*)(rowp + bj * 128) = w; } }
    }
};
__device__ __forceinline__ void p_moe_down(const Frame& F0, int l) {
    const Frame F = phase_frame(F0);
    LAS int* tab = (LAS int*)(F.lds + LDS_MISC);
    const int nt = moe_build_tab(F, l, tab);
    SchedMoeD S{(const char*)(F.ws + WS_HID), (const char*)(F.ws + WS_WD), tab, F.G, F.c, nt};
    EpiDown E{(bf16_t*)(F.ws + WS_YBUF), (const float*)(F.ws + WS_ROWW)};
    ge::gemm_phase<EpiDown, SchedMoeD, 0>(F.lds, F.tid, 512, 0, S, E);
}
template <int MODE>
__device__ __forceinline__ void p_combine(const Frame& F0, int lnext) {
    const Frame F = phase_frame(F0);
    float* x = F.out(); const bf16_t* y = (const bf16_t*)(F.ws + WS_YBUF);
    const float* g = MODE == 0 ? F.in(1) + lnext * D : F.in(21);
    for (int row = F.c * 8 + F.wave; row < T; row += F.G * 8) {
        const int* rt = (const int*)(F.ws + WS_ROUTE) + (size_t)row * 8; const int ra = rt[6], rb = rt[7];
        float* xr = x + (size_t)row * D; f32x4 v[8]; float ss = 0.f;
#pragma unroll
        for (int i = 0; i < 8; ++i) { v[i] = *(const f32x4*)(xr + i * 256 + F.lane * 4);
            const u32x2 ya = *(const u32x2*)(y + (size_t)ra * 2048 + i * 256 + F.lane * 4), yb = *(const u32x2*)(y + (size_t)rb * 2048 + i * 256 + F.lane * 4);
            v[i][0] += bf_lo(ya[0]) + bf_lo(yb[0]); v[i][1] += bf_hi(ya[0]) + bf_hi(yb[0]); v[i][2] += bf_lo(ya[1]) + bf_lo(yb[1]); v[i][3] += bf_hi(ya[1]) + bf_hi(yb[1]);
            ss += v[i][0] * v[i][0] + v[i][1] * v[i][1] + v[i][2] * v[i][2] + v[i][3] * v[i][3]; }
#pragma unroll
        for (int o = 32; o > 0; o >>= 1) ss += __shfl_xor(ss, o);
        const float rstd = rsqrtf(ss * (1.f / D) + 1e-6f);
#pragma unroll
        for (int i = 0; i < 8; ++i) { const f32x4 gv = *(const f32x4*)(g + i * 256 + F.lane * 4);
            if (MODE == 0) { *(f32x4*)(xr + i * 256 + F.lane * 4) = v[i]; store_h4(F.ws, (size_t)row * D + i * 256 + F.lane * 4, v[i][0] * rstd * gv[0], v[i][1] * rstd * gv[1], v[i][2] * rstd * gv[2], v[i][3] * rstd * gv[3]); }
            else { f32x4 o = {v[i][0] * rstd * gv[0], v[i][1] * rstd * gv[1], v[i][2] * rstd * gv[2], v[i][3] * rstd * gv[3]}; *(f32x4*)(xr + i * 256 + F.lane * 4) = o; } }
    }
}

namespace att {
constexpr float SCALE = 0.08838834764831845f;
constexpr int NW = 8, QBLK = 32, KVBLK = 64, QB = NW * QBLK, DH = 128;
constexpr int SHM_V = KVBLK * DH * 2, SHM_K = KVBLK * DH * 2;
constexpr int ATT_LDS = 2 * SHM_V + 2 * SHM_K + NW * 64 * 4;
constexpr float THR = 8.f;
typedef short s16x4 __attribute__((ext_vector_type(4)));

#define KSWZ(row, colB) ((row) * 256 + ((colB) ^ (((row) & 7) << 4)))
#define SBAR() __builtin_amdgcn_sched_barrier(0)
__device__ __forceinline__ int v_st(int k, int c) { const int kk = (k & ~0xC) | ((k & 4) << 1) | ((k & 8) >> 1); return ((kk >> 3) * 4 + (c >> 5)) * 512 + ((kk & 7) * 32 + (c & 31)) * 2; }
__device__ __forceinline__ int v_rd_base(int lane) { return ((lane & 3) << 3) | (((lane >> 2) & 3) << 6) | (((lane >> 4) & 1) << 5) | (((lane >> 5) & 1) << 8); }
constexpr int v_rd_off(int d0, int ks, int half) { return d0 * 512 + ks * 4096 + half * 2048; }
__device__ __forceinline__ int crow(int r, int hi) { return (r & 3) + 8 * (r >> 2) + 4 * hi; }
__device__ __forceinline__ bf16x8 load8(const bf16_t* p) { return *reinterpret_cast<const bf16x8*>(p); }

__device__ __forceinline__ void mask_tile(f32x16& p0, f32x16& p1, int dq, unsigned W) {
    const float NEG = -__builtin_inff();
#pragma unroll
    for (int r = 0; r < 16; ++r) {
        const int c = (r & 3) + 8 * (r >> 2);
        if ((unsigned)(dq - c) >= W) p0[r] = NEG;
        if ((unsigned)(dq - c - 32) >= W) p1[r] = NEG;
    }
}
__device__ __forceinline__ void mask_all(f32x16& p0, f32x16& p1, bool ok) {
    const float NEG = -__builtin_inff();
#pragma unroll
    for (int r = 0; r < 16; ++r) { p0[r] = ok ? p0[r] : NEG; p1[r] = ok ? p1[r] : NEG; }
}
__device__ __forceinline__ void partialSM(f32x16& p0, f32x16& p1, float& m_reg, float& mn, float& alpha) {
    float pmax = p0[0]; for (int r = 1; r < 16; ++r) pmax = fmaxf(pmax, p0[r]); for (int r = 0; r < 16; ++r) pmax = fmaxf(pmax, p1[r]);
    { auto rr = __builtin_amdgcn_permlane32_swap(__float_as_uint(pmax), __float_as_uint(pmax), false, false);
      pmax = fmaxf(__uint_as_float(rr[0]), __uint_as_float(rr[1])); }
    constexpr float C2 = 1.4426950408889634f * SCALE;
    if (__builtin_expect(__all((pmax - m_reg) * SCALE <= THR), 1)) { mn = m_reg; alpha = 1.f; }
    else { mn = fmaxf(m_reg, pmax); alpha = __builtin_amdgcn_exp2f((m_reg - mn) * C2); m_reg = mn; }
    const float mnL = -mn * C2;
    for (int r = 0; r < 16; ++r) p0[r] = fmaf(p0[r], C2, mnL); for (int r = 0; r < 16; ++r) p1[r] = fmaf(p1[r], C2, mnL);
    for (int r = 0; r < 16; ++r) p0[r] = __builtin_amdgcn_exp2f(p0[r]);
}
__device__ __forceinline__ void finishSM(f32x16& p0, f32x16& p1, float alpha, float& l_reg, bf16x8& pa0, bf16x8& pa1, bf16x8& pa2, bf16x8& pa3) {
    for (int r = 0; r < 16; ++r) p1[r] = __builtin_amdgcn_exp2f(p1[r]);
    float ps = 0; for (int r = 0; r < 16; ++r) ps += p0[r]; for (int r = 0; r < 16; ++r) ps += p1[r];
    { auto rr = __builtin_amdgcn_permlane32_swap(__float_as_uint(ps), __float_as_uint(ps), false, false);
      ps = __uint_as_float(rr[0]) + __uint_as_float(rr[1]); }
    l_reg = l_reg * alpha + ps;
#define PK4(P, B_, OUT) do { unsigned a0 = cvt_pk_bf16(P[B_+0], P[B_+1]), a1 = cvt_pk_bf16(P[B_+2], P[B_+3]);                          \
        unsigned b0 = cvt_pk_bf16(P[B_+4], P[B_+5]), b1 = cvt_pk_bf16(P[B_+6], P[B_+7]);                                             \
        auto r0 = __builtin_amdgcn_permlane32_swap(a0, b0, false, false); auto r1 = __builtin_amdgcn_permlane32_swap(a1, b1, false, false); \
        u32x4 w = {r0[0], r1[0], r0[1], r1[1]}; OUT = *reinterpret_cast<bf16x8*>(&w); } while (0)
    PK4(p0, 0, pa0); PK4(p0, 8, pa1); PK4(p1, 0, pa2); PK4(p1, 8, pa3);
#undef PK4
}
template <int KB, bool SK>
__device__ __forceinline__ void qkt(f32x16& p0, f32x16& p1, const char* K_lds, int r32, int hi, const bf16x8* qr, bool act) {
    if (SK && !act) { const float NEG = -__builtin_inff();
#pragma unroll
        for (int r = 0; r < 16; ++r) { p0[r] = NEG; p1[r] = NEG; } return; }
    p0 = f32x16{}; p1 = f32x16{};
    const unsigned kb0 = (unsigned)(uintptr_t)(const LAS char*)(K_lds + KB * SHM_K) + (unsigned)KSWZ(r32, (hi * 8) * 2);
    unsigned kbx[4]; kbx[0] = kb0;
    asm volatile("v_xor_b32 %0, 32, %1" : "=v"(kbx[1]) : "v"(kb0)); asm volatile("v_xor_b32 %0, 64, %1" : "=v"(kbx[2]) : "v"(kb0)); asm volatile("v_xor_b32 %0, 0x60, %1" : "=v"(kbx[3]) : "v"(kb0));
#pragma unroll
    for (int d0 = 0; d0 < 8; ++d0) { const unsigned a = kbx[d0 & 3] + (d0 >> 2) * 128;
        bf16x8 b0 = *(const LAS bf16x8*)(a);
        bf16x8 b1 = *(const LAS bf16x8*)(a + 32 * 256);
        p0 = __builtin_amdgcn_mfma_f32_32x32x16_bf16(b0, qr[d0], p0, 0, 0, 0);
        p1 = __builtin_amdgcn_mfma_f32_32x32x16_bf16(b1, qr[d0], p1, 0, 0, 0); }
}
template <int VB, bool SK>
__device__ __forceinline__ void pv_tile(f32x16* o, int vb0, bf16x8 pa0, bf16x8 pa1, bf16x8 pa2, bf16x8 pa3, bool act) {
    if (SK && !act) return;
#define TRRD(dst, off) asm volatile("ds_read_b64_tr_b16 %0, %1 offset:%2" : "=&v"(dst) : "v"(vb0), "i"(off) : "memory")
#define PV_D0(d0) do { s16x4 l0, l1, l2, l3, h0, h1, h2, h3; constexpr int b_ = VB * SHM_V + v_rd_off(d0, 0, 0); \
        TRRD(l0, b_); TRRD(h0, b_ + 2048); TRRD(l1, b_ + 4096); TRRD(h1, b_ + 6144); TRRD(l2, b_ + 8192); TRRD(h2, b_ + 10240); TRRD(l3, b_ + 12288); TRRD(h3, b_ + 14336); \
        asm volatile("s_waitcnt lgkmcnt(0)" ::: "memory"); SBAR(); \
        o[d0] = __builtin_amdgcn_mfma_f32_32x32x16_bf16(pa0, (bf16x8){l0[0], l0[1], l0[2], l0[3], h0[0], h0[1], h0[2], h0[3]}, o[d0], 0, 0, 0);   \
        o[d0] = __builtin_amdgcn_mfma_f32_32x32x16_bf16(pa1, (bf16x8){l1[0], l1[1], l1[2], l1[3], h1[0], h1[1], h1[2], h1[3]}, o[d0], 0, 0, 0);   \
        o[d0] = __builtin_amdgcn_mfma_f32_32x32x16_bf16(pa2, (bf16x8){l2[0], l2[1], l2[2], l2[3], h2[0], h2[1], h2[2], h2[3]}, o[d0], 0, 0, 0);   \
        o[d0] = __builtin_amdgcn_mfma_f32_32x32x16_bf16(pa3, (bf16x8){l3[0], l3[1], l3[2], l3[3], h3[0], h3[1], h3[2], h3[3]}, o[d0], 0, 0, 0); } while (0)
    PV_D0(0); PV_D0(1); PV_D0(2); PV_D0(3);
#undef PV_D0
#undef TRRD
}

struct BlockRef { const bf16_t* Q; const bf16_t* K; const bf16_t* V; bf16_t* O; const void* mask; const bf16_t* gate; int P0; int pad; };
struct Seam { bf16x8 qr[8]; bf16x8 st_v0, st_v1, st_k0, st_k1; };
__device__ __forceinline__ int swa_jlo(int P0, int W) { const int lowk = P0 - W + 1; return lowk > 0 ? lowk / KVBLK : 0; }
#define ROW(p, k0, rr) ((p) + (size_t)(k0) * LDP + (unsigned)((rr) * LDP + sc))
#define VMW() asm volatile("s_waitcnt vmcnt(0)" ::: "memory")
#define VMWN(n) asm volatile("s_waitcnt vmcnt(%0)" :: "i"(n) : "memory")
#define SLOAD_H(Kp, Vp, k0) do { S.st_v0 = load8(ROW(Vp, k0, sr)); S.st_v1 = load8(ROW(Vp, k0, 32 + sr));              \
                         S.st_k0 = load8(ROW(Kp, k0, sr)); S.st_k1 = load8(ROW(Kp, k0, 32 + sr)); } while (0)
#define SWRITE_HK(bf) do { *(bf16x8*)(K_lds + (bf) * SHM_K + kws) = S.st_k0; *(bf16x8*)(K_lds + (bf) * SHM_K + kws + 32 * 256) = S.st_k1; } while (0)
#define SWRITE_HV(bf) do { *(bf16x8*)(V_lds + (bf) * SHM_V + vst0) = S.st_v0; *(bf16x8*)(V_lds + (bf) * SHM_V + vst1) = S.st_v1; } while (0)
#define SWRITE_H(bf) do { SWRITE_HV(bf); SWRITE_HK(bf); } while (0)
__device__ __forceinline__ void prime(const BlockRef& cur, int W, char* lds, Seam& S, int tid) {
    const int wid = __builtin_amdgcn_readfirstlane(tid >> 6), lane = tid & 63, r32 = lane & 31, hi = lane >> 5;
    const int sr = tid >> 4, sc = (tid & 15) * 8, kws = KSWZ(sr, sc * 2); char* K_lds = lds + 2 * SHM_V;
    const int kb0 = swa_jlo(cur.P0, W) * KVBLK;
    for (int d0 = 0; d0 < 8; ++d0) S.qr[d0] = load8(cur.Q + (unsigned)((wid * QBLK + r32) * LDP + hi * 8) + d0 * 16);
    SLOAD_H(cur.K, cur.V, kb0); VMW(); SWRITE_HK(0);
    __syncthreads();
}
template <int MODE, bool SK>
__device__ __forceinline__ void block(const BlockRef& cur, const BlockRef& nxt, int skv, int W, char* lds, Seam& S, int tid) {
    const int wid = __builtin_amdgcn_readfirstlane(tid >> 6), lane = tid & 63, r32 = lane & 31, hi = lane >> 5;
    const int j_lo = swa_jlo(cur.P0, W);
    int j_hi = (cur.P0 + QB - 1) / KVBLK + 1; if (j_hi > skv / KVBLK) j_hi = skv / KVBLK;
    const int NT = j_hi - j_lo;
    const int kbn = swa_jlo(nxt.P0, W) * KVBLK;
    const int qlo = cur.P0 + wid * QBLK, qm = qlo + r32 - 4 * hi;
    char* V_lds = lds; char* K_lds = lds + 2 * SHM_V;
    float* ws = (float*)(lds + 2 * SHM_V + 2 * SHM_K) + wid * 64; float* li_l = ws, * al_l = ws + 32;
    float m_reg = -1e30f, l_reg = 0; f32x16 o[4] = {};
    const int sr = tid >> 4, sc = (tid & 15) * 8, vst0 = v_st(sr, sc), vst1 = v_st(32 + sr, sc), kws = KSWZ(sr, sc * 2);
    const int vb0 = (int)(uintptr_t)V_lds + v_rd_base(lane);
    const bf16_t* Kh = cur.K; const bf16_t* Vh = cur.V;
    unsigned rowmask = 0xffffffffu;
    if (MODE == 0) rowmask = ((const unsigned char*)cur.mask)[(unsigned)((wid * QBLK + r32) * 8)];
    if (MODE == 1) rowmask = ((const unsigned*)cur.mask)[(unsigned)((wid * QBLK + r32) * 2)];
    constexpr int BSH = (MODE == 0) ? 8 : 6;
#define RESC(a) do { if (__any((a) < 1.f)) { if (hi == 0) al_l[r32] = (a); asm volatile("s_waitcnt lgkmcnt(0)" ::: "memory");              \
                     for (int d_ = 0; d_ < 4; ++d_) for (int r = 0; r < 16; ++r) o[d_][r] *= al_l[crow(r, hi)]; } } while (0)
#define KBASE(t) ((j_lo + (t)) * KVBLK)
#define ACT(t) (KBASE(t) <= qlo + QBLK - 1 && KBASE(t) + KVBLK - 1 >= qlo - W + 1)
#define MASKT(P0_, P1_, t) do { const int kb_ = KBASE(t); if ((!SK || ACT(t)) && (kb_ + KVBLK - 1 > qlo || kb_ <= qlo + QBLK - 1 - W)) mask_tile(P0_, P1_, qm - kb_, (unsigned)W); \
        if (MODE != 2) { const bool ok_ = (rowmask >> (kb_ >> BSH)) & 1u; if (!__all(ok_)) mask_all(P0_, P1_, ok_); } } while (0)
    constexpr int NQL = 8;
#define SEAM_K0() do { VMWN(NQL); SWRITE_HK(0); SBAR(); } while (0)
    f32x16 pA0, pA1, pB0, pB1; float mnA, mnB, alA, alB; bf16x8 pa0, pa1, pa2, pa3;
    SWRITE_HV(0); SBAR();
    if (NT > 1) { SLOAD_H(Kh, Vh, KBASE(1)); }
    SBAR(); qkt<0, SK>(pA0, pA1, K_lds, r32, hi, S.qr, ACT(0));
    MASKT(pA0, pA1, 0); partialSM(pA0, pA1, m_reg, mnA, alA);
    if (NT > 1) { VMW(); SWRITE_H(1); }
    __syncthreads();
#define HALF_STEP(PX0, PX1, mnX, alX, PY0, PY1, alY, t, KB, VB, SB) do {                                                      \
        SBAR(); qkt<KB, SK>(PX0, PX1, K_lds, r32, hi, S.qr, ACT(t));                                             \
        finishSM(PY0, PY1, alY, l_reg, pa0, pa1, pa2, pa3); SBAR();                                                           \
        if ((t) + 1 < NT) { SLOAD_H(Kh, Vh, KBASE((t) + 1)); SBAR(); }                                               \
        pv_tile<VB, SK>(o, vb0, pa0, pa1, pa2, pa3, ACT((t) - 1)); MASKT(PX0, PX1, (t)); partialSM(PX0, PX1, m_reg, mnX, alX);                                        \
        __syncthreads();                                                                                                      \
        if ((t) + 1 < NT) { VMW(); SWRITE_H(SB); }                                                                          \
        RESC(alX); __syncthreads(); } while (0)
    for (int t = 1; t + 1 < NT; t += 2) {
        HALF_STEP(pB0, pB1, mnB, alB, pA0, pA1, alA, t, 1, 0, 0);
        HALF_STEP(pA0, pA1, mnA, alA, pB0, pB1, alB, t + 1, 0, 1, 1);
    }
    const bool even = (NT & 1) == 0;
    if (even) { SBAR(); qkt<1, SK>(pB0, pB1, K_lds, r32, hi, S.qr, ACT(NT - 1)); SBAR(); }
    SLOAD_H(nxt.K, nxt.V, kbn); SBAR();
#pragma unroll
    for (int d0 = 0; d0 < 8; ++d0) S.qr[d0] = load8(nxt.Q + (unsigned)((wid * QBLK + r32) * LDP + hi * 8) + d0 * 16);
    SBAR();
    finishSM(pA0, pA1, alA, l_reg, pa0, pa1, pa2, pa3); SBAR();
    pv_tile<0, SK>(o, vb0, pa0, pa1, pa2, pa3, ACT(even ? NT - 2 : NT - 1));
    if (even) { MASKT(pB0, pB1, NT - 1); partialSM(pB0, pB1, m_reg, mnB, alB); __syncthreads(); RESC(alB);
        finishSM(pB0, pB1, alB, l_reg, pa0, pa1, pa2, pa3); SBAR(); pv_tile<1, SK>(o, vb0, pa0, pa1, pa2, pa3, ACT(NT - 1)); }
    SBAR(); SEAM_K0();
    { int le = lane; asm volatile("" : "+v"(le)); const int r32e = le & 31, hie = le >> 5;
    if (hie == 0) { float sc_ = 1.f / l_reg;
        if (MODE != 0) { const float gl = bf2f(cur.gate[(unsigned)((wid * QBLK + r32e) * LDP)]); sc_ *= fast_sigmoid(gl); }
        li_l[r32e] = sc_; }
    asm volatile("s_waitcnt lgkmcnt(0)" ::: "memory");
    bf16_t* Ow = cur.O + (size_t)(wid * QBLK) * 1024;
#pragma unroll
    for (int r = 0; r < 16; ++r) { const int orow = crow(r, hie); const float rl = li_l[orow];
#pragma unroll
        for (int d0 = 0; d0 < 4; ++d0) { const float v = o[d0][r] * rl;
            const float vn = __shfl_xor(v, 1);
            if ((r32e & 1) == 0) { unsigned* dp = (unsigned*)(Ow + (unsigned)(orow * 1024 + r32e) + d0 * 32);
                float a = v, b = vn;
                if (MODE != 0) { const unsigned pw = *dp; a += bf_lo(pw); b += bf_hi(pw); }
                *dp = cvt_pk_bf16(a, b); } } } }
    __syncthreads();
#undef RESC
#undef KBASE
#undef ACT
#undef MASKT
#undef SEAM_K0
#undef HALF_STEP
}
#undef ROW
#undef VMW
#undef VMWN
#undef SLOAD_H
#undef SWRITE_HK
#undef SWRITE_HV
#undef SWRITE_H
#undef KSWZ
#undef SBAR
}
constexpr size_t WS_DUMMY = (size_t)1180 * 1000 * 1000;
constexpr size_t WS_MOBAMASK = WS_END2;
constexpr size_t WS_SELMASK = WS_MOBAMASK + al256((size_t)T * 8);
constexpr size_t WS_END3 = WS_SELMASK + al256((size_t)T * 2 * 4);

__device__ __forceinline__ void p_moba_prep(const Frame& F0, int wg0) {
    const Frame F = phase_frame(F0);
    if (F.c < wg0) return;
    const bf16_t* proj = (const bf16_t*)(F.ws + WS_PROJ); unsigned char* mm = (unsigned char*)(F.ws + WS_MOBAMASK);
    LAS float* km = (LAS float*)F.lds;
    LAS float* part = km + 8 * 128;
    for (int u = F.c - wg0; u < NB * 8 * 8; u += F.G - wg0) {
        const int pb = u & 7, h = (u >> 3) & 7, b = u >> 6;
        const int kgrp = F.tid >> 7, d = F.tid & 127;
        for (int n = 0; n < pb; ++n) {
            const bf16_t* kp = proj + ((size_t)b * S + n * 256 + kgrp * 64) * LDP + P_MK + h * 128 + d; float a = 0.f;
            for (int j = 0; j < 64; ++j) a += bf2f(kp[(size_t)j * LDP]);
            part[kgrp * 128 + d] = a; __syncthreads();
            if (F.tid < 128) km[n * 128 + d] = (part[d] + part[128 + d] + part[256 + d] + part[384 + d]) * (1.f / 256.f);
            __syncthreads();
        }
        const int pos = F.tid >> 1, half = F.tid & 1; const size_t t = (size_t)b * S + pb * 256 + pos;
        float gt[8];
#pragma unroll
        for (int n = 0; n < 8; ++n) gt[n] = 0.f;
        const bf16_t* qp = proj + t * LDP + P_MQ + h * 128 + half * 64;
        for (int c8 = 0; c8 < 8; ++c8) { const u32x4 qw = *(const u32x4*)(qp + c8 * 8);
            const float qf[8] = {bf_lo(qw[0]), bf_hi(qw[0]), bf_lo(qw[1]), bf_hi(qw[1]), bf_lo(qw[2]), bf_hi(qw[2]), bf_lo(qw[3]), bf_hi(qw[3])};
#pragma unroll
            for (int n = 0; n < 8; ++n) if (n < pb) {
#pragma unroll
                for (int j = 0; j < 8; ++j) gt[n] += qf[j] * km[n * 128 + half * 64 + c8 * 8 + j]; } }
        unsigned taken = 0;
#pragma unroll
        for (int n = 0; n < 8; ++n) { gt[n] += __shfl_xor(gt[n], 1); if (n >= pb) gt[n] = -1e30f; }
#pragma unroll
        for (int k = 0; k < 3; ++k) { int best = -1; float bv = 0.f;
#pragma unroll
            for (int n = 0; n < 8; ++n) if (!((taken >> n) & 1u) && (best < 0 || gt[n] > bv)) { best = n; bv = gt[n]; }
            taken |= 1u << best; }
        unsigned m = (taken & ((1u << pb) - 1u)) | (1u << pb);
        if (half == 0) mm[t * 8 + h] = (unsigned char)m;
        __syncthreads();
    }
}
__device__ __forceinline__ att::BlockRef ref_moba(const bf16_t* proj, bf16_t* om, const unsigned char* mm, int L, int pass) {
    const int bh = L >> 2, y = L & 3, b = bh >> 3, h = bh & 7; const int qb = pass ? 7 - y : y; const size_t t0 = (size_t)b * S + qb * 256;
    att::BlockRef r; r.Q = proj + t0 * LDP + P_MQ + h * 128; r.K = proj + (size_t)b * S * LDP + P_MK + h * 128; r.V = proj + (size_t)b * S * LDP + P_MV + h * 128;
    r.O = om + t0 * 1024 + h * 128; r.mask = mm + t0 * 8 + h; r.gate = nullptr; r.P0 = qb * 256; r.pad = 0; return r; }
template <int BR>
__device__ __forceinline__ att::BlockRef ref_nsa(const bf16_t* proj, bf16_t* on, const unsigned* sm, int L, int pass) {
    const int bh = L >> 2, y = L & 3, b = bh >> 3, h = bh & 7, g = h >> 2; const int qb = pass ? 7 - y : y; const size_t t0 = (size_t)b * S + qb * 256;
    att::BlockRef r; r.Q = proj + t0 * LDP + P_NQ + h * 128; r.K = proj + (size_t)b * S * LDP + P_NKV + (2 + 2 * BR) * 256 + g * 128; r.V = proj + (size_t)b * S * LDP + P_NKV + (3 + 2 * BR) * 256 + g * 128;
    r.O = on + t0 * 1024 + h * 128; r.mask = sm + t0 * 2 + g; r.gate = proj + t0 * LDP + P_NG + h * 3 + 1 + BR; r.P0 = qb * 256; r.pad = 0; return r; }
template <int WIN, bool DUMMY>
__device__ __forceinline__ void p_moba_attn_t(const Frame& F0) {
    const Frame F = phase_frame(F0);
    const bf16_t* proj = (const bf16_t*)(F.ws + WS_PROJ); bf16_t* om = (bf16_t*)(F.ws + (DUMMY ? WS_DUMMY : WS_OM)); const unsigned char* mm = (const unsigned char*)(F.ws + WS_MOBAMASK);
    const int total = NB * 8 * 8;

    const int nitems = total / 2;
    int L = F.c; if (L >= nitems) return;
    int pass = 0; att::BlockRef cur = ref_moba(proj, om, mm, L, 0); att::Seam Sm;
    att::prime(cur, WIN, (char*)F.lds, Sm, F.tid);
    for (;;) {
        const bool more_pass = pass == 0, more_item = L + F.G < nitems, last = !more_pass && !more_item;
        int passn = pass + 1, Ln = L; if (!more_pass) { passn = 0; Ln = more_item ? L + F.G : L; }
        const att::BlockRef nxt = last ? cur : ref_moba(proj, om, mm, Ln, passn);
        att::block<0, false>(cur, nxt, S, WIN, (char*)F.lds, Sm, F.tid);
        if (last) break;
        cur = nxt; pass = passn; L = Ln;
    }
}
__device__ __forceinline__ void p_moba_attn(const Frame& F0) { p_moba_attn_t<(1 << 20), false>(F0); }
__device__ __forceinline__ void p_nsa_attn(const Frame& F0) {
    const int nitems = NB * 8 * 4;
    if (F0.c >= nitems) return;
    {
        const Frame F = phase_frame(F0);
        const bf16_t* proj = (const bf16_t*)(F.ws + WS_PROJ); bf16_t* on = (bf16_t*)(F.ws + WS_ON); const unsigned* sm = (const unsigned*)(F.ws + WS_SELMASK);

        int L = F.c, pass = 0; att::BlockRef cur = ref_nsa<0>(proj, on, sm, L, 0); att::Seam Sm;
        att::prime(cur, 1 << 20, (char*)F.lds, Sm, F.tid);
        for (;;) {
            const bool more_pass = pass == 0, more_item = L + F.G < nitems, last = !more_pass && !more_item;
            int passn = pass + 1, Ln = L; if (!more_pass) { passn = 0; Ln = more_item ? L + F.G : L; }
            const att::BlockRef nxt = last ? cur : ref_nsa<0>(proj, on, sm, Ln, passn);
            att::block<1, false>(cur, nxt, S, 1 << 20, (char*)F.lds, Sm, F.tid);
            if (last) break;
            cur = nxt; pass = passn; L = Ln;
        }
    }
    {
        const Frame F = phase_frame(F0);
        const bf16_t* proj = (const bf16_t*)(F.ws + WS_PROJ); bf16_t* on = (bf16_t*)(F.ws + WS_ON); const unsigned* sm = (const unsigned*)(F.ws + WS_SELMASK);

        int L = F.c, pass = 0; att::BlockRef cur = ref_nsa<1>(proj, on, sm, L, 0); att::Seam Sm;
        att::prime(cur, 512, (char*)F.lds, Sm, F.tid);
        for (;;) {
            const bool more_pass = pass == 0, more_item = L + F.G < nitems, last = !more_pass && !more_item;
            int passn = pass + 1, Ln = L; if (!more_pass) { passn = 0; Ln = more_item ? L + F.G : L; }
            const att::BlockRef nxt = last ? cur : ref_nsa<1>(proj, on, sm, Ln, passn);
            att::block<2, false>(cur, nxt, S, 512, (char*)F.lds, Sm, F.tid);
            if (last) break;
            cur = nxt; pass = passn; L = Ln;
        }
    }
}

constexpr size_t WS_GDS = WS_MERGED;
constexpr size_t WS_GQT = WS_DEC;
constexpr size_t WS_GDL = WS_END3;
constexpr size_t WS_END4 = WS_GDL + al256((size_t)1024 * 128 * 4);

__device__ __forceinline__ void p_gla1(const Frame& F0, int l, int wg0) {
    const Frame F = phase_frame(F0);
    if (F.c < wg0) return;
    const bf16_t* proj = (const bf16_t*)(F.ws + WS_PROJ);
    const float* wa = F.in(6) + (size_t)l * 16 * 512; const float* ba = F.in(7) + (size_t)l * 512;
    float* ograw = (float*)(F.ws + WS_OGRAW); bf16_t* gds = (bf16_t*)(F.ws + WS_GDS); bf16_t* gqt = (bf16_t*)(F.ws + WS_GQT); float* gdl = (float*)(F.ws + WS_GDL);
    LAS bf16_t* bq = (LAS bf16_t*)F.lds;
    LAS bf16_t* bk = bq + 64 * 136;
    LAS bf16_t* bkT = bk + 64 * 136;
    LAS bf16_t* bvT = bkT + 128 * 72;
    LAS bf16_t* rv = bvT + 256 * 72;
    LAS bf16_t* bA = rv;
    LAS float* gs = (LAS float*)(rv + 64 * 256);
    LAS bf16_t* sga = (LAS bf16_t*)(gs + 512);
    const int tid = F.tid, lane = F.lane, w = F.wave, r32 = lane & 31, hh = lane >> 5;
    for (int u = F.c - wg0; u < 1024; u += F.G - wg0) {
        const int c = u & 31, h = (u >> 5) & 3, b = u >> 7; const size_t row0 = (size_t)b * S + c * 64;
        {
            u32x4 lq[2], lk[2], lv[4], lg = {0u, 0u, 0u, 0u};
#pragma unroll
            for (int i = 0; i < 2; ++i) { const int ch = i * NTHR + tid, t = ch >> 4, cc = ch & 15; lq[i] = *(const u32x4*)(proj + (row0 + t) * LDP + P_GQ + h * 128 + cc * 8); lk[i] = *(const u32x4*)(proj + (row0 + t) * LDP + P_GK + h * 128 + cc * 8); }
#pragma unroll
            for (int i = 0; i < 4; ++i) { const int ch = i * NTHR + tid, t = ch >> 5, cc = ch & 31; lv[i] = *(const u32x4*)(proj + (row0 + t) * LDP + P_GV + h * 256 + cc * 8); }
            if (tid < 128) lg = *(const u32x4*)(proj + (row0 + (tid >> 1)) * LDP + P_GA + (tid & 1) * 8);
#pragma unroll
            for (int i = 0; i < 2; ++i) { const int ch = i * NTHR + tid, t = ch >> 4, cc = ch & 15; *(LAS u32x4*)(bq + t * 136 + cc * 8) = lq[i]; *(LAS u32x4*)(bk + t * 136 + cc * 8) = lk[i]; }
#pragma unroll
            for (int i = 0; i < 4; ++i) { const int ch = i * NTHR + tid, t = ch >> 5, cc = ch & 31; *(LAS u32x4*)(rv + t * 256 + cc * 8) = lv[i]; }
            if (tid < 128) *(LAS u32x4*)(sga + (tid >> 1) * 16 + (tid & 1) * 8) = lg;
        }
        __syncthreads();
        {
            const int d = tid & 127, tq = tid >> 7, col = h * 128 + d;
            float war[16];
#pragma unroll
            for (int r = 0; r < 16; ++r) war[r] = wa[r * 512 + col];
            const float bias = ba[col];
            float bl[16]; float cum = 0.f;
#pragma unroll
            for (int i = 0; i < 16; ++i) { const LAS bf16_t* gp = sga + (tq * 16 + i) * 16;
                const u32x4 g0 = *(const LAS u32x4*)gp, g1 = *(const LAS u32x4*)(gp + 8);
                float x = bias + bf_lo(g0[0]) * war[0] + bf_hi(g0[0]) * war[1] + bf_lo(g0[1]) * war[2] + bf_hi(g0[1]) * war[3] + bf_lo(g0[2]) * war[4] + bf_hi(g0[2]) * war[5] + bf_lo(g0[3]) * war[6] + bf_hi(g0[3]) * war[7]
                        + bf_lo(g1[0]) * war[8] + bf_hi(g1[0]) * war[9] + bf_lo(g1[1]) * war[10] + bf_hi(g1[1]) * war[11] + bf_lo(g1[2]) * war[12] + bf_hi(g1[2]) * war[13] + bf_lo(g1[3]) * war[14] + bf_hi(g1[3]) * war[15];
                const float ls = fminf(x, 0.f) - 0.6931471805599453f * __builtin_amdgcn_logf(1.f + __builtin_amdgcn_exp2f(-1.4426950408889634f * fabsf(x)));
                cum += ls * (1.f / 16.f); bl[i] = cum; }
            gs[tq * 128 + d] = cum;
            __syncthreads();
            float off = 0.f, tot = 0.f;
#pragma unroll
            for (int q = 0; q < 4; ++q) { const float g = gs[q * 128 + d]; if (q < tq) off += g; tot += g; }
            unsigned kt[8];
#pragma unroll
            for (int i = 0; i < 16; ++i) { const float bt = off + bl[i]; const int t = tq * 16 + i;
                const float qv = bf2f(bq[t * 136 + d]), kv = bf2f(bk[t * 136 + d]);
                const float eb = __builtin_amdgcn_exp2f(1.4426950408889634f * bt);
                bq[t * 136 + d] = f2bf(qv * 0.08838834764831845f * eb); bk[t * 136 + d] = f2bf(kv * __builtin_amdgcn_rcpf(eb));
                const float kh = kv * __builtin_amdgcn_exp2f(1.4426950408889634f * (tot - bt));
                if (i & 1) kt[i >> 1] |= ((unsigned)f2bf(kh)) << 16; else kt[i >> 1] = f2bf(kh); }
            *(LAS u32x4*)(bkT + d * 72 + tq * 16) = (u32x4){kt[0], kt[1], kt[2], kt[3]}; *(LAS u32x4*)(bkT + d * 72 + tq * 16 + 8) = (u32x4){kt[4], kt[5], kt[6], kt[7]};
            if (tq == 0) gdl[(size_t)u * 128 + d] = __builtin_amdgcn_exp2f(1.4426950408889634f * tot);
        }
        {
            const int e = tid & 255, sg = tid >> 8;
#pragma unroll
            for (int q = 0; q < 4; ++q) { unsigned vt[4];
#pragma unroll
                for (int jj = 0; jj < 8; ++jj) { const bf16_t v = rv[(sg * 32 + q * 8 + jj) * 256 + e]; if (jj & 1) vt[jj >> 1] |= ((unsigned)v) << 16; else vt[jj >> 1] = v; }
                *(LAS u32x4*)(bvT + e * 72 + sg * 32 + q * 8) = (u32x4){vt[0], vt[1], vt[2], vt[3]}; }
        }
        __syncthreads();
        for (int i = tid; i < 1024; i += NTHR) { const int t = i >> 4, ch = i & 15; *(u32x4*)(gqt + (row0 + t) * 512 + h * 128 + ch * 8) = *(const LAS u32x4*)(bq + t * 136 + ch * 8); }
        if (w < 3) { const int tt = w == 0 ? 0 : 1, ss = w == 2 ? 1 : 0; f32x16 acc = {};
#pragma unroll
            for (int ks = 0; ks < 8; ++ks) { const bf16x8 a = *(const LAS bf16x8*)(bq + (tt * 32 + r32) * 136 + ks * 16 + hh * 8), bb = *(const LAS bf16x8*)(bk + (ss * 32 + r32) * 136 + ks * 16 + hh * 8);
                acc = __builtin_amdgcn_mfma_f32_32x32x16_bf16(a, bb, acc, 0, 0, 0); }
#pragma unroll
            for (int i = 0; i < 16; ++i) { const int t = tt * 32 + (i & 3) + 8 * (i >> 2) + 4 * hh, s = ss * 32 + r32; bA[t * 72 + s] = f2bf(t >= s ? acc[i] : 0.f); } }
        else if (w == 3) {
#pragma unroll
            for (int i = 0; i < 16; ++i) { const int t = (i & 3) + 8 * (i >> 2) + 4 * hh; bA[t * 72 + 32 + r32] = 0; } }
        __syncthreads();
        {
            f32x16 o0 = {}, o1 = {}, s0 = {}, s1 = {}, s2 = {}, s3 = {};
#pragma unroll
            for (int ks = 0; ks < 4; ++ks) { const bf16x8 vf = *(const LAS bf16x8*)(bvT + (w * 32 + r32) * 72 + ks * 16 + hh * 8);
                const bf16x8 a0 = *(const LAS bf16x8*)(bA + r32 * 72 + ks * 16 + hh * 8), a1 = *(const LAS bf16x8*)(bA + (32 + r32) * 72 + ks * 16 + hh * 8);
                o0 = __builtin_amdgcn_mfma_f32_32x32x16_bf16(a0, vf, o0, 0, 0, 0); o1 = __builtin_amdgcn_mfma_f32_32x32x16_bf16(a1, vf, o1, 0, 0, 0);
                const bf16x8 k0 = *(const LAS bf16x8*)(bkT + r32 * 72 + ks * 16 + hh * 8), k1 = *(const LAS bf16x8*)(bkT + (32 + r32) * 72 + ks * 16 + hh * 8),
                             k2 = *(const LAS bf16x8*)(bkT + (64 + r32) * 72 + ks * 16 + hh * 8), k3 = *(const LAS bf16x8*)(bkT + (96 + r32) * 72 + ks * 16 + hh * 8);
                s0 = __builtin_amdgcn_mfma_f32_32x32x16_bf16(vf, k0, s0, 0, 0, 0); s1 = __builtin_amdgcn_mfma_f32_32x32x16_bf16(vf, k1, s1, 0, 0, 0);
                s2 = __builtin_amdgcn_mfma_f32_32x32x16_bf16(vf, k2, s2, 0, 0, 0); s3 = __builtin_amdgcn_mfma_f32_32x32x16_bf16(vf, k3, s3, 0, 0, 0); }
#pragma unroll
            for (int i = 0; i < 16; ++i) { const int rr = (i & 3) + 8 * (i >> 2) + 4 * hh;
                ograw[(row0 + rr) * 1024 + h * 256 + w * 32 + r32] = o0[i]; ograw[(row0 + 32 + rr) * 1024 + h * 256 + w * 32 + r32] = o1[i];
                const float p0 = __shfl_xor(s0[i], 1), p1 = __shfl_xor(s1[i], 1), p2 = __shfl_xor(s2[i], 1), p3 = __shfl_xor(s3[i], 1);
                if ((r32 & 1) == 0) { unsigned* dp = (unsigned*)(gds + ((size_t)u * 256 + w * 32 + rr) * 128 + r32);
                    dp[0] = cvt_pk_bf16(s0[i], p0); dp[16] = cvt_pk_bf16(s1[i], p1); dp[32] = cvt_pk_bf16(s2[i], p2); dp[48] = cvt_pk_bf16(s3[i], p3); } }
        }
        __syncthreads();
    }
}
__device__ __forceinline__ void p_gla2(const Frame& F0) {
    const Frame F = phase_frame(F0);
    bf16_t* gds = (bf16_t*)(F.ws + WS_GDS); const float* gdl = (const float*)(F.ws + WS_GDL);
    for (int i = F.c * NTHR + F.tid; i < 32 * 4096; i += F.G * NTHR) {
        const int bh = i >> 12, e = (i >> 4) & 255, dg = i & 15;
        float st[8];
#pragma unroll
        for (int j = 0; j < 8; ++j) st[j] = 0.f;
        for (int c = 0; c < 32; ++c) { const size_t u = (size_t)bh * 32 + c; bf16_t* p = gds + (u * 256 + e) * 128 + dg * 8;
            const u32x4 dsv = *(const u32x4*)p; const f32x4 d0 = *(const f32x4*)(gdl + u * 128 + dg * 8), d1 = *(const f32x4*)(gdl + u * 128 + dg * 8 + 4);
            u32x4 o = {cvt_pk_bf16(st[0], st[1]), cvt_pk_bf16(st[2], st[3]), cvt_pk_bf16(st[4], st[5]), cvt_pk_bf16(st[6], st[7])};
            *(u32x4*)p = o;
            st[0] = d0[0] * st[0] + bf_lo(dsv[0]); st[1] = d0[1] * st[1] + bf_hi(dsv[0]); st[2] = d0[2] * st[2] + bf_lo(dsv[1]); st[3] = d0[3] * st[3] + bf_hi(dsv[1]);
            st[4] = d1[0] * st[4] + bf_lo(dsv[2]); st[5] = d1[1] * st[5] + bf_hi(dsv[2]); st[6] = d1[2] * st[6] + bf_lo(dsv[3]); st[7] = d1[3] * st[7] + bf_hi(dsv[3]); }
    }
}
__device__ __forceinline__ void p_gla3(const Frame& F0, int l) {
    const Frame F = phase_frame(F0);
    const bf16_t* proj = (const bf16_t*)(F.ws + WS_PROJ); const float* ng = F.in(8) + (size_t)l * 256;
    const float* ograw = (const float*)(F.ws + WS_OGRAW); const bf16_t* gds = (const bf16_t*)(F.ws + WS_GDS); const bf16_t* gqt = (const bf16_t*)(F.ws + WS_GQT); bf16_t* og = (bf16_t*)(F.ws + WS_OG);
    LAS float* ot = (LAS float*)F.lds;
    const int lane = F.lane, w = F.wave, r32 = lane & 31, hh = lane >> 5;
    for (int u = F.c; u < 1024; u += F.G) {
        const int c = u & 31, h = (u >> 5) & 3, b = u >> 7; const size_t row0 = (size_t)b * S + c * 64;
        f32x16 o0 = {}, o1 = {};
#pragma unroll
        for (int ks = 0; ks < 8; ++ks) { const bf16x8 sf = *(const bf16x8*)(gds + ((size_t)u * 256 + w * 32 + r32) * 128 + ks * 16 + hh * 8);
            const bf16x8 a0 = *(const bf16x8*)(gqt + (row0 + r32) * 512 + h * 128 + ks * 16 + hh * 8), a1 = *(const bf16x8*)(gqt + (row0 + 32 + r32) * 512 + h * 128 + ks * 16 + hh * 8);
            o0 = __builtin_amdgcn_mfma_f32_32x32x16_bf16(a0, sf, o0, 0, 0, 0); o1 = __builtin_amdgcn_mfma_f32_32x32x16_bf16(a1, sf, o1, 0, 0, 0); }
#pragma unroll
        for (int i = 0; i < 16; ++i) { const int rr = (i & 3) + 8 * (i >> 2) + 4 * hh;
            ot[rr * 260 + w * 32 + r32] = o0[i] + ograw[(row0 + rr) * 1024 + h * 256 + w * 32 + r32];
            ot[(32 + rr) * 260 + w * 32 + r32] = o1[i] + ograw[(row0 + 32 + rr) * 1024 + h * 256 + w * 32 + r32]; }
        __syncthreads();
#pragma unroll
        for (int q = 0; q < 8; ++q) { const int t = w * 8 + q; const f32x4 v = *(const LAS f32x4*)(ot + t * 260 + lane * 4);
            float ss = v[0] * v[0] + v[1] * v[1] + v[2] * v[2] + v[3] * v[3];
#pragma unroll
            for (int o = 32; o > 0; o >>= 1) ss += __shfl_xor(ss, o);
            const float rstd = rsqrtf(ss * (1.f / 256.f) + 1e-6f);
            const f32x4 gn = *(const f32x4*)(ng + lane * 4); const u32x2 gw = *(const u32x2*)(proj + (row0 + t) * LDP + P_GG + h * 256 + lane * 4);
            u32x2 ov; ov[0] = cvt_pk_bf16(v[0] * rstd * gn[0] * fast_silu(bf_lo(gw[0])), v[1] * rstd * gn[1] * fast_silu(bf_hi(gw[0])));
            ov[1] = cvt_pk_bf16(v[2] * rstd * gn[2] * fast_silu(bf_lo(gw[1])), v[3] * rstd * gn[3] * fast_silu(bf_hi(gw[1])));
            *(u32x2*)(og + (row0 + t) * 1024 + h * 256 + lane * 4) = ov; }
        __syncthreads();
    }
}

constexpr size_t WS_CHID = WS_GDL + al256((size_t)1024 * 128 * 4);
constexpr size_t WS_KC   = WS_CHID + al256((size_t)2 * 2048 * 256 * 2);
constexpr size_t WS_VCT  = WS_KC + al256((size_t)16 * 128 * 128 * 2);
constexpr size_t WS_END5 = WS_VCT + al256((size_t)16 * 128 * 128 * 2);

__device__ __forceinline__ void p_conv_cmp(const Frame& F0) {
    const Frame F = phase_frame(F0);
    const float* pe = F.in(3); const float* w1 = F.in(4); const float* w2 = F.in(5);
    bf16_t* wc2 = (bf16_t*)(F.ws + WS_WC2); float* bias1 = (float*)(F.ws + WS_BIAS1);
    for (int i = F.c * NTHR + F.tid; i < NL * 2 * 256 * 256; i += F.G * NTHR) { const int k = i & 255, n = (i >> 8) & 255, lc = i >> 16;
        wc2[i] = (k < 128 && n < 128) ? f2bf(w2[((size_t)lc * 128 + k) * 128 + n]) : (bf16_t)0; }
    LAS float* part = (LAS float*)F.lds;
    for (int lc = F.c; lc < NL * 2; lc += F.G) { const int o = F.tid & 127, kg = F.tid >> 7; float a = 0.f;
        for (int i = kg * 1024; i < kg * 1024 + 1024; ++i) a += pe[(size_t)lc * 4096 + i] * w1[((size_t)lc * 4096 + i) * 128 + o];
        part[kg * 128 + o] = a; __syncthreads();
        if (F.tid < 256) bias1[lc * 256 + F.tid] = F.tid < 128 ? part[F.tid] + part[128 + F.tid] + part[256 + F.tid] + part[384 + F.tid] : 0.f;
        __syncthreads(); }
}
struct SchedCmp1 {
    static constexpr bool GATHER = true;
    const char* proj; const char* W; int G, c;
    __device__ __forceinline__ bool next(int i, ge::Unit& u) const { const int L = i * G + c; if (L >= 16) return false; const int cc = L >> 3, pm = L & 7;
        u.A = proj + (size_t)(P_NKV + cc * 256) * 2; u.B = W + (size_t)cc * 256 * 4096 * 2; u.r0 = pm * 256; u.c0 = 0; u.aux = cc; u.aux2 = 0; return true; }
    __device__ __forceinline__ void voffA(const ge::Unit& u, int tid, unsigned (&v)[2][2]) const {
#pragma unroll
        for (int i = 0; i < 2; ++i) { int R, C; ge::stage_rc(tid * 16 + i * 8192, R, C);
#pragma unroll
            for (int hf = 0; hf < 2; ++hf) { const int r = u.r0 + hf * 128 + R; const int b = r >> 8, g = (r >> 7) & 1; int n = r & 127; n = n > 126 ? 126 : n;
                v[hf][i] = (unsigned)(((b * S + 16 * n) * LDP + g * 128 + C)) * 2u; } } }
};
struct EpiCmp1 {
    static constexpr bool PERM = true; bf16_t* hid; const float* bias1;
    __device__ __forceinline__ void operator()(const f32x4 (&acc)[2][2][4][2], const ge::Unit& u, int wr, int wc, int fr, int fq) const {
#pragma unroll
        for (int bj = 0; bj < 2; ++bj) { const int col = bj * 128 + wc * 32 + 8 * fq; const f32x4 b0 = *(const f32x4*)(bias1 + u.aux * 256 + col), b1 = *(const f32x4*)(bias1 + u.aux * 256 + col + 4);
#pragma unroll
            for (int ai = 0; ai < 2; ++ai)
#pragma unroll
                for (int m = 0; m < 4; ++m) { const f32x4 v0 = acc[ai][bj][m][0] + b0, v1 = acc[ai][bj][m][1] + b1;
                    u32x4 w = {cvt_pk_bf16(fast_silu(v0[0]), fast_silu(v0[1])), cvt_pk_bf16(fast_silu(v0[2]), fast_silu(v0[3])), cvt_pk_bf16(fast_silu(v1[0]), fast_silu(v1[1])), cvt_pk_bf16(fast_silu(v1[2]), fast_silu(v1[3]))};
                    *(u32x4*)(hid + ((size_t)u.aux * 2048 + u.r0 + ai * 128 + wr * 64 + m * 16 + fr) * 256 + col) = w; } }
    }
};
struct SchedCmp2 {
    static constexpr bool GATHER = false;
    const char* hid; const char* W; int G, c;
    __device__ __forceinline__ bool next(int i, ge::Unit& u) const { const int L = i * G + c; if (L >= 16) return false; const int cc = L >> 3, pm = L & 7;
        u.A = hid + ((size_t)cc * 2048 + pm * 256) * 256 * 2; u.B = W + (size_t)cc * 256 * 256 * 2; u.r0 = pm * 256; u.c0 = 0; u.aux = cc; u.aux2 = 0; return true; }
    __device__ __forceinline__ void voffA(const ge::Unit&, int tid, unsigned (&v)[2][2]) const { ge::dense_voffA(256, tid, v); }
};
struct EpiCmp2 {
    static constexpr bool PERM = false; bf16_t* kc; bf16_t* vct;
    __device__ __forceinline__ void operator()(const f32x4 (&acc)[2][2][4][2], const ge::Unit& u, int wr, int wc, int fr, int fq) const {
#pragma unroll
        for (int ai = 0; ai < 2; ++ai)
#pragma unroll
            for (int m = 0; m < 4; ++m) { const int r = u.r0 + ai * 128 + wr * 64 + m * 16 + fr; const int bg = r >> 7, n = r & 127;
#pragma unroll
                for (int nn = 0; nn < 2; ++nn) { const int d = wc * 32 + nn * 16 + 4 * fq; const f32x4 v = acc[ai][0][m][nn];
                    if (u.aux == 0) { u32x2 w = {cvt_pk_bf16(v[0], v[1]), cvt_pk_bf16(v[2], v[3])}; *(u32x2*)(kc + ((size_t)bg * 128 + n) * 128 + d) = w; }
                    else {
#pragma unroll
                        for (int j = 0; j < 4; ++j) vct[((size_t)bg * 128 + d + j) * 128 + n] = f2bf(v[j]); } } }
    }
};
__device__ __forceinline__ void p_nsa_cmp(const Frame& F0, int l) {
    const Frame F = phase_frame(F0);
    if (F.c >= 16) return;
    { SchedCmp1 S{(const char*)(F.ws + WS_PROJ), (const char*)(F.ws + WS_WC1) + (size_t)l * 2 * 256 * 4096 * 2, F.G, F.c};
      EpiCmp1 E{(bf16_t*)(F.ws + WS_CHID), (const float*)(F.ws + WS_BIAS1) + (size_t)l * 2 * 256};
      ge::gemm_phase<EpiCmp1, SchedCmp1, 1>(F.lds, F.tid, 4096, LDP * 2, S, E); }
    asm volatile("s_waitcnt vmcnt(0)" ::: "memory"); __syncthreads();
    { SchedCmp2 S{(const char*)(F.ws + WS_CHID), (const char*)(F.ws + WS_WC2) + (size_t)l * 2 * 256 * 256 * 2, F.G, F.c};
      EpiCmp2 E{(bf16_t*)(F.ws + WS_KC), (bf16_t*)(F.ws + WS_VCT)};
      ge::gemm_phase<EpiCmp2, SchedCmp2, 0>(F.lds, F.tid, 256, 0, S, E); }
}

__device__ __forceinline__ void p_nsa_cmpsel(const Frame& F0) {
    const Frame F = phase_frame(F0);
    const bf16_t* proj = (const bf16_t*)(F.ws + WS_PROJ); const bf16_t* kc = (const bf16_t*)(F.ws + WS_KC); const bf16_t* vct = (const bf16_t*)(F.ws + WS_VCT);
    bf16_t* on = (bf16_t*)(F.ws + WS_ON); unsigned* selm = (unsigned*)(F.ws + WS_SELMASK);
    LAS float* gl = (LAS float*)F.lds + F.wave * 32;
    const int lane = F.lane, w = F.wave, r32 = lane & 31, hi = lane >> 5;
    for (int u = F.c; u < NB * 2 * 32; u += F.G) {
        const int pb = u & 31, g = (u >> 5) & 1, b = u >> 6; const int bg = b * 2 + g;
        const int p = pb * 64 + w * 8 + (r32 >> 2), hd = g * 4 + (r32 & 3); const size_t t = (size_t)b * S + p;
        bf16x8 qf[8];
#pragma unroll
        for (int d0 = 0; d0 < 8; ++d0) qf[d0] = *(const bf16x8*)(proj + t * LDP + P_NQ + hd * 128 + d0 * 16 + hi * 8);
        f32x16 sc[4];
#pragma unroll
        for (int kt = 0; kt < 4; ++kt) { sc[kt] = f32x16{};
#pragma unroll
            for (int d0 = 0; d0 < 8; ++d0) { const bf16x8 kf = *(const bf16x8*)(kc + ((size_t)bg * 128 + kt * 32 + r32) * 128 + d0 * 16 + hi * 8);
                sc[kt] = __builtin_amdgcn_mfma_f32_32x32x16_bf16(kf, qf[d0], sc[kt], 0, 0, 0); } }
        const int nmax = p >= 31 ? (p - 31) >> 4 : -1;
        float mx = -1e30f;
#pragma unroll
        for (int kt = 0; kt < 4; ++kt)
#pragma unroll
            for (int i = 0; i < 16; ++i) { const int n = kt * 32 + (i & 3) + 8 * (i >> 2) + 4 * hi; const float s = n <= nmax ? sc[kt][i] * 0.08838834764831845f : -__builtin_inff(); sc[kt][i] = s; mx = fmaxf(mx, s); }
        mx = fmaxf(mx, __shfl_xor(mx, 32));
        float sum = 0.f;
#pragma unroll
        for (int kt = 0; kt < 4; ++kt)
#pragma unroll
            for (int i = 0; i < 16; ++i) { const float e = __expf(sc[kt][i] - mx); sc[kt][i] = e; sum += e; }
        sum += __shfl_xor(sum, 32);
        const float inv = sum > 0.f ? 1.f / sum : 0.f;
#pragma unroll
        for (int kt = 0; kt < 4; ++kt)
#pragma unroll
            for (int i = 0; i < 16; ++i) sc[kt][i] *= inv;
        f32x16 oc[4] = {};
#pragma unroll
        for (int kt = 0; kt < 4; ++kt) { bf16x8 pa0, pa1;
#define PK4(P, B_, OUT) do { unsigned a0 = cvt_pk_bf16(P[B_+0], P[B_+1]), a1 = cvt_pk_bf16(P[B_+2], P[B_+3]); unsigned b0 = cvt_pk_bf16(P[B_+4], P[B_+5]), b1 = cvt_pk_bf16(P[B_+6], P[B_+7]); \
        auto r0 = __builtin_amdgcn_permlane32_swap(a0, b0, false, false); auto r1 = __builtin_amdgcn_permlane32_swap(a1, b1, false, false); u32x4 w_ = {r0[0], r1[0], r0[1], r1[1]}; OUT = *reinterpret_cast<bf16x8*>(&w_); } while (0)
            PK4(sc[kt], 0, pa0); PK4(sc[kt], 8, pa1);
#undef PK4
#pragma unroll
            for (int dt = 0; dt < 4; ++dt) { const bf16x8 v0 = *(const bf16x8*)(vct + ((size_t)bg * 128 + dt * 32 + r32) * 128 + kt * 32 + hi * 8), v1 = *(const bf16x8*)(vct + ((size_t)bg * 128 + dt * 32 + r32) * 128 + kt * 32 + 16 + hi * 8);
                oc[dt] = __builtin_amdgcn_mfma_f32_32x32x16_bf16(pa0, v0, oc[dt], 0, 0, 0); oc[dt] = __builtin_amdgcn_mfma_f32_32x32x16_bf16(pa1, v1, oc[dt], 0, 0, 0); } }
        if (hi == 0) gl[r32] = fast_sigmoid(bf2f(proj[t * LDP + P_NG + hd * 3]));
        asm volatile("s_waitcnt lgkmcnt(0)" ::: "memory");
#pragma unroll
        for (int i = 0; i < 16; ++i) { const int rr = (i & 3) + 8 * (i >> 2) + 4 * hi; const float gt = gl[rr];
            const size_t tt = (size_t)b * S + pb * 64 + w * 8 + (rr >> 2); const int hh = g * 4 + (rr & 3);
#pragma unroll
            for (int dt = 0; dt < 4; ++dt) { const float v = oc[dt][i] * gt, vn = __shfl_xor(v, 1);
                if ((r32 & 1) == 0) *(unsigned*)(on + tt * 1024 + hh * 128 + dt * 32 + r32) = cvt_pk_bf16(v, vn); } }
#pragma unroll
        for (int kt = 0; kt < 4; ++kt)
#pragma unroll
            for (int i = 0; i < 16; ++i) { float v = sc[kt][i]; v += __shfl_xor(v, 1); v += __shfl_xor(v, 2); sc[kt][i] = v; }
        float imp[16];
#pragma unroll
        for (int kt = 0; kt < 4; ++kt)
#pragma unroll
            for (int q = 0; q < 4; ++q) { const float gsum = sc[kt][4 * q] + sc[kt][4 * q + 1] + sc[kt][4 * q + 2] + sc[kt][4 * q + 3];
                const float lastown = sc[kt][4 * q + 3]; const float lastprev = (kt * 4 + q) > 0 ? sc[(kt * 4 + q - 1) >> 2][4 * ((kt * 4 + q - 1) & 3) + 3] : 0.f;
                const float fromp_same = __shfl_xor(lastown, 32), fromp_prev = __shfl_xor(lastprev, 32);
                imp[kt * 4 + q] = gsum + (hi ? fromp_same : fromp_prev); }
        const int cb = p >> 6;
#pragma unroll
        for (int s_ = 0; s_ < 16; ++s_) { const int j = 8 * (s_ >> 2) + 2 * (s_ & 3) + hi; if (j == 0 || j == cb || j == cb - 1) imp[s_] = 1e9f; if (j > cb) imp[s_] = -1e30f; }
        unsigned mask = 0;
#pragma unroll
        for (int k = 0; k < 8; ++k) { float bv = -__builtin_inff(); int bj = 64;
#pragma unroll
            for (int s_ = 0; s_ < 16; ++s_) { const int j = 8 * (s_ >> 2) + 2 * (s_ & 3) + hi; if (imp[s_] > bv) { bv = imp[s_]; bj = j; } }
            const float ov = __shfl_xor(bv, 32); const int oj = __shfl_xor(bj, 32);
            const bool mine = (bv > ov) || (bv == ov && bj < oj); const int wj = mine ? bj : oj;
            mask |= 1u << wj;
#pragma unroll
            for (int s_ = 0; s_ < 16; ++s_) { const int j = 8 * (s_ >> 2) + 2 * (s_ & 3) + hi; if (j == wj) imp[s_] = -__builtin_inff(); } }
        if ((r32 & 3) == 0 && hi == 0) selm[t * 2 + g] = mask;
    }
}
constexpr int NSTEP = 1 + 11 * NL;

template <int l>
__device__ __forceinline__ void layer_steps(const Frame& F, const XcdBarrier& bar, const int lo, const int hi) {
#define IN(k) (lo <= (k) && (k) < hi)
#define SEAM(k) do { if (IN(k) && IN((k) + 1)) xcd_barrier(bar); } while (0)
    const int base = 1 + 11 * l;
    if (IN(base + 0)) { p_inproj(F, l);
#ifdef PROBE_INPROJ
        p_inproj(F, l);
#endif
#ifdef PROBE_INPROJ_LONGK
        p_inproj_longk(F, l);
#endif
#ifdef PROBE_INPROJ_SAME
        p_inproj_same(F, l);
#endif
#ifdef PROBE_INPROJ_NULL
        p_inproj_null(F, l);
#endif
    } SEAM(base + 0);
    if (IN(base + 1)) { p_nsa_cmp(F, l); p_moba_prep(F, 16); p_gla1(F, l, 16);
#ifdef PROBE_S1
        p_nsa_cmp(F, l); p_moba_prep(F, 16); p_gla1(F, l, 16);
#endif
#ifdef PROBE_GLA1
        p_gla1(F, l, 16);
#endif
#ifdef PROBE_MOBAPREP
        p_moba_prep(F, 16);
#endif
#ifdef PROBE_NSACMP
        p_nsa_cmp(F, l);
#endif
    } SEAM(base + 1);
    if (IN(base + 2)) { p_moba_attn(F);
#ifdef PROBE_MOBA
        p_moba_attn(F);
#endif
#ifdef PROBE_MOBA512
        p_moba_attn_t<512, true>(F);
#endif
#ifdef PROBE_MOBAFULL
        p_moba_attn_t<(1 << 20), true>(F);
#endif
        p_nsa_cmpsel(F); p_gla2(F); } SEAM(base + 2);
    if (IN(base + 3)) {
#ifndef PROBE_SKIP_NSA
        p_nsa_attn(F);
#endif
        p_gla3(F, l);
#ifdef PROBE_GLA3
        p_gla3(F, l);
#endif
    } SEAM(base + 3);
    if (IN(base + 4)) { p_merge(F, l);
#ifdef PROBE_MERGE
        p_merge(F, l);
#endif
    } SEAM(base + 4);
    if (IN(base + 5)) { p_wout(F, l); } SEAM(base + 5);
    if (IN(base + 6)) { p_route1(F, l); p_conv_experts(F, l);
#ifdef PROBE_CONVX
        p_conv_experts(F, l);
#endif
    } SEAM(base + 6);
    if (IN(base + 7)) { p_route2(F, l); } SEAM(base + 7);
    if (IN(base + 8)) { p_moe_gu(F, l);
#ifdef PROBE_GU
        p_moe_gu(F, l);
#endif
    } SEAM(base + 8);
    if (IN(base + 9)) { p_moe_down(F, l);
#ifdef PROBE_DOWN
        p_moe_down(F, l);
#endif
    } SEAM(base + 9);
    if (IN(base + 10)) { if (l + 1 < NL) p_combine<0>(F, l + 1); else p_combine<1>(F, 0); }
    if (l + 1 < NL) SEAM(base + 10);
#undef SEAM
#undef IN
}

__global__ void __launch_bounds__(NTHR, 2) k_fwd(Args args) {
    extern __shared__ __attribute__((aligned(16))) unsigned char lds_raw[];
    Frame F; F.lds = (LAS unsigned char*)lds_raw; F.tid = threadIdx.x; F.lane = F.tid & 63; F.wave = __builtin_amdgcn_readfirstlane(F.tid >> 6);
    F.G = gridDim.x; F.c = blockIdx.x; F.ws = args.ws;
    if (F.tid == 0) {
#pragma unroll
        for (int i = 0; i < 22; ++i) *(LAS unsigned long long*)(F.lds + LDS_ARGS + i * 8) = (unsigned long long)args.in[i];
        *(LAS unsigned long long*)(F.lds + LDS_ARGS + 22 * 8) = (unsigned long long)args.out;
        *(LAS unsigned long long*)(F.lds + LDS_XB) = 0ull; *(LAS unsigned long long*)(F.lds + LDS_XB + 8) = 0ull;
    }
    __syncthreads();
    const int lo = args.ph_lo, hi = args.ph_hi;
    XcdBarrier bar; bar.bar = (unsigned*)(args.ws + WS_CTL) + CW_BAR; bar.x = 0; bar.st = (volatile LAS unsigned*)(F.lds + LDS_XB);
    if (hi - lo > 1) bar = xcd_barrier_post((unsigned*)(args.ws + WS_CTL) + CW_BAR, (volatile LAS unsigned*)(F.lds + LDS_XB));
    if (lo <= 0 && 0 < hi) { p_conv_static(F); p_conv_router(F); p_conv_cmp(F); p_rmsnorm(F, 0);
#ifdef PROBE_CONV
        p_conv_static(F);
#endif
 if (1 < hi) xcd_barrier(bar); }
    layer_steps<0>(F, bar, lo, hi);
    layer_steps<1>(F, bar, lo, hi);
#ifdef DIAG_MODE
    xcd_barrier(bar);
    if (F.c == 0 && F.tid == 0) args.out[0] = *(LAS float*)(F.lds + LDS_MISC + 4000);
#endif
}

static int g_grid = 0;
extern "C" void kernel_launch(void* const* d_in, const int* in_sizes, int n_in,
                              void* d_out, int out_size, void* d_ws, size_t ws_size,
                              hipStream_t stream) {
    if (g_grid == 0) {
        int dev = 0, cus = 0; (void)hipGetDevice(&dev); (void)hipDeviceGetAttribute(&cus, hipDeviceAttributeMultiprocessorCount, dev);
        (void)hipFuncSetAttribute((const void*)k_fwd, hipFuncAttributeMaxDynamicSharedMemorySize, LDS_BYTES);
        int per_cu = 0; (void)hipOccupancyMaxActiveBlocksPerMultiprocessor(&per_cu, (const void*)k_fwd, NTHR, LDS_BYTES);
        g_grid = (cus > 0 ? cus : 256) * (per_cu >= 1 ? 1 : 1);
    }
    if (ws_size < WS_END5 || ws_size < WS_NEED || WS_END5 > WS_H8) return;
    Args a{}; for (int i = 0; i < 22; ++i) a.in[i] = (const float*)d_in[i];
    a.out = (float*)d_out; a.ws = (unsigned char*)d_ws;
    (void)hipMemsetAsync((unsigned char*)d_ws + WS_CTL, 0, CTL_BYTES, stream);
#ifdef MULTI_LAUNCH
    for (int s = 0; s < NSTEP; ++s) { a.ph_lo = s; a.ph_hi = s + 1; hipLaunchKernelGGL(k_fwd, dim3(g_grid), dim3(NTHR), LDS_BYTES, stream, a); }
#else
    a.ph_lo = 0; a.ph_hi = NSTEP;
    hipLaunchKernelGGL(k_fwd, dim3(g_grid), dim3(NTHR), LDS_BYTES, stream, a);
#endif
}
```

```cpp
#include <hip/hip_runtime.h>
#include <hip/hip_bf16.h>
#include <stdint.h>
#include <math.h>

constexpr int D=2048, NB=8, S=2048, T=NB*S, NL=2;
constexpr int INW=14888;
constexpr int O_MQ=0,O_MK=1024,O_MV=2048,O_NQ=3072,O_NKV=4096,O_NG=5632,O_GQ=5656,O_GK=6168,O_GV=6680,O_GA=7704,O_GG=7720,O_MG=8744;
using f32x16 = __attribute__((ext_vector_type(16))) float;
using f32x4  = __attribute__((ext_vector_type(4))) float;
using bf16x8 = __attribute__((ext_vector_type(8))) short;
#define LAS __attribute__((address_space(3)))
typedef unsigned short bf16_t;
typedef unsigned u32x4 __attribute__((ext_vector_type(4)));
typedef unsigned u32x2 __attribute__((ext_vector_type(2)));
typedef float f32x2 __attribute__((ext_vector_type(2)));

__device__ __forceinline__ unsigned cvt_pk_bf16(float lo, float hi) { unsigned r; asm volatile("v_cvt_pk_bf16_f32 %0, %1, %2" : "=v"(r) : "v"(lo), "v"(hi)); return r; }
__device__ __forceinline__ float bf_lo(unsigned w) { return __uint_as_float(w << 16); }
__device__ __forceinline__ float bf_hi(unsigned w) { return __uint_as_float(w & 0xffff0000u); }
__device__ __forceinline__ float bf2f(bf16_t b) { return __uint_as_float(((unsigned)b) << 16); }
__device__ __forceinline__ bf16_t f2bf(float f) { unsigned u = __float_as_uint(f); u += 0x7FFFu + ((u >> 16) & 1u); return (bf16_t)(u >> 16); }
__device__ __forceinline__ float fast_sigmoid(float x) { return __builtin_amdgcn_rcpf(1.f + __builtin_amdgcn_exp2f(-1.4426950408889634f * x)); }
__device__ __forceinline__ float fast_silu(float x) { return x * fast_sigmoid(x); }

#ifndef GE_SP2_DEFAULT
#define GE_SP2_DEFAULT true
#endif
#ifndef GE_ALIGN_DEFAULT
#define GE_ALIGN_DEFAULT true
#endif
namespace ge {
constexpr int BM = 256, BK = 64, HALF = 128, HTB = HALF * BK * 2, STAGE_BYTES = 8 * HTB, NXCD = 8, WGM = 8;
__host__ __device__ __forceinline__ int lds_byte(int r, int c) { const int st = (r >> 4) * 2 + (c >> 5), rr = r & 15, cc = c & 31, ob = rr * 64 + cc * 2; return st * 1024 + (ob ^ (((ob >> 9) & 1) << 5)); }
__host__ __device__ __forceinline__ void stage_rc(int b, int& R, int& C) { const int st = b / 1024, sb = b % 1024, swz = sb ^ (((sb >> 9) & 1) << 5); R = (st >> 1) * 16 + swz / 64; C = (st & 1) * 32 + (swz % 64) / 2; }
__host__ __device__ __forceinline__ int perm32(int rho) { const int n = rho >> 4, i = rho & 15; return 8 * (i >> 2) + 4 * n + (i & 3); }

typedef int i32x8 __attribute__((ext_vector_type(8)));
typedef int i32x4 __attribute__((ext_vector_type(4)));
__device__ __forceinline__ i32x8 cat8(bf16x8 a, bf16x8 b) { const i32x4 x = *reinterpret_cast<i32x4*>(&a), y = *reinterpret_cast<i32x4*>(&b); return (i32x8){x[0], x[1], x[2], x[3], y[0], y[1], y[2], y[3]}; }
constexpr int F8_SCALE_A = 0x7B7B7B7B, F8_SCALE_B = 0x76767676;
struct Unit { const char* A; const char* B; int r0; int c0; int aux; int aux2; };

__device__ __forceinline__ bool static_tile(int i, int G, int c, int nM, int nN, int& pm, int& pn) {
    const int nwg = nM * nN; const long L = (long)i * G + c; if (L >= nwg) return false;
    int wgid = (int)L; { const int q = nwg / NXCD, r = nwg % NXCD, xcd = wgid % NXCD, off = wgid / NXCD; wgid = (xcd < r ? xcd * (q + 1) : r * (q + 1) + (xcd - r) * q) + off; }
    const int nig = WGM * nN, gid = wgid / nig, fm = gid * WGM, gsz = (nM - fm) < WGM ? (nM - fm) : WGM;
    pm = fm + ((wgid % nig) % gsz); pn = (wgid % nig) / gsz; return true;
}

template <class Epi, class Sched, int KMODE, bool F8 = false, bool SP2 = GE_SP2_DEFAULT, bool ALIGN_EPI = GE_ALIGN_DEFAULT, int SCALE_A = F8_SCALE_A>
__device__ __forceinline__ void gemm_phase(LAS unsigned char* lds, const int tid_in, const int K, const int kbig, const Sched& S, const Epi& E) {
    int tid_ = tid_in; asm volatile("" : "+v"(tid_));
    const int tid = tid_, wid = __builtin_amdgcn_readfirstlane(tid >> 6), lane = tid & 63, wr = wid >> 2, wc = wid & 3, fr = lane & 15, fq = lane >> 4;
    const int nt = F8 ? K / 128 : K / BK;
    unsigned voffB[2];
#pragma unroll
    for (int i = 0; i < 2; ++i) { int R, C; stage_rc(tid * 16 + i * 8192, R, C); const int Rb = Epi::PERM ? ((R & ~31) + perm32(R & 31)) : R; voffB[i] = F8 ? (unsigned)(Rb * K + C * 2) : (unsigned)(Rb * K + C) * 2u; }
    const size_t hstepB = F8 ? (size_t)HALF * K : (size_t)HALF * K * 2;
    const unsigned ldsw = (unsigned)wid * 1024u;
    const int aoff = F8 ? lds_byte(wr * 64 + fr, fq * 16) : lds_byte(wr * 64 + fr, fq * 8), boff = F8 ? lds_byte(wc * 32 + fr, fq * 16) : lds_byte(wc * 32 + fr, fq * 8);
    const int aoff1 = F8 ? lds_byte(wr * 64 + fr, fq * 16 + 8) - aoff : 1024, boff1 = F8 ? lds_byte(wc * 32 + fr, fq * 16 + 8) - boff : 1024;
#define GE_KOFF(t) (KMODE == 0 ? (size_t)(t) * 128 : (size_t)((t) >> 1) * (size_t)kbig + (size_t)((t) & 1) * 128)
#define GE_SA(b, h) (((b) * 2 + (h)) * HTB)
#define GE_SB(b, h) ((4 + (b) * 2 + (h)) * HTB)
#define GE_STAGE_B(bufoff, gbase) do { _Pragma("unroll") for (int _i = 0; _i < 2; ++_i) \
        __builtin_amdgcn_global_load_lds((const unsigned*)((const char*)(gbase) + voffB[_i]), (LAS unsigned*)(lds + (bufoff) + ldsw + _i * 8192), 16, 0, 0); } while (0)
#define GE_STAGE_A(bufoff, gbase, v0, v1) do { \
        __builtin_amdgcn_global_load_lds((const unsigned*)((const char*)(gbase) + (v0)), (LAS unsigned*)(lds + (bufoff) + ldsw), 16, 0, 0); \
        __builtin_amdgcn_global_load_lds((const unsigned*)((const char*)(gbase) + (v1)), (LAS unsigned*)(lds + (bufoff) + ldsw + 8192), 16, 0, 0); } while (0)
#define GE_LDA(dst, b, h) do { _Pragma("unroll") for (int m = 0; m < 4; ++m) _Pragma("unroll") for (int k = 0; k < 2; ++k) dst[m][k] = *(const LAS bf16x8*)(lds + GE_SA(b, h) + aoff + m * 2048 + k * aoff1); } while (0)
#define GE_LDB(dst, b, h) do { _Pragma("unroll") for (int n = 0; n < 2; ++n) _Pragma("unroll") for (int k = 0; k < 2; ++k) dst[n][k] = *(const LAS bf16x8*)(lds + GE_SB(b, h) + boff + n * 2048 + k * boff1); } while (0)
#define GE_MMA(ai, bj, At, Bt) do { __builtin_amdgcn_s_setprio(1); _Pragma("unroll") for (int m = 0; m < 4; ++m) _Pragma("unroll") for (int n = 0; n < 2; ++n) { \
        if constexpr (F8) { const i32x8 b8_ = ge::cat8(Bt[n][0], Bt[n][1]), a8_ = ge::cat8(At[m][0], At[m][1]); \
              \
            asm volatile("v_mfma_scale_f32_16x16x128_f8f6f4 %0, %1, %2, %0, %3, %4 op_sel_hi:[0,0,0]" : "+v"(acc[ai][bj][m][n]) : "v"(b8_), "v"(a8_), "v"(f8sb), "v"(f8sa)); } \
        else { _Pragma("unroll") for (int k = 0; k < 2; ++k) acc[ai][bj][m][n] = __builtin_amdgcn_mfma_f32_16x16x32_bf16(Bt[n][k], At[m][k], acc[ai][bj][m][n], 0, 0, 0); } } \
        if constexpr (F8) asm volatile("s_nop 7" ::: "memory"); \
        __builtin_amdgcn_s_setprio(0); } while (0)
#define GE_WAIT_V(n) asm volatile("s_waitcnt vmcnt(" #n ")" ::: "memory")
#define GE_WAIT_L(n) asm volatile("s_waitcnt lgkmcnt(" #n ")" ::: "memory")
#define GE_BAR __builtin_amdgcn_s_barrier()
#define GE_SCHED __builtin_amdgcn_sched_barrier(0)
    Unit cur, nxt; int ui = 0;
    if (!S.next(0, cur)) return;
    int f8sa = SCALE_A, f8sb = F8_SCALE_B; if constexpr (F8) asm volatile("" : "+v"(f8sa), "+v"(f8sb));
    f32x4 acc[2][2][4][2];
#pragma unroll
    for (int a = 0; a < 2; ++a)
#pragma unroll
        for (int b = 0; b < 2; ++b)
#pragma unroll
            for (int m = 0; m < 4; ++m)
#pragma unroll
                for (int n = 0; n < 2; ++n) acc[a][b][m][n] = (f32x4){0.f, 0.f, 0.f, 0.f};
    bf16x8 At[4][2], B0[2][2], B1[2][2];
    unsigned va[2][2], vn[2][2];
    S.voffA(cur, tid, va);
    const char* cA = cur.A; const char* cB = cur.B;
    if constexpr (SP2) {
        GE_STAGE_B(GE_SB(0, 0), cB); GE_STAGE_B(GE_SB(0, 1), cB + hstepB); GE_STAGE_A(GE_SA(0, 0), cA, va[0][0], va[0][1]); GE_STAGE_A(GE_SA(0, 1), cA, va[1][0], va[1][1]);
        if (wr == 1) GE_BAR;
        GE_WAIT_V(2); GE_BAR;
        GE_STAGE_B(GE_SB(1, 0), cB + 128); GE_STAGE_A(GE_SA(1, 0), cA + GE_KOFF(1), va[0][0], va[0][1]); GE_STAGE_B(GE_SB(1, 1), cB + hstepB + 128);
        GE_WAIT_V(6); GE_BAR;
    } else {
    GE_STAGE_B(GE_SB(0, 0), cB); GE_STAGE_A(GE_SA(0, 0), cA, va[0][0], va[0][1]); GE_STAGE_B(GE_SB(0, 1), cB + hstepB); GE_STAGE_A(GE_SA(0, 1), cA, va[1][0], va[1][1]);
    if (wr == 1) GE_BAR;
    GE_WAIT_V(4); GE_BAR;
    GE_STAGE_B(GE_SB(1, 0), cB + 128); GE_STAGE_A(GE_SA(1, 0), cA + GE_KOFF(1), va[0][0], va[0][1]); GE_STAGE_B(GE_SB(1, 1), cB + hstepB + 128);
    GE_WAIT_V(6); GE_BAR;
    }
    for (;;) {
        const bool has_next = S.next(ui + 1, nxt);
        if constexpr (Sched::GATHER) { if (has_next) S.voffA(nxt, tid, vn); else { vn[0][0] = va[0][0]; vn[0][1] = va[0][1]; vn[1][0] = va[1][0]; vn[1][1] = va[1][1]; } }
        const char* nA = has_next ? nxt.A : cA; const char* nB = has_next ? nxt.B : cB;
        for (int t = 0; t < nt; t += 2) {
            const bool last = (t == nt - 2);
            const char* a1 = cA + GE_KOFF(t + 1);
            const char* a2 = last ? nA : cA + GE_KOFF(t + 2); const char* b2 = last ? nB : cB + (size_t)(t + 2) * 128;
            const char* a3 = last ? nA + GE_KOFF(1) : cA + GE_KOFF(t + 3); const char* b3 = b2 + 128;
            unsigned w00 = va[0][0], w01 = va[0][1], w10 = va[1][0], w11 = va[1][1];
            if constexpr (Sched::GATHER) { if (last) { w00 = vn[0][0]; w01 = vn[0][1]; w10 = vn[1][0]; w11 = vn[1][1]; } }
            if constexpr (SP2) {
            GE_LDB(B0, 0, 0); GE_LDB(B1, 0, 1); GE_SCHED; GE_LDA(At, 0, 0); GE_STAGE_A(GE_SA(1, 1), a1, va[1][0], va[1][1]);
            GE_WAIT_V(8); GE_WAIT_L(0); GE_BAR; GE_MMA(0, 0, At, B0); GE_MMA(0, 1, At, B1); GE_BAR; GE_SCHED;
            GE_LDA(At, 0, 1); GE_STAGE_B(GE_SB(0, 0), b2); GE_STAGE_B(GE_SB(0, 1), b2 + hstepB); GE_STAGE_A(GE_SA(0, 0), a2, w00, w01);
            GE_WAIT_V(8); GE_WAIT_L(0); GE_BAR; GE_MMA(1, 0, At, B0); GE_MMA(1, 1, At, B1); GE_BAR; GE_SCHED;
            GE_LDB(B0, 1, 0); GE_LDB(B1, 1, 1); GE_SCHED; GE_LDA(At, 1, 0); GE_STAGE_A(GE_SA(0, 1), a2, w10, w11);
            GE_WAIT_V(8); GE_WAIT_L(0); GE_BAR; GE_MMA(0, 0, At, B0); GE_MMA(0, 1, At, B1); GE_BAR; GE_SCHED;
            GE_LDA(At, 1, 1); GE_STAGE_B(GE_SB(1, 0), b3); GE_STAGE_B(GE_SB(1, 1), b3 + hstepB); GE_STAGE_A(GE_SA(1, 0), a3, w00, w01);
            GE_WAIT_V(8); GE_WAIT_L(0); GE_BAR; GE_MMA(1, 0, At, B0); GE_MMA(1, 1, At, B1); GE_BAR; GE_SCHED;
            } else {
            GE_LDB(B0, 0, 0); GE_SCHED; GE_LDA(At, 0, 0); GE_STAGE_A(GE_SA(1, 1), a1, va[1][0], va[1][1]);
            GE_WAIT_L(8); GE_BAR; GE_WAIT_L(0); GE_MMA(0, 0, At, B0); GE_BAR; GE_SCHED;
            GE_LDB(B1, 0, 1); GE_STAGE_B(GE_SB(0, 0), b2);
            GE_BAR; GE_WAIT_L(0); GE_MMA(0, 1, At, B1); GE_BAR;
            GE_LDA(At, 0, 1); GE_STAGE_A(GE_SA(0, 0), a2, w00, w01);
            GE_BAR; GE_WAIT_L(0); GE_MMA(1, 0, At, B0); GE_BAR; GE_SCHED;
            GE_STAGE_B(GE_SB(0, 1), b2 + hstepB);
            GE_WAIT_V(6); GE_BAR; GE_MMA(1, 1, At, B1); GE_BAR;
            GE_LDB(B0, 1, 0); GE_SCHED; GE_LDA(At, 1, 0); GE_STAGE_A(GE_SA(0, 1), a2, w10, w11);
            GE_WAIT_L(8); GE_BAR; GE_WAIT_L(0); GE_MMA(0, 0, At, B0); GE_BAR; GE_SCHED;
            GE_LDB(B1, 1, 1); GE_STAGE_B(GE_SB(1, 0), b3);
            GE_BAR; GE_WAIT_L(0); GE_MMA(0, 1, At, B1); GE_BAR;
            GE_LDA(At, 1, 1); GE_STAGE_A(GE_SA(1, 0), a3, w00, w01);
            GE_BAR; GE_WAIT_L(0); GE_MMA(1, 0, At, B0); GE_BAR; GE_SCHED;
            GE_STAGE_B(GE_SB(1, 1), b3 + hstepB);
            GE_WAIT_V(6); GE_BAR; GE_MMA(1, 1, At, B1); GE_BAR;
            }
        }
        if constexpr (ALIGN_EPI) { if (wr == 0) GE_BAR; }
        E(acc, cur, wr, wc, fr, fq);
        if (!has_next) break;
#pragma unroll
        for (int a = 0; a < 2; ++a)
#pragma unroll
            for (int b = 0; b < 2; ++b)
#pragma unroll
                for (int m = 0; m < 4; ++m)
#pragma unroll
                    for (int n = 0; n < 2; ++n) acc[a][b][m][n] = (f32x4){0.f, 0.f, 0.f, 0.f};
        cur = nxt; cA = nA; cB = nB; ++ui;
        if constexpr (Sched::GATHER) { va[0][0] = vn[0][0]; va[0][1] = vn[0][1]; va[1][0] = vn[1][0]; va[1][1] = vn[1][1]; }
        if constexpr (ALIGN_EPI) { if (wr == 1) GE_BAR; }
    }
    GE_WAIT_V(0);
    if constexpr (!ALIGN_EPI) { if (wr == 0) GE_BAR; }
    GE_BAR;
#undef GE_KOFF
#undef GE_SA
#undef GE_SB
#undef GE_STAGE_A
#undef GE_STAGE_B
#undef GE_LDA
#undef GE_LDB
#undef GE_MMA
#undef GE_WAIT_V
#undef GE_WAIT_L
#undef GE_BAR
#undef GE_SCHED
}

template <bool F8 = false>
__device__ __forceinline__ void dense_voffA(int lda, int tid, unsigned (&v)[2][2]) {
#pragma unroll
    for (int i = 0; i < 2; ++i) { int R, C; stage_rc(tid * 16 + i * 8192, R, C); v[0][i] = F8 ? (unsigned)(R * lda + C * 2) : (unsigned)(R * lda + C) * 2u; v[1][i] = F8 ? (unsigned)((R + HALF) * lda + C * 2) : (unsigned)((R + HALF) * lda + C) * 2u; }
}
}
#define XB_TMO      128
#define XB_XCNT(j)  (256  + 64 * (j))
#define XB_XSUB(j)  (1280 + 64 * (j))
#define XB_XGEN(j)  (2304 + 64 * (j))
#define XB_TOP      3328
#define XB_TOPGEN   3392
#define XCD_BAR_WORDS 3456
#define XB_SPIN_CAP (1u << 18)

__device__ __forceinline__ unsigned xb_ld(unsigned* p)              { return __hip_atomic_load(p, __ATOMIC_RELAXED, __HIP_MEMORY_SCOPE_AGENT); }
__device__ __forceinline__ unsigned xb_add(unsigned* p, unsigned v) { return __hip_atomic_fetch_add(p, v, __ATOMIC_RELAXED, __HIP_MEMORY_SCOPE_AGENT); }
__device__ __forceinline__ unsigned xb_xcc_id() { return (unsigned)__builtin_amdgcn_s_getreg((3 << 11) | 20) & 0xFu; }
#define XB_SPIN(cond, bar) do { unsigned _sp = 0; while (cond) { __builtin_amdgcn_s_sleep(1); \
    if ((++_sp & 255u) == 0u) { if (xb_ld(&(bar)[XB_TMO])) break; if (_sp > XB_SPIN_CAP) { atomicAdd(&(bar)[XB_TMO], 1u); break; } } } } while (0)

struct XcdBarrier {
    unsigned* bar; unsigned x;
    volatile LAS unsigned* st;
};

__device__ __forceinline__ XcdBarrier xcd_barrier_post(unsigned* bar, volatile LAS unsigned* st) {
    XcdBarrier b; b.bar = bar; b.x = xb_xcc_id(); b.st = st;
    if (threadIdx.x == 0) (void)xb_add(&bar[XB_XCNT(b.x)], 1u);
    return b;
}
__device__ __forceinline__ void xcd_barrier_complete(unsigned* bar, unsigned x, unsigned& nloc, unsigned& nx) {
    const unsigned G = gridDim.x * gridDim.y * gridDim.z;
    unsigned sum, cnt, mine, sp = 0u;
    for (;;) {
        sum = 0u; cnt = 0u; mine = 0u;
#pragma unroll
        for (unsigned j = 0; j < 16; ++j) { const unsigned c = xb_ld(&bar[XB_XCNT(j)]); sum += c; cnt += (c > 0u) ? 1u : 0u; mine = (j == x) ? c : mine; }
        if (sum == G) break;
        __builtin_amdgcn_s_sleep(1);
        if ((++sp & 255u) == 0u) { if (xb_ld(&bar[XB_TMO])) break; if (sp > XB_SPIN_CAP) { atomicAdd(&bar[XB_TMO], 1u); break; } }
    }
    nloc = mine > 0u ? mine : 1u; nx = cnt > 0u ? cnt : 1u;
}

__device__ __forceinline__ void xcd_barrier(const XcdBarrier& b) {
    asm volatile("s_waitcnt vmcnt(0)" ::: "memory");
    __syncthreads();
    if (threadIdx.x == 0) {
        unsigned* bar = b.bar;
        __builtin_amdgcn_s_waitcnt(0);
        unsigned nloc = b.st[0], nx = b.st[1];
        if (nloc == 0u) { xcd_barrier_complete(bar, b.x, nloc, nx); b.st[0] = nloc; b.st[1] = nx; }
        const unsigned old = xb_add(&bar[XB_XSUB(b.x)], 1u);
        const unsigned gen = old / nloc;
        if (old + 1u == (gen + 1u) * nloc) {
            __builtin_amdgcn_fence(__ATOMIC_RELEASE, "agent");
            asm volatile("s_waitcnt vmcnt(0)" ::: "memory");
            const unsigned og = xb_add(&bar[XB_TOP], 1u);
            const unsigned tg = og / nx;
            if (og + 1u == (tg + 1u) * nx) xb_add(&bar[XB_TOPGEN], 1u);
            else XB_SPIN(xb_ld(&bar[XB_TOPGEN]) == tg, bar);
            __builtin_amdgcn_fence(__ATOMIC_ACQUIRE, "agent");
            xb_add(&bar[XB_XGEN(b.x)], 1u);
            asm volatile("s_waitcnt vmcnt(0)" ::: "memory");
        } else {
            XB_SPIN(xb_ld(&bar[XB_XGEN(b.x)]) == gen, bar);
            __builtin_amdgcn_fence(__ATOMIC_ACQUIRE, "agent");
            asm volatile("s_waitcnt vmcnt(0)" ::: "memory");
        }
    }
    __syncthreads();
}

constexpr int LDP = 15104;
constexpr int P_MQ=0,P_MK=1024,P_MV=2048,P_NQ=3072,P_NKV=4096,P_GQ=5632,P_GK=6144,P_GV=6656,P_GG=7680,P_MG=8704,P_NG=14848,P_GA=14872;
constexpr int NTHR = 512;
#ifndef MOE_F8
#define MOE_F8 1
#endif
#ifndef INPROJ_F8
#define INPROJ_F8 2
#endif
constexpr int LDS_BYTES = 147456;
constexpr int MOE_ROWS = 40960;
constexpr int MOE_TILES = MOE_ROWS / 256;

constexpr size_t al256(size_t x) { return (x + 255) & ~(size_t)255; }
constexpr size_t WS_CTL   = 0;
constexpr size_t CTL_BYTES = 65536;
constexpr size_t WS_WIN   = WS_CTL + CTL_BYTES;
constexpr size_t WS_WBR   = WS_WIN + al256((size_t)NL * LDP * 2048 * 2);
constexpr size_t WS_WOUT  = WS_WBR + al256((size_t)NL * 3 * 2048 * 1024 * 2);
constexpr size_t WS_WC1   = WS_WOUT + al256((size_t)NL * 2048 * 2048 * 2);
constexpr size_t WS_WC2   = WS_WC1 + al256((size_t)NL * 2 * 256 * 4096 * 2);
constexpr size_t WS_BIAS1 = WS_WC2 + al256((size_t)NL * 2 * 256 * 256 * 2);
constexpr size_t WS_WGU   = WS_BIAS1 + al256((size_t)NL * 2 * 256 * 4);
constexpr size_t WS_WD    = WS_WGU + al256((size_t)32 * 1024 * 2048 * 2);
constexpr size_t WS_H     = WS_WD + al256((size_t)32 * 2048 * 512 * 2);
constexpr size_t WS_PROJ  = WS_H + al256((size_t)T * 2048 * 2);
constexpr size_t WS_OM    = WS_PROJ + al256((size_t)T * LDP * 2);
constexpr size_t WS_ON    = WS_OM + al256((size_t)T * 1024 * 2);
constexpr size_t WS_OG    = WS_ON + al256((size_t)T * 1024 * 2);
constexpr size_t WS_MERGED= WS_OG + al256((size_t)T * 1024 * 2);
constexpr size_t WS_MISC  = WS_MERGED + al256((size_t)T * 2048 * 2);
constexpr size_t WS_KMEAN = WS_MISC;
constexpr size_t WS_KVC   = WS_KMEAN + al256((size_t)NB * 8 * 8 * 128 * 4);
constexpr size_t WS_DEC   = WS_KVC + al256((size_t)NB * 127 * 4 * 128 * 4);
constexpr size_t WS_OGRAW = WS_H;
constexpr size_t WS_ROUTE = WS_DEC + al256((size_t)T * 512 * 4);
constexpr size_t WS_ROWTOK= WS_ROUTE + al256((size_t)T * 8 * 4);
constexpr size_t WS_ROWW  = WS_ROWTOK + al256((size_t)MOE_ROWS * 4);
constexpr size_t WS_TILEE = WS_ROWW + al256((size_t)MOE_ROWS * 4);
constexpr size_t WS_END_SMALL = WS_TILEE + al256((size_t)(MOE_TILES + 64) * 4);
constexpr size_t WS_HID   = WS_PROJ;
constexpr size_t WS_YBUF  = WS_HID + al256((size_t)MOE_ROWS * 512 * 2);
static_assert(WS_YBUF + (size_t)MOE_ROWS * 2048 * 2 <= WS_OM, "MoE buffers must fit in the PROJ region");
constexpr size_t WS_TOTAL = WS_END_SMALL;

constexpr int CW_BAR = 0;
constexpr int CW_CNT = 4096;
constexpr int CW_CUR = 4096 + 64;
constexpr int CW_MISC = 4096 + 128;

constexpr size_t WS_H8 = (size_t)1152 * 1024 * 1024;
constexpr size_t WS_NEED = WS_H8 + (size_t)T * 2048;
#ifndef MIX_SET
#define MIX_SET 0
#endif
#if MIX_SET == 0
constexpr int NT16 = 24, NT8 = 35;
__host__ __device__ __forceinline__ int tile16(int p) { return p < 8 ? p : p < 12 ? p + 4 : p == 12 ? 16 : p == 13 ? 18 : p == 14 ? 20 : p < 19 ? p + 7 : p < 23 ? p + 11 : 58; }
__host__ __device__ __forceinline__ int tile8(int p) { return p < 4 ? p + 8 : p == 4 ? 17 : p == 5 ? 19 : p == 6 ? 21 : p < 11 ? p + 19 : p + 23; }
#else
constexpr int NT16 = 35, NT8 = 24;
__host__ __device__ __forceinline__ int tile16(int p) { return p < 34 ? p : 58; }
__host__ __device__ __forceinline__ int tile8(int p) { return p + 34; }
#endif
struct Args { const float* in[22]; float* out; unsigned char* ws; int ph_lo, ph_hi; };
constexpr int LDS_ARGS = 131072;
constexpr int LDS_XB = LDS_ARGS + 256;
constexpr int LDS_MISC = LDS_ARGS + 512;

struct Frame {
    LAS unsigned char* lds; int tid, lane, wave, G, c;
    unsigned char* ws;
    __device__ __forceinline__ const float* in(int k) const { const unsigned long long v = *(const volatile LAS unsigned long long*)(lds + LDS_ARGS + k * 8); return (const float*)(const __attribute__((address_space(1))) float*)(((unsigned long long)__builtin_amdgcn_readfirstlane((unsigned)(v >> 32)) << 32) | (unsigned)__builtin_amdgcn_readfirstlane((unsigned)v)); }
    __device__ __forceinline__ float* out() const { return (float*)in(22); }
};
template <class P> __device__ __forceinline__ P* opaque_ptr(P* p) {
    const unsigned long long v = (unsigned long long)p; unsigned lo = __builtin_amdgcn_readfirstlane((unsigned)v), hi = __builtin_amdgcn_readfirstlane((unsigned)(v >> 32));
    asm volatile("" : "+s"(lo), "+s"(hi)); return (P*)(__attribute__((address_space(1))) P*)(((unsigned long long)hi << 32) | lo);
}
__device__ __forceinline__ Frame phase_frame(const Frame& F0) {
    __syncthreads();
    Frame F = F0; F.ws = opaque_ptr(F0.ws);
    int t; asm volatile("v_mbcnt_lo_u32_b32 %0, -1, 0\n\tv_mbcnt_hi_u32_b32 %0, -1, %0" : "=v"(t)); t += F0.wave * 64; asm volatile("" : "+v"(t));
    F.tid = t; F.lane = t & 63; F.wave = __builtin_amdgcn_readfirstlane(t >> 6); return F;
}

__device__ __forceinline__ float clamp_fp8(float v) { return __builtin_amdgcn_fmed3f(v, -448.f, 448.f); }
__device__ __forceinline__ unsigned pack_fp8x4(float a, float b, float c, float d) { int w = __builtin_amdgcn_cvt_pk_fp8_f32(clamp_fp8(a), clamp_fp8(b), 0, false); w = __builtin_amdgcn_cvt_pk_fp8_f32(clamp_fp8(c), clamp_fp8(d), w, true); return (unsigned)w; }
template <bool F8, class Fn>
__device__ __forceinline__ void conv_t(const Frame& F, Fn colsrc, int ld, int K, int N, void* dstv, float scale = 1.f) {
    LAS float* tile = (LAS float*)F.lds;
    const int ntn = N / 256, ntk = K / 64, tot = ntn * ntk;
    for (int ti = F.c; ti < tot; ti += F.G) {
        const int tn = ti % ntn, tk = ti / ntn; const int n0 = tn * 256, k0 = tk * 64;
        const int n4 = (F.tid & 63) * 4, kq = F.tid >> 6;
        const float* sp = colsrc(n0 + n4);
        f32x4 v[8];
#pragma unroll
        for (int p = 0; p < 8; ++p) v[p] = sp ? *(const f32x4*)(sp + (size_t)(k0 + p * 8 + kq) * ld) : (f32x4){0.f, 0.f, 0.f, 0.f};
#pragma unroll
        for (int p = 0; p < 8; ++p) *(LAS f32x4*)(tile + (p * 8 + kq) * 260 + n4) = v[p];
        __syncthreads();
#pragma unroll
        for (int q = 0; q < 4; ++q) { const int idx = q * NTHR + F.tid; const int n = idx >> 3, k8 = (idx & 7) * 8;
            float t[8];
#pragma unroll
            for (int jj = 0; jj < 8; ++jj) t[jj] = tile[(k8 + jj) * 260 + n] * scale;
            if (F8) { u32x2 w = {pack_fp8x4(t[0], t[1], t[2], t[3]), pack_fp8x4(t[4], t[5], t[6], t[7])}; *(u32x2*)((unsigned char*)dstv + (size_t)(n0 + n) * K + k0 + k8) = w; }
            else { u32x4 w = {cvt_pk_bf16(t[0], t[1]), cvt_pk_bf16(t[2], t[3]), cvt_pk_bf16(t[4], t[5]), cvt_pk_bf16(t[6], t[7])}; *(u32x4*)((bf16_t*)dstv + (size_t)(n0 + n) * K + k0 + k8) = w; } }
        __syncthreads();
    }
}

__device__ __forceinline__ void p_conv_static(const Frame& F0) {
    const Frame F = phase_frame(F0);
    for (int l = 0; l < NL; ++l) {
        { const float* w = F.in(2) + (size_t)l * D * INW;
          auto srcpad = [=](int n) -> const float* { int s; if (n < 5632) s = n; else if (n < 7680) s = n + 24; else if (n < 14848) s = n + 40; else if (n < 14872) s = O_NG + (n - 14848); else if (n < 14888) s = O_GA + (n - 14872); else return nullptr; return w + s; };
#if INPROJ_F8 == 2
          conv_t<false>(F, [=](int n) -> const float* { return srcpad(tile16(n >> 8) * 256 + (n & 255)); }, INW, 2048, NT16 * 256, (bf16_t*)(F.ws + WS_WIN) + (size_t)l * NT16 * 256 * 2048);
          conv_t<true>(F, [=](int n) -> const float* { return srcpad(tile8(n >> 8) * 256 + (n & 255)); }, INW, 2048, NT8 * 256, F.ws + WS_WIN + (size_t)NL * NT16 * 256 * 2048 * 2 + (size_t)l * NT8 * 256 * 2048, 512.f);
#elif INPROJ_F8 == 1
          conv_t<true>(F, srcpad, INW, 2048, LDP, F.ws + WS_WIN + (size_t)l * LDP * 2048, 512.f);
#else
          conv_t<false>(F, srcpad, INW, 2048, LDP, (bf16_t*)(F.ws + WS_WIN) + (size_t)l * LDP * 2048);
#endif
        }
#define CONV_BR(b, idx) { const float* w = F.in(idx) + (size_t)l * 1024 * D; bf16_t* dst = (bf16_t*)(F.ws + WS_WBR) + ((size_t)l * 3 + b) * 2048 * 1024; \
          conv_t<false>(F, [=](int n) -> const float* { return w + n; }, D, 1024, 2048, dst); }
        CONV_BR(0, 9) CONV_BR(1, 10) CONV_BR(2, 11)
#undef CONV_BR
        { const float* w = F.in(12) + (size_t)l * D * D; bf16_t* dst = (bf16_t*)(F.ws + WS_WOUT) + (size_t)l * 2048 * 2048;
          conv_t<false>(F, [=](int n) -> const float* { return w + n; }, D, 2048, 2048, dst); }
        for (int c = 0; c < 2; ++c) { const float* w = F.in(4) + ((size_t)l * 2 + c) * 4096 * 128; bf16_t* dst = (bf16_t*)(F.ws + WS_WC1) + ((size_t)l * 2 + c) * 256 * 2048;
          conv_t<false>(F, [=](int n) -> const float* { return w + (n >= 128 ? (size_t)2048 * 128 : 0) + (n & 127); }, 128, 2048, 256, dst); }
    }
}
template <bool F8>
__device__ __forceinline__ void p_conv_experts(const Frame& F0, int l) {
    const Frame F = phase_frame(F0);
    const float* wg = F.in(18) + (size_t)l * 32 * D * 512; const float* wu = F.in(19) + (size_t)l * 32 * D * 512; const float* wd = F.in(20) + (size_t)l * 32 * 512 * D;
    conv_t<F8>(F, [=](int n) -> const float* { const int e = n >> 10, r = n & 1023, j = r >> 8, wi = r & 255; const unsigned long long dlt = (unsigned long long)wu - (unsigned long long)wg; const float* base = (const float*)((unsigned long long)wg + (dlt & (0ull - (unsigned long long)(wi >> 7)))) + (size_t)e * D * 512; return base + j * 128 + (wi & 127); }, 512, 2048, 32 * 1024, F.ws + WS_WGU, F8 ? 512.f : 1.f);
    conv_t<F8>(F, [=](int n) -> const float* { return wd + (size_t)(n >> 11) * 512 * D + (n & 2047); }, D, 512, 32 * 2048, F.ws + WS_WD, F8 ? 512.f : 1.f);
}

__device__ __forceinline__ void store_h4(unsigned char* ws, size_t idx, float a, float b, float c, float d) {
#if INPROJ_F8 >= 1
    *(unsigned*)(ws + (INPROJ_F8 == 2 ? WS_H8 : WS_H) + idx) = pack_fp8x4(a * 16.f, b * 16.f, c * 16.f, d * 16.f);
#endif
#if INPROJ_F8 != 1
    u32x2 w; w[0] = cvt_pk_bf16(a, b); w[1] = cvt_pk_bf16(c, d); *(u32x2*)((bf16_t*)(ws + WS_H) + idx) = w;
#endif
}
__device__ __forceinline__ void p_rmsnorm(const Frame& F0, int l) {
    const Frame F = phase_frame(F0);
    const float* x = (l == 0) ? F.in(0) : F.out(); const float* g = F.in(1) + l * D; unsigned char* h = F.ws;
    for (int row = F.c * 8 + F.wave; row < T; row += F.G * 8) {
        const float* xr = x + (size_t)row * D; f32x4 v[8]; float ss = 0.f;
#pragma unroll
        for (int i = 0; i < 8; ++i) { v[i] = *(const f32x4*)(xr + i * 256 + F.lane * 4); ss += v[i][0] * v[i][0] + v[i][1] * v[i][1] + v[i][2] * v[i][2] + v[i][3] * v[i][3]; }
#pragma unroll
        for (int o = 32; o > 0; o >>= 1) ss += __shfl_xor(ss, o);
        const float rstd = rsqrtf(ss * (1.f / D) + 1e-6f);
#pragma unroll
        for (int i = 0; i < 8; ++i) { const f32x4 gv = *(const f32x4*)(g + i * 256 + F.lane * 4);
            store_h4(h, (size_t)row * D + i * 256 + F.lane * 4, v[i][0] * rstd * gv[0], v[i][1] * rstd * gv[1], v[i][2] * rstd * gv[2], v[i][3] * rstd * gv[3]); }
    }
}

template <bool F8 = false>
struct SchedDenseT {
    static constexpr bool GATHER = false;
    const char* A; const char* B; int lda, K, nM, nN, G, c;
    __device__ __forceinline__ bool next(int i, ge::Unit& u) const { int pm, pn; if (!ge::static_tile(i, G, c, nM, nN, pm, pn)) return false;
        u.A = A + (size_t)pm * 256 * lda * (F8 ? 1 : 2); u.B = B + (size_t)pn * 256 * K * (F8 ? 1 : 2); u.r0 = pm * 256; u.c0 = pn * 256; u.aux = 0; u.aux2 = 0; return true; }
    __device__ __forceinline__ void voffA(const ge::Unit&, int tid, unsigned (&v)[2][2]) const { ge::dense_voffA<F8>(lda, tid, v); }
};
typedef SchedDenseT<false> SchedDense;
struct EpiStoreBf16 {
    static constexpr bool PERM = true; bf16_t* O; int ldc;
    __device__ __forceinline__ void operator()(const f32x4 (&acc)[2][2][4][2], const ge::Unit& u, int wr, int wc, int fr, int fq) const {
#pragma unroll
        for (int ai = 0; ai < 2; ++ai)
#pragma unroll
            for (int m = 0; m < 4; ++m) { bf16_t* rowp = O + (size_t)(u.r0 + ai * 128 + wr * 64 + m * 16 + fr) * ldc + u.c0 + wc * 32 + 8 * fq;
#pragma unroll
                for (int bj = 0; bj < 2; ++bj) { const f32x4 v0 = acc[ai][bj][m][0], v1 = acc[ai][bj][m][1]; u32x4 w = {cvt_pk_bf16(v0[0], v0[1]), cvt_pk_bf16(v0[2], v0[3]), cvt_pk_bf16(v1[0], v1[1]), cvt_pk_bf16(v1[2], v1[3])};
                    *(u32x4*)(rowp + bj * 128) = w; } }
    }
};
struct EpiNull {
    static constexpr bool PERM = true;
    __device__ __forceinline__ void operator()(const f32x4 (&acc)[2][2][4][2], const ge::Unit&, int, int, int, int) const {
#pragma unroll
        for (int ai = 0; ai < 2; ++ai)
#pragma unroll
            for (int bj = 0; bj < 2; ++bj)
#pragma unroll
                for (int m = 0; m < 4; ++m) asm volatile("" :: "v"(acc[ai][bj][m][0]), "v"(acc[ai][bj][m][1]));
    }
};
struct SchedSame {
    static constexpr bool GATHER = false; const char* A; const char* B; int n;
    __device__ __forceinline__ bool next(int i, ge::Unit& u) const { if (i >= n) return false; u.A = A; u.B = B; u.r0 = 0; u.c0 = 0; u.aux = 0; u.aux2 = 0; return true; }
    __device__ __forceinline__ void voffA(const ge::Unit&, int tid, unsigned (&v)[2][2]) const { ge::dense_voffA<false>(2048, tid, v); }
};
__device__ __forceinline__ void p_inproj_same(const Frame& F0, int l) {
    const Frame F = phase_frame(F0);
    EpiNull E{};
    SchedSame S{(const char*)(F.ws + WS_H), (const char*)(F.ws + WS_WIN) + (size_t)l * LDP * 2048 * 2, 15};
    ge::gemm_phase<EpiNull, SchedSame, 0>(F.lds, F.tid, 2048, 0, S, E);
}
__device__ __forceinline__ void p_inproj_longk(const Frame& F0, int l) {
    const Frame F = phase_frame(F0);
    EpiNull E{};
    SchedSame S{(const char*)(F.ws + WS_H), (const char*)(F.ws + WS_WIN) + (size_t)l * LDP * 2048 * 2, 1};
    ge::gemm_phase<EpiNull, SchedSame, 0>(F.lds, F.tid, 2048 * 15, 0, S, E);
}
__device__ __forceinline__ void p_inproj_null(const Frame& F0, int l) {
    const Frame F = phase_frame(F0);
    EpiNull E{};
    SchedDense S{(const char*)(F.ws + WS_H), (const char*)(F.ws + WS_WIN) + (size_t)l * LDP * 2048 * 2, 2048, 2048, T / 256, LDP / 256, F.G, F.c};
    ge::gemm_phase<EpiNull, SchedDense, 0>(F.lds, F.tid, 2048, 0, S, E);
}
#ifndef INPROJ_F8
#define INPROJ_F8 1
#endif
template <bool F8>
struct SchedInprojMix {
    static constexpr bool GATHER = false;
    const char* A; const char* B; int G, c;
    __device__ __forceinline__ bool next(int i, ge::Unit& u) const { int pm, pn; if (!ge::static_tile(i, G, c, T / 256, F8 ? NT8 : NT16, pm, pn)) return false;
        u.A = A + (size_t)pm * 256 * 2048 * (F8 ? 1 : 2); u.B = B + (size_t)pn * 256 * 2048 * (F8 ? 1 : 2); u.r0 = pm * 256; u.c0 = (F8 ? tile8(pn) : tile16(pn)) * 256; u.aux = 0; u.aux2 = 0; return true; }
    __device__ __forceinline__ void voffA(const ge::Unit&, int tid, unsigned (&v)[2][2]) const { ge::dense_voffA<F8>(2048, tid, v); }
};
__device__ __forceinline__ void p_inproj(const Frame& F0, int l) {
    const Frame F = phase_frame(F0);
    EpiStoreBf16 E{(bf16_t*)(F.ws + WS_PROJ), LDP};
#if INPROJ_F8 == 2
    { SchedInprojMix<false> S{(const char*)(F.ws + WS_H), (const char*)(F.ws + WS_WIN) + (size_t)l * NT16 * 256 * 2048 * 2, F.G, F.c};
      ge::gemm_phase<EpiStoreBf16, SchedInprojMix<false>, 0, false>(F.lds, F.tid, 2048, 0, S, E); }
    { const Frame F2 = phase_frame(F0);
      SchedInprojMix<true> S{(const char*)(F2.ws + WS_H8), (const char*)(F2.ws + WS_WIN) + (size_t)NL * NT16 * 256 * 2048 * 2 + (size_t)l * NT8 * 256 * 2048, F2.G, F2.c};
      EpiStoreBf16 E2{(bf16_t*)(F2.ws + WS_PROJ), LDP};
      ge::gemm_phase<EpiStoreBf16, SchedInprojMix<true>, 0, true>(F2.lds, F2.tid, 2048, 0, S, E2); }
#elif INPROJ_F8 == 1
    SchedDenseT<true> S{(const char*)(F.ws + WS_H), (const char*)(F.ws + WS_WIN) + (size_t)l * LDP * 2048, 2048, 2048, T / 256, LDP / 256, F.G, F.c};
    ge::gemm_phase<EpiStoreBf16, SchedDenseT<true>, 0, true>(F.lds, F.tid, 2048, 0, S, E);
#else
    SchedDense S{(const char*)(F.ws + WS_H), (const char*)(F.ws + WS_WIN) + (size_t)l * LDP * 2048 * 2, 2048, 2048, T / 256, LDP / 256, F.G, F.c};
    ge::gemm_phase<EpiStoreBf16, SchedDense, 0>(F.lds, F.tid, 2048, 0, S, E);
#endif
}

struct SchedMerge {
    static constexpr bool GATHER = false;
    const char* O3; const char* W; int G, c;
    __device__ __forceinline__ bool next(int i, ge::Unit& u) const { const int ti = i / 3, b = i - ti * 3; int pm, pn; if (!ge::static_tile(ti, G, c, T / 256, 8, pm, pn)) return false;
        u.A = O3 + (size_t)b * T * 1024 * 2 + (size_t)pm * 256 * 1024 * 2; u.B = W + (size_t)b * 2048 * 1024 * 2 + (size_t)pn * 256 * 1024 * 2; u.r0 = pm * 256; u.c0 = pn * 256; u.aux = b; u.aux2 = 0; return true; }
    __device__ __forceinline__ void voffA(const ge::Unit&, int tid, unsigned (&v)[2][2]) const { ge::dense_voffA(1024, tid, v); }
};
struct EpiMerge {
    static constexpr bool PERM = true; const bf16_t* proj; bf16_t* merged;
    __device__ __forceinline__ void operator()(const f32x4 (&acc)[2][2][4][2], const ge::Unit& u, int wr, int wc, int fr, int fq) const {
        const int col = u.c0 + wc * 32 + 8 * fq;
#pragma unroll
        for (int ai = 0; ai < 2; ++ai) {
            u32x4 gw[4][2], pw[4][2];
#pragma unroll
            for (int m = 0; m < 4; ++m) { const size_t row = (size_t)(u.r0 + ai * 128 + wr * 64 + m * 16 + fr);
#pragma unroll
                for (int bj = 0; bj < 2; ++bj) { gw[m][bj] = *(const u32x4*)(proj + row * LDP + P_MG + u.aux * 2048 + col + bj * 128);
                    if (u.aux > 0) pw[m][bj] = *(const u32x4*)(merged + row * 2048 + col + bj * 128); else pw[m][bj] = (u32x4){0u, 0u, 0u, 0u}; } }
#pragma unroll
            for (int m = 0; m < 4; ++m) { const size_t row = (size_t)(u.r0 + ai * 128 + wr * 64 + m * 16 + fr);
#pragma unroll
                for (int bj = 0; bj < 2; ++bj) { const u32x4 g = gw[m][bj], q = pw[m][bj]; const f32x4 v0 = acc[ai][bj][m][0], v1 = acc[ai][bj][m][1];
                    const float o0 = v0[0] * fast_sigmoid(bf_lo(g[0])) + bf_lo(q[0]), o1 = v0[1] * fast_sigmoid(bf_hi(g[0])) + bf_hi(q[0]), o2 = v0[2] * fast_sigmoid(bf_lo(g[1])) + bf_lo(q[1]), o3 = v0[3] * fast_sigmoid(bf_hi(g[1])) + bf_hi(q[1]);
                    const float o4 = v1[0] * fast_sigmoid(bf_lo(g[2])) + bf_lo(q[2]), o5 = v1[1] * fast_sigmoid(bf_hi(g[2])) + bf_hi(q[2]), o6 = v1[2] * fast_sigmoid(bf_lo(g[3])) + bf_lo(q[3]), o7 = v1[3] * fast_sigmoid(bf_hi(g[3])) + bf_hi(q[3]);
                    u32x4 w = {cvt_pk_bf16(o0, o1), cvt_pk_bf16(o2, o3), cvt_pk_bf16(o4, o5), cvt_pk_bf16(o6, o7)};
                    *(u32x4*)(merged + row * 2048 + col + bj * 128) = w; } }
        }
    }
};
__device__ __forceinline__ void p_merge(const Frame& F0, int l) {
    const Frame F = phase_frame(F0);
    SchedMerge S{(const char*)(F.ws + WS_OM), (const char*)(F.ws + WS_WBR) + (size_t)l * 3 * 2048 * 1024 * 2, F.G, F.c};
    EpiMerge E{(const bf16_t*)(F.ws + WS_PROJ), (bf16_t*)(F.ws + WS_MERGED)};
    ge::gemm_phase<EpiMerge, SchedMerge, 0>(F.lds, F.tid, 1024, 0, S, E);
}

struct EpiResF32 {
    static constexpr bool PERM = false; const float* R; float* C;
    __device__ __forceinline__ void operator()(const f32x4 (&acc)[2][2][4][2], const ge::Unit& u, int wr, int wc, int fr, int fq) const {
#pragma unroll
        for (int ai = 0; ai < 2; ++ai) {
            f32x4 r[4][2][2];
#pragma unroll
            for (int m = 0; m < 4; ++m) { const size_t off = (size_t)(u.r0 + ai * 128 + wr * 64 + m * 16 + fr) * D + u.c0 + wc * 32 + 4 * fq;
#pragma unroll
                for (int bj = 0; bj < 2; ++bj)
#pragma unroll
                    for (int n = 0; n < 2; ++n) r[m][bj][n] = *(const f32x4*)(R + off + bj * 128 + n * 16); }
#pragma unroll
            for (int m = 0; m < 4; ++m) { const size_t off = (size_t)(u.r0 + ai * 128 + wr * 64 + m * 16 + fr) * D + u.c0 + wc * 32 + 4 * fq;
#pragma unroll
                for (int bj = 0; bj < 2; ++bj)
#pragma unroll
                    for (int n = 0; n < 2; ++n) *(f32x4*)(C + off + bj * 128 + n * 16) = acc[ai][bj][m][n] + r[m][bj][n]; }
        }
    }
};
__device__ __forceinline__ void p_wout(const Frame& F0, int l) {
    const Frame F = phase_frame(F0);
    const float* xsrc = (l == 0) ? F.in(0) : F.out();
    SchedDense S{(const char*)(F.ws + WS_MERGED), (const char*)(F.ws + WS_WOUT) + (size_t)l * 2048 * 2048 * 2, 2048, 2048, T / 256, 8, F.G, F.c};
    EpiResF32 E{xsrc, F.out()};
    ge::gemm_phase<EpiResF32, SchedDense, 0>(F.lds, F.tid, 2048, 0, S, E);
}

constexpr size_t WS_WR = WS_END_SMALL;
constexpr size_t WS_END2 = WS_WR + al256((size_t)NL * 2048 * 64 * 4);

__device__ __forceinline__ void p_conv_router(const Frame& F0) {
    const Frame F = phase_frame(F0);
    float* wr = (float*)(F.ws + WS_WR);
    const float* g2 = F.in(13); const float* rgw = F.in(14); const float* rew = F.in(16);
    for (int i = F.c * NTHR + F.tid; i < NL * 2048 * 64; i += F.G * NTHR) {
        const int j = i & 63, d = (i >> 6) & 2047, l = i >> 17;
        float v = 0.f;
        if (j < 4) v = rgw[((size_t)l * 2048 + d) * 4 + j]; else if (j < 36) v = rew[((size_t)l * 2048 + d) * 32 + (j - 4)];
        wr[i] = v * g2[l * 2048 + d];
    }
}

template <bool F8>
__device__ __forceinline__ void p_route1(const Frame& F0, int l) {
    const Frame F = phase_frame(F0);
    const float* x = F.out();
    const float* wr = (const float*)(F.ws + WS_WR) + (size_t)l * 2048 * 64;
    const float* g2 = F.in(13) + l * D; const float* rgb = F.in(15) + l * 4; const float* reb = F.in(17) + l * 32;
    unsigned* ctl = (unsigned*)(F.ws + WS_CTL);
    int* rowtok = (int*)(F.ws + WS_ROWTOK); float* roww = (float*)(F.ws + WS_ROWW);
    for (int i = F.c * NTHR + F.tid; i < MOE_ROWS; i += F.G * NTHR) { rowtok[i] = 0; roww[i] = 0.f; }
    LAS float* part = (LAS float*)F.lds;
    LAS float* ssq = (LAS float*)(F.lds + 65536);
    LAS float* lg = (LAS float*)(F.lds + 65536 + 1024);
    LAS float* rstd_s = (LAS float*)(F.lds + 65536 + 1024 + 64 * 40 * 4);
    const int w = F.wave, lane = F.lane, rh = w >> 2, kq = w & 3, r32 = lane & 31, hi = lane >> 5;
    for (int rg = F.c; rg < T / 64; rg += F.G) {
        const int row0 = rg * 64;
        f32x16 acc0, acc1;
#pragma unroll
        for (int r = 0; r < 16; ++r) { acc0[r] = 0.f; acc1[r] = 0.f; }
        float ss = 0.f;
        const float* xr = x + (size_t)(row0 + rh * 32 + r32) * D + kq * 512 + 8 * hi;
        const float* wp = wr + (size_t)(kq * 512 + 8 * hi) * 64 + r32;
        for (int ks = 0; ks < 32; ++ks) {
            const f32x4 xa = *(const f32x4*)(xr + ks * 16), xb = *(const f32x4*)(xr + ks * 16 + 4);
            const float xv[8] = {xa[0], xa[1], xa[2], xa[3], xb[0], xb[1], xb[2], xb[3]};
#pragma unroll
            for (int j = 0; j < 8; ++j) {
                const float b0 = wp[(size_t)(ks * 16 + j) * 64], b1 = wp[(size_t)(ks * 16 + j) * 64 + 32];
                ss += xv[j] * xv[j];
                acc0 = __builtin_amdgcn_mfma_f32_32x32x2f32(xv[j], b0, acc0, 0, 0, 0);
                acc1 = __builtin_amdgcn_mfma_f32_32x32x2f32(xv[j], b1, acc1, 0, 0, 0);
            }
        }
        ss += __shfl_xor(ss, 32);
        if (hi == 0) ssq[w * 32 + r32] = ss;
#pragma unroll
        for (int r = 0; r < 16; ++r) { const int row = (r & 3) + 8 * (r >> 2) + 4 * hi; part[(w * 32 + row) * 64 + r32] = acc0[r]; part[(w * 32 + row) * 64 + 32 + r32] = acc1[r]; }
        __syncthreads();
        { const int row = F.tid >> 3, sub = F.tid & 7, rr = row & 31, rhh = row >> 5;
          float s2 = ssq[(rhh * 4 + 0) * 32 + rr] + ssq[(rhh * 4 + 1) * 32 + rr] + ssq[(rhh * 4 + 2) * 32 + rr] + ssq[(rhh * 4 + 3) * 32 + rr];
          const float rstd = rsqrtf(s2 * (1.f / D) + 1e-6f);
          if (sub == 0) rstd_s[row] = rstd;
#pragma unroll
          for (int q = 0; q < 5; ++q) { const int j = sub * 5 + q; if (j < 36) {
              float a = part[((rhh * 4 + 0) * 32 + rr) * 64 + j] + part[((rhh * 4 + 1) * 32 + rr) * 64 + j] + part[((rhh * 4 + 2) * 32 + rr) * 64 + j] + part[((rhh * 4 + 3) * 32 + rr) * 64 + j];
              lg[row * 40 + j] = a * rstd + (j < 4 ? rgb[j] : reb[j - 4]); } } }
        __syncthreads();
        if (F.tid < 64) {
            const int row = F.tid; const LAS float* L = lg + row * 40;
            int grp = 0; float gm = L[0];
#pragma unroll
            for (int j = 1; j < 4; ++j) if (L[j] > gm) { gm = L[j]; grp = j; }
            float den = 0.f;
#pragma unroll
            for (int j = 0; j < 4; ++j) den += expf(L[j] - gm);
            const float pg = 1.f / den;
            const LAS float* el = L + 4 + grp * 8;
            int i0 = 0; for (int j = 1; j < 8; ++j) if (el[j] > el[i0]) i0 = j;
            int i1 = -1; for (int j = 0; j < 8; ++j) { if (j == i0) continue; if (i1 < 0 || el[j] > el[i1]) i1 = j; }
            const float e1 = expf(el[i1] - el[i0]), d2 = 1.f + e1;
            const int ea = grp * 8 + i0, eb = grp * 8 + i1;
            const unsigned pa = atomicAdd(&ctl[CW_CNT + l * 32 + ea], 1u), pb = atomicAdd(&ctl[CW_CNT + l * 32 + eb], 1u);
            int* rt = (int*)(F.ws + WS_ROUTE) + (size_t)(row0 + row) * 8;
            rt[0] = ea; rt[1] = eb; ((float*)rt)[2] = pg / d2; ((float*)rt)[3] = pg * e1 / d2; rt[4] = (int)pa; rt[5] = (int)pb;
        }
        for (int q = 0; q < 8; ++q) { const int row = w * 8 + q; const float rstd = rstd_s[row];
            const float* xr2 = x + (size_t)(row0 + row) * D; bf16_t* hr = (bf16_t*)(F.ws + WS_H) + (size_t)(row0 + row) * D; unsigned char* hr8 = F.ws + WS_H + (size_t)(row0 + row) * D;
#pragma unroll
            for (int i = 0; i < 8; ++i) { const f32x4 v = *(const f32x4*)(xr2 + i * 256 + lane * 4); const f32x4 gv = *(const f32x4*)(g2 + i * 256 + lane * 4);
                if (F8) { *(unsigned*)(hr8 + i * 256 + lane * 4) = pack_fp8x4(v[0] * rstd * gv[0] * 16.f, v[1] * rstd * gv[1] * 16.f, v[2] * rstd * gv[2] * 16.f, v[3] * rstd * gv[3] * 16.f); }
                else { u32x2 wv; wv[0] = cvt_pk_bf16(v[0] * rstd * gv[0], v[1] * rstd * gv[1]); wv[1] = cvt_pk_bf16(v[2] * rstd * gv[2], v[3] * rstd * gv[3]); *(u32x2*)(hr + i * 256 + lane * 4) = wv; } } }
        __syncthreads();
    }
}

struct MoeTab { int ntiles; };
__device__ __forceinline__ int moe_build_tab(const Frame& F, int l, LAS int* tab  ) {
    unsigned* ctl = (unsigned*)(F.ws + WS_CTL);
    if (F.tid < 32) tab[32 + F.tid] = (int)__hip_atomic_load(&ctl[CW_CNT + l * 32 + F.tid], __ATOMIC_RELAXED, __HIP_MEMORY_SCOPE_AGENT);
    __syncthreads();
    if (F.tid == 0) { int off = 0, nt = 0;
#pragma nounroll
        for (int e = 0; e < 32; ++e) { tab[e] = off; const int n = (tab[32 + e] + 255) >> 8;
#pragma nounroll
            for (int k = 0; k < n; ++k) { tab[64 + nt] = e; tab[224 + nt] = off + k * 256; ++nt; } off += n * 256; } tab[384] = nt; }
    __syncthreads();
    return tab[384];
}
__device__ __forceinline__ void p_route2(const Frame& F0, int l) {
    const Frame F = phase_frame(F0);
    LAS int* tab = (LAS int*)(F.lds + LDS_MISC);
    moe_build_tab(F, l, tab);
    int* rowtok = (int*)(F.ws + WS_ROWTOK); float* roww = (float*)(F.ws + WS_ROWW);
    for (int t = F.c * NTHR + F.tid; t < T; t += F.G * NTHR) {
        int* rt = (int*)(F.ws + WS_ROUTE) + (size_t)t * 8;
        const int ea = rt[0], eb = rt[1]; const float wa = ((float*)rt)[2], wb = ((float*)rt)[3];
        const int ra = tab[ea] + rt[4], rb = tab[eb] + rt[5];
        rowtok[ra] = t; roww[ra] = wa; rowtok[rb] = t; roww[rb] = wb; rt[6] = ra; rt[7] = rb;
    }
}

template <bool F8>
struct SchedMoeGUT {
    static constexpr bool GATHER = true;
    const char* H; const char* W; const int* rowtok; LAS int* tab; int G, c, ntiles;
    __device__ __forceinline__ bool next(int i, ge::Unit& u) const { const int L = i * G + c; if (L >= ntiles * 4) return false; const int ti = L >> 2, ct = L & 3; const int e = tab[64 + ti];
        u.A = H; u.B = W + ((size_t)e * 1024 + ct * 256) * 2048 * (F8 ? 1 : 2); u.r0 = tab[224 + ti]; u.c0 = ct * 128; u.aux = e; u.aux2 = 0; return true; }
    __device__ __forceinline__ void voffA(const ge::Unit& u, int tid, unsigned (&v)[2][2]) const {
#pragma unroll
        for (int i = 0; i < 2; ++i) { int R, C; ge::stage_rc(tid * 16 + i * 8192, R, C); const int t0 = rowtok[u.r0 + R], t1 = rowtok[u.r0 + 128 + R]; v[0][i] = F8 ? (unsigned)(t0 * 2048 + C * 2) : (unsigned)(t0 * 2048 + C) * 2u; v[1][i] = F8 ? (unsigned)(t1 * 2048 + C * 2) : (unsigned)(t1 * 2048 + C) * 2u; } }
};
template <bool F8>
struct EpiGUT {
    static constexpr bool PERM = true; void* hidv;
    __device__ __forceinline__ void operator()(const f32x4 (&acc)[2][2][4][2], const ge::Unit& u, int wr, int wc, int fr, int fq) const {
#pragma unroll
        for (int ai = 0; ai < 2; ++ai)
#pragma unroll
            for (int m = 0; m < 4; ++m) { const f32x4 g0 = acc[ai][0][m][0], g1 = acc[ai][0][m][1], u0 = acc[ai][1][m][0], u1 = acc[ai][1][m][1];
                float h[8] = {fast_silu(g0[0]) * u0[0], fast_silu(g0[1]) * u0[1], fast_silu(g0[2]) * u0[2], fast_silu(g0[3]) * u0[3], fast_silu(g1[0]) * u1[0], fast_silu(g1[1]) * u1[1], fast_silu(g1[2]) * u1[2], fast_silu(g1[3]) * u1[3]};
                const size_t off = (size_t)(u.r0 + ai * 128 + wr * 64 + m * 16 + fr) * 512 + u.c0 + wc * 32 + 8 * fq;
                if (F8) {
#pragma unroll
                    for (int j = 0; j < 8; ++j) h[j] = fminf(fmaxf(h[j] * 8.f, -440.f), 440.f);
                    u32x2 w = {pack_fp8x4(h[0], h[1], h[2], h[3]), pack_fp8x4(h[4], h[5], h[6], h[7])}; *(u32x2*)((unsigned char*)hidv + off) = w; }
                else { u32x4 w = {cvt_pk_bf16(h[0], h[1]), cvt_pk_bf16(h[2], h[3]), cvt_pk_bf16(h[4], h[5]), cvt_pk_bf16(h[6], h[7])}; *(u32x4*)((bf16_t*)hidv + off) = w; } }
    }
};
template <bool F8>
__device__ __forceinline__ void p_moe_gu(const Frame& F0, int l) {
    const Frame F = phase_frame(F0);
    LAS int* tab = (LAS int*)(F.lds + LDS_MISC);
    const int nt = moe_build_tab(F, l, tab);
    SchedMoeGUT<F8> S{(const char*)(F.ws + WS_H), (const char*)(F.ws + WS_WGU), (const int*)(F.ws + WS_ROWTOK), tab, F.G, F.c, nt};
    EpiGUT<F8> E{(void*)(F.ws + WS_HID)};
    ge::gemm_phase<EpiGUT<F8>, SchedMoeGUT<F8>, 0, F8>(F.lds, F.tid, 2048, 0, S, E);
}
template <bool F8>
struct SchedMoeDT {
    static constexpr bool GATHER = false;
    const char* HID; const char* W; LAS int* tab; int G, c, ntiles;
    __device__ __forceinline__ bool next(int i, ge::Unit& u) const { const int L = i * G + c; if (L >= ntiles * 8) return false; const int ti = L >> 3, ct = L & 7; const int e = tab[64 + ti];
        u.r0 = tab[224 + ti]; u.A = HID + (size_t)u.r0 * 512 * (F8 ? 1 : 2); u.B = W + ((size_t)e * 2048 + ct * 256) * 512 * (F8 ? 1 : 2); u.c0 = ct * 256; u.aux = e; u.aux2 = 0; return true; }
    __device__ __forceinline__ void voffA(const ge::Unit&, int tid, unsigned (&v)[2][2]) const { ge::dense_voffA<F8>(512, tid, v); }
};
struct EpiDown {
    static constexpr bool PERM = true; bf16_t* y; const float* roww;
    __device__ __forceinline__ void operator()(const f32x4 (&acc)[2][2][4][2], const ge::Unit& u, int wr, int wc, int fr, int fq) const {
#pragma unroll
        for (int ai = 0; ai < 2; ++ai)
#pragma unroll
            for (int m = 0; m < 4; ++m) { const int row = u.r0 + ai * 128 + wr * 64 + m * 16 + fr; const float s = roww[row]; bf16_t* rowp = y + (size_t)row * 2048 + u.c0 + wc * 32 + 8 * fq;
#pragma unroll
                for (int bj = 0; bj < 2; ++bj) { const f32x4 v0 = acc[ai][bj][m][0] * s, v1 = acc[ai][bj][m][1] * s; u32x4 w = {cvt_pk_bf16(v0[0], v0[1]), cvt_pk_bf16(v0[2], v0[3]), cvt_pk_bf16(v1[0], v1[1]), cvt_pk_bf16(v1[2], v1[3])};
                    *(u32x4*)(rowp + bj * 128) = w; } }
    }
};
template <bool F8>
__device__ __forceinline__ void p_moe_down(const Frame& F0, int l) {
    const Frame F = phase_frame(F0);
    LAS int* tab = (LAS int*)(F.lds + LDS_MISC);
    const int nt = moe_build_tab(F, l, tab);
    SchedMoeDT<F8> S{(const char*)(F.ws + WS_HID), (const char*)(F.ws + WS_WD), tab, F.G, F.c, nt};
    EpiDown E{(bf16_t*)(F.ws + WS_YBUF), (const float*)(F.ws + WS_ROWW)};
    ge::gemm_phase<EpiDown, SchedMoeDT<F8>, 0, F8, GE_SP2_DEFAULT, GE_ALIGN_DEFAULT, 0x7C7C7C7C>(F.lds, F.tid, 512, 0, S, E);
}
template <int MODE>
__device__ __forceinline__ void p_combine(const Frame& F0, int lnext) {
    const Frame F = phase_frame(F0);
    float* x = F.out(); const bf16_t* y = (const bf16_t*)(F.ws + WS_YBUF);
    const float* g = MODE == 0 ? F.in(1) + lnext * D : F.in(21);
    for (int row = F.c * 8 + F.wave; row < T; row += F.G * 8) {
        const int* rt = (const int*)(F.ws + WS_ROUTE) + (size_t)row * 8; const int ra = rt[6], rb = rt[7];
        float* xr = x + (size_t)row * D; f32x4 v[8]; float ss = 0.f;
#pragma unroll
        for (int i = 0; i < 8; ++i) { v[i] = *(const f32x4*)(xr + i * 256 + F.lane * 4);
            const u32x2 ya = *(const u32x2*)(y + (size_t)ra * 2048 + i * 256 + F.lane * 4), yb = *(const u32x2*)(y + (size_t)rb * 2048 + i * 256 + F.lane * 4);
            v[i][0] += bf_lo(ya[0]) + bf_lo(yb[0]); v[i][1] += bf_hi(ya[0]) + bf_hi(yb[0]); v[i][2] += bf_lo(ya[1]) + bf_lo(yb[1]); v[i][3] += bf_hi(ya[1]) + bf_hi(yb[1]);
            ss += v[i][0] * v[i][0] + v[i][1] * v[i][1] + v[i][2] * v[i][2] + v[i][3] * v[i][3]; }
#pragma unroll
        for (int o = 32; o > 0; o >>= 1) ss += __shfl_xor(ss, o);
        const float rstd = rsqrtf(ss * (1.f / D) + 1e-6f);
#pragma unroll
        for (int i = 0; i < 8; ++i) { const f32x4 gv = *(const f32x4*)(g + i * 256 + F.lane * 4);
            if (MODE == 0) { *(f32x4*)(xr + i * 256 + F.lane * 4) = v[i]; store_h4(F.ws, (size_t)row * D + i * 256 + F.lane * 4, v[i][0] * rstd * gv[0], v[i][1] * rstd * gv[1], v[i][2] * rstd * gv[2], v[i][3] * rstd * gv[3]); }
            else { f32x4 o = {v[i][0] * rstd * gv[0], v[i][1] * rstd * gv[1], v[i][2] * rstd * gv[2], v[i][3] * rstd * gv[3]}; *(f32x4*)(xr + i * 256 + F.lane * 4) = o; } }
    }
}

namespace att {
constexpr float SCALE = 0.08838834764831845f;
constexpr int NW = 8, QBLK = 32, KVBLK = 64, QB = NW * QBLK, DH = 128;
constexpr int SHM_V = KVBLK * DH * 2, SHM_K = KVBLK * DH * 2;
constexpr int ATT_LDS = 2 * SHM_V + 2 * SHM_K + NW * 64 * 4;
constexpr float THR = 8.f;
typedef short s16x4 __attribute__((ext_vector_type(4)));

#define KSWZ(row, colB) ((row) * 256 + ((colB) ^ (((row) & 7) << 4)))
#define SBAR() __builtin_amdgcn_sched_barrier(0)
__device__ __forceinline__ int v_st(int k, int c) { const int kk = (k & ~0xC) | ((k & 4) << 1) | ((k & 8) >> 1); return ((kk >> 3) * 4 + (c >> 5)) * 512 + ((kk & 7) * 32 + (c & 31)) * 2; }
__device__ __forceinline__ int v_rd_base(int lane) { return ((lane & 3) << 3) | (((lane >> 2) & 3) << 6) | (((lane >> 4) & 1) << 5) | (((lane >> 5) & 1) << 8); }
constexpr int v_rd_off(int d0, int ks, int half) { return d0 * 512 + ks * 4096 + half * 2048; }
__device__ __forceinline__ int crow(int r, int hi) { return (r & 3) + 8 * (r >> 2) + 4 * hi; }
__device__ __forceinline__ bf16x8 load8(const bf16_t* p) { return *reinterpret_cast<const bf16x8*>(p); }

__device__ __forceinline__ void mask_tile(f32x16& p0, f32x16& p1, int dq, unsigned W) {
    const float NEG = -__builtin_inff();
#pragma unroll
    for (int r = 0; r < 16; ++r) {
        const int c = (r & 3) + 8 * (r >> 2);
        if ((unsigned)(dq - c) >= W) p0[r] = NEG;
        if ((unsigned)(dq - c - 32) >= W) p1[r] = NEG;
    }
}
__device__ __forceinline__ void mask_all(f32x16& p0, f32x16& p1, bool ok) {
    const float NEG = -__builtin_inff();
#pragma unroll
    for (int r = 0; r < 16; ++r) { p0[r] = ok ? p0[r] : NEG; p1[r] = ok ? p1[r] : NEG; }
}
__device__ __forceinline__ void partialSM(f32x16& p0, f32x16& p1, float& m_reg, float& mn, float& alpha) {
    float pmax = p0[0]; for (int r = 1; r < 16; ++r) pmax = fmaxf(pmax, p0[r]); for (int r = 0; r < 16; ++r) pmax = fmaxf(pmax, p1[r]);
    { auto rr = __builtin_amdgcn_permlane32_swap(__float_as_uint(pmax), __float_as_uint(pmax), false, false);
      pmax = fmaxf(__uint_as_float(rr[0]), __uint_as_float(rr[1])); }
    constexpr float C2 = 1.4426950408889634f * SCALE;
    if (__builtin_expect(__all((pmax - m_reg) * SCALE <= THR), 1)) { mn = m_reg; alpha = 1.f; }
    else { mn = fmaxf(m_reg, pmax); alpha = __builtin_amdgcn_exp2f((m_reg - mn) * C2); m_reg = mn; }
    const float mnL = -mn * C2;
    for (int r = 0; r < 16; ++r) p0[r] = fmaf(p0[r], C2, mnL); for (int r = 0; r < 16; ++r) p1[r] = fmaf(p1[r], C2, mnL);
    for (int r = 0; r < 16; ++r) p0[r] = __builtin_amdgcn_exp2f(p0[r]);
}
__device__ __forceinline__ void finishSM(f32x16& p0, f32x16& p1, float alpha, float& l_reg, bf16x8& pa0, bf16x8& pa1, bf16x8& pa2, bf16x8& pa3) {
    for (int r = 0; r < 16; ++r) p1[r] = __builtin_amdgcn_exp2f(p1[r]);
    float ps = 0; for (int r = 0; r < 16; ++r) ps += p0[r]; for (int r = 0; r < 16; ++r) ps += p1[r];
    { auto rr = __builtin_amdgcn_permlane32_swap(__float_as_uint(ps), __float_as_uint(ps), false, false);
      ps = __uint_as_float(rr[0]) + __uint_as_float(rr[1]); }
    l_reg = l_reg * alpha + ps;
#define PK4(P, B_, OUT) do { unsigned a0 = cvt_pk_bf16(P[B_+0], P[B_+1]), a1 = cvt_pk_bf16(P[B_+2], P[B_+3]);                          \
        unsigned b0 = cvt_pk_bf16(P[B_+4], P[B_+5]), b1 = cvt_pk_bf16(P[B_+6], P[B_+7]);                                             \
        auto r0 = __builtin_amdgcn_permlane32_swap(a0, b0, false, false); auto r1 = __builtin_amdgcn_permlane32_swap(a1, b1, false, false); \
        u32x4 w = {r0[0], r1[0], r0[1], r1[1]}; OUT = *reinterpret_cast<bf16x8*>(&w); } while (0)
    PK4(p0, 0, pa0); PK4(p0, 8, pa1); PK4(p1, 0, pa2); PK4(p1, 8, pa3);
#undef PK4
}
template <int KB, bool SK>
__device__ __forceinline__ void qkt(f32x16& p0, f32x16& p1, const char* K_lds, int r32, int hi, const bf16x8* qr, bool act) {
    if (SK && !act) { const float NEG = -__builtin_inff();
#pragma unroll
        for (int r = 0; r < 16; ++r) { p0[r] = NEG; p1[r] = NEG; } return; }
    p0 = f32x16{}; p1 = f32x16{};
    const unsigned kb0 = (unsigned)(uintptr_t)(const LAS char*)(K_lds + KB * SHM_K) + (unsigned)KSWZ(r32, (hi * 8) * 2);
    unsigned kbx[4]; kbx[0] = kb0;
    asm volatile("v_xor_b32 %0, 32, %1" : "=v"(kbx[1]) : "v"(kb0)); asm volatile("v_xor_b32 %0, 64, %1" : "=v"(kbx[2]) : "v"(kb0)); asm volatile("v_xor_b32 %0, 0x60, %1" : "=v"(kbx[3]) : "v"(kb0));
#pragma unroll
    for (int d0 = 0; d0 < 8; ++d0) { const unsigned a = kbx[d0 & 3] + (d0 >> 2) * 128;
        bf16x8 b0 = *(const LAS bf16x8*)(a);
        bf16x8 b1 = *(const LAS bf16x8*)(a + 32 * 256);
        p0 = __builtin_amdgcn_mfma_f32_32x32x16_bf16(b0, qr[d0], p0, 0, 0, 0);
        p1 = __builtin_amdgcn_mfma_f32_32x32x16_bf16(b1, qr[d0], p1, 0, 0, 0); }
}
template <int VB, bool SK>
__device__ __forceinline__ void pv_tile(f32x16* o, int vb0, bf16x8 pa0, bf16x8 pa1, bf16x8 pa2, bf16x8 pa3, bool act) {
    if (SK && !act) return;
#define TRRD(dst, off) asm volatile("ds_read_b64_tr_b16 %0, %1 offset:%2" : "=&v"(dst) : "v"(vb0), "i"(off) : "memory")
#define PV_D0(d0) do { s16x4 l0, l1, l2, l3, h0, h1, h2, h3; constexpr int b_ = VB * SHM_V + v_rd_off(d0, 0, 0); \
        TRRD(l0, b_); TRRD(h0, b_ + 2048); TRRD(l1, b_ + 4096); TRRD(h1, b_ + 6144); TRRD(l2, b_ + 8192); TRRD(h2, b_ + 10240); TRRD(l3, b_ + 12288); TRRD(h3, b_ + 14336); \
        asm volatile("s_waitcnt lgkmcnt(0)" ::: "memory"); SBAR(); \
        o[d0] = __builtin_amdgcn_mfma_f32_32x32x16_bf16(pa0, (bf16x8){l0[0], l0[1], l0[2], l0[3], h0[0], h0[1], h0[2], h0[3]}, o[d0], 0, 0, 0);   \
        o[d0] = __builtin_amdgcn_mfma_f32_32x32x16_bf16(pa1, (bf16x8){l1[0], l1[1], l1[2], l1[3], h1[0], h1[1], h1[2], h1[3]}, o[d0], 0, 0, 0);   \
        o[d0] = __builtin_amdgcn_mfma_f32_32x32x16_bf16(pa2, (bf16x8){l2[0], l2[1], l2[2], l2[3], h2[0], h2[1], h2[2], h2[3]}, o[d0], 0, 0, 0);   \
        o[d0] = __builtin_amdgcn_mfma_f32_32x32x16_bf16(pa3, (bf16x8){l3[0], l3[1], l3[2], l3[3], h3[0], h3[1], h3[2], h3[3]}, o[d0], 0, 0, 0); } while (0)
    PV_D0(0); PV_D0(1); PV_D0(2); PV_D0(3);
#undef PV_D0
#undef TRRD
}

struct BlockRef { const bf16_t* Q; const bf16_t* K; const bf16_t* V; bf16_t* O; const void* mask; const bf16_t* gate; int P0; int pad; };
struct Seam { bf16x8 qr[8]; bf16x8 st_v0, st_v1, st_k0, st_k1; };
__device__ __forceinline__ int swa_jlo(int P0, int W) { const int lowk = P0 - W + 1; return lowk > 0 ? lowk / KVBLK : 0; }
#define ROW(p, k0, rr) ((p) + (size_t)(k0) * LDP + (unsigned)((rr) * LDP + sc))
#define VMW() asm volatile("s_waitcnt vmcnt(0)" ::: "memory")
#define VMWN(n) asm volatile("s_waitcnt vmcnt(%0)" :: "i"(n) : "memory")
#define SLOAD_H(Kp, Vp, k0) do { S.st_v0 = load8(ROW(Vp, k0, sr)); S.st_v1 = load8(ROW(Vp, k0, 32 + sr));              \
                         S.st_k0 = load8(ROW(Kp, k0, sr)); S.st_k1 = load8(ROW(Kp, k0, 32 + sr)); } while (0)
#define SWRITE_HK(bf) do { *(bf16x8*)(K_lds + (bf) * SHM_K + kws) = S.st_k0; *(bf16x8*)(K_lds + (bf) * SHM_K + kws + 32 * 256) = S.st_k1; } while (0)
#define SWRITE_HV(bf) do { *(bf16x8*)(V_lds + (bf) * SHM_V + vst0) = S.st_v0; *(bf16x8*)(V_lds + (bf) * SHM_V + vst1) = S.st_v1; } while (0)
#define SWRITE_H(bf) do { SWRITE_HV(bf); SWRITE_HK(bf); } while (0)
__device__ __forceinline__ void prime(const BlockRef& cur, int W, char* lds, Seam& S, int tid) {
    const int wid = __builtin_amdgcn_readfirstlane(tid >> 6), lane = tid & 63, r32 = lane & 31, hi = lane >> 5;
    const int sr = tid >> 4, sc = (tid & 15) * 8, kws = KSWZ(sr, sc * 2); char* K_lds = lds + 2 * SHM_V;
    const int kb0 = swa_jlo(cur.P0, W) * KVBLK;
    for (int d0 = 0; d0 < 8; ++d0) S.qr[d0] = load8(cur.Q + (unsigned)((wid * QBLK + r32) * LDP + hi * 8) + d0 * 16);
    SLOAD_H(cur.K, cur.V, kb0); VMW(); SWRITE_HK(0);
    __syncthreads();
}
template <int MODE, bool SK>
__device__ __forceinline__ void block(const BlockRef& cur, const BlockRef& nxt, int skv, int W, char* lds, Seam& S, int tid) {
    const int wid = __builtin_amdgcn_readfirstlane(tid >> 6), lane = tid & 63, r32 = lane & 31, hi = lane >> 5;
    const int j_lo = swa_jlo(cur.P0, W);
    int j_hi = (cur.P0 + QB - 1) / KVBLK + 1; if (j_hi > skv / KVBLK) j_hi = skv / KVBLK;
    const int NT = j_hi - j_lo;
    const int kbn = swa_jlo(nxt.P0, W) * KVBLK;
    const int qlo = cur.P0 + wid * QBLK, qm = qlo + r32 - 4 * hi;
    char* V_lds = lds; char* K_lds = lds + 2 * SHM_V;
    float* ws = (float*)(lds + 2 * SHM_V + 2 * SHM_K) + wid * 64; float* li_l = ws, * al_l = ws + 32;
    float m_reg = -1e30f, l_reg = 0; f32x16 o[4] = {};
    const int sr = tid >> 4, sc = (tid & 15) * 8, vst0 = v_st(sr, sc), vst1 = v_st(32 + sr, sc), kws = KSWZ(sr, sc * 2);
    const int vb0 = (int)(uintptr_t)V_lds + v_rd_base(lane);
    const bf16_t* Kh = cur.K; const bf16_t* Vh = cur.V;
    unsigned rowmask = 0xffffffffu;
    if (MODE == 0) rowmask = ((const unsigned char*)cur.mask)[(unsigned)((wid * QBLK + r32) * 8)];
    if (MODE == 1) rowmask = ((const unsigned*)cur.mask)[(unsigned)((wid * QBLK + r32) * 2)];
    constexpr int BSH = (MODE == 0) ? 8 : 6;
#define RESC(a) do { if (__any((a) < 1.f)) { if (hi == 0) al_l[r32] = (a); asm volatile("s_waitcnt lgkmcnt(0)" ::: "memory");              \
                     for (int d_ = 0; d_ < 4; ++d_) for (int r = 0; r < 16; ++r) o[d_][r] *= al_l[crow(r, hi)]; } } while (0)
#define KBASE(t) ((j_lo + (t)) * KVBLK)
#define ACT(t) (KBASE(t) <= qlo + QBLK - 1 && KBASE(t) + KVBLK - 1 >= qlo - W + 1)
#define MASKT(P0_, P1_, t) do { const int kb_ = KBASE(t); if ((!SK || ACT(t)) && (kb_ + KVBLK - 1 > qlo || kb_ <= qlo + QBLK - 1 - W)) mask_tile(P0_, P1_, qm - kb_, (unsigned)W); \
        if (MODE != 2) { const bool ok_ = (rowmask >> (kb_ >> BSH)) & 1u; if (!__all(ok_)) mask_all(P0_, P1_, ok_); } } while (0)
    constexpr int NQL = 8;
#define SEAM_K0() do { VMWN(NQL); SWRITE_HK(0); SBAR(); } while (0)
    f32x16 pA0, pA1, pB0, pB1; float mnA, mnB, alA, alB; bf16x8 pa0, pa1, pa2, pa3;
    SWRITE_HV(0); SBAR();
    if (NT > 1) { SLOAD_H(Kh, Vh, KBASE(1)); }
    SBAR(); qkt<0, SK>(pA0, pA1, K_lds, r32, hi, S.qr, ACT(0));
    MASKT(pA0, pA1, 0); partialSM(pA0, pA1, m_reg, mnA, alA);
    if (NT > 1) { VMW(); SWRITE_H(1); }
    __syncthreads();
#define HALF_STEP(PX0, PX1, mnX, alX, PY0, PY1, alY, t, KB, VB, SB) do {                                                      \
        SBAR(); qkt<KB, SK>(PX0, PX1, K_lds, r32, hi, S.qr, ACT(t));                                             \
        finishSM(PY0, PY1, alY, l_reg, pa0, pa1, pa2, pa3); SBAR();                                                           \
        if ((t) + 1 < NT) { SLOAD_H(Kh, Vh, KBASE((t) + 1)); SBAR(); }                                               \
        pv_tile<VB, SK>(o, vb0, pa0, pa1, pa2, pa3, ACT((t) - 1)); MASKT(PX0, PX1, (t)); partialSM(PX0, PX1, m_reg, mnX, alX);                                        \
        __syncthreads();                                                                                                      \
        if ((t) + 1 < NT) { VMW(); SWRITE_H(SB); }                                                                          \
        RESC(alX); __syncthreads(); } while (0)
    for (int t = 1; t + 1 < NT; t += 2) {
        HALF_STEP(pB0, pB1, mnB, alB, pA0, pA1, alA, t, 1, 0, 0);
        HALF_STEP(pA0, pA1, mnA, alA, pB0, pB1, alB, t + 1, 0, 1, 1);
    }
    const bool even = (NT & 1) == 0;
    if (even) { SBAR(); qkt<1, SK>(pB0, pB1, K_lds, r32, hi, S.qr, ACT(NT - 1)); SBAR(); }
    SLOAD_H(nxt.K, nxt.V, kbn); SBAR();
#pragma unroll
    for (int d0 = 0; d0 < 8; ++d0) S.qr[d0] = load8(nxt.Q + (unsigned)((wid * QBLK + r32) * LDP + hi * 8) + d0 * 16);
    SBAR();
    finishSM(pA0, pA1, alA, l_reg, pa0, pa1, pa2, pa3); SBAR();
    pv_tile<0, SK>(o, vb0, pa0, pa1, pa2, pa3, ACT(even ? NT - 2 : NT - 1));
    if (even) { MASKT(pB0, pB1, NT - 1); partialSM(pB0, pB1, m_reg, mnB, alB); __syncthreads(); RESC(alB);
        finishSM(pB0, pB1, alB, l_reg, pa0, pa1, pa2, pa3); SBAR(); pv_tile<1, SK>(o, vb0, pa0, pa1, pa2, pa3, ACT(NT - 1)); }
    SBAR(); SEAM_K0();
    { int le = lane; asm volatile("" : "+v"(le)); const int r32e = le & 31, hie = le >> 5;
    if (hie == 0) { float sc_ = 1.f / l_reg;
        if (MODE != 0) { const float gl = bf2f(cur.gate[(unsigned)((wid * QBLK + r32e) * LDP)]); sc_ *= fast_sigmoid(gl); }
        li_l[r32e] = sc_; }
    asm volatile("s_waitcnt lgkmcnt(0)" ::: "memory");
    bf16_t* Ow = cur.O + (size_t)(wid * QBLK) * 1024;
#pragma unroll
    for (int r = 0; r < 16; ++r) { const int orow = crow(r, hie); const float rl = li_l[orow];
#pragma unroll
        for (int d0 = 0; d0 < 4; ++d0) { const float v = o[d0][r] * rl;
            const float vn = __shfl_xor(v, 1);
            if ((r32e & 1) == 0) { unsigned* dp = (unsigned*)(Ow + (unsigned)(orow * 1024 + r32e) + d0 * 32);
                float a = v, b = vn;
                if (MODE != 0) { const unsigned pw = *dp; a += bf_lo(pw); b += bf_hi(pw); }
                *dp = cvt_pk_bf16(a, b); } } } }
    __syncthreads();
#undef RESC
#undef KBASE
#undef ACT
#undef MASKT
#undef SEAM_K0
#undef HALF_STEP
}
#undef ROW
#undef VMW
#undef VMWN
#undef SLOAD_H
#undef SWRITE_HK
#undef SWRITE_HV
#undef SWRITE_H
#undef KSWZ
#undef SBAR
}
constexpr size_t WS_DUMMY = (size_t)1180 * 1000 * 1000;
constexpr size_t WS_MOBAMASK = WS_END2;
constexpr size_t WS_SELMASK = WS_MOBAMASK + al256((size_t)T * 8);
constexpr size_t WS_END3 = WS_SELMASK + al256((size_t)T * 2 * 4);

__device__ __forceinline__ void p_moba_prep(const Frame& F0, int wg0) {
    const Frame F = phase_frame(F0);
    if (F.c < wg0) return;
    const bf16_t* proj = (const bf16_t*)(F.ws + WS_PROJ); unsigned char* mm = (unsigned char*)(F.ws + WS_MOBAMASK);
    LAS float* km = (LAS float*)F.lds;
    LAS float* part = km + 8 * 128;
    for (int u = F.c - wg0; u < NB * 8 * 8; u += F.G - wg0) {
        const int pb = u & 7, h = (u >> 3) & 7, b = u >> 6;
        const int kgrp = F.tid >> 7, d = F.tid & 127;
        for (int n = 0; n < pb; ++n) {
            const bf16_t* kp = proj + ((size_t)b * S + n * 256 + kgrp * 64) * LDP + P_MK + h * 128 + d; float a = 0.f;
            for (int j = 0; j < 64; ++j) a += bf2f(kp[(size_t)j * LDP]);
            part[kgrp * 128 + d] = a; __syncthreads();
            if (F.tid < 128) km[n * 128 + d] = (part[d] + part[128 + d] + part[256 + d] + part[384 + d]) * (1.f / 256.f);
            __syncthreads();
        }
        const int pos = F.tid >> 1, half = F.tid & 1; const size_t t = (size_t)b * S + pb * 256 + pos;
        float gt[8];
#pragma unroll
        for (int n = 0; n < 8; ++n) gt[n] = 0.f;
        const bf16_t* qp = proj + t * LDP + P_MQ + h * 128 + half * 64;
        for (int c8 = 0; c8 < 8; ++c8) { const u32x4 qw = *(const u32x4*)(qp + c8 * 8);
            const float qf[8] = {bf_lo(qw[0]), bf_hi(qw[0]), bf_lo(qw[1]), bf_hi(qw[1]), bf_lo(qw[2]), bf_hi(qw[2]), bf_lo(qw[3]), bf_hi(qw[3])};
#pragma unroll
            for (int n = 0; n < 8; ++n) if (n < pb) {
#pragma unroll
                for (int j = 0; j < 8; ++j) gt[n] += qf[j] * km[n * 128 + half * 64 + c8 * 8 + j]; } }
        unsigned taken = 0;
#pragma unroll
        for (int n = 0; n < 8; ++n) { gt[n] += __shfl_xor(gt[n], 1); if (n >= pb) gt[n] = -1e30f; }
#pragma unroll
        for (int k = 0; k < 3; ++k) { int best = -1; float bv = 0.f;
#pragma unroll
            for (int n = 0; n < 8; ++n) if (!((taken >> n) & 1u) && (best < 0 || gt[n] > bv)) { best = n; bv = gt[n]; }
            taken |= 1u << best; }
        unsigned m = (taken & ((1u << pb) - 1u)) | (1u << pb);
        if (half == 0) mm[t * 8 + h] = (unsigned char)m;
        __syncthreads();
    }
}
__device__ __forceinline__ att::BlockRef ref_moba(const bf16_t* proj, bf16_t* om, const unsigned char* mm, int L, int pass) {
    const int bh = L >> 2, y = L & 3, b = bh >> 3, h = bh & 7; const int qb = pass ? 7 - y : y; const size_t t0 = (size_t)b * S + qb * 256;
    att::BlockRef r; r.Q = proj + t0 * LDP + P_MQ + h * 128; r.K = proj + (size_t)b * S * LDP + P_MK + h * 128; r.V = proj + (size_t)b * S * LDP + P_MV + h * 128;
    r.O = om + t0 * 1024 + h * 128; r.mask = mm + t0 * 8 + h; r.gate = nullptr; r.P0 = qb * 256; r.pad = 0; return r; }
template <int BR>
__device__ __forceinline__ att::BlockRef ref_nsa(const bf16_t* proj, bf16_t* on, const unsigned* sm, int L, int pass) {
    const int bh = L >> 2, y = L & 3, b = bh >> 3, h = bh & 7, g = h >> 2; const int qb = pass ? 7 - y : y; const size_t t0 = (size_t)b * S + qb * 256;
    att::BlockRef r; r.Q = proj + t0 * LDP + P_NQ + h * 128; r.K = proj + (size_t)b * S * LDP + P_NKV + (2 + 2 * BR) * 256 + g * 128; r.V = proj + (size_t)b * S * LDP + P_NKV + (3 + 2 * BR) * 256 + g * 128;
    r.O = on + t0 * 1024 + h * 128; r.mask = sm + t0 * 2 + g; r.gate = proj + t0 * LDP + P_NG + h * 3 + 1 + BR; r.P0 = qb * 256; r.pad = 0; return r; }
template <int WIN, bool DUMMY>
__device__ __forceinline__ void p_moba_attn_t(const Frame& F0) {
    const Frame F = phase_frame(F0);
    const bf16_t* proj = (const bf16_t*)(F.ws + WS_PROJ); bf16_t* om = (bf16_t*)(F.ws + (DUMMY ? WS_DUMMY : WS_OM)); const unsigned char* mm = (const unsigned char*)(F.ws + WS_MOBAMASK);
    const int total = NB * 8 * 8;

    const int nitems = total / 2;
    int L = F.c; if (L >= nitems) return;
    int pass = 0; att::BlockRef cur = ref_moba(proj, om, mm, L, 0); att::Seam Sm;
    att::prime(cur, WIN, (char*)F.lds, Sm, F.tid);
    for (;;) {
        const bool more_pass = pass == 0, more_item = L + F.G < nitems, last = !more_pass && !more_item;
        int passn = pass + 1, Ln = L; if (!more_pass) { passn = 0; Ln = more_item ? L + F.G : L; }
        const att::BlockRef nxt = last ? cur : ref_moba(proj, om, mm, Ln, passn);
        att::block<0, false>(cur, nxt, S, WIN, (char*)F.lds, Sm, F.tid);
        if (last) break;
        cur = nxt; pass = passn; L = Ln;
    }
}
__device__ __forceinline__ void p_moba_attn(const Frame& F0) { p_moba_attn_t<(1 << 20), false>(F0); }
__device__ __forceinline__ void p_nsa_attn(const Frame& F0) {
    const int nitems = NB * 8 * 4;
    if (F0.c >= nitems) return;
    {
        const Frame F = phase_frame(F0);
        const bf16_t* proj = (const bf16_t*)(F.ws + WS_PROJ); bf16_t* on = (bf16_t*)(F.ws + WS_ON); const unsigned* sm = (const unsigned*)(F.ws + WS_SELMASK);

        int L = F.c, pass = 0; att::BlockRef cur = ref_nsa<0>(proj, on, sm, L, 0); att::Seam Sm;
        att::prime(cur, 1 << 20, (char*)F.lds, Sm, F.tid);
        for (;;) {
            const bool more_pass = pass == 0, more_item = L + F.G < nitems, last = !more_pass && !more_item;
            int passn = pass + 1, Ln = L; if (!more_pass) { passn = 0; Ln = more_item ? L + F.G : L; }
            const att::BlockRef nxt = last ? cur : ref_nsa<0>(proj, on, sm, Ln, passn);
            att::block<1, false>(cur, nxt, S, 1 << 20, (char*)F.lds, Sm, F.tid);
            if (last) break;
            cur = nxt; pass = passn; L = Ln;
        }
    }
    {
        const Frame F = phase_frame(F0);
        const bf16_t* proj = (const bf16_t*)(F.ws + WS_PROJ); bf16_t* on = (bf16_t*)(F.ws + WS_ON); const unsigned* sm = (const unsigned*)(F.ws + WS_SELMASK);

        int L = F.c, pass = 0; att::BlockRef cur = ref_nsa<1>(proj, on, sm, L, 0); att::Seam Sm;
        att::prime(cur, 512, (char*)F.lds, Sm, F.tid);
        for (;;) {
            const bool more_pass = pass == 0, more_item = L + F.G < nitems, last = !more_pass && !more_item;
            int passn = pass + 1, Ln = L; if (!more_pass) { passn = 0; Ln = more_item ? L + F.G : L; }
            const att::BlockRef nxt = last ? cur : ref_nsa<1>(proj, on, sm, Ln, passn);
            att::block<2, false>(cur, nxt, S, 512, (char*)F.lds, Sm, F.tid);
            if (last) break;
            cur = nxt; pass = passn; L = Ln;
        }
    }
}

constexpr size_t WS_GDS = WS_MERGED;
constexpr size_t WS_GQT = WS_DEC;
constexpr size_t WS_GDL = WS_END3;
constexpr size_t WS_END4 = WS_GDL + al256((size_t)1024 * 128 * 4);

__device__ __forceinline__ void p_gla1(const Frame& F0, int l, int wg0) {
    const Frame F = phase_frame(F0);
    if (F.c < wg0) return;
    const bf16_t* proj = (const bf16_t*)(F.ws + WS_PROJ);
    const float* wa = F.in(6) + (size_t)l * 16 * 512; const float* ba = F.in(7) + (size_t)l * 512;
    float* ograw = (float*)(F.ws + WS_OGRAW); bf16_t* gds = (bf16_t*)(F.ws + WS_GDS); bf16_t* gqt = (bf16_t*)(F.ws + WS_GQT); float* gdl = (float*)(F.ws + WS_GDL);
    LAS bf16_t* bq = (LAS bf16_t*)F.lds;
    LAS bf16_t* bk = bq + 64 * 136;
    LAS bf16_t* bkT = bk + 64 * 136;
    LAS bf16_t* bvT = bkT + 128 * 72;
    LAS bf16_t* rv = bvT + 256 * 72;
    LAS bf16_t* bA = rv;
    LAS float* gs = (LAS float*)(rv + 64 * 256);
    LAS bf16_t* sga = (LAS bf16_t*)(gs + 512);
    const int tid = F.tid, lane = F.lane, w = F.wave, r32 = lane & 31, hh = lane >> 5;
    for (int u = F.c - wg0; u < 1024; u += F.G - wg0) {
        const int c = u & 31, h = (u >> 5) & 3, b = u >> 7; const size_t row0 = (size_t)b * S + c * 64;
        {
            u32x4 lq[2], lk[2], lv[4], lg = {0u, 0u, 0u, 0u};
#pragma unroll
            for (int i = 0; i < 2; ++i) { const int ch = i * NTHR + tid, t = ch >> 4, cc = ch & 15; lq[i] = *(const u32x4*)(proj + (row0 + t) * LDP + P_GQ + h * 128 + cc * 8); lk[i] = *(const u32x4*)(proj + (row0 + t) * LDP + P_GK + h * 128 + cc * 8); }
#pragma unroll
            for (int i = 0; i < 4; ++i) { const int ch = i * NTHR + tid, t = ch >> 5, cc = ch & 31; lv[i] = *(const u32x4*)(proj + (row0 + t) * LDP + P_GV + h * 256 + cc * 8); }
            if (tid < 128) lg = *(const u32x4*)(proj + (row0 + (tid >> 1)) * LDP + P_GA + (tid & 1) * 8);
#pragma unroll
            for (int i = 0; i < 2; ++i) { const int ch = i * NTHR + tid, t = ch >> 4, cc = ch & 15; *(LAS u32x4*)(bq + t * 136 + cc * 8) = lq[i]; *(LAS u32x4*)(bk + t * 136 + cc * 8) = lk[i]; }
#pragma unroll
            for (int i = 0; i < 4; ++i) { const int ch = i * NTHR + tid, t = ch >> 5, cc = ch & 31; *(LAS u32x4*)(rv + t * 256 + cc * 8) = lv[i]; }
            if (tid < 128) *(LAS u32x4*)(sga + (tid >> 1) * 16 + (tid & 1) * 8) = lg;
        }
        __syncthreads();
        {
            const int d = tid & 127, tq = tid >> 7, col = h * 128 + d;
            float war[16];
#pragma unroll
            for (int r = 0; r < 16; ++r) war[r] = wa[r * 512 + col];
            const float bias = ba[col];
            float bl[16]; float cum = 0.f;
#pragma unroll
            for (int i = 0; i < 16; ++i) { const LAS bf16_t* gp = sga + (tq * 16 + i) * 16;
                const u32x4 g0 = *(const LAS u32x4*)gp, g1 = *(const LAS u32x4*)(gp + 8);
                float x = bias + bf_lo(g0[0]) * war[0] + bf_hi(g0[0]) * war[1] + bf_lo(g0[1]) * war[2] + bf_hi(g0[1]) * war[3] + bf_lo(g0[2]) * war[4] + bf_hi(g0[2]) * war[5] + bf_lo(g0[3]) * war[6] + bf_hi(g0[3]) * war[7]
                        + bf_lo(g1[0]) * war[8] + bf_hi(g1[0]) * war[9] + bf_lo(g1[1]) * war[10] + bf_hi(g1[1]) * war[11] + bf_lo(g1[2]) * war[12] + bf_hi(g1[2]) * war[13] + bf_lo(g1[3]) * war[14] + bf_hi(g1[3]) * war[15];
                const float ls = fminf(x, 0.f) - 0.6931471805599453f * __builtin_amdgcn_logf(1.f + __builtin_amdgcn_exp2f(-1.4426950408889634f * fabsf(x)));
                cum += ls * (1.f / 16.f); bl[i] = cum; }
            gs[tq * 128 + d] = cum;
            __syncthreads();
            float off = 0.f, tot = 0.f;
#pragma unroll
            for (int q = 0; q < 4; ++q) { const float g = gs[q * 128 + d]; if (q < tq) off += g; tot += g; }
            unsigned kt[8];
#pragma unroll
            for (int i = 0; i < 16; ++i) { const float bt = off + bl[i]; const int t = tq * 16 + i;
                const float qv = bf2f(bq[t * 136 + d]), kv = bf2f(bk[t * 136 + d]);
                const float eb = __builtin_amdgcn_exp2f(1.4426950408889634f * bt);
                bq[t * 136 + d] = f2bf(qv * 0.08838834764831845f * eb); bk[t * 136 + d] = f2bf(kv * __builtin_amdgcn_rcpf(eb));
                const float kh = kv * __builtin_amdgcn_exp2f(1.4426950408889634f * (tot - bt));
                if (i & 1) kt[i >> 1] |= ((unsigned)f2bf(kh)) << 16; else kt[i >> 1] = f2bf(kh); }
            *(LAS u32x4*)(bkT + d * 72 + tq * 16) = (u32x4){kt[0], kt[1], kt[2], kt[3]}; *(LAS u32x4*)(bkT + d * 72 + tq * 16 + 8) = (u32x4){kt[4], kt[5], kt[6], kt[7]};
            if (tq == 0) gdl[(size_t)u * 128 + d] = __builtin_amdgcn_exp2f(1.4426950408889634f * tot);
        }
        {
            const int e = tid & 255, sg = tid >> 8;
#pragma unroll
            for (int q = 0; q < 4; ++q) { unsigned vt[4];
#pragma unroll
                for (int jj = 0; jj < 8; ++jj) { const bf16_t v = rv[(sg * 32 + q * 8 + jj) * 256 + e]; if (jj & 1) vt[jj >> 1] |= ((unsigned)v) << 16; else vt[jj >> 1] = v; }
                *(LAS u32x4*)(bvT + e * 72 + sg * 32 + q * 8) = (u32x4){vt[0], vt[1], vt[2], vt[3]}; }
        }
        __syncthreads();
        for (int i = tid; i < 1024; i += NTHR) { const int t = i >> 4, ch = i & 15; *(u32x4*)(gqt + (row0 + t) * 512 + h * 128 + ch * 8) = *(const LAS u32x4*)(bq + t * 136 + ch * 8); }
        if (w < 3) { const int tt = w == 0 ? 0 : 1, ss = w == 2 ? 1 : 0; f32x16 acc = {};
#pragma unroll
            for (int ks = 0; ks < 8; ++ks) { const bf16x8 a = *(const LAS bf16x8*)(bq + (tt * 32 + r32) * 136 + ks * 16 + hh * 8), bb = *(const LAS bf16x8*)(bk + (ss * 32 + r32) * 136 + ks * 16 + hh * 8);
                acc = __builtin_amdgcn_mfma_f32_32x32x16_bf16(a, bb, acc, 0, 0, 0); }
#pragma unroll
            for (int i = 0; i < 16; ++i) { const int t = tt * 32 + (i & 3) + 8 * (i >> 2) + 4 * hh, s = ss * 32 + r32; bA[t * 72 + s] = f2bf(t >= s ? acc[i] : 0.f); } }
        else if (w == 3) {
#pragma unroll
            for (int i = 0; i < 16; ++i) { const int t = (i & 3) + 8 * (i >> 2) + 4 * hh; bA[t * 72 + 32 + r32] = 0; } }
        __syncthreads();
        {
            f32x16 o0 = {}, o1 = {}, s0 = {}, s1 = {}, s2 = {}, s3 = {};
#pragma unroll
            for (int ks = 0; ks < 4; ++ks) { const bf16x8 vf = *(const LAS bf16x8*)(bvT + (w * 32 + r32) * 72 + ks * 16 + hh * 8);
                const bf16x8 a0 = *(const LAS bf16x8*)(bA + r32 * 72 + ks * 16 + hh * 8), a1 = *(const LAS bf16x8*)(bA + (32 + r32) * 72 + ks * 16 + hh * 8);
                o0 = __builtin_amdgcn_mfma_f32_32x32x16_bf16(a0, vf, o0, 0, 0, 0); o1 = __builtin_amdgcn_mfma_f32_32x32x16_bf16(a1, vf, o1, 0, 0, 0);
                const bf16x8 k0 = *(const LAS bf16x8*)(bkT + r32 * 72 + ks * 16 + hh * 8), k1 = *(const LAS bf16x8*)(bkT + (32 + r32) * 72 + ks * 16 + hh * 8),
                             k2 = *(const LAS bf16x8*)(bkT + (64 + r32) * 72 + ks * 16 + hh * 8), k3 = *(const LAS bf16x8*)(bkT + (96 + r32) * 72 + ks * 16 + hh * 8);
                s0 = __builtin_amdgcn_mfma_f32_32x32x16_bf16(vf, k0, s0, 0, 0, 0); s1 = __builtin_amdgcn_mfma_f32_32x32x16_bf16(vf, k1, s1, 0, 0, 0);
                s2 = __builtin_amdgcn_mfma_f32_32x32x16_bf16(vf, k2, s2, 0, 0, 0); s3 = __builtin_amdgcn_mfma_f32_32x32x16_bf16(vf, k3, s3, 0, 0, 0); }
#pragma unroll
            for (int i = 0; i < 16; ++i) { const int rr = (i & 3) + 8 * (i >> 2) + 4 * hh;
                ograw[(row0 + rr) * 1024 + h * 256 + w * 32 + r32] = o0[i]; ograw[(row0 + 32 + rr) * 1024 + h * 256 + w * 32 + r32] = o1[i];
                const float p0 = __shfl_xor(s0[i], 1), p1 = __shfl_xor(s1[i], 1), p2 = __shfl_xor(s2[i], 1), p3 = __shfl_xor(s3[i], 1);
                if ((r32 & 1) == 0) { unsigned* dp = (unsigned*)(gds + ((size_t)u * 256 + w * 32 + rr) * 128 + r32);
                    dp[0] = cvt_pk_bf16(s0[i], p0); dp[16] = cvt_pk_bf16(s1[i], p1); dp[32] = cvt_pk_bf16(s2[i], p2); dp[48] = cvt_pk_bf16(s3[i], p3); } }
        }
        __syncthreads();
    }
}
__device__ __forceinline__ void p_gla2(const Frame& F0) {
    const Frame F = phase_frame(F0);
    bf16_t* gds = (bf16_t*)(F.ws + WS_GDS); const float* gdl = (const float*)(F.ws + WS_GDL);
    for (int i = F.c * NTHR + F.tid; i < 32 * 4096; i += F.G * NTHR) {
        const int bh = i >> 12, e = (i >> 4) & 255, dg = i & 15;
        float st[8];
#pragma unroll
        for (int j = 0; j < 8; ++j) st[j] = 0.f;
        for (int c = 0; c < 32; ++c) { const size_t u = (size_t)bh * 32 + c; bf16_t* p = gds + (u * 256 + e) * 128 + dg * 8;
            const u32x4 dsv = *(const u32x4*)p; const f32x4 d0 = *(const f32x4*)(gdl + u * 128 + dg * 8), d1 = *(const f32x4*)(gdl + u * 128 + dg * 8 + 4);
            u32x4 o = {cvt_pk_bf16(st[0], st[1]), cvt_pk_bf16(st[2], st[3]), cvt_pk_bf16(st[4], st[5]), cvt_pk_bf16(st[6], st[7])};
            *(u32x4*)p = o;
            st[0] = d0[0] * st[0] + bf_lo(dsv[0]); st[1] = d0[1] * st[1] + bf_hi(dsv[0]); st[2] = d0[2] * st[2] + bf_lo(dsv[1]); st[3] = d0[3] * st[3] + bf_hi(dsv[1]);
            st[4] = d1[0] * st[4] + bf_lo(dsv[2]); st[5] = d1[1] * st[5] + bf_hi(dsv[2]); st[6] = d1[2] * st[6] + bf_lo(dsv[3]); st[7] = d1[3] * st[7] + bf_hi(dsv[3]); }
    }
}
__device__ __forceinline__ void p_gla3(const Frame& F0, int l) {
    const Frame F = phase_frame(F0);
    const bf16_t* proj = (const bf16_t*)(F.ws + WS_PROJ); const float* ng = F.in(8) + (size_t)l * 256;
    const float* ograw = (const float*)(F.ws + WS_OGRAW); const bf16_t* gds = (const bf16_t*)(F.ws + WS_GDS); const bf16_t* gqt = (const bf16_t*)(F.ws + WS_GQT); bf16_t* og = (bf16_t*)(F.ws + WS_OG);
    LAS float* ot = (LAS float*)F.lds;
    const int lane = F.lane, w = F.wave, r32 = lane & 31, hh = lane >> 5;
    for (int u = F.c; u < 1024; u += F.G) {
        const int c = u & 31, h = (u >> 5) & 3, b = u >> 7; const size_t row0 = (size_t)b * S + c * 64;
        f32x16 o0 = {}, o1 = {};
#pragma unroll
        for (int ks = 0; ks < 8; ++ks) { const bf16x8 sf = *(const bf16x8*)(gds + ((size_t)u * 256 + w * 32 + r32) * 128 + ks * 16 + hh * 8);
            const bf16x8 a0 = *(const bf16x8*)(gqt + (row0 + r32) * 512 + h * 128 + ks * 16 + hh * 8), a1 = *(const bf16x8*)(gqt + (row0 + 32 + r32) * 512 + h * 128 + ks * 16 + hh * 8);
            o0 = __builtin_amdgcn_mfma_f32_32x32x16_bf16(a0, sf, o0, 0, 0, 0); o1 = __builtin_amdgcn_mfma_f32_32x32x16_bf16(a1, sf, o1, 0, 0, 0); }
#pragma unroll
        for (int i = 0; i < 16; ++i) { const int rr = (i & 3) + 8 * (i >> 2) + 4 * hh;
            ot[rr * 260 + w * 32 + r32] = o0[i] + ograw[(row0 + rr) * 1024 + h * 256 + w * 32 + r32];
            ot[(32 + rr) * 260 + w * 32 + r32] = o1[i] + ograw[(row0 + 32 + rr) * 1024 + h * 256 + w * 32 + r32]; }
        __syncthreads();
#pragma unroll
        for (int q = 0; q < 8; ++q) { const int t = w * 8 + q; const f32x4 v = *(const LAS f32x4*)(ot + t * 260 + lane * 4);
            float ss = v[0] * v[0] + v[1] * v[1] + v[2] * v[2] + v[3] * v[3];
#pragma unroll
            for (int o = 32; o > 0; o >>= 1) ss += __shfl_xor(ss, o);
            const float rstd = rsqrtf(ss * (1.f / 256.f) + 1e-6f);
            const f32x4 gn = *(const f32x4*)(ng + lane * 4); const u32x2 gw = *(const u32x2*)(proj + (row0 + t) * LDP + P_GG + h * 256 + lane * 4);
            u32x2 ov; ov[0] = cvt_pk_bf16(v[0] * rstd * gn[0] * fast_silu(bf_lo(gw[0])), v[1] * rstd * gn[1] * fast_silu(bf_hi(gw[0])));
            ov[1] = cvt_pk_bf16(v[2] * rstd * gn[2] * fast_silu(bf_lo(gw[1])), v[3] * rstd * gn[3] * fast_silu(bf_hi(gw[1])));
            *(u32x2*)(og + (row0 + t) * 1024 + h * 256 + lane * 4) = ov; }
        __syncthreads();
    }
}

constexpr size_t WS_CHID = WS_GDL + al256((size_t)1024 * 128 * 4);
constexpr size_t WS_KC   = WS_CHID + al256((size_t)2 * 2048 * 256 * 2);
constexpr size_t WS_VCT  = WS_KC + al256((size_t)16 * 128 * 128 * 2);
constexpr size_t WS_CP   = WS_VCT + al256((size_t)16 * 128 * 128 * 2);
constexpr size_t WS_END5 = WS_CP + al256((size_t)2 * 2048 * 256 * 2);

__device__ __forceinline__ void p_conv_cmp(const Frame& F0) {
    const Frame F = phase_frame(F0);
    const float* pe = F.in(3); const float* w1 = F.in(4); const float* w2 = F.in(5);
    bf16_t* wc2 = (bf16_t*)(F.ws + WS_WC2); float* bias1 = (float*)(F.ws + WS_BIAS1);
    for (int i = F.c * NTHR + F.tid; i < NL * 2 * 256 * 256; i += F.G * NTHR) { const int k = i & 255, n = (i >> 8) & 255, lc = i >> 16;
        wc2[i] = (k < 128 && n < 128) ? f2bf(w2[((size_t)lc * 128 + k) * 128 + n]) : (bf16_t)0; }
    LAS float* part = (LAS float*)F.lds;
    for (int lc = F.c; lc < NL * 2; lc += F.G) { const int o = F.tid & 127, kg = F.tid >> 7; float a = 0.f;
        for (int i = kg * 1024; i < kg * 1024 + 1024; ++i) a += pe[(size_t)lc * 4096 + i] * w1[((size_t)lc * 4096 + i) * 128 + o];
        part[kg * 128 + o] = a; __syncthreads();
        if (F.tid < 256) bias1[lc * 256 + F.tid] = F.tid < 128 ? part[F.tid] + part[128 + F.tid] + part[256 + F.tid] + part[384 + F.tid] : 0.f;
        __syncthreads(); }
}
struct SchedCmp1 {
    static constexpr bool GATHER = true;
    const char* proj; const char* W; int G, c;
    __device__ __forceinline__ bool next(int i, ge::Unit& u) const { const int L = i * G + c; if (L >= 16) return false; const int cc = L >> 3, pm = L & 7;
        u.A = proj + (size_t)(P_NKV + cc * 256) * 2; u.B = W + (size_t)cc * 256 * 2048 * 2; u.r0 = pm * 256; u.c0 = 0; u.aux = cc; u.aux2 = 0; return true; }
    __device__ __forceinline__ void voffA(const ge::Unit& u, int tid, unsigned (&v)[2][2]) const {
#pragma unroll
        for (int i = 0; i < 2; ++i) { int R, C; ge::stage_rc(tid * 16 + i * 8192, R, C);
#pragma unroll
            for (int hf = 0; hf < 2; ++hf) { const int r = u.r0 + hf * 128 + R; const int b = r >> 8, g = (r >> 7) & 1, m = r & 127;
                v[hf][i] = (unsigned)(((b * S + 16 * m) * LDP + g * 128 + C)) * 2u; } } }
};
struct EpiCmp1 {
    static constexpr bool PERM = true; bf16_t* P;
    __device__ __forceinline__ void operator()(const f32x4 (&acc)[2][2][4][2], const ge::Unit& u, int wr, int wc, int fr, int fq) const {
#pragma unroll
        for (int ai = 0; ai < 2; ++ai)
#pragma unroll
            for (int m = 0; m < 4; ++m) { bf16_t* rowp = P + ((size_t)u.aux * 2048 + u.r0 + ai * 128 + wr * 64 + m * 16 + fr) * 256 + wc * 32 + 8 * fq;
#pragma unroll
                for (int bj = 0; bj < 2; ++bj) { const f32x4 v0 = acc[ai][bj][m][0], v1 = acc[ai][bj][m][1]; u32x4 w = {cvt_pk_bf16(v0[0], v0[1]), cvt_pk_bf16(v0[2], v0[3]), cvt_pk_bf16(v1[0], v1[1]), cvt_pk_bf16(v1[2], v1[3])};
                    *(u32x4*)(rowp + bj * 128) = w; } }
    }
};
struct SchedCmp2 {
    static constexpr bool GATHER = false;
    const char* hid; const char* W; int G, c;
    __device__ __forceinline__ bool next(int i, ge::Unit& u) const { const int L = i * G + c; if (L >= 16) return false; const int cc = L >> 3, pm = L & 7;
        u.A = hid + ((size_t)cc * 2048 + pm * 256) * 256 * 2; u.B = W + (size_t)cc * 256 * 256 * 2; u.r0 = pm * 256; u.c0 = 0; u.aux = cc; u.aux2 = 0; return true; }
    __device__ __forceinline__ void voffA(const ge::Unit&, int tid, unsigned (&v)[2][2]) const { ge::dense_voffA(256, tid, v); }
};
struct EpiCmp2 {
    static constexpr bool PERM = false; bf16_t* kc; bf16_t* vct;
    __device__ __forceinline__ void operator()(const f32x4 (&acc)[2][2][4][2], const ge::Unit& u, int wr, int wc, int fr, int fq) const {
#pragma unroll
        for (int ai = 0; ai < 2; ++ai)
#pragma unroll
            for (int m = 0; m < 4; ++m) { const int r = u.r0 + ai * 128 + wr * 64 + m * 16 + fr; const int bg = r >> 7, n = r & 127;
#pragma unroll
                for (int nn = 0; nn < 2; ++nn) { const int d = wc * 32 + nn * 16 + 4 * fq; const f32x4 v = acc[ai][0][m][nn];
                    if (u.aux == 0) { u32x2 w = {cvt_pk_bf16(v[0], v[1]), cvt_pk_bf16(v[2], v[3])}; *(u32x2*)(kc + ((size_t)bg * 128 + n) * 128 + d) = w; }
                    else {
#pragma unroll
                        for (int j = 0; j < 4; ++j) vct[((size_t)bg * 128 + d + j) * 128 + n] = f2bf(v[j]); } } }
    }
};
__device__ __forceinline__ void p_nsa_cmp(const Frame& F0, int l) {
    const Frame F = phase_frame(F0);
    if (F.c >= 16) return;
    { SchedCmp1 S{(const char*)(F.ws + WS_PROJ), (const char*)(F.ws + WS_WC1) + (size_t)l * 2 * 256 * 2048 * 2, F.G, F.c};
      EpiCmp1 E{(bf16_t*)(F.ws + WS_CP)};
      ge::gemm_phase<EpiCmp1, SchedCmp1, 1>(F.lds, F.tid, 2048, LDP * 2, S, E); }
    asm volatile("s_waitcnt vmcnt(0)" ::: "memory"); __syncthreads();
    {
        const bf16_t* P = (const bf16_t*)(F.ws + WS_CP); bf16_t* hid = (bf16_t*)(F.ws + WS_CHID); const float* bias1 = (const float*)(F.ws + WS_BIAS1) + (size_t)l * 2 * 256;
        for (int L = F.c; L < 16; L += F.G) { const int cc = L >> 3, pm = L & 7;
            for (int idx = F.tid; idx < 256 * 16; idx += NTHR) { const int row = idx >> 4, ch = idx & 15; const size_t r = (size_t)cc * 2048 + pm * 256 + row;
                u32x4 w = {0u, 0u, 0u, 0u};
                if ((row & 127) != 127) { const u32x4 a = *(const u32x4*)(P + r * 256 + ch * 8), b = *(const u32x4*)(P + (r + 1) * 256 + 128 + ch * 8);
                    const f32x4 b0 = *(const f32x4*)(bias1 + cc * 256 + ch * 8), b1 = *(const f32x4*)(bias1 + cc * 256 + ch * 8 + 4);
                    w[0] = cvt_pk_bf16(fast_silu(bf_lo(a[0]) + bf_lo(b[0]) + b0[0]), fast_silu(bf_hi(a[0]) + bf_hi(b[0]) + b0[1])); w[1] = cvt_pk_bf16(fast_silu(bf_lo(a[1]) + bf_lo(b[1]) + b0[2]), fast_silu(bf_hi(a[1]) + bf_hi(b[1]) + b0[3]));
                    w[2] = cvt_pk_bf16(fast_silu(bf_lo(a[2]) + bf_lo(b[2]) + b1[0]), fast_silu(bf_hi(a[2]) + bf_hi(b[2]) + b1[1])); w[3] = cvt_pk_bf16(fast_silu(bf_lo(a[3]) + bf_lo(b[3]) + b1[2]), fast_silu(bf_hi(a[3]) + bf_hi(b[3]) + b1[3])); }
                *(u32x4*)(hid + r * 256 + ch * 8) = w; *(u32x4*)(hid + r * 256 + 128 + ch * 8) = (u32x4){0u, 0u, 0u, 0u}; } }
    }
    asm volatile("s_waitcnt vmcnt(0)" ::: "memory"); __syncthreads();
    { SchedCmp2 S{(const char*)(F.ws + WS_CHID), (const char*)(F.ws + WS_WC2) + (size_t)l * 2 * 256 * 256 * 2, F.G, F.c};
      EpiCmp2 E{(bf16_t*)(F.ws + WS_KC), (bf16_t*)(F.ws + WS_VCT)};
      ge::gemm_phase<EpiCmp2, SchedCmp2, 0>(F.lds, F.tid, 256, 0, S, E); }
}

__device__ __forceinline__ void p_nsa_cmpsel(const Frame& F0) {
    const Frame F = phase_frame(F0);
    const bf16_t* proj = (const bf16_t*)(F.ws + WS_PROJ); const bf16_t* kc = (const bf16_t*)(F.ws + WS_KC); const bf16_t* vct = (const bf16_t*)(F.ws + WS_VCT);
    bf16_t* on = (bf16_t*)(F.ws + WS_ON); unsigned* selm = (unsigned*)(F.ws + WS_SELMASK);
    LAS float* gl = (LAS float*)F.lds + F.wave * 32;
    const int lane = F.lane, w = F.wave, r32 = lane & 31, hi = lane >> 5;
    for (int u = F.c; u < NB * 2 * 32; u += F.G) {
        const int pb = u & 31, g = (u >> 5) & 1, b = u >> 6; const int bg = b * 2 + g;
        const int p = pb * 64 + w * 8 + (r32 >> 2), hd = g * 4 + (r32 & 3); const size_t t = (size_t)b * S + p;
        bf16x8 qf[8];
#pragma unroll
        for (int d0 = 0; d0 < 8; ++d0) qf[d0] = *(const bf16x8*)(proj + t * LDP + P_NQ + hd * 128 + d0 * 16 + hi * 8);
        f32x16 sc[4];
#pragma unroll
        for (int kt = 0; kt < 4; ++kt) { sc[kt] = f32x16{};
#pragma unroll
            for (int d0 = 0; d0 < 8; ++d0) { const bf16x8 kf = *(const bf16x8*)(kc + ((size_t)bg * 128 + kt * 32 + r32) * 128 + d0 * 16 + hi * 8);
                sc[kt] = __builtin_amdgcn_mfma_f32_32x32x16_bf16(kf, qf[d0], sc[kt], 0, 0, 0); } }
        const int nmax = p >= 31 ? (p - 31) >> 4 : -1;
        float mx = -1e30f;
#pragma unroll
        for (int kt = 0; kt < 4; ++kt)
#pragma unroll
            for (int i = 0; i < 16; ++i) { const int n = kt * 32 + (i & 3) + 8 * (i >> 2) + 4 * hi; const float s = n <= nmax ? sc[kt][i] * 0.08838834764831845f : -__builtin_inff(); sc[kt][i] = s; mx = fmaxf(mx, s); }
        mx = fmaxf(mx, __shfl_xor(mx, 32));
        float sum = 0.f;
#pragma unroll
        for (int kt = 0; kt < 4; ++kt)
#pragma unroll
            for (int i = 0; i < 16; ++i) { const float e = __expf(sc[kt][i] - mx); sc[kt][i] = e; sum += e; }
        sum += __shfl_xor(sum, 32);
        const float inv = sum > 0.f ? 1.f / sum : 0.f;
#pragma unroll
        for (int kt = 0; kt < 4; ++kt)
#pragma unroll
            for (int i = 0; i < 16; ++i) sc[kt][i] *= inv;
        f32x16 oc[4] = {};
#pragma unroll
        for (int kt = 0; kt < 4; ++kt) { bf16x8 pa0, pa1;
#define PK4(P, B_, OUT) do { unsigned a0 = cvt_pk_bf16(P[B_+0], P[B_+1]), a1 = cvt_pk_bf16(P[B_+2], P[B_+3]); unsigned b0 = cvt_pk_bf16(P[B_+4], P[B_+5]), b1 = cvt_pk_bf16(P[B_+6], P[B_+7]); \
        auto r0 = __builtin_amdgcn_permlane32_swap(a0, b0, false, false); auto r1 = __builtin_amdgcn_permlane32_swap(a1, b1, false, false); u32x4 w_ = {r0[0], r1[0], r0[1], r1[1]}; OUT = *reinterpret_cast<bf16x8*>(&w_); } while (0)
            PK4(sc[kt], 0, pa0); PK4(sc[kt], 8, pa1);
#undef PK4
#pragma unroll
            for (int dt = 0; dt < 4; ++dt) { const bf16x8 v0 = *(const bf16x8*)(vct + ((size_t)bg * 128 + dt * 32 + r32) * 128 + kt * 32 + hi * 8), v1 = *(const bf16x8*)(vct + ((size_t)bg * 128 + dt * 32 + r32) * 128 + kt * 32 + 16 + hi * 8);
                oc[dt] = __builtin_amdgcn_mfma_f32_32x32x16_bf16(pa0, v0, oc[dt], 0, 0, 0); oc[dt] = __builtin_amdgcn_mfma_f32_32x32x16_bf16(pa1, v1, oc[dt], 0, 0, 0); } }
        if (hi == 0) gl[r32] = fast_sigmoid(bf2f(proj[t * LDP + P_NG + hd * 3]));
        asm volatile("s_waitcnt lgkmcnt(0)" ::: "memory");
#pragma unroll
        for (int i = 0; i < 16; ++i) { const int rr = (i & 3) + 8 * (i >> 2) + 4 * hi; const float gt = gl[rr];
            const size_t tt = (size_t)b * S + pb * 64 + w * 8 + (rr >> 2); const int hh = g * 4 + (rr & 3);
#pragma unroll
            for (int dt = 0; dt < 4; ++dt) { const float v = oc[dt][i] * gt, vn = __shfl_xor(v, 1);
                if ((r32 & 1) == 0) *(unsigned*)(on + tt * 1024 + hh * 128 + dt * 32 + r32) = cvt_pk_bf16(v, vn); } }
#pragma unroll
        for (int kt = 0; kt < 4; ++kt)
#pragma unroll
            for (int i = 0; i < 16; ++i) { float v = sc[kt][i]; v += __shfl_xor(v, 1); v += __shfl_xor(v, 2); sc[kt][i] = v; }
        float imp[16];
#pragma unroll
        for (int kt = 0; kt < 4; ++kt)
#pragma unroll
            for (int q = 0; q < 4; ++q) { const float gsum = sc[kt][4 * q] + sc[kt][4 * q + 1] + sc[kt][4 * q + 2] + sc[kt][4 * q + 3];
                const float lastown = sc[kt][4 * q + 3]; const float lastprev = (kt * 4 + q) > 0 ? sc[(kt * 4 + q - 1) >> 2][4 * ((kt * 4 + q - 1) & 3) + 3] : 0.f;
                const float fromp_same = __shfl_xor(lastown, 32), fromp_prev = __shfl_xor(lastprev, 32);
                imp[kt * 4 + q] = gsum + (hi ? fromp_same : fromp_prev); }
        const int cb = p >> 6;
#pragma unroll
        for (int s_ = 0; s_ < 16; ++s_) { const int j = 8 * (s_ >> 2) + 2 * (s_ & 3) + hi; if (j == 0 || j == cb || j == cb - 1) imp[s_] = 1e9f; if (j > cb) imp[s_] = -1e30f; }
        unsigned mask = 0;
#pragma unroll
        for (int k = 0; k < 8; ++k) { float bv = -__builtin_inff(); int bj = 64;
#pragma unroll
            for (int s_ = 0; s_ < 16; ++s_) { const int j = 8 * (s_ >> 2) + 2 * (s_ & 3) + hi; if (imp[s_] > bv) { bv = imp[s_]; bj = j; } }
            const float ov = __shfl_xor(bv, 32); const int oj = __shfl_xor(bj, 32);
            const bool mine = (bv > ov) || (bv == ov && bj < oj); const int wj = mine ? bj : oj;
            mask |= 1u << wj;
#pragma unroll
            for (int s_ = 0; s_ < 16; ++s_) { const int j = 8 * (s_ >> 2) + 2 * (s_ & 3) + hi; if (j == wj) imp[s_] = -__builtin_inff(); } }
        if ((r32 & 3) == 0 && hi == 0) selm[t * 2 + g] = mask;
    }
}
constexpr int NSTEP = 1 + 11 * NL;

template <int l>
__device__ __forceinline__ void layer_steps(const Frame& F, const XcdBarrier& bar, const int lo, const int hi) {
#define IN(k) (lo <= (k) && (k) < hi)
#define SEAM(k) do { if (IN(k) && IN((k) + 1)) xcd_barrier(bar); } while (0)
    const int base = 1 + 11 * l;
    if (IN(base + 0)) { p_inproj(F, l);
#ifdef PROBE_INPROJ
        p_inproj(F, l);
#endif
#ifdef PROBE_INPROJ_LONGK
        p_inproj_longk(F, l);
#endif
#ifdef PROBE_INPROJ_SAME
        p_inproj_same(F, l);
#endif
#ifdef PROBE_INPROJ_NULL
        p_inproj_null(F, l);
#endif
    } SEAM(base + 0);
    if (IN(base + 1)) { p_nsa_cmp(F, l); p_moba_prep(F, F.G > 32 ? 16 : 0); p_gla1(F, l, F.G > 32 ? 16 : 0);
#ifdef PROBE_S1
        p_nsa_cmp(F, l); p_moba_prep(F, 16); p_gla1(F, l, 16);
#endif
#ifdef PROBE_GLA1
        p_gla1(F, l, 16);
#endif
#ifdef PROBE_MOBAPREP
        p_moba_prep(F, 16);
#endif
#ifdef PROBE_NSACMP
        p_nsa_cmp(F, l);
#endif
    } SEAM(base + 1);
    if (IN(base + 2)) { p_moba_attn(F);
#ifdef PROBE_MOBA
        p_moba_attn(F);
#endif
#ifdef PROBE_MOBA512
        p_moba_attn_t<512, true>(F);
#endif
#ifdef PROBE_MOBAFULL
        p_moba_attn_t<(1 << 20), true>(F);
#endif
        p_nsa_cmpsel(F); p_gla2(F); } SEAM(base + 2);
    if (IN(base + 3)) {
#ifndef PROBE_SKIP_NSA
        p_nsa_attn(F);
#endif
        p_gla3(F, l);
#ifdef PROBE_GLA3
        p_gla3(F, l);
#endif
    } SEAM(base + 3);
    if (IN(base + 4)) { p_merge(F, l);
#ifdef PROBE_MERGE
        p_merge(F, l);
#endif
    } SEAM(base + 4);
    if (IN(base + 5)) { p_wout(F, l); } SEAM(base + 5);
    if (IN(base + 6)) { p_route1<MOE_F8 && l == NL - 1>(F, l); p_conv_experts<MOE_F8 && l == NL - 1>(F, l);
#ifdef PROBE_CONVX
        p_conv_experts<MOE_F8 && l == NL - 1>(F, l);
#endif
    } SEAM(base + 6);
    if (IN(base + 7)) { p_route2(F, l); } SEAM(base + 7);
    if (IN(base + 8)) { p_moe_gu<MOE_F8 && l == NL - 1>(F, l);
#ifdef PROBE_GU
        p_moe_gu<MOE_F8 && l == NL - 1>(F, l);
#endif
    } SEAM(base + 8);
    if (IN(base + 9)) { p_moe_down<MOE_F8 && l == NL - 1>(F, l);
#ifdef PROBE_DOWN
        p_moe_down<MOE_F8 && l == NL - 1>(F, l);
#endif
    } SEAM(base + 9);
    if (IN(base + 10)) { if (l + 1 < NL) p_combine<0>(F, l + 1); else p_combine<1>(F, 0); }
    if (l + 1 < NL) SEAM(base + 10);
#undef SEAM
#undef IN
}

__global__ void __launch_bounds__(NTHR, 2) k_fwd(Args args) {
    extern __shared__ __attribute__((aligned(16))) unsigned char lds_raw[];
    Frame F; F.lds = (LAS unsigned char*)lds_raw; F.tid = threadIdx.x; F.lane = F.tid & 63; F.wave = __builtin_amdgcn_readfirstlane(F.tid >> 6);
    F.G = gridDim.x; F.c = blockIdx.x; F.ws = args.ws;
    if (F.tid == 0) {
#pragma unroll
        for (int i = 0; i < 22; ++i) *(LAS unsigned long long*)(F.lds + LDS_ARGS + i * 8) = (unsigned long long)args.in[i];
        *(LAS unsigned long long*)(F.lds + LDS_ARGS + 22 * 8) = (unsigned long long)args.out;
        *(LAS unsigned long long*)(F.lds + LDS_XB) = 0ull; *(LAS unsigned long long*)(F.lds + LDS_XB + 8) = 0ull;
    }
    __syncthreads();
    const int lo = args.ph_lo, hi = args.ph_hi;
    XcdBarrier bar; bar.bar = (unsigned*)(args.ws + WS_CTL) + CW_BAR; bar.x = 0; bar.st = (volatile LAS unsigned*)(F.lds + LDS_XB);
    if (hi - lo > 1) bar = xcd_barrier_post((unsigned*)(args.ws + WS_CTL) + CW_BAR, (volatile LAS unsigned*)(F.lds + LDS_XB));
    if (lo <= 0 && 0 < hi) { p_conv_static(F); p_conv_router(F); p_conv_cmp(F); p_rmsnorm(F, 0);
#ifdef PROBE_CONV
        p_conv_static(F);
#endif
 if (1 < hi) xcd_barrier(bar); }
    layer_steps<0>(F, bar, lo, hi);
    layer_steps<1>(F, bar, lo, hi);
#ifdef DIAG_MODE
    xcd_barrier(bar);
    if (F.c == 0 && F.tid == 0) args.out[0] = *(LAS float*)(F.lds + LDS_MISC + 4000);
#endif
}

static int g_grid = 0;
extern "C" void kernel_launch(void* const* d_in, const int* in_sizes, int n_in,
                              void* d_out, int out_size, void* d_ws, size_t ws_size,
                              hipStream_t stream) {
    if (g_grid == 0) {
        int dev = 0, cus = 0; (void)hipGetDevice(&dev); (void)hipDeviceGetAttribute(&cus, hipDeviceAttributeMultiprocessorCount, dev);
        (void)hipFuncSetAttribute((const void*)k_fwd, hipFuncAttributeMaxDynamicSharedMemorySize, LDS_BYTES);
        int per_cu = 0; (void)hipOccupancyMaxActiveBlocksPerMultiprocessor(&per_cu, (const void*)k_fwd, NTHR, LDS_BYTES);
        g_grid = (cus > 0 ? cus : 256) * (per_cu >= 1 ? 1 : 1);
    }
    if (ws_size < WS_END5 || ws_size < WS_NEED || WS_END5 > WS_H8) return;
    Args a{}; for (int i = 0; i < 22; ++i) a.in[i] = (const float*)d_in[i];
    a.out = (float*)d_out; a.ws = (unsigned char*)d_ws;
    (void)hipMemsetAsync((unsigned char*)d_ws + WS_CTL, 0, CTL_BYTES, stream);
#ifdef MULTI_LAUNCH
    for (int s = 0; s < NSTEP; ++s) { a.ph_lo = s; a.ph_hi = s + 1; hipLaunchKernelGGL(k_fwd, dim3(g_grid), dim3(NTHR), LDS_BYTES, stream, a); }
#else
    a.ph_lo = 0; a.ph_hi = NSTEP;
    hipLaunchKernelGGL(k_fwd, dim3(g_grid), dim3(NTHR), LDS_BYTES, stream, a);
#endif
}
```

```cpp
#define INPROJ_F8 3
#include <hip/hip_runtime.h>
#include <hip/hip_bf16.h>
#include <stdint.h>
#include <math.h>

constexpr int D=2048, NB=8, S=2048, T=NB*S, NL=2;
constexpr int INW=14888;
constexpr int O_MQ=0,O_MK=1024,O_MV=2048,O_NQ=3072,O_NKV=4096,O_NG=5632,O_GQ=5656,O_GK=6168,O_GV=6680,O_GA=7704,O_GG=7720,O_MG=8744;
using f32x16 = __attribute__((ext_vector_type(16))) float;
using f32x4  = __attribute__((ext_vector_type(4))) float;
using bf16x8 = __attribute__((ext_vector_type(8))) short;
#define LAS __attribute__((address_space(3)))
typedef unsigned short bf16_t;
typedef unsigned u32x4 __attribute__((ext_vector_type(4)));
typedef unsigned u32x2 __attribute__((ext_vector_type(2)));
typedef float f32x2 __attribute__((ext_vector_type(2)));

__device__ __forceinline__ unsigned cvt_pk_bf16(float lo, float hi) { unsigned r; asm volatile("v_cvt_pk_bf16_f32 %0, %1, %2" : "=v"(r) : "v"(lo), "v"(hi)); return r; }
__device__ __forceinline__ float bf_lo(unsigned w) { return __uint_as_float(w << 16); }
__device__ __forceinline__ float bf_hi(unsigned w) { return __uint_as_float(w & 0xffff0000u); }
__device__ __forceinline__ float bf2f(bf16_t b) { return __uint_as_float(((unsigned)b) << 16); }
__device__ __forceinline__ bf16_t f2bf(float f) { unsigned u = __float_as_uint(f); u += 0x7FFFu + ((u >> 16) & 1u); return (bf16_t)(u >> 16); }
__device__ __forceinline__ float fast_sigmoid(float x) { return __builtin_amdgcn_rcpf(1.f + __builtin_amdgcn_exp2f(-1.4426950408889634f * x)); }
__device__ __forceinline__ float fast_silu(float x) { return x * fast_sigmoid(x); }

#ifndef GE_SP2_DEFAULT
#define GE_SP2_DEFAULT true
#endif
#ifndef GE_ALIGN_DEFAULT
#define GE_ALIGN_DEFAULT true
#endif
namespace ge {
constexpr int BM = 256, BK = 64, HALF = 128, HTB = HALF * BK * 2, STAGE_BYTES = 8 * HTB, NXCD = 8, WGM = 8;
__host__ __device__ __forceinline__ int lds_byte(int r, int c) { const int st = (r >> 4) * 2 + (c >> 5), rr = r & 15, cc = c & 31, ob = rr * 64 + cc * 2; return st * 1024 + (ob ^ (((ob >> 9) & 1) << 5)); }
__host__ __device__ __forceinline__ void stage_rc(int b, int& R, int& C) { const int st = b / 1024, sb = b % 1024, swz = sb ^ (((sb >> 9) & 1) << 5); R = (st >> 1) * 16 + swz / 64; C = (st & 1) * 32 + (swz % 64) / 2; }
__host__ __device__ __forceinline__ int perm32(int rho) { const int n = rho >> 4, i = rho & 15; return 8 * (i >> 2) + 4 * n + (i & 3); }

typedef int i32x8 __attribute__((ext_vector_type(8)));
typedef int i32x4 __attribute__((ext_vector_type(4)));
__device__ __forceinline__ i32x8 cat8(bf16x8 a, bf16x8 b) { const i32x4 x = *reinterpret_cast<i32x4*>(&a), y = *reinterpret_cast<i32x4*>(&b); return (i32x8){x[0], x[1], x[2], x[3], y[0], y[1], y[2], y[3]}; }
constexpr int F8_SCALE_A = 0x7B7B7B7B, F8_SCALE_B = 0x76767676;
struct Unit { const char* A; const char* B; int r0; int c0; int aux; int aux2; };

__device__ __forceinline__ bool static_tile(int i, int G, int c, int nM, int nN, int& pm, int& pn) {
    const int nwg = nM * nN; const long L = (long)i * G + c; if (L >= nwg) return false;
    int wgid = (int)L; { const int q = nwg / NXCD, r = nwg % NXCD, xcd = wgid % NXCD, off = wgid / NXCD; wgid = (xcd < r ? xcd * (q + 1) : r * (q + 1) + (xcd - r) * q) + off; }
    const int nig = WGM * nN, gid = wgid / nig, fm = gid * WGM, gsz = (nM - fm) < WGM ? (nM - fm) : WGM;
    pm = fm + ((wgid % nig) % gsz); pn = (wgid % nig) / gsz; return true;
}

template <class Epi, class Sched, int KMODE, bool F8 = false, bool SP2 = GE_SP2_DEFAULT, bool ALIGN_EPI = GE_ALIGN_DEFAULT, int SCALE_A = F8_SCALE_A, bool I8 = false>
__device__ __forceinline__ void gemm_phase(LAS unsigned char* lds, const int tid_in, const int K, const int kbig, const Sched& S, const Epi& E) {
    int tid_ = tid_in; asm volatile("" : "+v"(tid_));
    const int tid = tid_, wid = __builtin_amdgcn_readfirstlane(tid >> 6), lane = tid & 63, wr = wid >> 2, wc = wid & 3, fr = lane & 15, fq = lane >> 4;
    constexpr bool BYTE = F8 || I8;
    const int nt = BYTE ? K / 128 : K / BK;
    unsigned voffB[2];
#pragma unroll
    for (int i = 0; i < 2; ++i) { int R, C; stage_rc(tid * 16 + i * 8192, R, C); const int Rb = Epi::PERM ? ((R & ~31) + perm32(R & 31)) : R; voffB[i] = BYTE ? (unsigned)(Rb * K + C * 2) : (unsigned)(Rb * K + C) * 2u; }
    const size_t hstepB = BYTE ? (size_t)HALF * K : (size_t)HALF * K * 2;
    const unsigned ldsw = (unsigned)wid * 1024u;
    const int aoff = F8 ? lds_byte(wr * 64 + fr, fq * 16) : lds_byte(wr * 64 + fr, fq * 8), boff = F8 ? lds_byte(wc * 32 + fr, fq * 16) : lds_byte(wc * 32 + fr, fq * 8);
    const int aoff1 = F8 ? lds_byte(wr * 64 + fr, fq * 16 + 8) - aoff : 1024, boff1 = F8 ? lds_byte(wc * 32 + fr, fq * 16 + 8) - boff : 1024;
#define GE_KOFF(t) (KMODE == 0 ? (size_t)(t) * 128 : (size_t)((t) >> 1) * (size_t)kbig + (size_t)((t) & 1) * 128)
#define GE_SA(b, h) (((b) * 2 + (h)) * HTB)
#define GE_SB(b, h) ((4 + (b) * 2 + (h)) * HTB)
#define GE_STAGE_B(bufoff, gbase) do { _Pragma("unroll") for (int _i = 0; _i < 2; ++_i) \
        __builtin_amdgcn_global_load_lds((const unsigned*)((const char*)(gbase) + voffB[_i]), (LAS unsigned*)(lds + (bufoff) + ldsw + _i * 8192), 16, 0, 0); } while (0)
#define GE_STAGE_A(bufoff, gbase, v0, v1) do { \
        __builtin_amdgcn_global_load_lds((const unsigned*)((const char*)(gbase) + (v0)), (LAS unsigned*)(lds + (bufoff) + ldsw), 16, 0, 0); \
        __builtin_amdgcn_global_load_lds((const unsigned*)((const char*)(gbase) + (v1)), (LAS unsigned*)(lds + (bufoff) + ldsw + 8192), 16, 0, 0); } while (0)
#define GE_LDA(dst, b, h) do { _Pragma("unroll") for (int m = 0; m < 4; ++m) _Pragma("unroll") for (int k = 0; k < 2; ++k) dst[m][k] = *(const LAS bf16x8*)(lds + GE_SA(b, h) + aoff + m * 2048 + k * aoff1); } while (0)
#define GE_LDB(dst, b, h) do { _Pragma("unroll") for (int n = 0; n < 2; ++n) _Pragma("unroll") for (int k = 0; k < 2; ++k) dst[n][k] = *(const LAS bf16x8*)(lds + GE_SB(b, h) + boff + n * 2048 + k * boff1); } while (0)
#define GE_MMA(ai, bj, At, Bt) do { __builtin_amdgcn_s_setprio(1); _Pragma("unroll") for (int m = 0; m < 4; ++m) _Pragma("unroll") for (int n = 0; n < 2; ++n) { \
        if constexpr (F8) { const i32x8 b8_ = ge::cat8(Bt[n][0], Bt[n][1]), a8_ = ge::cat8(At[m][0], At[m][1]); \
              \
            asm volatile("v_mfma_scale_f32_16x16x128_f8f6f4 %0, %1, %2, %0, %3, %4 op_sel_hi:[0,0,0]" : "+v"(acc[ai][bj][m][n]) : "v"(b8_), "v"(a8_), "v"(f8sb), "v"(f8sa)); } \
        else if constexpr (I8) { ge::i32x4 ci_ = __builtin_bit_cast(ge::i32x4, acc[ai][bj][m][n]); \
            _Pragma("unroll") for (int k = 0; k < 2; ++k) ci_ = __builtin_amdgcn_mfma_i32_16x16x64_i8(__builtin_bit_cast(ge::i32x4, Bt[n][k]), __builtin_bit_cast(ge::i32x4, At[m][k]), ci_, 0, 0, 0); \
            acc[ai][bj][m][n] = __builtin_bit_cast(f32x4, ci_); } \
        else { _Pragma("unroll") for (int k = 0; k < 2; ++k) acc[ai][bj][m][n] = __builtin_amdgcn_mfma_f32_16x16x32_bf16(Bt[n][k], At[m][k], acc[ai][bj][m][n], 0, 0, 0); } } \
        if constexpr (F8) asm volatile("s_nop 7" ::: "memory"); \
        __builtin_amdgcn_s_setprio(0); } while (0)
#define GE_WAIT_V(n) asm volatile("s_waitcnt vmcnt(" #n ")" ::: "memory")
#define GE_WAIT_L(n) asm volatile("s_waitcnt lgkmcnt(" #n ")" ::: "memory")
#define GE_BAR __builtin_amdgcn_s_barrier()
#define GE_SCHED __builtin_amdgcn_sched_barrier(0)
    Unit cur, nxt; int ui = 0;
    if (!S.next(0, cur)) return;
    int f8sa = SCALE_A, f8sb = F8_SCALE_B; if constexpr (F8) asm volatile("" : "+v"(f8sa), "+v"(f8sb));
    f32x4 acc[2][2][4][2];
#pragma unroll
    for (int a = 0; a < 2; ++a)
#pragma unroll
        for (int b = 0; b < 2; ++b)
#pragma unroll
            for (int m = 0; m < 4; ++m)
#pragma unroll
                for (int n = 0; n < 2; ++n) acc[a][b][m][n] = (f32x4){0.f, 0.f, 0.f, 0.f};
    bf16x8 At[4][2], B0[2][2], B1[2][2];
    unsigned va[2][2], vn[2][2];
    S.voffA(cur, tid, va);
    const char* cA = cur.A; const char* cB = cur.B;
    if constexpr (SP2) {
        GE_STAGE_B(GE_SB(0, 0), cB); GE_STAGE_B(GE_SB(0, 1), cB + hstepB); GE_STAGE_A(GE_SA(0, 0), cA, va[0][0], va[0][1]); GE_STAGE_A(GE_SA(0, 1), cA, va[1][0], va[1][1]);
        if (wr == 1) GE_BAR;
        GE_WAIT_V(2); GE_BAR;
        GE_STAGE_B(GE_SB(1, 0), cB + 128); GE_STAGE_A(GE_SA(1, 0), cA + GE_KOFF(1), va[0][0], va[0][1]); GE_STAGE_B(GE_SB(1, 1), cB + hstepB + 128);
        GE_WAIT_V(6); GE_BAR;
    } else {
    GE_STAGE_B(GE_SB(0, 0), cB); GE_STAGE_A(GE_SA(0, 0), cA, va[0][0], va[0][1]); GE_STAGE_B(GE_SB(0, 1), cB + hstepB); GE_STAGE_A(GE_SA(0, 1), cA, va[1][0], va[1][1]);
    if (wr == 1) GE_BAR;
    GE_WAIT_V(4); GE_BAR;
    GE_STAGE_B(GE_SB(1, 0), cB + 128); GE_STAGE_A(GE_SA(1, 0), cA + GE_KOFF(1), va[0][0], va[0][1]); GE_STAGE_B(GE_SB(1, 1), cB + hstepB + 128);
    GE_WAIT_V(6); GE_BAR;
    }
    for (;;) {
        const bool has_next = S.next(ui + 1, nxt);
        if constexpr (Sched::GATHER) { if (has_next) S.voffA(nxt, tid, vn); else { vn[0][0] = va[0][0]; vn[0][1] = va[0][1]; vn[1][0] = va[1][0]; vn[1][1] = va[1][1]; } }
        const char* nA = has_next ? nxt.A : cA; const char* nB = has_next ? nxt.B : cB;
        for (int t = 0; t < nt; t += 2) {
            const bool last = (t == nt - 2);
            const char* a1 = cA + GE_KOFF(t + 1);
            const char* a2 = last ? nA : cA + GE_KOFF(t + 2); const char* b2 = last ? nB : cB + (size_t)(t + 2) * 128;
            const char* a3 = last ? nA + GE_KOFF(1) : cA + GE_KOFF(t + 3); const char* b3 = b2 + 128;
            unsigned w00 = va[0][0], w01 = va[0][1], w10 = va[1][0], w11 = va[1][1];
            if constexpr (Sched::GATHER) { if (last) { w00 = vn[0][0]; w01 = vn[0][1]; w10 = vn[1][0]; w11 = vn[1][1]; } }
            if constexpr (SP2) {
            GE_LDB(B0, 0, 0); GE_LDB(B1, 0, 1); GE_SCHED; GE_LDA(At, 0, 0); GE_STAGE_A(GE_SA(1, 1), a1, va[1][0], va[1][1]);
            GE_WAIT_V(8); GE_WAIT_L(0); GE_BAR; GE_MMA(0, 0, At, B0); GE_MMA(0, 1, At, B1); GE_BAR; GE_SCHED;
            GE_LDA(At, 0, 1); GE_STAGE_B(GE_SB(0, 0), b2); GE_STAGE_B(GE_SB(0, 1), b2 + hstepB); GE_STAGE_A(GE_SA(0, 0), a2, w00, w01);
            GE_WAIT_V(8); GE_WAIT_L(0); GE_BAR; GE_MMA(1, 0, At, B0); GE_MMA(1, 1, At, B1); GE_BAR; GE_SCHED;
            GE_LDB(B0, 1, 0); GE_LDB(B1, 1, 1); GE_SCHED; GE_LDA(At, 1, 0); GE_STAGE_A(GE_SA(0, 1), a2, w10, w11);
            GE_WAIT_V(8); GE_WAIT_L(0); GE_BAR; GE_MMA(0, 0, At, B0); GE_MMA(0, 1, At, B1); GE_BAR; GE_SCHED;
            GE_LDA(At, 1, 1); GE_STAGE_B(GE_SB(1, 0), b3); GE_STAGE_B(GE_SB(1, 1), b3 + hstepB); GE_STAGE_A(GE_SA(1, 0), a3, w00, w01);
            GE_WAIT_V(8); GE_WAIT_L(0); GE_BAR; GE_MMA(1, 0, At, B0); GE_MMA(1, 1, At, B1); GE_BAR; GE_SCHED;
            } else {
            GE_LDB(B0, 0, 0); GE_SCHED; GE_LDA(At, 0, 0); GE_STAGE_A(GE_SA(1, 1), a1, va[1][0], va[1][1]);
            GE_WAIT_L(8); GE_BAR; GE_WAIT_L(0); GE_MMA(0, 0, At, B0); GE_BAR; GE_SCHED;
            GE_LDB(B1, 0, 1); GE_STAGE_B(GE_SB(0, 0), b2);
            GE_BAR; GE_WAIT_L(0); GE_MMA(0, 1, At, B1); GE_BAR;
            GE_LDA(At, 0, 1); GE_STAGE_A(GE_SA(0, 0), a2, w00, w01);
            GE_BAR; GE_WAIT_L(0); GE_MMA(1, 0, At, B0); GE_BAR; GE_SCHED;
            GE_STAGE_B(GE_SB(0, 1), b2 + hstepB);
            GE_WAIT_V(6); GE_BAR; GE_MMA(1, 1, At, B1); GE_BAR;
            GE_LDB(B0, 1, 0); GE_SCHED; GE_LDA(At, 1, 0); GE_STAGE_A(GE_SA(0, 1), a2, w10, w11);
            GE_WAIT_L(8); GE_BAR; GE_WAIT_L(0); GE_MMA(0, 0, At, B0); GE_BAR; GE_SCHED;
            GE_LDB(B1, 1, 1); GE_STAGE_B(GE_SB(1, 0), b3);
            GE_BAR; GE_WAIT_L(0); GE_MMA(0, 1, At, B1); GE_BAR;
            GE_LDA(At, 1, 1); GE_STAGE_A(GE_SA(1, 0), a3, w00, w01);
            GE_BAR; GE_WAIT_L(0); GE_MMA(1, 0, At, B0); GE_BAR; GE_SCHED;
            GE_STAGE_B(GE_SB(1, 1), b3 + hstepB);
            GE_WAIT_V(6); GE_BAR; GE_MMA(1, 1, At, B1); GE_BAR;
            }
        }
        if constexpr (ALIGN_EPI) { if (wr == 0) GE_BAR; }
        if constexpr (I8) {
#pragma unroll
            for (int a = 0; a < 2; ++a)
#pragma unroll
                for (int b = 0; b < 2; ++b)
#pragma unroll
                    for (int m = 0; m < 4; ++m)
#pragma unroll
                        for (int n = 0; n < 2; ++n) { const ge::i32x4 ci_ = __builtin_bit_cast(ge::i32x4, acc[a][b][m][n]); acc[a][b][m][n] = (f32x4){(float)ci_[0], (float)ci_[1], (float)ci_[2], (float)ci_[3]}; } }
        E(acc, cur, wr, wc, fr, fq);
        if (!has_next) break;
#pragma unroll
        for (int a = 0; a < 2; ++a)
#pragma unroll
            for (int b = 0; b < 2; ++b)
#pragma unroll
                for (int m = 0; m < 4; ++m)
#pragma unroll
                    for (int n = 0; n < 2; ++n) acc[a][b][m][n] = (f32x4){0.f, 0.f, 0.f, 0.f};
        cur = nxt; cA = nA; cB = nB; ++ui;
        if constexpr (Sched::GATHER) { va[0][0] = vn[0][0]; va[0][1] = vn[0][1]; va[1][0] = vn[1][0]; va[1][1] = vn[1][1]; }
        if constexpr (ALIGN_EPI) { if (wr == 1) GE_BAR; }
    }
    GE_WAIT_V(0);
    if constexpr (!ALIGN_EPI) { if (wr == 0) GE_BAR; }
    GE_BAR;
#undef GE_KOFF
#undef GE_SA
#undef GE_SB
#undef GE_STAGE_A
#undef GE_STAGE_B
#undef GE_LDA
#undef GE_LDB
#undef GE_MMA
#undef GE_WAIT_V
#undef GE_WAIT_L
#undef GE_BAR
#undef GE_SCHED
}

template <bool F8 = false>
__device__ __forceinline__ void dense_voffA(int lda, int tid, unsigned (&v)[2][2]) {
#pragma unroll
    for (int i = 0; i < 2; ++i) { int R, C; stage_rc(tid * 16 + i * 8192, R, C); v[0][i] = F8 ? (unsigned)(R * lda + C * 2) : (unsigned)(R * lda + C) * 2u; v[1][i] = F8 ? (unsigned)((R + HALF) * lda + C * 2) : (unsigned)((R + HALF) * lda + C) * 2u; }
}
}
#define XB_TMO      128
#define XB_XCNT(j)  (256  + 64 * (j))
#define XB_XSUB(j)  (1280 + 64 * (j))
#define XB_XGEN(j)  (2304 + 64 * (j))
#define XB_TOP      3328
#define XB_TOPGEN   3392
#define XCD_BAR_WORDS 3456
#define XB_SPIN_CAP (1u << 18)

__device__ __forceinline__ unsigned xb_ld(unsigned* p)              { return __hip_atomic_load(p, __ATOMIC_RELAXED, __HIP_MEMORY_SCOPE_AGENT); }
__device__ __forceinline__ unsigned xb_add(unsigned* p, unsigned v) { return __hip_atomic_fetch_add(p, v, __ATOMIC_RELAXED, __HIP_MEMORY_SCOPE_AGENT); }
__device__ __forceinline__ unsigned xb_xcc_id() { return (unsigned)__builtin_amdgcn_s_getreg((3 << 11) | 20) & 0xFu; }
#define XB_SPIN(cond, bar) do { unsigned _sp = 0; while (cond) { __builtin_amdgcn_s_sleep(1); \
    if ((++_sp & 255u) == 0u) { if (xb_ld(&(bar)[XB_TMO])) break; if (_sp > XB_SPIN_CAP) { atomicAdd(&(bar)[XB_TMO], 1u); break; } } } } while (0)

struct XcdBarrier {
    unsigned* bar; unsigned x;
    volatile LAS unsigned* st;
};

__device__ __forceinline__ XcdBarrier xcd_barrier_post(unsigned* bar, volatile LAS unsigned* st) {
    XcdBarrier b; b.bar = bar; b.x = xb_xcc_id(); b.st = st;
    if (threadIdx.x == 0) (void)xb_add(&bar[XB_XCNT(b.x)], 1u);
    return b;
}
__device__ __forceinline__ void xcd_barrier_complete(unsigned* bar, unsigned x, unsigned& nloc, unsigned& nx) {
    const unsigned G = gridDim.x * gridDim.y * gridDim.z;
    unsigned sum, cnt, mine, sp = 0u;
    for (;;) {
        sum = 0u; cnt = 0u; mine = 0u;
#pragma unroll
        for (unsigned j = 0; j < 16; ++j) { const unsigned c = xb_ld(&bar[XB_XCNT(j)]); sum += c; cnt += (c > 0u) ? 1u : 0u; mine = (j == x) ? c : mine; }
        if (sum == G) break;
        __builtin_amdgcn_s_sleep(1);
        if ((++sp & 255u) == 0u) { if (xb_ld(&bar[XB_TMO])) break; if (sp > XB_SPIN_CAP) { atomicAdd(&bar[XB_TMO], 1u); break; } }
    }
    nloc = mine > 0u ? mine : 1u; nx = cnt > 0u ? cnt : 1u;
}

__device__ __forceinline__ void xcd_barrier(const XcdBarrier& b) {
    asm volatile("s_waitcnt vmcnt(0)" ::: "memory");
    __syncthreads();
    if (threadIdx.x == 0) {
        unsigned* bar = b.bar;
        __builtin_amdgcn_s_waitcnt(0);
        unsigned nloc = b.st[0], nx = b.st[1];
        if (nloc == 0u) { xcd_barrier_complete(bar, b.x, nloc, nx); b.st[0] = nloc; b.st[1] = nx; }
        const unsigned old = xb_add(&bar[XB_XSUB(b.x)], 1u);
        const unsigned gen = old / nloc;
        if (old + 1u == (gen + 1u) * nloc) {
            __builtin_amdgcn_fence(__ATOMIC_RELEASE, "agent");
            asm volatile("s_waitcnt vmcnt(0)" ::: "memory");
            const unsigned og = xb_add(&bar[XB_TOP], 1u);
            const unsigned tg = og / nx;
            if (og + 1u == (tg + 1u) * nx) xb_add(&bar[XB_TOPGEN], 1u);
            else XB_SPIN(xb_ld(&bar[XB_TOPGEN]) == tg, bar);
            __builtin_amdgcn_fence(__ATOMIC_ACQUIRE, "agent");
            xb_add(&bar[XB_XGEN(b.x)], 1u);
            asm volatile("s_waitcnt vmcnt(0)" ::: "memory");
        } else {
            XB_SPIN(xb_ld(&bar[XB_XGEN(b.x)]) == gen, bar);
            __builtin_amdgcn_fence(__ATOMIC_ACQUIRE, "agent");
            asm volatile("s_waitcnt vmcnt(0)" ::: "memory");
        }
    }
    __syncthreads();
}

constexpr int LDP = 15104;
constexpr int P_MQ=0,P_MK=1024,P_MV=2048,P_NQ=3072,P_NKV=4096,P_GQ=5632,P_GK=6144,P_GV=6656,P_GG=7680,P_MG=8704,P_NG=14848,P_GA=14872;
constexpr int NTHR = 512;
#ifndef MOE_F8
#define MOE_F8 1
#endif
#ifndef INPROJ_F8
#define INPROJ_F8 2
#endif
constexpr int LDS_BYTES = 147456;
constexpr int MOE_ROWS = 40960;
constexpr int MOE_TILES = MOE_ROWS / 256;

constexpr size_t al256(size_t x) { return (x + 255) & ~(size_t)255; }
constexpr size_t WS_CTL   = 0;
constexpr size_t CTL_BYTES = 65536;
constexpr size_t WS_WIN   = WS_CTL + CTL_BYTES;
constexpr size_t WS_WBR   = WS_WIN + al256((size_t)NL * LDP * 2048 * 2);
constexpr size_t WS_WOUT  = WS_WBR + al256((size_t)NL * 3 * 2048 * 1024 * 2);
constexpr size_t WS_WC1   = WS_WOUT + al256((size_t)NL * 2048 * 2048 * 2);
constexpr size_t WS_WC2   = WS_WC1 + al256((size_t)NL * 2 * 256 * 4096 * 2);
constexpr size_t WS_BIAS1 = WS_WC2 + al256((size_t)NL * 2 * 256 * 256 * 2);
constexpr size_t WS_WGU   = WS_BIAS1 + al256((size_t)NL * 2 * 256 * 4);
constexpr size_t WS_WD    = WS_WGU + al256((size_t)32 * 1024 * 2048 * 2);
constexpr size_t WS_H     = WS_WD + al256((size_t)32 * 2048 * 512 * 2);
constexpr size_t WS_PROJ  = WS_H + al256((size_t)T * 2048 * 2);
constexpr size_t WS_OM    = WS_PROJ + al256((size_t)T * LDP * 2);
constexpr size_t WS_ON    = WS_OM + al256((size_t)T * 1024 * 2);
constexpr size_t WS_OG    = WS_ON + al256((size_t)T * 1024 * 2);
constexpr size_t WS_MERGED= WS_OG + al256((size_t)T * 1024 * 2);
constexpr size_t WS_MISC  = WS_MERGED + al256((size_t)T * 2048 * 2);
constexpr size_t WS_KMEAN = WS_MISC;
constexpr size_t WS_KVC   = WS_KMEAN + al256((size_t)NB * 8 * 8 * 128 * 4);
constexpr size_t WS_DEC   = WS_KVC + al256((size_t)NB * 127 * 4 * 128 * 4);
constexpr size_t WS_OGRAW = WS_H;
constexpr size_t WS_ROUTE = WS_DEC + al256((size_t)T * 512 * 4);
constexpr size_t WS_ROWTOK= WS_ROUTE + al256((size_t)T * 8 * 4);
constexpr size_t WS_ROWW  = WS_ROWTOK + al256((size_t)MOE_ROWS * 4);
constexpr size_t WS_TILEE = WS_ROWW + al256((size_t)MOE_ROWS * 4);
constexpr size_t WS_END_SMALL = WS_TILEE + al256((size_t)(MOE_TILES + 64) * 4);
constexpr size_t WS_HID   = WS_PROJ;
constexpr size_t WS_YBUF  = WS_HID + al256((size_t)MOE_ROWS * 512 * 2);
static_assert(WS_YBUF + (size_t)MOE_ROWS * 2048 * 2 <= WS_OM, "MoE buffers must fit in the PROJ region");
constexpr size_t WS_TOTAL = WS_END_SMALL;

constexpr int CW_BAR = 0;
constexpr int CW_CNT = 4096;
constexpr int CW_CUR = 4096 + 64;
constexpr int CW_MISC = 4096 + 128;

constexpr size_t WS_H8 = (size_t)1152 * 1024 * 1024;
constexpr size_t WS_SA = WS_H8 + (size_t)T * 2048;
constexpr size_t WS_SB = WS_SA + (size_t)T * 4;
constexpr size_t WS_NEED = WS_SB + (size_t)2 * NL * 15104 * 4;
__host__ __device__ __forceinline__ int inproj_src(int n) {
    if (n < 5632) return n; if (n < 7680) return n + 24; if (n < 14848) return n + 40; if (n < 14872) return O_NG + (n - 14848); if (n < 14888) return O_GA + (n - 14872); return -1; }
#ifndef MIX_SET
#define MIX_SET 0
#endif
#if MIX_SET == 0
constexpr int NT16 = 24, NT8 = 35;
__host__ __device__ __forceinline__ int tile16(int p) { return p < 8 ? p : p < 12 ? p + 4 : p == 12 ? 16 : p == 13 ? 18 : p == 14 ? 20 : p < 19 ? p + 7 : p < 23 ? p + 11 : 58; }
__host__ __device__ __forceinline__ int tile8(int p) { return p < 4 ? p + 8 : p == 4 ? 17 : p == 5 ? 19 : p == 6 ? 21 : p < 11 ? p + 19 : p + 23; }
#else
constexpr int NT16 = 35, NT8 = 24;
__host__ __device__ __forceinline__ int tile16(int p) { return p < 34 ? p : 58; }
__host__ __device__ __forceinline__ int tile8(int p) { return p + 34; }
#endif
struct Args { const float* in[22]; float* out; unsigned char* ws; int ph_lo, ph_hi; };
constexpr int LDS_ARGS = 131072;
constexpr int LDS_XB = LDS_ARGS + 256;
constexpr int LDS_MISC = LDS_ARGS + 512;

struct Frame {
    LAS unsigned char* lds; int tid, lane, wave, G, c;
    unsigned char* ws;
    __device__ __forceinline__ const float* in(int k) const { const unsigned long long v = *(const volatile LAS unsigned long long*)(lds + LDS_ARGS + k * 8); return (const float*)(const __attribute__((address_space(1))) float*)(((unsigned long long)__builtin_amdgcn_readfirstlane((unsigned)(v >> 32)) << 32) | (unsigned)__builtin_amdgcn_readfirstlane((unsigned)v)); }
    __device__ __forceinline__ float* out() const { return (float*)in(22); }
};
template <class P> __device__ __forceinline__ P* opaque_ptr(P* p) {
    const unsigned long long v = (unsigned long long)p; unsigned lo = __builtin_amdgcn_readfirstlane((unsigned)v), hi = __builtin_amdgcn_readfirstlane((unsigned)(v >> 32));
    asm volatile("" : "+s"(lo), "+s"(hi)); return (P*)(__attribute__((address_space(1))) P*)(((unsigned long long)hi << 32) | lo);
}
__device__ __forceinline__ Frame phase_frame(const Frame& F0) {
    __syncthreads();
    Frame F = F0; F.ws = opaque_ptr(F0.ws);
    int t; asm volatile("v_mbcnt_lo_u32_b32 %0, -1, 0\n\tv_mbcnt_hi_u32_b32 %0, -1, %0" : "=v"(t)); t += F0.wave * 64; asm volatile("" : "+v"(t));
    F.tid = t; F.lane = t & 63; F.wave = __builtin_amdgcn_readfirstlane(t >> 6); return F;
}

__device__ __forceinline__ float clamp_fp8(float v) { return __builtin_amdgcn_fmed3f(v, -448.f, 448.f); }
__device__ __forceinline__ unsigned pack_fp8x4(float a, float b, float c, float d) { int w = __builtin_amdgcn_cvt_pk_fp8_f32(clamp_fp8(a), clamp_fp8(b), 0, false); w = __builtin_amdgcn_cvt_pk_fp8_f32(clamp_fp8(c), clamp_fp8(d), w, true); return (unsigned)w; }
__device__ __forceinline__ unsigned pack_i8x4(float a, float b, float c, float d) {
    const int ia = (int)rintf(__builtin_amdgcn_fmed3f(a, -127.f, 127.f)), ib = (int)rintf(__builtin_amdgcn_fmed3f(b, -127.f, 127.f)), ic = (int)rintf(__builtin_amdgcn_fmed3f(c, -127.f, 127.f)), id = (int)rintf(__builtin_amdgcn_fmed3f(d, -127.f, 127.f));
    return (unsigned)(ia & 255) | ((unsigned)(ib & 255) << 8) | ((unsigned)(ic & 255) << 16) | ((unsigned)(id & 255) << 24); }
template <bool F8, class Fn>
__device__ __forceinline__ void conv_t(const Frame& F, Fn colsrc, int ld, int K, int N, void* dstv, float scale = 1.f, const float* rowinv = nullptr  ) {
    LAS float* tile = (LAS float*)F.lds;
    const int ntn = N / 256, ntk = K / 64, tot = ntn * ntk;
    for (int ti = F.c; ti < tot; ti += F.G) {
        const int tn = ti % ntn, tk = ti / ntn; const int n0 = tn * 256, k0 = tk * 64;
        const int n4 = (F.tid & 63) * 4, kq = F.tid >> 6;
        const float* sp = colsrc(n0 + n4);
        f32x4 v[8];
#pragma unroll
        for (int p = 0; p < 8; ++p) v[p] = sp ? *(const f32x4*)(sp + (size_t)(k0 + p * 8 + kq) * ld) : (f32x4){0.f, 0.f, 0.f, 0.f};
#pragma unroll
        for (int p = 0; p < 8; ++p) *(LAS f32x4*)(tile + (p * 8 + kq) * 260 + n4) = v[p];
        __syncthreads();
#pragma unroll
        for (int q = 0; q < 4; ++q) { const int idx = q * NTHR + F.tid; const int n = idx >> 3, k8 = (idx & 7) * 8;
            float t[8];
#pragma unroll
            for (int jj = 0; jj < 8; ++jj) t[jj] = tile[(k8 + jj) * 260 + n] * scale;
            if (rowinv) { const float ri = rowinv[n0 + n]; u32x2 w = {pack_i8x4(t[0] * ri, t[1] * ri, t[2] * ri, t[3] * ri), pack_i8x4(t[4] * ri, t[5] * ri, t[6] * ri, t[7] * ri)}; *(u32x2*)((unsigned char*)dstv + (size_t)(n0 + n) * K + k0 + k8) = w; }
            else if (F8) { u32x2 w = {pack_fp8x4(t[0], t[1], t[2], t[3]), pack_fp8x4(t[4], t[5], t[6], t[7])}; *(u32x2*)((unsigned char*)dstv + (size_t)(n0 + n) * K + k0 + k8) = w; }
            else { u32x4 w = {cvt_pk_bf16(t[0], t[1]), cvt_pk_bf16(t[2], t[3]), cvt_pk_bf16(t[4], t[5]), cvt_pk_bf16(t[6], t[7])}; *(u32x4*)((bf16_t*)dstv + (size_t)(n0 + n) * K + k0 + k8) = w; } }
        __syncthreads();
    }
}

__device__ __forceinline__ void p_colmax(const Frame& F0) {
    const Frame F = phase_frame(F0);
    unsigned* amax = (unsigned*)(F.ws + WS_SB);
    LAS float* red = (LAS float*)F.lds;
    for (int task = F.c; task < NL * 59 * 4; task += F.G) { const int kh = task & 3, nb = (task >> 2) % 59, l = (task >> 2) / 59;
        const int n4 = (F.tid & 63) * 4, kq = F.tid >> 6; const int src = inproj_src(nb * 256 + n4);
        f32x4 m = {0.f, 0.f, 0.f, 0.f};
        if (src >= 0) { const float* sp = F.in(2) + (size_t)l * D * INW + src;
            for (int k = kh * 512 + kq; k < kh * 512 + 512; k += 8) { const f32x4 v = *(const f32x4*)(sp + (size_t)k * INW); m[0] = fmaxf(m[0], fabsf(v[0])); m[1] = fmaxf(m[1], fabsf(v[1])); m[2] = fmaxf(m[2], fabsf(v[2])); m[3] = fmaxf(m[3], fabsf(v[3])); } }
        *(LAS f32x4*)(red + kq * 256 + n4) = m; __syncthreads();
        if (F.tid < 256) { float a = 0.f;
#pragma unroll
            for (int q = 0; q < 8; ++q) a = fmaxf(a, red[q * 256 + F.tid]);
            atomicMax(&amax[(size_t)l * LDP + nb * 256 + F.tid], __float_as_uint(a)); }
        __syncthreads(); }
}
__device__ __forceinline__ void p_colscale(const Frame& F0) {
    const Frame F = phase_frame(F0);
    float* sb = (float*)(F.ws + WS_SB);
    for (int i = F.c * NTHR + F.tid; i < NL * LDP; i += F.G * NTHR) { const float a = sb[i]; const float sc = a > 0.f ? a * (1.f / 127.f) : 1.f; sb[i] = sc; sb[NL * LDP + i] = 1.f / sc; }
}
__device__ __forceinline__ void p_conv_static(const Frame& F0) {
    const Frame F = phase_frame(F0);
    for (int l = 0; l < NL; ++l) {
        { const float* w = F.in(2) + (size_t)l * D * INW;
          auto srcpad = [=](int n) -> const float* { int s; if (n < 5632) s = n; else if (n < 7680) s = n + 24; else if (n < 14848) s = n + 40; else if (n < 14872) s = O_NG + (n - 14848); else if (n < 14888) s = O_GA + (n - 14872); else return nullptr; return w + s; };
#if INPROJ_F8 == 3
          conv_t<true>(F, srcpad, INW, 2048, LDP, F.ws + WS_WIN + (size_t)l * LDP * 2048, 1.f, (const float*)(F.ws + WS_SB) + NL * LDP + (size_t)l * LDP);
#elif INPROJ_F8 == 2
          conv_t<false>(F, [=](int n) -> const float* { return srcpad(tile16(n >> 8) * 256 + (n & 255)); }, INW, 2048, NT16 * 256, (bf16_t*)(F.ws + WS_WIN) + (size_t)l * NT16 * 256 * 2048);
          conv_t<true>(F, [=](int n) -> const float* { return srcpad(tile8(n >> 8) * 256 + (n & 255)); }, INW, 2048, NT8 * 256, F.ws + WS_WIN + (size_t)NL * NT16 * 256 * 2048 * 2 + (size_t)l * NT8 * 256 * 2048, 512.f);
#elif INPROJ_F8 == 1
          conv_t<true>(F, srcpad, INW, 2048, LDP, F.ws + WS_WIN + (size_t)l * LDP * 2048, 512.f);
#else
          conv_t<false>(F, srcpad, INW, 2048, LDP, (bf16_t*)(F.ws + WS_WIN) + (size_t)l * LDP * 2048);
#endif
        }
#define CONV_BR(b, idx) { const float* w = F.in(idx) + (size_t)l * 1024 * D; bf16_t* dst = (bf16_t*)(F.ws + WS_WBR) + ((size_t)l * 3 + b) * 2048 * 1024; \
          conv_t<false>(F, [=](int n) -> const float* { return w + n; }, D, 1024, 2048, dst); }
        CONV_BR(0, 9) CONV_BR(1, 10) CONV_BR(2, 11)
#undef CONV_BR
        { const float* w = F.in(12) + (size_t)l * D * D; bf16_t* dst = (bf16_t*)(F.ws + WS_WOUT) + (size_t)l * 2048 * 2048;
          conv_t<false>(F, [=](int n) -> const float* { return w + n; }, D, 2048, 2048, dst); }
        for (int c = 0; c < 2; ++c) { const float* w = F.in(4) + ((size_t)l * 2 + c) * 4096 * 128; bf16_t* dst = (bf16_t*)(F.ws + WS_WC1) + ((size_t)l * 2 + c) * 256 * 2048;
          conv_t<false>(F, [=](int n) -> const float* { return w + (n >= 128 ? (size_t)2048 * 128 : 0) + (n & 127); }, 128, 2048, 256, dst); }
    }
}
template <bool F8>
__device__ __forceinline__ void p_conv_experts(const Frame& F0, int l) {
    const Frame F = phase_frame(F0);
    const float* wg = F.in(18) + (size_t)l * 32 * D * 512; const float* wu = F.in(19) + (size_t)l * 32 * D * 512; const float* wd = F.in(20) + (size_t)l * 32 * 512 * D;
    conv_t<F8>(F, [=](int n) -> const float* { const int e = n >> 10, r = n & 1023, j = r >> 8, wi = r & 255; const unsigned long long dlt = (unsigned long long)wu - (unsigned long long)wg; const float* base = (const float*)((unsigned long long)wg + (dlt & (0ull - (unsigned long long)(wi >> 7)))) + (size_t)e * D * 512; return base + j * 128 + (wi & 127); }, 512, 2048, 32 * 1024, F.ws + WS_WGU, F8 ? 512.f : 1.f);
    conv_t<F8>(F, [=](int n) -> const float* { return wd + (size_t)(n >> 11) * 512 * D + (n & 2047); }, D, 512, 32 * 2048, F.ws + WS_WD, F8 ? 512.f : 1.f);
}

__device__ __forceinline__ void store_h4(unsigned char* ws, size_t idx, float a, float b, float c, float d) {
#if INPROJ_F8 == 1 || INPROJ_F8 == 2
    *(unsigned*)(ws + (INPROJ_F8 == 2 ? WS_H8 : WS_H) + idx) = pack_fp8x4(a * 16.f, b * 16.f, c * 16.f, d * 16.f);
#endif
#if INPROJ_F8 == 0 || INPROJ_F8 == 2
    u32x2 w; w[0] = cvt_pk_bf16(a, b); w[1] = cvt_pk_bf16(c, d); *(u32x2*)((bf16_t*)(ws + WS_H) + idx) = w;
#endif
}
__device__ __forceinline__ void store_h_row(unsigned char* ws, int row, const f32x4 (&y)[8], int lane) {
#if INPROJ_F8 == 3
    float am = 0.f;
#pragma unroll
    for (int i = 0; i < 8; ++i) am = fmaxf(fmaxf(am, fmaxf(fabsf(y[i][0]), fabsf(y[i][1]))), fmaxf(fabsf(y[i][2]), fabsf(y[i][3])));
#pragma unroll
    for (int o = 32; o > 0; o >>= 1) am = fmaxf(am, __shfl_xor(am, o));
    const float inv = am > 0.f ? 127.f / am : 0.f;
    if (lane == 0) ((float*)(ws + WS_SA))[row] = am > 0.f ? am * (1.f / 127.f) : 1.f;
#pragma unroll
    for (int i = 0; i < 8; ++i) *(unsigned*)(ws + WS_H8 + (size_t)row * D + i * 256 + lane * 4) = pack_i8x4(y[i][0] * inv, y[i][1] * inv, y[i][2] * inv, y[i][3] * inv);
#else
#pragma unroll
    for (int i = 0; i < 8; ++i) store_h4(ws, (size_t)row * D + i * 256 + lane * 4, y[i][0], y[i][1], y[i][2], y[i][3]);
#endif
}
__device__ __forceinline__ void p_rmsnorm(const Frame& F0, int l) {
    const Frame F = phase_frame(F0);
    const float* x = (l == 0) ? F.in(0) : F.out(); const float* g = F.in(1) + l * D; unsigned char* h = F.ws;
    for (int row = F.c * 8 + F.wave; row < T; row += F.G * 8) {
        const float* xr = x + (size_t)row * D; f32x4 v[8]; float ss = 0.f;
#pragma unroll
        for (int i = 0; i < 8; ++i) { v[i] = *(const f32x4*)(xr + i * 256 + F.lane * 4); ss += v[i][0] * v[i][0] + v[i][1] * v[i][1] + v[i][2] * v[i][2] + v[i][3] * v[i][3]; }
#pragma unroll
        for (int o = 32; o > 0; o >>= 1) ss += __shfl_xor(ss, o);
        const float rstd = rsqrtf(ss * (1.f / D) + 1e-6f);
#pragma unroll
        for (int i = 0; i < 8; ++i) { const f32x4 gv = *(const f32x4*)(g + i * 256 + F.lane * 4); v[i] = (f32x4){v[i][0] * rstd * gv[0], v[i][1] * rstd * gv[1], v[i][2] * rstd * gv[2], v[i][3] * rstd * gv[3]}; }
        store_h_row(h, row, v, F.lane);
    }
}

template <bool F8 = false>
struct SchedDenseT {
    static constexpr bool GATHER = false;
    const char* A; const char* B; int lda, K, nM, nN, G, c;
    __device__ __forceinline__ bool next(int i, ge::Unit& u) const { int pm, pn; if (!ge::static_tile(i, G, c, nM, nN, pm, pn)) return false;
        u.A = A + (size_t)pm * 256 * lda * (F8 ? 1 : 2); u.B = B + (size_t)pn * 256 * K * (F8 ? 1 : 2); u.r0 = pm * 256; u.c0 = pn * 256; u.aux = 0; u.aux2 = 0; return true; }
    __device__ __forceinline__ void voffA(const ge::Unit&, int tid, unsigned (&v)[2][2]) const { ge::dense_voffA<F8>(lda, tid, v); }
};
typedef SchedDenseT<false> SchedDense;
struct EpiStoreBf16 {
    static constexpr bool PERM = true; bf16_t* O; int ldc;
    __device__ __forceinline__ void operator()(const f32x4 (&acc)[2][2][4][2], const ge::Unit& u, int wr, int wc, int fr, int fq) const {
#pragma unroll
        for (int ai = 0; ai < 2; ++ai)
#pragma unroll
            for (int m = 0; m < 4; ++m) { bf16_t* rowp = O + (size_t)(u.r0 + ai * 128 + wr * 64 + m * 16 + fr) * ldc + u.c0 + wc * 32 + 8 * fq;
#pragma unroll
                for (int bj = 0; bj < 2; ++bj) { const f32x4 v0 = acc[ai][bj][m][0], v1 = acc[ai][bj][m][1]; u32x4 w = {cvt_pk_bf16(v0[0], v0[1]), cvt_pk_bf16(v0[2], v0[3]), cvt_pk_bf16(v1[0], v1[1]), cvt_pk_bf16(v1[2], v1[3])};
                    *(u32x4*)(rowp + bj * 128) = w; } }
    }
};
struct EpiNull {
    static constexpr bool PERM = true;
    __device__ __forceinline__ void operator()(const f32x4 (&acc)[2][2][4][2], const ge::Unit&, int, int, int, int) const {
#pragma unroll
        for (int ai = 0; ai < 2; ++ai)
#pragma unroll
            for (int bj = 0; bj < 2; ++bj)
#pragma unroll
                for (int m = 0; m < 4; ++m) asm volatile("" :: "v"(acc[ai][bj][m][0]), "v"(acc[ai][bj][m][1]));
    }
};
struct SchedSame {
    static constexpr bool GATHER = false; const char* A; const char* B; int n;
    __device__ __forceinline__ bool next(int i, ge::Unit& u) const { if (i >= n) return false; u.A = A; u.B = B; u.r0 = 0; u.c0 = 0; u.aux = 0; u.aux2 = 0; return true; }
    __device__ __forceinline__ void voffA(const ge::Unit&, int tid, unsigned (&v)[2][2]) const { ge::dense_voffA<false>(2048, tid, v); }
};
__device__ __forceinline__ void p_inproj_same(const Frame& F0, int l) {
    const Frame F = phase_frame(F0);
    EpiNull E{};
    SchedSame S{(const char*)(F.ws + WS_H), (const char*)(F.ws + WS_WIN) + (size_t)l * LDP * 2048 * 2, 15};
    ge::gemm_phase<EpiNull, SchedSame, 0>(F.lds, F.tid, 2048, 0, S, E);
}
__device__ __forceinline__ void p_inproj_longk(const Frame& F0, int l) {
    const Frame F = phase_frame(F0);
    EpiNull E{};
    SchedSame S{(const char*)(F.ws + WS_H), (const char*)(F.ws + WS_WIN) + (size_t)l * LDP * 2048 * 2, 1};
    ge::gemm_phase<EpiNull, SchedSame, 0>(F.lds, F.tid, 2048 * 15, 0, S, E);
}
__device__ __forceinline__ void p_inproj_null(const Frame& F0, int l) {
    const Frame F = phase_frame(F0);
    EpiNull E{};
    SchedDense S{(const char*)(F.ws + WS_H), (const char*)(F.ws + WS_WIN) + (size_t)l * LDP * 2048 * 2, 2048, 2048, T / 256, LDP / 256, F.G, F.c};
    ge::gemm_phase<EpiNull, SchedDense, 0>(F.lds, F.tid, 2048, 0, S, E);
}
#ifndef INPROJ_F8
#define INPROJ_F8 1
#endif
struct EpiStoreBf16Scaled {
    static constexpr bool PERM = true; bf16_t* O; int ldc; const float* sa; const float* sb;
    __device__ __forceinline__ void operator()(const f32x4 (&acc)[2][2][4][2], const ge::Unit& u, int wr, int wc, int fr, int fq) const {
        float rs[2][4];
#pragma unroll
        for (int ai = 0; ai < 2; ++ai)
#pragma unroll
            for (int m = 0; m < 4; ++m) rs[ai][m] = sa[u.r0 + ai * 128 + wr * 64 + m * 16 + fr];
#pragma unroll
        for (int bj = 0; bj < 2; ++bj) { const int col = u.c0 + bj * 128 + wc * 32 + 8 * fq; const f32x4 c0 = *(const f32x4*)(sb + col), c1 = *(const f32x4*)(sb + col + 4);
#pragma unroll
            for (int ai = 0; ai < 2; ++ai)
#pragma unroll
                for (int m = 0; m < 4; ++m) { const f32x4 v0 = acc[ai][bj][m][0] * c0 * rs[ai][m], v1 = acc[ai][bj][m][1] * c1 * rs[ai][m];
                    u32x4 w = {cvt_pk_bf16(v0[0], v0[1]), cvt_pk_bf16(v0[2], v0[3]), cvt_pk_bf16(v1[0], v1[1]), cvt_pk_bf16(v1[2], v1[3])};
                    *(u32x4*)(O + (size_t)(u.r0 + ai * 128 + wr * 64 + m * 16 + fr) * ldc + col) = w; } }
    }
};
template <bool F8>
struct SchedInprojMix {
    static constexpr bool GATHER = false;
    const char* A; const char* B; int G, c;
    __device__ __forceinline__ bool next(int i, ge::Unit& u) const { int pm, pn; if (!ge::static_tile(i, G, c, T / 256, F8 ? NT8 : NT16, pm, pn)) return false;
        u.A = A + (size_t)pm * 256 * 2048 * (F8 ? 1 : 2); u.B = B + (size_t)pn * 256 * 2048 * (F8 ? 1 : 2); u.r0 = pm * 256; u.c0 = (F8 ? tile8(pn) : tile16(pn)) * 256; u.aux = 0; u.aux2 = 0; return true; }
    __device__ __forceinline__ void voffA(const ge::Unit&, int tid, unsigned (&v)[2][2]) const { ge::dense_voffA<F8>(2048, tid, v); }
};
__device__ __forceinline__ void p_inproj(const Frame& F0, int l) {
    const Frame F = phase_frame(F0);
    EpiStoreBf16 E{(bf16_t*)(F.ws + WS_PROJ), LDP};
#if INPROJ_F8 == 3
    { SchedDenseT<true> S{(const char*)(F.ws + WS_H8), (const char*)(F.ws + WS_WIN) + (size_t)l * LDP * 2048, 2048, 2048, T / 256, LDP / 256, F.G, F.c};
      EpiStoreBf16Scaled E3{(bf16_t*)(F.ws + WS_PROJ), LDP, (const float*)(F.ws + WS_SA), (const float*)(F.ws + WS_SB) + (size_t)l * LDP};
      ge::gemm_phase<EpiStoreBf16Scaled, SchedDenseT<true>, 0, false, GE_SP2_DEFAULT, GE_ALIGN_DEFAULT, 0, true>(F.lds, F.tid, 2048, 0, S, E3); }
#elif INPROJ_F8 == 2
    { SchedInprojMix<false> S{(const char*)(F.ws + WS_H), (const char*)(F.ws + WS_WIN) + (size_t)l * NT16 * 256 * 2048 * 2, F.G, F.c};
      ge::gemm_phase<EpiStoreBf16, SchedInprojMix<false>, 0, false>(F.lds, F.tid, 2048, 0, S, E); }
    { const Frame F2 = phase_frame(F0);
      SchedInprojMix<true> S{(const char*)(F2.ws + WS_H8), (const char*)(F2.ws + WS_WIN) + (size_t)NL * NT16 * 256 * 2048 * 2 + (size_t)l * NT8 * 256 * 2048, F2.G, F2.c};
      EpiStoreBf16 E2{(bf16_t*)(F2.ws + WS_PROJ), LDP};
      ge::gemm_phase<EpiStoreBf16, SchedInprojMix<true>, 0, true>(F2.lds, F2.tid, 2048, 0, S, E2); }
#elif INPROJ_F8 == 1
    SchedDenseT<true> S{(const char*)(F.ws + WS_H), (const char*)(F.ws + WS_WIN) + (size_t)l * LDP * 2048, 2048, 2048, T / 256, LDP / 256, F.G, F.c};
    ge::gemm_phase<EpiStoreBf16, SchedDenseT<true>, 0, true>(F.lds, F.tid, 2048, 0, S, E);
#else
    SchedDense S{(const char*)(F.ws + WS_H), (const char*)(F.ws + WS_WIN) + (size_t)l * LDP * 2048 * 2, 2048, 2048, T / 256, LDP / 256, F.G, F.c};
    ge::gemm_phase<EpiStoreBf16, SchedDense, 0>(F.lds, F.tid, 2048, 0, S, E);
#endif
}

struct SchedMerge {
    static constexpr bool GATHER = false;
    const char* O3; const char* W; int G, c;
    __device__ __forceinline__ bool next(int i, ge::Unit& u) const { const int ti = i / 3, b = i - ti * 3; int pm, pn; if (!ge::static_tile(ti, G, c, T / 256, 8, pm, pn)) return false;
        u.A = O3 + (size_t)b * T * 1024 * 2 + (size_t)pm * 256 * 1024 * 2; u.B = W + (size_t)b * 2048 * 1024 * 2 + (size_t)pn * 256 * 1024 * 2; u.r0 = pm * 256; u.c0 = pn * 256; u.aux = b; u.aux2 = 0; return true; }
    __device__ __forceinline__ void voffA(const ge::Unit&, int tid, unsigned (&v)[2][2]) const { ge::dense_voffA(1024, tid, v); }
};
struct EpiMerge {
    static constexpr bool PERM = true; const bf16_t* proj; bf16_t* merged;
    __device__ __forceinline__ void operator()(const f32x4 (&acc)[2][2][4][2], const ge::Unit& u, int wr, int wc, int fr, int fq) const {
        const int col = u.c0 + wc * 32 + 8 * fq;
#pragma unroll
        for (int ai = 0; ai < 2; ++ai) {
            u32x4 gw[4][2], pw[4][2];
#pragma unroll
            for (int m = 0; m < 4; ++m) { const size_t row = (size_t)(u.r0 + ai * 128 + wr * 64 + m * 16 + fr);
#pragma unroll
                for (int bj = 0; bj < 2; ++bj) { gw[m][bj] = *(const u32x4*)(proj + row * LDP + P_MG + u.aux * 2048 + col + bj * 128);
                    if (u.aux > 0) pw[m][bj] = *(const u32x4*)(merged + row * 2048 + col + bj * 128); else pw[m][bj] = (u32x4){0u, 0u, 0u, 0u}; } }
#pragma unroll
            for (int m = 0; m < 4; ++m) { const size_t row = (size_t)(u.r0 + ai * 128 + wr * 64 + m * 16 + fr);
#pragma unroll
                for (int bj = 0; bj < 2; ++bj) { const u32x4 g = gw[m][bj], q = pw[m][bj]; const f32x4 v0 = acc[ai][bj][m][0], v1 = acc[ai][bj][m][1];
                    const float o0 = v0[0] * fast_sigmoid(bf_lo(g[0])) + bf_lo(q[0]), o1 = v0[1] * fast_sigmoid(bf_hi(g[0])) + bf_hi(q[0]), o2 = v0[2] * fast_sigmoid(bf_lo(g[1])) + bf_lo(q[1]), o3 = v0[3] * fast_sigmoid(bf_hi(g[1])) + bf_hi(q[1]);
                    const float o4 = v1[0] * fast_sigmoid(bf_lo(g[2])) + bf_lo(q[2]), o5 = v1[1] * fast_sigmoid(bf_hi(g[2])) + bf_hi(q[2]), o6 = v1[2] * fast_sigmoid(bf_lo(g[3])) + bf_lo(q[3]), o7 = v1[3] * fast_sigmoid(bf_hi(g[3])) + bf_hi(q[3]);
                    u32x4 w = {cvt_pk_bf16(o0, o1), cvt_pk_bf16(o2, o3), cvt_pk_bf16(o4, o5), cvt_pk_bf16(o6, o7)};
                    *(u32x4*)(merged + row * 2048 + col + bj * 128) = w; } }
        }
    }
};
__device__ __forceinline__ void p_merge(const Frame& F0, int l) {
    const Frame F = phase_frame(F0);
    SchedMerge S{(const char*)(F.ws + WS_OM), (const char*)(F.ws + WS_WBR) + (size_t)l * 3 * 2048 * 1024 * 2, F.G, F.c};
    EpiMerge E{(const bf16_t*)(F.ws + WS_PROJ), (bf16_t*)(F.ws + WS_MERGED)};
    ge::gemm_phase<EpiMerge, SchedMerge, 0>(F.lds, F.tid, 1024, 0, S, E);
}

struct EpiResF32 {
    static constexpr bool PERM = false; const float* R; float* C;
    __device__ __forceinline__ void operator()(const f32x4 (&acc)[2][2][4][2], const ge::Unit& u, int wr, int wc, int fr, int fq) const {
#pragma unroll
        for (int ai = 0; ai < 2; ++ai) {
            f32x4 r[4][2][2];
#pragma unroll
            for (int m = 0; m < 4; ++m) { const size_t off = (size_t)(u.r0 + ai * 128 + wr * 64 + m * 16 + fr) * D + u.c0 + wc * 32 + 4 * fq;
#pragma unroll
                for (int bj = 0; bj < 2; ++bj)
#pragma unroll
                    for (int n = 0; n < 2; ++n) r[m][bj][n] = *(const f32x4*)(R + off + bj * 128 + n * 16); }
#pragma unroll
            for (int m = 0; m < 4; ++m) { const size_t off = (size_t)(u.r0 + ai * 128 + wr * 64 + m * 16 + fr) * D + u.c0 + wc * 32 + 4 * fq;
#pragma unroll
                for (int bj = 0; bj < 2; ++bj)
#pragma unroll
                    for (int n = 0; n < 2; ++n) *(f32x4*)(C + off + bj * 128 + n * 16) = acc[ai][bj][m][n] + r[m][bj][n]; }
        }
    }
};
__device__ __forceinline__ void p_wout(const Frame& F0, int l) {
    const Frame F = phase_frame(F0);
    const float* xsrc = (l == 0) ? F.in(0) : F.out();
    SchedDense S{(const char*)(F.ws + WS_MERGED), (const char*)(F.ws + WS_WOUT) + (size_t)l * 2048 * 2048 * 2, 2048, 2048, T / 256, 8, F.G, F.c};
    EpiResF32 E{xsrc, F.out()};
    ge::gemm_phase<EpiResF32, SchedDense, 0>(F.lds, F.tid, 2048, 0, S, E);
}

constexpr size_t WS_WR = WS_END_SMALL;
constexpr size_t WS_END2 = WS_WR + al256((size_t)NL * 2048 * 64 * 4);

__device__ __forceinline__ void p_conv_router(const Frame& F0) {
    const Frame F = phase_frame(F0);
    float* wr = (float*)(F.ws + WS_WR);
    const float* g2 = F.in(13); const float* rgw = F.in(14); const float* rew = F.in(16);
    for (int i = F.c * NTHR + F.tid; i < NL * 2048 * 64; i += F.G * NTHR) {
        const int j = i & 63, d = (i >> 6) & 2047, l = i >> 17;
        float v = 0.f;
        if (j < 4) v = rgw[((size_t)l * 2048 + d) * 4 + j]; else if (j < 36) v = rew[((size_t)l * 2048 + d) * 32 + (j - 4)];
        wr[i] = v * g2[l * 2048 + d];
    }
}

template <bool F8>
__device__ __forceinline__ void p_route1(const Frame& F0, int l) {
    const Frame F = phase_frame(F0);
    const float* x = F.out();
    const float* wr = (const float*)(F.ws + WS_WR) + (size_t)l * 2048 * 64;
    const float* g2 = F.in(13) + l * D; const float* rgb = F.in(15) + l * 4; const float* reb = F.in(17) + l * 32;
    unsigned* ctl = (unsigned*)(F.ws + WS_CTL);
    int* rowtok = (int*)(F.ws + WS_ROWTOK); float* roww = (float*)(F.ws + WS_ROWW);
    for (int i = F.c * NTHR + F.tid; i < MOE_ROWS; i += F.G * NTHR) { rowtok[i] = 0; roww[i] = 0.f; }
    LAS float* part = (LAS float*)F.lds;
    LAS float* ssq = (LAS float*)(F.lds + 65536);
    LAS float* lg = (LAS float*)(F.lds + 65536 + 1024);
    LAS float* rstd_s = (LAS float*)(F.lds + 65536 + 1024 + 64 * 40 * 4);
    const int w = F.wave, lane = F.lane, rh = w >> 2, kq = w & 3, r32 = lane & 31, hi = lane >> 5;
    for (int rg = F.c; rg < T / 64; rg += F.G) {
        const int row0 = rg * 64;
        f32x16 acc0, acc1;
#pragma unroll
        for (int r = 0; r < 16; ++r) { acc0[r] = 0.f; acc1[r] = 0.f; }
        float ss = 0.f;
        const float* xr = x + (size_t)(row0 + rh * 32 + r32) * D + kq * 512 + 8 * hi;
        const float* wp = wr + (size_t)(kq * 512 + 8 * hi) * 64 + r32;
        for (int ks = 0; ks < 32; ++ks) {
            const f32x4 xa = *(const f32x4*)(xr + ks * 16), xb = *(const f32x4*)(xr + ks * 16 + 4);
            const float xv[8] = {xa[0], xa[1], xa[2], xa[3], xb[0], xb[1], xb[2], xb[3]};
#pragma unroll
            for (int j = 0; j < 8; ++j) {
                const float b0 = wp[(size_t)(ks * 16 + j) * 64], b1 = wp[(size_t)(ks * 16 + j) * 64 + 32];
                ss += xv[j] * xv[j];
                acc0 = __builtin_amdgcn_mfma_f32_32x32x2f32(xv[j], b0, acc0, 0, 0, 0);
                acc1 = __builtin_amdgcn_mfma_f32_32x32x2f32(xv[j], b1, acc1, 0, 0, 0);
            }
        }
        ss += __shfl_xor(ss, 32);
        if (hi == 0) ssq[w * 32 + r32] = ss;
#pragma unroll
        for (int r = 0; r < 16; ++r) { const int row = (r & 3) + 8 * (r >> 2) + 4 * hi; part[(w * 32 + row) * 64 + r32] = acc0[r]; part[(w * 32 + row) * 64 + 32 + r32] = acc1[r]; }
        __syncthreads();
        { const int row = F.tid >> 3, sub = F.tid & 7, rr = row & 31, rhh = row >> 5;
          float s2 = ssq[(rhh * 4 + 0) * 32 + rr] + ssq[(rhh * 4 + 1) * 32 + rr] + ssq[(rhh * 4 + 2) * 32 + rr] + ssq[(rhh * 4 + 3) * 32 + rr];
          const float rstd = rsqrtf(s2 * (1.f / D) + 1e-6f);
          if (sub == 0) rstd_s[row] = rstd;
#pragma unroll
          for (int q = 0; q < 5; ++q) { const int j = sub * 5 + q; if (j < 36) {
              float a = part[((rhh * 4 + 0) * 32 + rr) * 64 + j] + part[((rhh * 4 + 1) * 32 + rr) * 64 + j] + part[((rhh * 4 + 2) * 32 + rr) * 64 + j] + part[((rhh * 4 + 3) * 32 + rr) * 64 + j];
              lg[row * 40 + j] = a * rstd + (j < 4 ? rgb[j] : reb[j - 4]); } } }
        __syncthreads();
        if (F.tid < 64) {
            const int row = F.tid; const LAS float* L = lg + row * 40;
            int grp = 0; float gm = L[0];
#pragma unroll
            for (int j = 1; j < 4; ++j) if (L[j] > gm) { gm = L[j]; grp = j; }
            float den = 0.f;
#pragma unroll
            for (int j = 0; j < 4; ++j) den += expf(L[j] - gm);
            const float pg = 1.f / den;
            const LAS float* el = L + 4 + grp * 8;
            int i0 = 0; for (int j = 1; j < 8; ++j) if (el[j] > el[i0]) i0 = j;
            int i1 = -1; for (int j = 0; j < 8; ++j) { if (j == i0) continue; if (i1 < 0 || el[j] > el[i1]) i1 = j; }
            const float e1 = expf(el[i1] - el[i0]), d2 = 1.f + e1;
            const int ea = grp * 8 + i0, eb = grp * 8 + i1;
            const unsigned pa = atomicAdd(&ctl[CW_CNT + l * 32 + ea], 1u), pb = atomicAdd(&ctl[CW_CNT + l * 32 + eb], 1u);
            int* rt = (int*)(F.ws + WS_ROUTE) + (size_t)(row0 + row) * 8;
            rt[0] = ea; rt[1] = eb; ((float*)rt)[2] = pg / d2; ((float*)rt)[3] = pg * e1 / d2; rt[4] = (int)pa; rt[5] = (int)pb;
        }
        for (int q = 0; q < 8; ++q) { const int row = w * 8 + q; const float rstd = rstd_s[row];
            const float* xr2 = x + (size_t)(row0 + row) * D; bf16_t* hr = (bf16_t*)(F.ws + WS_H) + (size_t)(row0 + row) * D; unsigned char* hr8 = F.ws + WS_H + (size_t)(row0 + row) * D;
#pragma unroll
            for (int i = 0; i < 8; ++i) { const f32x4 v = *(const f32x4*)(xr2 + i * 256 + lane * 4); const f32x4 gv = *(const f32x4*)(g2 + i * 256 + lane * 4);
                if (F8) { *(unsigned*)(hr8 + i * 256 + lane * 4) = pack_fp8x4(v[0] * rstd * gv[0] * 16.f, v[1] * rstd * gv[1] * 16.f, v[2] * rstd * gv[2] * 16.f, v[3] * rstd * gv[3] * 16.f); }
                else { u32x2 wv; wv[0] = cvt_pk_bf16(v[0] * rstd * gv[0], v[1] * rstd * gv[1]); wv[1] = cvt_pk_bf16(v[2] * rstd * gv[2], v[3] * rstd * gv[3]); *(u32x2*)(hr + i * 256 + lane * 4) = wv; } } }
        __syncthreads();
    }
}

struct MoeTab { int ntiles; };
__device__ __forceinline__ int moe_build_tab(const Frame& F, int l, LAS int* tab  ) {
    unsigned* ctl = (unsigned*)(F.ws + WS_CTL);
    if (F.tid < 32) tab[32 + F.tid] = (int)__hip_atomic_load(&ctl[CW_CNT + l * 32 + F.tid], __ATOMIC_RELAXED, __HIP_MEMORY_SCOPE_AGENT);
    __syncthreads();
    if (F.tid == 0) { int off = 0, nt = 0;
#pragma nounroll
        for (int e = 0; e < 32; ++e) { tab[e] = off; const int n = (tab[32 + e] + 255) >> 8;
#pragma nounroll
            for (int k = 0; k < n; ++k) { tab[64 + nt] = e; tab[224 + nt] = off + k * 256; ++nt; } off += n * 256; } tab[384] = nt; }
    __syncthreads();
    return tab[384];
}
__device__ __forceinline__ void p_route2(const Frame& F0, int l) {
    const Frame F = phase_frame(F0);
    LAS int* tab = (LAS int*)(F.lds + LDS_MISC);
    moe_build_tab(F, l, tab);
    int* rowtok = (int*)(F.ws + WS_ROWTOK); float* roww = (float*)(F.ws + WS_ROWW);
    for (int t = F.c * NTHR + F.tid; t < T; t += F.G * NTHR) {
        int* rt = (int*)(F.ws + WS_ROUTE) + (size_t)t * 8;
        const int ea = rt[0], eb = rt[1]; const float wa = ((float*)rt)[2], wb = ((float*)rt)[3];
        const int ra = tab[ea] + rt[4], rb = tab[eb] + rt[5];
        rowtok[ra] = t; roww[ra] = wa; rowtok[rb] = t; roww[rb] = wb; rt[6] = ra; rt[7] = rb;
    }
}

template <bool F8>
struct SchedMoeGUT {
    static constexpr bool GATHER = true;
    const char* H; const char* W; const int* rowtok; LAS int* tab; int G, c, ntiles;
    __device__ __forceinline__ bool next(int i, ge::Unit& u) const { const int L = i * G + c; if (L >= ntiles * 4) return false; const int ti = L >> 2, ct = L & 3; const int e = tab[64 + ti];
        u.A = H; u.B = W + ((size_t)e * 1024 + ct * 256) * 2048 * (F8 ? 1 : 2); u.r0 = tab[224 + ti]; u.c0 = ct * 128; u.aux = e; u.aux2 = 0; return true; }
    __device__ __forceinline__ void voffA(const ge::Unit& u, int tid, unsigned (&v)[2][2]) const {
#pragma unroll
        for (int i = 0; i < 2; ++i) { int R, C; ge::stage_rc(tid * 16 + i * 8192, R, C); const int t0 = rowtok[u.r0 + R], t1 = rowtok[u.r0 + 128 + R]; v[0][i] = F8 ? (unsigned)(t0 * 2048 + C * 2) : (unsigned)(t0 * 2048 + C) * 2u; v[1][i] = F8 ? (unsigned)(t1 * 2048 + C * 2) : (unsigned)(t1 * 2048 + C) * 2u; } }
};
template <bool F8>
struct EpiGUT {
    static constexpr bool PERM = true; void* hidv;
    __device__ __forceinline__ void operator()(const f32x4 (&acc)[2][2][4][2], const ge::Unit& u, int wr, int wc, int fr, int fq) const {
#pragma unroll
        for (int ai = 0; ai < 2; ++ai)
#pragma unroll
            for (int m = 0; m < 4; ++m) { const f32x4 g0 = acc[ai][0][m][0], g1 = acc[ai][0][m][1], u0 = acc[ai][1][m][0], u1 = acc[ai][1][m][1];
                float h[8] = {fast_silu(g0[0]) * u0[0], fast_silu(g0[1]) * u0[1], fast_silu(g0[2]) * u0[2], fast_silu(g0[3]) * u0[3], fast_silu(g1[0]) * u1[0], fast_silu(g1[1]) * u1[1], fast_silu(g1[2]) * u1[2], fast_silu(g1[3]) * u1[3]};
                const size_t off = (size_t)(u.r0 + ai * 128 + wr * 64 + m * 16 + fr) * 512 + u.c0 + wc * 32 + 8 * fq;
                if (F8) {
#pragma unroll
                    for (int j = 0; j < 8; ++j) h[j] = fminf(fmaxf(h[j] * 8.f, -440.f), 440.f);
                    u32x2 w = {pack_fp8x4(h[0], h[1], h[2], h[3]), pack_fp8x4(h[4], h[5], h[6], h[7])}; *(u32x2*)((unsigned char*)hidv + off) = w; }
                else { u32x4 w = {cvt_pk_bf16(h[0], h[1]), cvt_pk_bf16(h[2], h[3]), cvt_pk_bf16(h[4], h[5]), cvt_pk_bf16(h[6], h[7])}; *(u32x4*)((bf16_t*)hidv + off) = w; } }
    }
};
template <bool F8>
__device__ __forceinline__ void p_moe_gu(const Frame& F0, int l) {
    const Frame F = phase_frame(F0);
    LAS int* tab = (LAS int*)(F.lds + LDS_MISC);
    const int nt = moe_build_tab(F, l, tab);
    SchedMoeGUT<F8> S{(const char*)(F.ws + WS_H), (const char*)(F.ws + WS_WGU), (const int*)(F.ws + WS_ROWTOK), tab, F.G, F.c, nt};
    EpiGUT<F8> E{(void*)(F.ws + WS_HID)};
    ge::gemm_phase<EpiGUT<F8>, SchedMoeGUT<F8>, 0, F8>(F.lds, F.tid, 2048, 0, S, E);
}
template <bool F8>
struct SchedMoeDT {
    static constexpr bool GATHER = false;
    const char* HID; const char* W; LAS int* tab; int G, c, ntiles;
    __device__ __forceinline__ bool next(int i, ge::Unit& u) const { const int L = i * G + c; if (L >= ntiles * 8) return false; const int ti = L >> 3, ct = L & 7; const int e = tab[64 + ti];
        u.r0 = tab[224 + ti]; u.A = HID + (size_t)u.r0 * 512 * (F8 ? 1 : 2); u.B = W + ((size_t)e * 2048 + ct * 256) * 512 * (F8 ? 1 : 2); u.c0 = ct * 256; u.aux = e; u.aux2 = 0; return true; }
    __device__ __forceinline__ void voffA(const ge::Unit&, int tid, unsigned (&v)[2][2]) const { ge::dense_voffA<F8>(512, tid, v); }
};
struct EpiDown {
    static constexpr bool PERM = true; bf16_t* y; const float* roww;
    __device__ __forceinline__ void operator()(const f32x4 (&acc)[2][2][4][2], const ge::Unit& u, int wr, int wc, int fr, int fq) const {
#pragma unroll
        for (int ai = 0; ai < 2; ++ai)
#pragma unroll
            for (int m = 0; m < 4; ++m) { const int row = u.r0 + ai * 128 + wr * 64 + m * 16 + fr; const float s = roww[row]; bf16_t* rowp = y + (size_t)row * 2048 + u.c0 + wc * 32 + 8 * fq;
#pragma unroll
                for (int bj = 0; bj < 2; ++bj) { const f32x4 v0 = acc[ai][bj][m][0] * s, v1 = acc[ai][bj][m][1] * s; u32x4 w = {cvt_pk_bf16(v0[0], v0[1]), cvt_pk_bf16(v0[2], v0[3]), cvt_pk_bf16(v1[0], v1[1]), cvt_pk_bf16(v1[2], v1[3])};
                    *(u32x4*)(rowp + bj * 128) = w; } }
    }
};
template <bool F8>
__device__ __forceinline__ void p_moe_down(const Frame& F0, int l) {
    const Frame F = phase_frame(F0);
    LAS int* tab = (LAS int*)(F.lds + LDS_MISC);
    const int nt = moe_build_tab(F, l, tab);
    SchedMoeDT<F8> S{(const char*)(F.ws + WS_HID), (const char*)(F.ws + WS_WD), tab, F.G, F.c, nt};
    EpiDown E{(bf16_t*)(F.ws + WS_YBUF), (const float*)(F.ws + WS_ROWW)};
    ge::gemm_phase<EpiDown, SchedMoeDT<F8>, 0, F8, GE_SP2_DEFAULT, GE_ALIGN_DEFAULT, 0x7C7C7C7C>(F.lds, F.tid, 512, 0, S, E);
}
template <int MODE>
__device__ __forceinline__ void p_combine(const Frame& F0, int lnext) {
    const Frame F = phase_frame(F0);
    float* x = F.out(); const bf16_t* y = (const bf16_t*)(F.ws + WS_YBUF);
    const float* g = MODE == 0 ? F.in(1) + lnext * D : F.in(21);
    for (int row = F.c * 8 + F.wave; row < T; row += F.G * 8) {
        const int* rt = (const int*)(F.ws + WS_ROUTE) + (size_t)row * 8; const int ra = rt[6], rb = rt[7];
        float* xr = x + (size_t)row * D; f32x4 v[8]; float ss = 0.f;
#pragma unroll
        for (int i = 0; i < 8; ++i) { v[i] = *(const f32x4*)(xr + i * 256 + F.lane * 4);
            const u32x2 ya = *(const u32x2*)(y + (size_t)ra * 2048 + i * 256 + F.lane * 4), yb = *(const u32x2*)(y + (size_t)rb * 2048 + i * 256 + F.lane * 4);
            v[i][0] += bf_lo(ya[0]) + bf_lo(yb[0]); v[i][1] += bf_hi(ya[0]) + bf_hi(yb[0]); v[i][2] += bf_lo(ya[1]) + bf_lo(yb[1]); v[i][3] += bf_hi(ya[1]) + bf_hi(yb[1]);
            ss += v[i][0] * v[i][0] + v[i][1] * v[i][1] + v[i][2] * v[i][2] + v[i][3] * v[i][3]; }
#pragma unroll
        for (int o = 32; o > 0; o >>= 1) ss += __shfl_xor(ss, o);
        const float rstd = rsqrtf(ss * (1.f / D) + 1e-6f);
#pragma unroll
        for (int i = 0; i < 8; ++i) { const f32x4 gv = *(const f32x4*)(g + i * 256 + F.lane * 4);
            if (MODE == 0) { *(f32x4*)(xr + i * 256 + F.lane * 4) = v[i]; v[i] = (f32x4){v[i][0] * rstd * gv[0], v[i][1] * rstd * gv[1], v[i][2] * rstd * gv[2], v[i][3] * rstd * gv[3]}; }
            else { f32x4 o = {v[i][0] * rstd * gv[0], v[i][1] * rstd * gv[1], v[i][2] * rstd * gv[2], v[i][3] * rstd * gv[3]}; *(f32x4*)(xr + i * 256 + F.lane * 4) = o; } }
        if (MODE == 0) store_h_row(F.ws, row, v, F.lane);
    }
}

namespace att {
constexpr float SCALE = 0.08838834764831845f;
constexpr int NW = 8, QBLK = 32, KVBLK = 64, QB = NW * QBLK, DH = 128;
constexpr int SHM_V = KVBLK * DH * 2, SHM_K = KVBLK * DH * 2;
constexpr int ATT_LDS = 2 * SHM_V + 2 * SHM_K + NW * 64 * 4;
constexpr float THR = 8.f;
typedef short s16x4 __attribute__((ext_vector_type(4)));

#define KSWZ(row, colB) ((row) * 256 + ((colB) ^ (((row) & 7) << 4)))
#define SBAR() __builtin_amdgcn_sched_barrier(0)
__device__ __forceinline__ int v_st(int k, int c) { const int kk = (k & ~0xC) | ((k & 4) << 1) | ((k & 8) >> 1); return ((kk >> 3) * 4 + (c >> 5)) * 512 + ((kk & 7) * 32 + (c & 31)) * 2; }
__device__ __forceinline__ int v_rd_base(int lane) { return ((lane & 3) << 3) | (((lane >> 2) & 3) << 6) | (((lane >> 4) & 1) << 5) | (((lane >> 5) & 1) << 8); }
constexpr int v_rd_off(int d0, int ks, int half) { return d0 * 512 + ks * 4096 + half * 2048; }
__device__ __forceinline__ int crow(int r, int hi) { return (r & 3) + 8 * (r >> 2) + 4 * hi; }
__device__ __forceinline__ bf16x8 load8(const bf16_t* p) { return *reinterpret_cast<const bf16x8*>(p); }

__device__ __forceinline__ void mask_tile(f32x16& p0, f32x16& p1, int dq, unsigned W) {
    const float NEG = -__builtin_inff();
#pragma unroll
    for (int r = 0; r < 16; ++r) {
        const int c = (r & 3) + 8 * (r >> 2);
        if ((unsigned)(dq - c) >= W) p0[r] = NEG;
        if ((unsigned)(dq - c - 32) >= W) p1[r] = NEG;
    }
}
__device__ __forceinline__ void mask_all(f32x16& p0, f32x16& p1, bool ok) {
    const float NEG = -__builtin_inff();
#pragma unroll
    for (int r = 0; r < 16; ++r) { p0[r] = ok ? p0[r] : NEG; p1[r] = ok ? p1[r] : NEG; }
}
__device__ __forceinline__ void partialSM(f32x16& p0, f32x16& p1, float& m_reg, float& mn, float& alpha) {
    float pmax = p0[0]; for (int r = 1; r < 16; ++r) pmax = fmaxf(pmax, p0[r]); for (int r = 0; r < 16; ++r) pmax = fmaxf(pmax, p1[r]);
    { auto rr = __builtin_amdgcn_permlane32_swap(__float_as_uint(pmax), __float_as_uint(pmax), false, false);
      pmax = fmaxf(__uint_as_float(rr[0]), __uint_as_float(rr[1])); }
    constexpr float C2 = 1.4426950408889634f * SCALE;
    if (__builtin_expect(__all((pmax - m_reg) * SCALE <= THR), 1)) { mn = m_reg; alpha = 1.f; }
    else { mn = fmaxf(m_reg, pmax); alpha = __builtin_amdgcn_exp2f((m_reg - mn) * C2); m_reg = mn; }
    const float mnL = -mn * C2;
    for (int r = 0; r < 16; ++r) p0[r] = fmaf(p0[r], C2, mnL); for (int r = 0; r < 16; ++r) p1[r] = fmaf(p1[r], C2, mnL);
    for (int r = 0; r < 16; ++r) p0[r] = __builtin_amdgcn_exp2f(p0[r]);
}
__device__ __forceinline__ void finishSM(f32x16& p0, f32x16& p1, float alpha, float& l_reg, bf16x8& pa0, bf16x8& pa1, bf16x8& pa2, bf16x8& pa3) {
    for (int r = 0; r < 16; ++r) p1[r] = __builtin_amdgcn_exp2f(p1[r]);
    float ps = 0; for (int r = 0; r < 16; ++r) ps += p0[r]; for (int r = 0; r < 16; ++r) ps += p1[r];
    { auto rr = __builtin_amdgcn_permlane32_swap(__float_as_uint(ps), __float_as_uint(ps), false, false);
      ps = __uint_as_float(rr[0]) + __uint_as_float(rr[1]); }
    l_reg = l_reg * alpha + ps;
#define PK4(P, B_, OUT) do { unsigned a0 = cvt_pk_bf16(P[B_+0], P[B_+1]), a1 = cvt_pk_bf16(P[B_+2], P[B_+3]);                          \
        unsigned b0 = cvt_pk_bf16(P[B_+4], P[B_+5]), b1 = cvt_pk_bf16(P[B_+6], P[B_+7]);                                             \
        auto r0 = __builtin_amdgcn_permlane32_swap(a0, b0, false, false); auto r1 = __builtin_amdgcn_permlane32_swap(a1, b1, false, false); \
        u32x4 w = {r0[0], r1[0], r0[1], r1[1]}; OUT = *reinterpret_cast<bf16x8*>(&w); } while (0)
    PK4(p0, 0, pa0); PK4(p0, 8, pa1); PK4(p1, 0, pa2); PK4(p1, 8, pa3);
#undef PK4
}
template <int KB, bool SK>
__device__ __forceinline__ void qkt(f32x16& p0, f32x16& p1, const char* K_lds, int r32, int hi, const bf16x8* qr, bool act) {
    if (SK && !act) { const float NEG = -__builtin_inff();
#pragma unroll
        for (int r = 0; r < 16; ++r) { p0[r] = NEG; p1[r] = NEG; } return; }
    p0 = f32x16{}; p1 = f32x16{};
    const unsigned kb0 = (unsigned)(uintptr_t)(const LAS char*)(K_lds + KB * SHM_K) + (unsigned)KSWZ(r32, (hi * 8) * 2);
    unsigned kbx[4]; kbx[0] = kb0;
    asm volatile("v_xor_b32 %0, 32, %1" : "=v"(kbx[1]) : "v"(kb0)); asm volatile("v_xor_b32 %0, 64, %1" : "=v"(kbx[2]) : "v"(kb0)); asm volatile("v_xor_b32 %0, 0x60, %1" : "=v"(kbx[3]) : "v"(kb0));
#pragma unroll
    for (int d0 = 0; d0 < 8; ++d0) { const unsigned a = kbx[d0 & 3] + (d0 >> 2) * 128;
        bf16x8 b0 = *(const LAS bf16x8*)(a);
        bf16x8 b1 = *(const LAS bf16x8*)(a + 32 * 256);
        p0 = __builtin_amdgcn_mfma_f32_32x32x16_bf16(b0, qr[d0], p0, 0, 0, 0);
        p1 = __builtin_amdgcn_mfma_f32_32x32x16_bf16(b1, qr[d0], p1, 0, 0, 0); }
}
template <int VB, bool SK>
__device__ __forceinline__ void pv_tile(f32x16* o, int vb0, bf16x8 pa0, bf16x8 pa1, bf16x8 pa2, bf16x8 pa3, bool act) {
    if (SK && !act) return;
#define TRRD(dst, off) asm volatile("ds_read_b64_tr_b16 %0, %1 offset:%2" : "=&v"(dst) : "v"(vb0), "i"(off) : "memory")
#define PV_D0(d0) do { s16x4 l0, l1, l2, l3, h0, h1, h2, h3; constexpr int b_ = VB * SHM_V + v_rd_off(d0, 0, 0); \
        TRRD(l0, b_); TRRD(h0, b_ + 2048); TRRD(l1, b_ + 4096); TRRD(h1, b_ + 6144); TRRD(l2, b_ + 8192); TRRD(h2, b_ + 10240); TRRD(l3, b_ + 12288); TRRD(h3, b_ + 14336); \
        asm volatile("s_waitcnt lgkmcnt(0)" ::: "memory"); SBAR(); \
        o[d0] = __builtin_amdgcn_mfma_f32_32x32x16_bf16(pa0, (bf16x8){l0[0], l0[1], l0[2], l0[3], h0[0], h0[1], h0[2], h0[3]}, o[d0], 0, 0, 0);   \
        o[d0] = __builtin_amdgcn_mfma_f32_32x32x16_bf16(pa1, (bf16x8){l1[0], l1[1], l1[2], l1[3], h1[0], h1[1], h1[2], h1[3]}, o[d0], 0, 0, 0);   \
        o[d0] = __builtin_amdgcn_mfma_f32_32x32x16_bf16(pa2, (bf16x8){l2[0], l2[1], l2[2], l2[3], h2[0], h2[1], h2[2], h2[3]}, o[d0], 0, 0, 0);   \
        o[d0] = __builtin_amdgcn_mfma_f32_32x32x16_bf16(pa3, (bf16x8){l3[0], l3[1], l3[2], l3[3], h3[0], h3[1], h3[2], h3[3]}, o[d0], 0, 0, 0); } while (0)
    PV_D0(0); PV_D0(1); PV_D0(2); PV_D0(3);
#undef PV_D0
#undef TRRD
}

struct BlockRef { const bf16_t* Q; const bf16_t* K; const bf16_t* V; bf16_t* O; const void* mask; const bf16_t* gate; int P0; int pad; };
struct Seam { bf16x8 qr[8]; bf16x8 st_v0, st_v1, st_k0, st_k1; };
__device__ __forceinline__ int swa_jlo(int P0, int W) { const int lowk = P0 - W + 1; return lowk > 0 ? lowk / KVBLK : 0; }
#define ROW(p, k0, rr) ((p) + (size_t)(k0) * LDP + (unsigned)((rr) * LDP + sc))
#define VMW() asm volatile("s_waitcnt vmcnt(0)" ::: "memory")
#define VMWN(n) asm volatile("s_waitcnt vmcnt(%0)" :: "i"(n) : "memory")
#define SLOAD_H(Kp, Vp, k0) do { S.st_v0 = load8(ROW(Vp, k0, sr)); S.st_v1 = load8(ROW(Vp, k0, 32 + sr));              \
                         S.st_k0 = load8(ROW(Kp, k0, sr)); S.st_k1 = load8(ROW(Kp, k0, 32 + sr)); } while (0)
#define SWRITE_HK(bf) do { *(bf16x8*)(K_lds + (bf) * SHM_K + kws) = S.st_k0; *(bf16x8*)(K_lds + (bf) * SHM_K + kws + 32 * 256) = S.st_k1; } while (0)
#define SWRITE_HV(bf) do { *(bf16x8*)(V_lds + (bf) * SHM_V + vst0) = S.st_v0; *(bf16x8*)(V_lds + (bf) * SHM_V + vst1) = S.st_v1; } while (0)
#define SWRITE_H(bf) do { SWRITE_HV(bf); SWRITE_HK(bf); } while (0)
__device__ __forceinline__ void prime(const BlockRef& cur, int W, char* lds, Seam& S, int tid) {
    const int wid = __builtin_amdgcn_readfirstlane(tid >> 6), lane = tid & 63, r32 = lane & 31, hi = lane >> 5;
    const int sr = tid >> 4, sc = (tid & 15) * 8, kws = KSWZ(sr, sc * 2); char* K_lds = lds + 2 * SHM_V;
    const int kb0 = swa_jlo(cur.P0, W) * KVBLK;
    for (int d0 = 0; d0 < 8; ++d0) S.qr[d0] = load8(cur.Q + (unsigned)((wid * QBLK + r32) * LDP + hi * 8) + d0 * 16);
    SLOAD_H(cur.K, cur.V, kb0); VMW(); SWRITE_HK(0);
    __syncthreads();
}
template <int MODE, bool SK>
__device__ __forceinline__ void block(const BlockRef& cur, const BlockRef& nxt, int skv, int W, char* lds, Seam& S, int tid) {
    const int wid = __builtin_amdgcn_readfirstlane(tid >> 6), lane = tid & 63, r32 = lane & 31, hi = lane >> 5;
    const int j_lo = swa_jlo(cur.P0, W);
    int j_hi = (cur.P0 + QB - 1) / KVBLK + 1; if (j_hi > skv / KVBLK) j_hi = skv / KVBLK;
    const int NT = j_hi - j_lo;
    const int kbn = swa_jlo(nxt.P0, W) * KVBLK;
    const int qlo = cur.P0 + wid * QBLK, qm = qlo + r32 - 4 * hi;
    char* V_lds = lds; char* K_lds = lds + 2 * SHM_V;
    float* ws = (float*)(lds + 2 * SHM_V + 2 * SHM_K) + wid * 64; float* li_l = ws, * al_l = ws + 32;
    float m_reg = -1e30f, l_reg = 0; f32x16 o[4] = {};
    const int sr = tid >> 4, sc = (tid & 15) * 8, vst0 = v_st(sr, sc), vst1 = v_st(32 + sr, sc), kws = KSWZ(sr, sc * 2);
    const int vb0 = (int)(uintptr_t)V_lds + v_rd_base(lane);
    const bf16_t* Kh = cur.K; const bf16_t* Vh = cur.V;
    unsigned rowmask = 0xffffffffu;
    if (MODE == 0) rowmask = ((const unsigned char*)cur.mask)[(unsigned)((wid * QBLK + r32) * 8)];
    if (MODE == 1) rowmask = ((const unsigned*)cur.mask)[(unsigned)((wid * QBLK + r32) * 2)];
    constexpr int BSH = (MODE == 0) ? 8 : 6;
#define RESC(a) do { if (__any((a) < 1.f)) { if (hi == 0) al_l[r32] = (a); asm volatile("s_waitcnt lgkmcnt(0)" ::: "memory");              \
                     for (int d_ = 0; d_ < 4; ++d_) for (int r = 0; r < 16; ++r) o[d_][r] *= al_l[crow(r, hi)]; } } while (0)
#define KBASE(t) ((j_lo + (t)) * KVBLK)
#define ACT(t) (KBASE(t) <= qlo + QBLK - 1 && KBASE(t) + KVBLK - 1 >= qlo - W + 1)
#define MASKT(P0_, P1_, t) do { const int kb_ = KBASE(t); if ((!SK || ACT(t)) && (kb_ + KVBLK - 1 > qlo || kb_ <= qlo + QBLK - 1 - W)) mask_tile(P0_, P1_, qm - kb_, (unsigned)W); \
        if (MODE != 2) { const bool ok_ = (rowmask >> (kb_ >> BSH)) & 1u; if (!__all(ok_)) mask_all(P0_, P1_, ok_); } } while (0)
    constexpr int NQL = 8;
#define SEAM_K0() do { VMWN(NQL); SWRITE_HK(0); SBAR(); } while (0)
    f32x16 pA0, pA1, pB0, pB1; float mnA, mnB, alA, alB; bf16x8 pa0, pa1, pa2, pa3;
    SWRITE_HV(0); SBAR();
    if (NT > 1) { SLOAD_H(Kh, Vh, KBASE(1)); }
    SBAR(); qkt<0, SK>(pA0, pA1, K_lds, r32, hi, S.qr, ACT(0));
    MASKT(pA0, pA1, 0); partialSM(pA0, pA1, m_reg, mnA, alA);
    if (NT > 1) { VMW(); SWRITE_H(1); }
    __syncthreads();
#define HALF_STEP(PX0, PX1, mnX, alX, PY0, PY1, alY, t, KB, VB, SB) do {                                                      \
        SBAR(); qkt<KB, SK>(PX0, PX1, K_lds, r32, hi, S.qr, ACT(t));                                             \
        finishSM(PY0, PY1, alY, l_reg, pa0, pa1, pa2, pa3); SBAR();                                                           \
        if ((t) + 1 < NT) { SLOAD_H(Kh, Vh, KBASE((t) + 1)); SBAR(); }                                               \
        pv_tile<VB, SK>(o, vb0, pa0, pa1, pa2, pa3, ACT((t) - 1)); MASKT(PX0, PX1, (t)); partialSM(PX0, PX1, m_reg, mnX, alX);                                        \
        __syncthreads();                                                                                                      \
        if ((t) + 1 < NT) { VMW(); SWRITE_H(SB); }                                                                          \
        RESC(alX); __syncthreads(); } while (0)
    for (int t = 1; t + 1 < NT; t += 2) {
        HALF_STEP(pB0, pB1, mnB, alB, pA0, pA1, alA, t, 1, 0, 0);
        HALF_STEP(pA0, pA1, mnA, alA, pB0, pB1, alB, t + 1, 0, 1, 1);
    }
    const bool even = (NT & 1) == 0;
    if (even) { SBAR(); qkt<1, SK>(pB0, pB1, K_lds, r32, hi, S.qr, ACT(NT - 1)); SBAR(); }
    SLOAD_H(nxt.K, nxt.V, kbn); SBAR();
#pragma unroll
    for (int d0 = 0; d0 < 8; ++d0) S.qr[d0] = load8(nxt.Q + (unsigned)((wid * QBLK + r32) * LDP + hi * 8) + d0 * 16);
    SBAR();
    finishSM(pA0, pA1, alA, l_reg, pa0, pa1, pa2, pa3); SBAR();
    pv_tile<0, SK>(o, vb0, pa0, pa1, pa2, pa3, ACT(even ? NT - 2 : NT - 1));
    if (even) { MASKT(pB0, pB1, NT - 1); partialSM(pB0, pB1, m_reg, mnB, alB); __syncthreads(); RESC(alB);
        finishSM(pB0, pB1, alB, l_reg, pa0, pa1, pa2, pa3); SBAR(); pv_tile<1, SK>(o, vb0, pa0, pa1, pa2, pa3, ACT(NT - 1)); }
    SBAR(); SEAM_K0();
    { int le = lane; asm volatile("" : "+v"(le)); const int r32e = le & 31, hie = le >> 5;
    if (hie == 0) { float sc_ = 1.f / l_reg;
        if (MODE != 0) { const float gl = bf2f(cur.gate[(unsigned)((wid * QBLK + r32e) * LDP)]); sc_ *= fast_sigmoid(gl); }
        li_l[r32e] = sc_; }
    asm volatile("s_waitcnt lgkmcnt(0)" ::: "memory");
    bf16_t* Ow = cur.O + (size_t)(wid * QBLK) * 1024;
#pragma unroll
    for (int r = 0; r < 16; ++r) { const int orow = crow(r, hie); const float rl = li_l[orow];
#pragma unroll
        for (int d0 = 0; d0 < 4; ++d0) { const float v = o[d0][r] * rl;
            const float vn = __shfl_xor(v, 1);
            if ((r32e & 1) == 0) { unsigned* dp = (unsigned*)(Ow + (unsigned)(orow * 1024 + r32e) + d0 * 32);
                float a = v, b = vn;
                if (MODE != 0) { const unsigned pw = *dp; a += bf_lo(pw); b += bf_hi(pw); }
                *dp = cvt_pk_bf16(a, b); } } } }
    __syncthreads();
#undef RESC
#undef KBASE
#undef ACT
#undef MASKT
#undef SEAM_K0
#undef HALF_STEP
}
#undef ROW
#undef VMW
#undef VMWN
#undef SLOAD_H
#undef SWRITE_HK
#undef SWRITE_HV
#undef SWRITE_H
#undef KSWZ
#undef SBAR
}
constexpr size_t WS_DUMMY = (size_t)1180 * 1000 * 1000;
constexpr size_t WS_MOBAMASK = WS_END2;
constexpr size_t WS_SELMASK = WS_MOBAMASK + al256((size_t)T * 8);
constexpr size_t WS_END3 = WS_SELMASK + al256((size_t)T * 2 * 4);

__device__ __forceinline__ void p_moba_prep(const Frame& F0, int wg0) {
    const Frame F = phase_frame(F0);
    if (F.c < wg0) return;
    const bf16_t* proj = (const bf16_t*)(F.ws + WS_PROJ); unsigned char* mm = (unsigned char*)(F.ws + WS_MOBAMASK);
    LAS float* km = (LAS float*)F.lds;
    LAS float* part = km + 8 * 128;
    for (int u = F.c - wg0; u < NB * 8 * 8; u += F.G - wg0) {
        const int pb = u & 7, h = (u >> 3) & 7, b = u >> 6;
        const int kgrp = F.tid >> 7, d = F.tid & 127;
        for (int n = 0; n < pb; ++n) {
            const bf16_t* kp = proj + ((size_t)b * S + n * 256 + kgrp * 64) * LDP + P_MK + h * 128 + d; float a = 0.f;
            for (int j = 0; j < 64; ++j) a += bf2f(kp[(size_t)j * LDP]);
            part[kgrp * 128 + d] = a; __syncthreads();
            if (F.tid < 128) km[n * 128 + d] = (part[d] + part[128 + d] + part[256 + d] + part[384 + d]) * (1.f / 256.f);
            __syncthreads();
        }
        const int pos = F.tid >> 1, half = F.tid & 1; const size_t t = (size_t)b * S + pb * 256 + pos;
        float gt[8];
#pragma unroll
        for (int n = 0; n < 8; ++n) gt[n] = 0.f;
        const bf16_t* qp = proj + t * LDP + P_MQ + h * 128 + half * 64;
        for (int c8 = 0; c8 < 8; ++c8) { const u32x4 qw = *(const u32x4*)(qp + c8 * 8);
            const float qf[8] = {bf_lo(qw[0]), bf_hi(qw[0]), bf_lo(qw[1]), bf_hi(qw[1]), bf_lo(qw[2]), bf_hi(qw[2]), bf_lo(qw[3]), bf_hi(qw[3])};
#pragma unroll
            for (int n = 0; n < 8; ++n) if (n < pb) {
#pragma unroll
                for (int j = 0; j < 8; ++j) gt[n] += qf[j] * km[n * 128 + half * 64 + c8 * 8 + j]; } }
        unsigned taken = 0;
#pragma unroll
        for (int n = 0; n < 8; ++n) { gt[n] += __shfl_xor(gt[n], 1); if (n >= pb) gt[n] = -1e30f; }
#pragma unroll
        for (int k = 0; k < 3; ++k) { int best = -1; float bv = 0.f;
#pragma unroll
            for (int n = 0; n < 8; ++n) if (!((taken >> n) & 1u) && (best < 0 || gt[n] > bv)) { best = n; bv = gt[n]; }
            taken |= 1u << best; }
        unsigned m = (taken & ((1u << pb) - 1u)) | (1u << pb);
        if (half == 0) mm[t * 8 + h] = (unsigned char)m;
        __syncthreads();
    }
}
__device__ __forceinline__ att::BlockRef ref_moba(const bf16_t* proj, bf16_t* om, const unsigned char* mm, int L, int pass) {
    const int bh = L >> 2, y = L & 3, b = bh >> 3, h = bh & 7; const int qb = pass ? 7 - y : y; const size_t t0 = (size_t)b * S + qb * 256;
    att::BlockRef r; r.Q = proj + t0 * LDP + P_MQ + h * 128; r.K = proj + (size_t)b * S * LDP + P_MK + h * 128; r.V = proj + (size_t)b * S * LDP + P_MV + h * 128;
    r.O = om + t0 * 1024 + h * 128; r.mask = mm + t0 * 8 + h; r.gate = nullptr; r.P0 = qb * 256; r.pad = 0; return r; }
template <int BR>
__device__ __forceinline__ att::BlockRef ref_nsa(const bf16_t* proj, bf16_t* on, const unsigned* sm, int L, int pass) {
    const int bh = L >> 2, y = L & 3, b = bh >> 3, h = bh & 7, g = h >> 2; const int qb = pass ? 7 - y : y; const size_t t0 = (size_t)b * S + qb * 256;
    att::BlockRef r; r.Q = proj + t0 * LDP + P_NQ + h * 128; r.K = proj + (size_t)b * S * LDP + P_NKV + (2 + 2 * BR) * 256 + g * 128; r.V = proj + (size_t)b * S * LDP + P_NKV + (3 + 2 * BR) * 256 + g * 128;
    r.O = on + t0 * 1024 + h * 128; r.mask = sm + t0 * 2 + g; r.gate = proj + t0 * LDP + P_NG + h * 3 + 1 + BR; r.P0 = qb * 256; r.pad = 0; return r; }
template <int WIN, bool DUMMY>
__device__ __forceinline__ void p_moba_attn_t(const Frame& F0) {
    const Frame F = phase_frame(F0);
    const bf16_t* proj = (const bf16_t*)(F.ws + WS_PROJ); bf16_t* om = (bf16_t*)(F.ws + (DUMMY ? WS_DUMMY : WS_OM)); const unsigned char* mm = (const unsigned char*)(F.ws + WS_MOBAMASK);
    const int total = NB * 8 * 8;

    const int nitems = total / 2;
    int L = F.c; if (L >= nitems) return;
    int pass = 0; att::BlockRef cur = ref_moba(proj, om, mm, L, 0); att::Seam Sm;
    att::prime(cur, WIN, (char*)F.lds, Sm, F.tid);
    for (;;) {
        const bool more_pass = pass == 0, more_item = L + F.G < nitems, last = !more_pass && !more_item;
        int passn = pass + 1, Ln = L; if (!more_pass) { passn = 0; Ln = more_item ? L + F.G : L; }
        const att::BlockRef nxt = last ? cur : ref_moba(proj, om, mm, Ln, passn);
        att::block<0, false>(cur, nxt, S, WIN, (char*)F.lds, Sm, F.tid);
        if (last) break;
        cur = nxt; pass = passn; L = Ln;
    }
}
__device__ __forceinline__ void p_moba_attn(const Frame& F0) { p_moba_attn_t<(1 << 20), false>(F0); }
__device__ __forceinline__ void p_nsa_attn(const Frame& F0) {
    const int nitems = NB * 8 * 4;
    if (F0.c >= nitems) return;
    {
        const Frame F = phase_frame(F0);
        const bf16_t* proj = (const bf16_t*)(F.ws + WS_PROJ); bf16_t* on = (bf16_t*)(F.ws + WS_ON); const unsigned* sm = (const unsigned*)(F.ws + WS_SELMASK);

        int L = F.c, pass = 0; att::BlockRef cur = ref_nsa<0>(proj, on, sm, L, 0); att::Seam Sm;
        att::prime(cur, 1 << 20, (char*)F.lds, Sm, F.tid);
        for (;;) {
            const bool more_pass = pass == 0, more_item = L + F.G < nitems, last = !more_pass && !more_item;
            int passn = pass + 1, Ln = L; if (!more_pass) { passn = 0; Ln = more_item ? L + F.G : L; }
            const att::BlockRef nxt = last ? cur : ref_nsa<0>(proj, on, sm, Ln, passn);
            att::block<1, false>(cur, nxt, S, 1 << 20, (char*)F.lds, Sm, F.tid);
            if (last) break;
            cur = nxt; pass = passn; L = Ln;
        }
    }
    {
        const Frame F = phase_frame(F0);
        const bf16_t* proj = (const bf16_t*)(F.ws + WS_PROJ); bf16_t* on = (bf16_t*)(F.ws + WS_ON); const unsigned* sm = (const unsigned*)(F.ws + WS_SELMASK);

        int L = F.c, pass = 0; att::BlockRef cur = ref_nsa<1>(proj, on, sm, L, 0); att::Seam Sm;
        att::prime(cur, 512, (char*)F.lds, Sm, F.tid);
        for (;;) {
            const bool more_pass = pass == 0, more_item = L + F.G < nitems, last = !more_pass && !more_item;
            int passn = pass + 1, Ln = L; if (!more_pass) { passn = 0; Ln = more_item ? L + F.G : L; }
            const att::BlockRef nxt = last ? cur : ref_nsa<1>(proj, on, sm, Ln, passn);
            att::block<2, false>(cur, nxt, S, 512, (char*)F.lds, Sm, F.tid);
            if (last) break;
            cur = nxt; pass = passn; L = Ln;
        }
    }
}

constexpr size_t WS_GDS = WS_MERGED;
constexpr size_t WS_GQT = WS_DEC;
constexpr size_t WS_GDL = WS_END3;
constexpr size_t WS_END4 = WS_GDL + al256((size_t)1024 * 128 * 4);

__device__ __forceinline__ void p_gla1(const Frame& F0, int l, int wg0) {
    const Frame F = phase_frame(F0);
    if (F.c < wg0) return;
    const bf16_t* proj = (const bf16_t*)(F.ws + WS_PROJ);
    const float* wa = F.in(6) + (size_t)l * 16 * 512; const float* ba = F.in(7) + (size_t)l * 512;
    float* ograw = (float*)(F.ws + WS_OGRAW); bf16_t* gds = (bf16_t*)(F.ws + WS_GDS); bf16_t* gqt = (bf16_t*)(F.ws + WS_GQT); float* gdl = (float*)(F.ws + WS_GDL);
    LAS bf16_t* bq = (LAS bf16_t*)F.lds;
    LAS bf16_t* bk = bq + 64 * 136;
    LAS bf16_t* bkT = bk + 64 * 136;
    LAS bf16_t* bvT = bkT + 128 * 72;
    LAS bf16_t* rv = bvT + 256 * 72;
    LAS bf16_t* bA = rv;
    LAS float* gs = (LAS float*)(rv + 64 * 256);
    LAS bf16_t* sga = (LAS bf16_t*)(gs + 512);
    const int tid = F.tid, lane = F.lane, w = F.wave, r32 = lane & 31, hh = lane >> 5;
    for (int u = F.c - wg0; u < 1024; u += F.G - wg0) {
        const int c = u & 31, h = (u >> 5) & 3, b = u >> 7; const size_t row0 = (size_t)b * S + c * 64;
        {
            u32x4 lq[2], lk[2], lv[4], lg = {0u, 0u, 0u, 0u};
#pragma unroll
            for (int i = 0; i < 2; ++i) { const int ch = i * NTHR + tid, t = ch >> 4, cc = ch & 15; lq[i] = *(const u32x4*)(proj + (row0 + t) * LDP + P_GQ + h * 128 + cc * 8); lk[i] = *(const u32x4*)(proj + (row0 + t) * LDP + P_GK + h * 128 + cc * 8); }
#pragma unroll
            for (int i = 0; i < 4; ++i) { const int ch = i * NTHR + tid, t = ch >> 5, cc = ch & 31; lv[i] = *(const u32x4*)(proj + (row0 + t) * LDP + P_GV + h * 256 + cc * 8); }
            if (tid < 128) lg = *(const u32x4*)(proj + (row0 + (tid >> 1)) * LDP + P_GA + (tid & 1) * 8);
#pragma unroll
            for (int i = 0; i < 2; ++i) { const int ch = i * NTHR + tid, t = ch >> 4, cc = ch & 15; *(LAS u32x4*)(bq + t * 136 + cc * 8) = lq[i]; *(LAS u32x4*)(bk + t * 136 + cc * 8) = lk[i]; }
#pragma unroll
            for (int i = 0; i < 4; ++i) { const int ch = i * NTHR + tid, t = ch >> 5, cc = ch & 31; *(LAS u32x4*)(rv + t * 256 + cc * 8) = lv[i]; }
            if (tid < 128) *(LAS u32x4*)(sga + (tid >> 1) * 16 + (tid & 1) * 8) = lg;
        }
        __syncthreads();
        {
            const int d = tid & 127, tq = tid >> 7, col = h * 128 + d;
            float war[16];
#pragma unroll
            for (int r = 0; r < 16; ++r) war[r] = wa[r * 512 + col];
            const float bias = ba[col];
            float bl[16]; float cum = 0.f;
#pragma unroll
            for (int i = 0; i < 16; ++i) { const LAS bf16_t* gp = sga + (tq * 16 + i) * 16;
                const u32x4 g0 = *(const LAS u32x4*)gp, g1 = *(const LAS u32x4*)(gp + 8);
                float x = bias + bf_lo(g0[0]) * war[0] + bf_hi(g0[0]) * war[1] + bf_lo(g0[1]) * war[2] + bf_hi(g0[1]) * war[3] + bf_lo(g0[2]) * war[4] + bf_hi(g0[2]) * war[5] + bf_lo(g0[3]) * war[6] + bf_hi(g0[3]) * war[7]
                        + bf_lo(g1[0]) * war[8] + bf_hi(g1[0]) * war[9] + bf_lo(g1[1]) * war[10] + bf_hi(g1[1]) * war[11] + bf_lo(g1[2]) * war[12] + bf_hi(g1[2]) * war[13] + bf_lo(g1[3]) * war[14] + bf_hi(g1[3]) * war[15];
                const float ls = fminf(x, 0.f) - 0.6931471805599453f * __builtin_amdgcn_logf(1.f + __builtin_amdgcn_exp2f(-1.4426950408889634f * fabsf(x)));
                cum += ls * (1.f / 16.f); bl[i] = cum; }
            gs[tq * 128 + d] = cum;
            __syncthreads();
            float off = 0.f, tot = 0.f;
#pragma unroll
            for (int q = 0; q < 4; ++q) { const float g = gs[q * 128 + d]; if (q < tq) off += g; tot += g; }
            unsigned kt[8];
#pragma unroll
            for (int i = 0; i < 16; ++i) { const float bt = off + bl[i]; const int t = tq * 16 + i;
                const float qv = bf2f(bq[t * 136 + d]), kv = bf2f(bk[t * 136 + d]);
                const float eb = __builtin_amdgcn_exp2f(1.4426950408889634f * bt);
                bq[t * 136 + d] = f2bf(qv * 0.08838834764831845f * eb); bk[t * 136 + d] = f2bf(kv * __builtin_amdgcn_rcpf(eb));
                const float kh = kv * __builtin_amdgcn_exp2f(1.4426950408889634f * (tot - bt));
                if (i & 1) kt[i >> 1] |= ((unsigned)f2bf(kh)) << 16; else kt[i >> 1] = f2bf(kh); }
            *(LAS u32x4*)(bkT + d * 72 + tq * 16) = (u32x4){kt[0], kt[1], kt[2], kt[3]}; *(LAS u32x4*)(bkT + d * 72 + tq * 16 + 8) = (u32x4){kt[4], kt[5], kt[6], kt[7]};
            if (tq == 0) gdl[(size_t)u * 128 + d] = __builtin_amdgcn_exp2f(1.4426950408889634f * tot);
        }
        {
            const int e = tid & 255, sg = tid >> 8;
#pragma unroll
            for (int q = 0; q < 4; ++q) { unsigned vt[4];
#pragma unroll
                for (int jj = 0; jj < 8; ++jj) { const bf16_t v = rv[(sg * 32 + q * 8 + jj) * 256 + e]; if (jj & 1) vt[jj >> 1] |= ((unsigned)v) << 16; else vt[jj >> 1] = v; }
                *(LAS u32x4*)(bvT + e * 72 + sg * 32 + q * 8) = (u32x4){vt[0], vt[1], vt[2], vt[3]}; }
        }
        __syncthreads();
        for (int i = tid; i < 1024; i += NTHR) { const int t = i >> 4, ch = i & 15; *(u32x4*)(gqt + (row0 + t) * 512 + h * 128 + ch * 8) = *(const LAS u32x4*)(bq + t * 136 + ch * 8); }
        if (w < 3) { const int tt = w == 0 ? 0 : 1, ss = w == 2 ? 1 : 0; f32x16 acc = {};
#pragma unroll
            for (int ks = 0; ks < 8; ++ks) { const bf16x8 a = *(const LAS bf16x8*)(bq + (tt * 32 + r32) * 136 + ks * 16 + hh * 8), bb = *(const LAS bf16x8*)(bk + (ss * 32 + r32) * 136 + ks * 16 + hh * 8);
                acc = __builtin_amdgcn_mfma_f32_32x32x16_bf16(a, bb, acc, 0, 0, 0); }
#pragma unroll
            for (int i = 0; i < 16; ++i) { const int t = tt * 32 + (i & 3) + 8 * (i >> 2) + 4 * hh, s = ss * 32 + r32; bA[t * 72 + s] = f2bf(t >= s ? acc[i] : 0.f); } }
        else if (w == 3) {
#pragma unroll
            for (int i = 0; i < 16; ++i) { const int t = (i & 3) + 8 * (i >> 2) + 4 * hh; bA[t * 72 + 32 + r32] = 0; } }
        __syncthreads();
        {
            f32x16 o0 = {}, o1 = {}, s0 = {}, s1 = {}, s2 = {}, s3 = {};
#pragma unroll
            for (int ks = 0; ks < 4; ++ks) { const bf16x8 vf = *(const LAS bf16x8*)(bvT + (w * 32 + r32) * 72 + ks * 16 + hh * 8);
                const bf16x8 a0 = *(const LAS bf16x8*)(bA + r32 * 72 + ks * 16 + hh * 8), a1 = *(const LAS bf16x8*)(bA + (32 + r32) * 72 + ks * 16 + hh * 8);
                o0 = __builtin_amdgcn_mfma_f32_32x32x16_bf16(a0, vf, o0, 0, 0, 0); o1 = __builtin_amdgcn_mfma_f32_32x32x16_bf16(a1, vf, o1, 0, 0, 0);
                const bf16x8 k0 = *(const LAS bf16x8*)(bkT + r32 * 72 + ks * 16 + hh * 8), k1 = *(const LAS bf16x8*)(bkT + (32 + r32) * 72 + ks * 16 + hh * 8),
                             k2 = *(const LAS bf16x8*)(bkT + (64 + r32) * 72 + ks * 16 + hh * 8), k3 = *(const LAS bf16x8*)(bkT + (96 + r32) * 72 + ks * 16 + hh * 8);
                s0 = __builtin_amdgcn_mfma_f32_32x32x16_bf16(vf, k0, s0, 0, 0, 0); s1 = __builtin_amdgcn_mfma_f32_32x32x16_bf16(vf, k1, s1, 0, 0, 0);
                s2 = __builtin_amdgcn_mfma_f32_32x32x16_bf16(vf, k2, s2, 0, 0, 0); s3 = __builtin_amdgcn_mfma_f32_32x32x16_bf16(vf, k3, s3, 0, 0, 0); }
#pragma unroll
            for (int i = 0; i < 16; ++i) { const int rr = (i & 3) + 8 * (i >> 2) + 4 * hh;
                ograw[(row0 + rr) * 1024 + h * 256 + w * 32 + r32] = o0[i]; ograw[(row0 + 32 + rr) * 1024 + h * 256 + w * 32 + r32] = o1[i];
                const float p0 = __shfl_xor(s0[i], 1), p1 = __shfl_xor(s1[i], 1), p2 = __shfl_xor(s2[i], 1), p3 = __shfl_xor(s3[i], 1);
                if ((r32 & 1) == 0) { unsigned* dp = (unsigned*)(gds + ((size_t)u * 256 + w * 32 + rr) * 128 + r32);
                    dp[0] = cvt_pk_bf16(s0[i], p0); dp[16] = cvt_pk_bf16(s1[i], p1); dp[32] = cvt_pk_bf16(s2[i], p2); dp[48] = cvt_pk_bf16(s3[i], p3); } }
        }
        __syncthreads();
    }
}
__device__ __forceinline__ void p_gla2(const Frame& F0) {
    const Frame F = phase_frame(F0);
    bf16_t* gds = (bf16_t*)(F.ws + WS_GDS); const float* gdl = (const float*)(F.ws + WS_GDL);
    for (int i = F.c * NTHR + F.tid; i < 32 * 4096; i += F.G * NTHR) {
        const int bh = i >> 12, e = (i >> 4) & 255, dg = i & 15;
        float st[8];
#pragma unroll
        for (int j = 0; j < 8; ++j) st[j] = 0.f;
        for (int c = 0; c < 32; ++c) { const size_t u = (size_t)bh * 32 + c; bf16_t* p = gds + (u * 256 + e) * 128 + dg * 8;
            const u32x4 dsv = *(const u32x4*)p; const f32x4 d0 = *(const f32x4*)(gdl + u * 128 + dg * 8), d1 = *(const f32x4*)(gdl + u * 128 + dg * 8 + 4);
            u32x4 o = {cvt_pk_bf16(st[0], st[1]), cvt_pk_bf16(st[2], st[3]), cvt_pk_bf16(st[4], st[5]), cvt_pk_bf16(st[6], st[7])};
            *(u32x4*)p = o;
            st[0] = d0[0] * st[0] + bf_lo(dsv[0]); st[1] = d0[1] * st[1] + bf_hi(dsv[0]); st[2] = d0[2] * st[2] + bf_lo(dsv[1]); st[3] = d0[3] * st[3] + bf_hi(dsv[1]);
            st[4] = d1[0] * st[4] + bf_lo(dsv[2]); st[5] = d1[1] * st[5] + bf_hi(dsv[2]); st[6] = d1[2] * st[6] + bf_lo(dsv[3]); st[7] = d1[3] * st[7] + bf_hi(dsv[3]); }
    }
}
__device__ __forceinline__ void p_gla3(const Frame& F0, int l) {
    const Frame F = phase_frame(F0);
    const bf16_t* proj = (const bf16_t*)(F.ws + WS_PROJ); const float* ng = F.in(8) + (size_t)l * 256;
    const float* ograw = (const float*)(F.ws + WS_OGRAW); const bf16_t* gds = (const bf16_t*)(F.ws + WS_GDS); const bf16_t* gqt = (const bf16_t*)(F.ws + WS_GQT); bf16_t* og = (bf16_t*)(F.ws + WS_OG);
    LAS float* ot = (LAS float*)F.lds;
    const int lane = F.lane, w = F.wave, r32 = lane & 31, hh = lane >> 5;
    for (int u = F.c; u < 1024; u += F.G) {
        const int c = u & 31, h = (u >> 5) & 3, b = u >> 7; const size_t row0 = (size_t)b * S + c * 64;
        f32x16 o0 = {}, o1 = {};
#pragma unroll
        for (int ks = 0; ks < 8; ++ks) { const bf16x8 sf = *(const bf16x8*)(gds + ((size_t)u * 256 + w * 32 + r32) * 128 + ks * 16 + hh * 8);
            const bf16x8 a0 = *(const bf16x8*)(gqt + (row0 + r32) * 512 + h * 128 + ks * 16 + hh * 8), a1 = *(const bf16x8*)(gqt + (row0 + 32 + r32) * 512 + h * 128 + ks * 16 + hh * 8);
            o0 = __builtin_amdgcn_mfma_f32_32x32x16_bf16(a0, sf, o0, 0, 0, 0); o1 = __builtin_amdgcn_mfma_f32_32x32x16_bf16(a1, sf, o1, 0, 0, 0); }
#pragma unroll
        for (int i = 0; i < 16; ++i) { const int rr = (i & 3) + 8 * (i >> 2) + 4 * hh;
            ot[rr * 260 + w * 32 + r32] = o0[i] + ograw[(row0 + rr) * 1024 + h * 256 + w * 32 + r32];
            ot[(32 + rr) * 260 + w * 32 + r32] = o1[i] + ograw[(row0 + 32 + rr) * 1024 + h * 256 + w * 32 + r32]; }
        __syncthreads();
#pragma unroll
        for (int q = 0; q < 8; ++q) { const int t = w * 8 + q; const f32x4 v = *(const LAS f32x4*)(ot + t * 260 + lane * 4);
            float ss = v[0] * v[0] + v[1] * v[1] + v[2] * v[2] + v[3] * v[3];
#pragma unroll
            for (int o = 32; o > 0; o >>= 1) ss += __shfl_xor(ss, o);
            const float rstd = rsqrtf(ss * (1.f / 256.f) + 1e-6f);
            const f32x4 gn = *(const f32x4*)(ng + lane * 4); const u32x2 gw = *(const u32x2*)(proj + (row0 + t) * LDP + P_GG + h * 256 + lane * 4);
            u32x2 ov; ov[0] = cvt_pk_bf16(v[0] * rstd * gn[0] * fast_silu(bf_lo(gw[0])), v[1] * rstd * gn[1] * fast_silu(bf_hi(gw[0])));
            ov[1] = cvt_pk_bf16(v[2] * rstd * gn[2] * fast_silu(bf_lo(gw[1])), v[3] * rstd * gn[3] * fast_silu(bf_hi(gw[1])));
            *(u32x2*)(og + (row0 + t) * 1024 + h * 256 + lane * 4) = ov; }
        __syncthreads();
    }
}

constexpr size_t WS_CHID = WS_GDL + al256((size_t)1024 * 128 * 4);
constexpr size_t WS_KC   = WS_CHID + al256((size_t)2 * 2048 * 256 * 2);
constexpr size_t WS_VCT  = WS_KC + al256((size_t)16 * 128 * 128 * 2);
constexpr size_t WS_CP   = WS_VCT + al256((size_t)16 * 128 * 128 * 2);
constexpr size_t WS_END5 = WS_CP + al256((size_t)2 * 2048 * 256 * 2);

__device__ __forceinline__ void p_conv_cmp(const Frame& F0) {
    const Frame F = phase_frame(F0);
    const float* pe = F.in(3); const float* w1 = F.in(4); const float* w2 = F.in(5);
    bf16_t* wc2 = (bf16_t*)(F.ws + WS_WC2); float* bias1 = (float*)(F.ws + WS_BIAS1);
    for (int i = F.c * NTHR + F.tid; i < NL * 2 * 256 * 256; i += F.G * NTHR) { const int k = i & 255, n = (i >> 8) & 255, lc = i >> 16;
        wc2[i] = (k < 128 && n < 128) ? f2bf(w2[((size_t)lc * 128 + k) * 128 + n]) : (bf16_t)0; }
    LAS float* part = (LAS float*)F.lds;
    for (int lc = F.c; lc < NL * 2; lc += F.G) { const int o = F.tid & 127, kg = F.tid >> 7; float a = 0.f;
        for (int i = kg * 1024; i < kg * 1024 + 1024; ++i) a += pe[(size_t)lc * 4096 + i] * w1[((size_t)lc * 4096 + i) * 128 + o];
        part[kg * 128 + o] = a; __syncthreads();
        if (F.tid < 256) bias1[lc * 256 + F.tid] = F.tid < 128 ? part[F.tid] + part[128 + F.tid] + part[256 + F.tid] + part[384 + F.tid] : 0.f;
        __syncthreads(); }
}
struct SchedCmp1 {
    static constexpr bool GATHER = true;
    const char* proj; const char* W; int G, c;
    __device__ __forceinline__ bool next(int i, ge::Unit& u) const { const int L = i * G + c; if (L >= 16) return false; const int cc = L >> 3, pm = L & 7;
        u.A = proj + (size_t)(P_NKV + cc * 256) * 2; u.B = W + (size_t)cc * 256 * 2048 * 2; u.r0 = pm * 256; u.c0 = 0; u.aux = cc; u.aux2 = 0; return true; }
    __device__ __forceinline__ void voffA(const ge::Unit& u, int tid, unsigned (&v)[2][2]) const {
#pragma unroll
        for (int i = 0; i < 2; ++i) { int R, C; ge::stage_rc(tid * 16 + i * 8192, R, C);
#pragma unroll
            for (int hf = 0; hf < 2; ++hf) { const int r = u.r0 + hf * 128 + R; const int b = r >> 8, g = (r >> 7) & 1, m = r & 127;
                v[hf][i] = (unsigned)(((b * S + 16 * m) * LDP + g * 128 + C)) * 2u; } } }
};
struct EpiCmp1 {
    static constexpr bool PERM = true; bf16_t* P;
    __device__ __forceinline__ void operator()(const f32x4 (&acc)[2][2][4][2], const ge::Unit& u, int wr, int wc, int fr, int fq) const {
#pragma unroll
        for (int ai = 0; ai < 2; ++ai)
#pragma unroll
            for (int m = 0; m < 4; ++m) { bf16_t* rowp = P + ((size_t)u.aux * 2048 + u.r0 + ai * 128 + wr * 64 + m * 16 + fr) * 256 + wc * 32 + 8 * fq;
#pragma unroll
                for (int bj = 0; bj < 2; ++bj) { const f32x4 v0 = acc[ai][bj][m][0], v1 = acc[ai][bj][m][1]; u32x4 w = {cvt_pk_bf16(v0[0], v0[1]), cvt_pk_bf16(v0[2], v0[3]), cvt_pk_bf16(v1[0], v1[1]), cvt_pk_bf16(v1[2], v1[3])};
                    *(u32x4*)(rowp + bj * 128) = w; } }
    }
};
struct SchedCmp2 {
    static constexpr bool GATHER = false;
    const char* hid; const char* W; int G, c;
    __device__ __forceinline__ bool next(int i, ge::Unit& u) const { const int L = i * G + c; if (L >= 16) return false; const int cc = L >> 3, pm = L & 7;
        u.A = hid + ((size_t)cc * 2048 + pm * 256) * 256 * 2; u.B = W + (size_t)cc * 256 * 256 * 2; u.r0 = pm * 256; u.c0 = 0; u.aux = cc; u.aux2 = 0; return true; }
    __device__ __forceinline__ void voffA(const ge::Unit&, int tid, unsigned (&v)[2][2]) const { ge::dense_voffA(256, tid, v); }
};
struct EpiCmp2 {
    static constexpr bool PERM = false; bf16_t* kc; bf16_t* vct;
    __device__ __forceinline__ void operator()(const f32x4 (&acc)[2][2][4][2], const ge::Unit& u, int wr, int wc, int fr, int fq) const {
#pragma unroll
        for (int ai = 0; ai < 2; ++ai)
#pragma unroll
            for (int m = 0; m < 4; ++m) { const int r = u.r0 + ai * 128 + wr * 64 + m * 16 + fr; const int bg = r >> 7, n = r & 127;
#pragma unroll
                for (int nn = 0; nn < 2; ++nn) { const int d = wc * 32 + nn * 16 + 4 * fq; const f32x4 v = acc[ai][0][m][nn];
                    if (u.aux == 0) { u32x2 w = {cvt_pk_bf16(v[0], v[1]), cvt_pk_bf16(v[2], v[3])}; *(u32x2*)(kc + ((size_t)bg * 128 + n) * 128 + d) = w; }
                    else {
#pragma unroll
                        for (int j = 0; j < 4; ++j) vct[((size_t)bg * 128 + d + j) * 128 + n] = f2bf(v[j]); } } }
    }
};
__device__ __forceinline__ void p_nsa_cmp(const Frame& F0, int l) {
    const Frame F = phase_frame(F0);
    if (F.c >= 16) return;
    { SchedCmp1 S{(const char*)(F.ws + WS_PROJ), (const char*)(F.ws + WS_WC1) + (size_t)l * 2 * 256 * 2048 * 2, F.G, F.c};
      EpiCmp1 E{(bf16_t*)(F.ws + WS_CP)};
      ge::gemm_phase<EpiCmp1, SchedCmp1, 1>(F.lds, F.tid, 2048, LDP * 2, S, E); }
    asm volatile("s_waitcnt vmcnt(0)" ::: "memory"); __syncthreads();
    {
        const bf16_t* P = (const bf16_t*)(F.ws + WS_CP); bf16_t* hid = (bf16_t*)(F.ws + WS_CHID); const float* bias1 = (const float*)(F.ws + WS_BIAS1) + (size_t)l * 2 * 256;
        for (int L = F.c; L < 16; L += F.G) { const int cc = L >> 3, pm = L & 7;
            for (int idx = F.tid; idx < 256 * 16; idx += NTHR) { const int row = idx >> 4, ch = idx & 15; const size_t r = (size_t)cc * 2048 + pm * 256 + row;
                u32x4 w = {0u, 0u, 0u, 0u};
                if ((row & 127) != 127) { const u32x4 a = *(const u32x4*)(P + r * 256 + ch * 8), b = *(const u32x4*)(P + (r + 1) * 256 + 128 + ch * 8);
                    const f32x4 b0 = *(const f32x4*)(bias1 + cc * 256 + ch * 8), b1 = *(const f32x4*)(bias1 + cc * 256 + ch * 8 + 4);
                    w[0] = cvt_pk_bf16(fast_silu(bf_lo(a[0]) + bf_lo(b[0]) + b0[0]), fast_silu(bf_hi(a[0]) + bf_hi(b[0]) + b0[1])); w[1] = cvt_pk_bf16(fast_silu(bf_lo(a[1]) + bf_lo(b[1]) + b0[2]), fast_silu(bf_hi(a[1]) + bf_hi(b[1]) + b0[3]));
                    w[2] = cvt_pk_bf16(fast_silu(bf_lo(a[2]) + bf_lo(b[2]) + b1[0]), fast_silu(bf_hi(a[2]) + bf_hi(b[2]) + b1[1])); w[3] = cvt_pk_bf16(fast_silu(bf_lo(a[3]) + bf_lo(b[3]) + b1[2]), fast_silu(bf_hi(a[3]) + bf_hi(b[3]) + b1[3])); }
                *(u32x4*)(hid + r * 256 + ch * 8) = w; *(u32x4*)(hid + r * 256 + 128 + ch * 8) = (u32x4){0u, 0u, 0u, 0u}; } }
    }
    asm volatile("s_waitcnt vmcnt(0)" ::: "memory"); __syncthreads();
    { SchedCmp2 S{(const char*)(F.ws + WS_CHID), (const char*)(F.ws + WS_WC2) + (size_t)l * 2 * 256 * 256 * 2, F.G, F.c};
      EpiCmp2 E{(bf16_t*)(F.ws + WS_KC), (bf16_t*)(F.ws + WS_VCT)};
      ge::gemm_phase<EpiCmp2, SchedCmp2, 0>(F.lds, F.tid, 256, 0, S, E); }
}

__device__ __forceinline__ void p_nsa_cmpsel(const Frame& F0) {
    const Frame F = phase_frame(F0);
    const bf16_t* proj = (const bf16_t*)(F.ws + WS_PROJ); const bf16_t* kc = (const bf16_t*)(F.ws + WS_KC); const bf16_t* vct = (const bf16_t*)(F.ws + WS_VCT);
    bf16_t* on = (bf16_t*)(F.ws + WS_ON); unsigned* selm = (unsigned*)(F.ws + WS_SELMASK);
    LAS float* gl = (LAS float*)F.lds + F.wave * 32;
    const int lane = F.lane, w = F.wave, r32 = lane & 31, hi = lane >> 5;
    for (int u = F.c; u < NB * 2 * 32; u += F.G) {
        const int pb = u & 31, g = (u >> 5) & 1, b = u >> 6; const int bg = b * 2 + g;
        const int p = pb * 64 + w * 8 + (r32 >> 2), hd = g * 4 + (r32 & 3); const size_t t = (size_t)b * S + p;
        bf16x8 qf[8];
#pragma unroll
        for (int d0 = 0; d0 < 8; ++d0) qf[d0] = *(const bf16x8*)(proj + t * LDP + P_NQ + hd * 128 + d0 * 16 + hi * 8);
        f32x16 sc[4];
#pragma unroll
        for (int kt = 0; kt < 4; ++kt) { sc[kt] = f32x16{};
#pragma unroll
            for (int d0 = 0; d0 < 8; ++d0) { const bf16x8 kf = *(const bf16x8*)(kc + ((size_t)bg * 128 + kt * 32 + r32) * 128 + d0 * 16 + hi * 8);
                sc[kt] = __builtin_amdgcn_mfma_f32_32x32x16_bf16(kf, qf[d0], sc[kt], 0, 0, 0); } }
        const int nmax = p >= 31 ? (p - 31) >> 4 : -1;
        float mx = -1e30f;
#pragma unroll
        for (int kt = 0; kt < 4; ++kt)
#pragma unroll
            for (int i = 0; i < 16; ++i) { const int n = kt * 32 + (i & 3) + 8 * (i >> 2) + 4 * hi; const float s = n <= nmax ? sc[kt][i] * 0.08838834764831845f : -__builtin_inff(); sc[kt][i] = s; mx = fmaxf(mx, s); }
        mx = fmaxf(mx, __shfl_xor(mx, 32));
        float sum = 0.f;
#pragma unroll
        for (int kt = 0; kt < 4; ++kt)
#pragma unroll
            for (int i = 0; i < 16; ++i) { const float e = __expf(sc[kt][i] - mx); sc[kt][i] = e; sum += e; }
        sum += __shfl_xor(sum, 32);
        const float inv = sum > 0.f ? 1.f / sum : 0.f;
#pragma unroll
        for (int kt = 0; kt < 4; ++kt)
#pragma unroll
            for (int i = 0; i < 16; ++i) sc[kt][i] *= inv;
        f32x16 oc[4] = {};
#pragma unroll
        for (int kt = 0; kt < 4; ++kt) { bf16x8 pa0, pa1;
#define PK4(P, B_, OUT) do { unsigned a0 = cvt_pk_bf16(P[B_+0], P[B_+1]), a1 = cvt_pk_bf16(P[B_+2], P[B_+3]); unsigned b0 = cvt_pk_bf16(P[B_+4], P[B_+5]), b1 = cvt_pk_bf16(P[B_+6], P[B_+7]); \
        auto r0 = __builtin_amdgcn_permlane32_swap(a0, b0, false, false); auto r1 = __builtin_amdgcn_permlane32_swap(a1, b1, false, false); u32x4 w_ = {r0[0], r1[0], r0[1], r1[1]}; OUT = *reinterpret_cast<bf16x8*>(&w_); } while (0)
            PK4(sc[kt], 0, pa0); PK4(sc[kt], 8, pa1);
#undef PK4
#pragma unroll
            for (int dt = 0; dt < 4; ++dt) { const bf16x8 v0 = *(const bf16x8*)(vct + ((size_t)bg * 128 + dt * 32 + r32) * 128 + kt * 32 + hi * 8), v1 = *(const bf16x8*)(vct + ((size_t)bg * 128 + dt * 32 + r32) * 128 + kt * 32 + 16 + hi * 8);
                oc[dt] = __builtin_amdgcn_mfma_f32_32x32x16_bf16(pa0, v0, oc[dt], 0, 0, 0); oc[dt] = __builtin_amdgcn_mfma_f32_32x32x16_bf16(pa1, v1, oc[dt], 0, 0, 0); } }
        if (hi == 0) gl[r32] = fast_sigmoid(bf2f(proj[t * LDP + P_NG + hd * 3]));
        asm volatile("s_waitcnt lgkmcnt(0)" ::: "memory");
#pragma unroll
        for (int i = 0; i < 16; ++i) { const int rr = (i & 3) + 8 * (i >> 2) + 4 * hi; const float gt = gl[rr];
            const size_t tt = (size_t)b * S + pb * 64 + w * 8 + (rr >> 2); const int hh = g * 4 + (rr & 3);
#pragma unroll
            for (int dt = 0; dt < 4; ++dt) { const float v = oc[dt][i] * gt, vn = __shfl_xor(v, 1);
                if ((r32 & 1) == 0) *(unsigned*)(on + tt * 1024 + hh * 128 + dt * 32 + r32) = cvt_pk_bf16(v, vn); } }
#pragma unroll
        for (int kt = 0; kt < 4; ++kt)
#pragma unroll
            for (int i = 0; i < 16; ++i) { float v = sc[kt][i]; v += __shfl_xor(v, 1); v += __shfl_xor(v, 2); sc[kt][i] = v; }
        float imp[16];
#pragma unroll
        for (int kt = 0; kt < 4; ++kt)
#pragma unroll
            for (int q = 0; q < 4; ++q) { const float gsum = sc[kt][4 * q] + sc[kt][4 * q + 1] + sc[kt][4 * q + 2] + sc[kt][4 * q + 3];
                const float lastown = sc[kt][4 * q + 3]; const float lastprev = (kt * 4 + q) > 0 ? sc[(kt * 4 + q - 1) >> 2][4 * ((kt * 4 + q - 1) & 3) + 3] : 0.f;
                const float fromp_same = __shfl_xor(lastown, 32), fromp_prev = __shfl_xor(lastprev, 32);
                imp[kt * 4 + q] = gsum + (hi ? fromp_same : fromp_prev); }
        const int cb = p >> 6;
#pragma unroll
        for (int s_ = 0; s_ < 16; ++s_) { const int j = 8 * (s_ >> 2) + 2 * (s_ & 3) + hi; if (j == 0 || j == cb || j == cb - 1) imp[s_] = 1e9f; if (j > cb) imp[s_] = -1e30f; }
        unsigned mask = 0;
#pragma unroll
        for (int k = 0; k < 8; ++k) { float bv = -__builtin_inff(); int bj = 64;
#pragma unroll
            for (int s_ = 0; s_ < 16; ++s_) { const int j = 8 * (s_ >> 2) + 2 * (s_ & 3) + hi; if (imp[s_] > bv) { bv = imp[s_]; bj = j; } }
            const float ov = __shfl_xor(bv, 32); const int oj = __shfl_xor(bj, 32);
            const bool mine = (bv > ov) || (bv == ov && bj < oj); const int wj = mine ? bj : oj;
            mask |= 1u << wj;
#pragma unroll
            for (int s_ = 0; s_ < 16; ++s_) { const int j = 8 * (s_ >> 2) + 2 * (s_ & 3) + hi; if (j == wj) imp[s_] = -__builtin_inff(); } }
        if ((r32 & 3) == 0 && hi == 0) selm[t * 2 + g] = mask;
    }
}
constexpr int NSTEP = 1 + 11 * NL;

template <int l>
__device__ __forceinline__ void layer_steps(const Frame& F, const XcdBarrier& bar, const int lo, const int hi) {
#define IN(k) (lo <= (k) && (k) < hi)
#define SEAM(k) do { if (IN(k) && IN((k) + 1)) xcd_barrier(bar); } while (0)
    const int base = 1 + 11 * l;
    if (IN(base + 0)) { p_inproj(F, l);
#ifdef PROBE_INPROJ
        p_inproj(F, l);
#endif
#ifdef PROBE_INPROJ_LONGK
        p_inproj_longk(F, l);
#endif
#ifdef PROBE_INPROJ_SAME
        p_inproj_same(F, l);
#endif
#ifdef PROBE_INPROJ_NULL
        p_inproj_null(F, l);
#endif
    } SEAM(base + 0);
    if (IN(base + 1)) { p_nsa_cmp(F, l); p_moba_prep(F, F.G > 32 ? 16 : 0); p_gla1(F, l, F.G > 32 ? 16 : 0);
#ifdef PROBE_S1
        p_nsa_cmp(F, l); p_moba_prep(F, 16); p_gla1(F, l, 16);
#endif
#ifdef PROBE_GLA1
        p_gla1(F, l, 16);
#endif
#ifdef PROBE_MOBAPREP
        p_moba_prep(F, 16);
#endif
#ifdef PROBE_NSACMP
        p_nsa_cmp(F, l);
#endif
    } SEAM(base + 1);
    if (IN(base + 2)) { p_moba_attn(F);
#ifdef PROBE_MOBA
        p_moba_attn(F);
#endif
#ifdef PROBE_MOBA512
        p_moba_attn_t<512, true>(F);
#endif
#ifdef PROBE_MOBAFULL
        p_moba_attn_t<(1 << 20), true>(F);
#endif
        p_nsa_cmpsel(F); p_gla2(F); } SEAM(base + 2);
    if (IN(base + 3)) {
#ifndef PROBE_SKIP_NSA
        p_nsa_attn(F);
#endif
        p_gla3(F, l);
#ifdef PROBE_GLA3
        p_gla3(F, l);
#endif
    } SEAM(base + 3);
    if (IN(base + 4)) { p_merge(F, l);
#ifdef PROBE_MERGE
        p_merge(F, l);
#endif
    } SEAM(base + 4);
    if (IN(base + 5)) { p_wout(F, l); } SEAM(base + 5);
    if (IN(base + 6)) { p_route1<MOE_F8 && l == NL - 1>(F, l); p_conv_experts<MOE_F8 && l == NL - 1>(F, l);
#ifdef PROBE_CONVX
        p_conv_experts<MOE_F8 && l == NL - 1>(F, l);
#endif
    } SEAM(base + 6);
    if (IN(base + 7)) { p_route2(F, l); } SEAM(base + 7);
    if (IN(base + 8)) { p_moe_gu<MOE_F8 && l == NL - 1>(F, l);
#ifdef PROBE_GU
        p_moe_gu<MOE_F8 && l == NL - 1>(F, l);
#endif
    } SEAM(base + 8);
    if (IN(base + 9)) { p_moe_down<MOE_F8 && l == NL - 1>(F, l);
#ifdef PROBE_DOWN
        p_moe_down<MOE_F8 && l == NL - 1>(F, l);
#endif
    } SEAM(base + 9);
    if (IN(base + 10)) { if (l + 1 < NL) p_combine<0>(F, l + 1); else p_combine<1>(F, 0); }
    if (l + 1 < NL) SEAM(base + 10);
#undef SEAM
#undef IN
}

__global__ void __launch_bounds__(NTHR, 2) k_fwd(Args args) {
    extern __shared__ __attribute__((aligned(16))) unsigned char lds_raw[];
    Frame F; F.lds = (LAS unsigned char*)lds_raw; F.tid = threadIdx.x; F.lane = F.tid & 63; F.wave = __builtin_amdgcn_readfirstlane(F.tid >> 6);
    F.G = gridDim.x; F.c = blockIdx.x; F.ws = args.ws;
    if (F.tid == 0) {
#pragma unroll
        for (int i = 0; i < 22; ++i) *(LAS unsigned long long*)(F.lds + LDS_ARGS + i * 8) = (unsigned long long)args.in[i];
        *(LAS unsigned long long*)(F.lds + LDS_ARGS + 22 * 8) = (unsigned long long)args.out;
        *(LAS unsigned long long*)(F.lds + LDS_XB) = 0ull; *(LAS unsigned long long*)(F.lds + LDS_XB + 8) = 0ull;
    }
    __syncthreads();
    const int lo = args.ph_lo, hi = args.ph_hi;
    XcdBarrier bar; bar.bar = (unsigned*)(args.ws + WS_CTL) + CW_BAR; bar.x = 0; bar.st = (volatile LAS unsigned*)(F.lds + LDS_XB);
    if (hi - lo > 1) bar = xcd_barrier_post((unsigned*)(args.ws + WS_CTL) + CW_BAR, (volatile LAS unsigned*)(F.lds + LDS_XB));
    if (lo <= 0 && 0 < hi) {
#if INPROJ_F8 == 3
        p_colmax(F); xcd_barrier(bar); p_colscale(F); xcd_barrier(bar);
#endif
        p_conv_static(F); p_conv_router(F); p_conv_cmp(F); p_rmsnorm(F, 0);
#ifdef PROBE_CONV
        p_conv_static(F);
#endif
 if (1 < hi) xcd_barrier(bar); }
    layer_steps<0>(F, bar, lo, hi);
    layer_steps<1>(F, bar, lo, hi);
#ifdef DIAG_MODE
    xcd_barrier(bar);
    if (F.c == 0 && F.tid == 0) args.out[0] = *(LAS float*)(F.lds + LDS_MISC + 4000);
#endif
}

static int g_grid = 0;
extern "C" void kernel_launch(void* const* d_in, const int* in_sizes, int n_in,
                              void* d_out, int out_size, void* d_ws, size_t ws_size,
                              hipStream_t stream) {
    if (g_grid == 0) {
        int dev = 0, cus = 0; (void)hipGetDevice(&dev); (void)hipDeviceGetAttribute(&cus, hipDeviceAttributeMultiprocessorCount, dev);
        (void)hipFuncSetAttribute((const void*)k_fwd, hipFuncAttributeMaxDynamicSharedMemorySize, LDS_BYTES);
        int per_cu = 0; (void)hipOccupancyMaxActiveBlocksPerMultiprocessor(&per_cu, (const void*)k_fwd, NTHR, LDS_BYTES);
        g_grid = (cus > 0 ? cus : 256) * (per_cu >= 1 ? 1 : 1);
    }
    if (ws_size < WS_END5 || ws_size < WS_NEED || WS_END5 > WS_H8) return;
    Args a{}; for (int i = 0; i < 22; ++i) a.in[i] = (const float*)d_in[i];
    a.out = (float*)d_out; a.ws = (unsigned char*)d_ws;
    (void)hipMemsetAsync((unsigned char*)d_ws + WS_CTL, 0, CTL_BYTES, stream);
#if INPROJ_F8 == 3
    (void)hipMemsetAsync((unsigned char*)d_ws + WS_SB, 0, (size_t)NL * LDP * 4, stream);
#endif
#ifdef MULTI_LAUNCH
    for (int s = 0; s < NSTEP; ++s) { a.ph_lo = s; a.ph_hi = s + 1; hipLaunchKernelGGL(k_fwd, dim3(g_grid), dim3(NTHR), LDS_BYTES, stream, a); }
#else
    a.ph_lo = 0; a.ph_hi = NSTEP;
    hipLaunchKernelGGL(k_fwd, dim3(g_grid), dim3(NTHR), LDS_BYTES, stream, a);
#endif
}
```

```cpp
#define INPROJ_F8 3
#include <hip/hip_runtime.h>
#include <hip/hip_bf16.h>
#include <stdint.h>
#include <math.h>

constexpr int D=2048, NB=8, S=2048, T=NB*S, NL=2;
constexpr int INW=14888;
constexpr int O_MQ=0,O_MK=1024,O_MV=2048,O_NQ=3072,O_NKV=4096,O_NG=5632,O_GQ=5656,O_GK=6168,O_GV=6680,O_GA=7704,O_GG=7720,O_MG=8744;
using f32x16 = __attribute__((ext_vector_type(16))) float;
using f32x4  = __attribute__((ext_vector_type(4))) float;
using bf16x8 = __attribute__((ext_vector_type(8))) short;
#define LAS __attribute__((address_space(3)))
typedef unsigned short bf16_t;
typedef unsigned u32x4 __attribute__((ext_vector_type(4)));
typedef unsigned u32x2 __attribute__((ext_vector_type(2)));
typedef float f32x2 __attribute__((ext_vector_type(2)));

__device__ __forceinline__ unsigned cvt_pk_bf16(float lo, float hi) { unsigned r; asm volatile("v_cvt_pk_bf16_f32 %0, %1, %2" : "=v"(r) : "v"(lo), "v"(hi)); return r; }
__device__ __forceinline__ float bf_lo(unsigned w) { return __uint_as_float(w << 16); }
__device__ __forceinline__ float bf_hi(unsigned w) { return __uint_as_float(w & 0xffff0000u); }
__device__ __forceinline__ float bf2f(bf16_t b) { return __uint_as_float(((unsigned)b) << 16); }
__device__ __forceinline__ bf16_t f2bf(float f) { unsigned u = __float_as_uint(f); u += 0x7FFFu + ((u >> 16) & 1u); return (bf16_t)(u >> 16); }
__device__ __forceinline__ float fast_sigmoid(float x) { return __builtin_amdgcn_rcpf(1.f + __builtin_amdgcn_exp2f(-1.4426950408889634f * x)); }
__device__ __forceinline__ float fast_silu(float x) { return x * fast_sigmoid(x); }

#ifndef GE_SP2_DEFAULT
#define GE_SP2_DEFAULT true
#endif
#ifndef GE_ALIGN_DEFAULT
#define GE_ALIGN_DEFAULT true
#endif
namespace ge {
constexpr int BM = 256, BK = 64, HALF = 128, HTB = HALF * BK * 2, STAGE_BYTES = 8 * HTB, NXCD = 8, WGM = 4;
__host__ __device__ __forceinline__ int lds_byte(int r, int c) { const int st = (r >> 4) * 2 + (c >> 5), rr = r & 15, cc = c & 31, ob = rr * 64 + cc * 2; return st * 1024 + (ob ^ (((ob >> 9) & 1) << 5)); }
__host__ __device__ __forceinline__ void stage_rc(int b, int& R, int& C) { const int st = b / 1024, sb = b % 1024, swz = sb ^ (((sb >> 9) & 1) << 5); R = (st >> 1) * 16 + swz / 64; C = (st & 1) * 32 + (swz % 64) / 2; }
__host__ __device__ __forceinline__ int perm32(int rho) { const int n = rho >> 4, i = rho & 15; return 8 * (i >> 2) + 4 * n + (i & 3); }

typedef int i32x8 __attribute__((ext_vector_type(8)));
typedef int i32x4 __attribute__((ext_vector_type(4)));
__device__ __forceinline__ i32x8 cat8(bf16x8 a, bf16x8 b) { const i32x4 x = *reinterpret_cast<i32x4*>(&a), y = *reinterpret_cast<i32x4*>(&b); return (i32x8){x[0], x[1], x[2], x[3], y[0], y[1], y[2], y[3]}; }
constexpr int F8_SCALE_A = 0x7B7B7B7B, F8_SCALE_B = 0x76767676;
struct Unit { const char* A; const char* B; int r0; int c0; int aux; int aux2; };

__device__ __forceinline__ bool static_tile(int i, int G, int c, int nM, int nN, int& pm, int& pn) {
    const int nwg = nM * nN; const long L = (long)i * G + c; if (L >= nwg) return false;
    int wgid = (int)L; { const int q = nwg / NXCD, r = nwg % NXCD, xcd = wgid % NXCD, off = wgid / NXCD; wgid = (xcd < r ? xcd * (q + 1) : r * (q + 1) + (xcd - r) * q) + off; }
    const int nig = WGM * nN, gid = wgid / nig, fm = gid * WGM, gsz = (nM - fm) < WGM ? (nM - fm) : WGM;
    pm = fm + ((wgid % nig) % gsz); pn = (wgid % nig) / gsz; return true;
}

template <class S, class = void> struct sched_waits { static constexpr bool value = false; };
template <class E, class = void> struct epi_inplace { static constexpr bool value = false; };
template <class E> struct epi_inplace<E, decltype((void)E::INPLACE)> { static constexpr bool value = true; };
template <class S> struct sched_waits<S, decltype((void)S::WAITS)> { static constexpr bool value = true; };
template <class Epi, class Sched, int KMODE, bool F8 = false, bool SP2 = GE_SP2_DEFAULT, bool ALIGN_EPI = GE_ALIGN_DEFAULT, int SCALE_A = F8_SCALE_A, bool I8 = false>
__device__ __forceinline__ void gemm_phase(LAS unsigned char* lds, const int tid_in, const int K, const int kbig, const Sched& S, const Epi& E, const int ldb_ = 0) {
    const int KB_ = ldb_ ? ldb_ : K;
    int tid_ = tid_in; asm volatile("" : "+v"(tid_));
    const int tid = tid_, wid = __builtin_amdgcn_readfirstlane(tid >> 6), lane = tid & 63, wr = wid >> 2, wc = wid & 3, fr = lane & 15, fq = lane >> 4;
    constexpr bool BYTE = F8 || I8;
    const int nt = BYTE ? K / 128 : K / BK;
    unsigned voffB[2];
#pragma unroll
    for (int i = 0; i < 2; ++i) { int R, C; stage_rc(tid * 16 + i * 8192, R, C); const int Rb = Epi::PERM ? ((R & ~31) + perm32(R & 31)) : R; voffB[i] = BYTE ? (unsigned)(Rb * KB_ + C * 2) : (unsigned)(Rb * KB_ + C) * 2u; }
    const size_t hstepB = BYTE ? (size_t)HALF * KB_ : (size_t)HALF * KB_ * 2;
    const unsigned ldsw = (unsigned)wid * 1024u;
    const int aoff = F8 ? lds_byte(wr * 64 + fr, fq * 16) : lds_byte(wr * 64 + fr, fq * 8), boff = F8 ? lds_byte(wc * 32 + fr, fq * 16) : lds_byte(wc * 32 + fr, fq * 8);
    const int aoff1 = F8 ? lds_byte(wr * 64 + fr, fq * 16 + 8) - aoff : 1024, boff1 = F8 ? lds_byte(wc * 32 + fr, fq * 16 + 8) - boff : 1024;
#define GE_KOFF(t) (KMODE == 0 ? (size_t)(t) * 128 : (size_t)((t) >> 1) * (size_t)kbig + (size_t)((t) & 1) * 128)
#define GE_SA(b, h) (((b) * 2 + (h)) * HTB)
#define GE_SB(b, h) ((4 + (b) * 2 + (h)) * HTB)
#define GE_STAGE_B(bufoff, gbase) do { _Pragma("unroll") for (int _i = 0; _i < 2; ++_i) \
        __builtin_amdgcn_global_load_lds((const unsigned*)((const char*)(gbase) + voffB[_i]), (LAS unsigned*)(lds + (bufoff) + ldsw + _i * 8192), 16, 0, 0); } while (0)
#define GE_STAGE_A(bufoff, gbase, v0, v1) do { \
        __builtin_amdgcn_global_load_lds((const unsigned*)((const char*)(gbase) + (v0)), (LAS unsigned*)(lds + (bufoff) + ldsw), 16, 0, 0); \
        __builtin_amdgcn_global_load_lds((const unsigned*)((const char*)(gbase) + (v1)), (LAS unsigned*)(lds + (bufoff) + ldsw + 8192), 16, 0, 0); } while (0)
#define GE_LDA(dst, b, h) do { _Pragma("unroll") for (int m = 0; m < 4; ++m) _Pragma("unroll") for (int k = 0; k < 2; ++k) dst[m][k] = *(const LAS bf16x8*)(lds + GE_SA(b, h) + aoff + m * 2048 + k * aoff1); } while (0)
#define GE_LDB(dst, b, h) do { _Pragma("unroll") for (int n = 0; n < 2; ++n) _Pragma("unroll") for (int k = 0; k < 2; ++k) dst[n][k] = *(const LAS bf16x8*)(lds + GE_SB(b, h) + boff + n * 2048 + k * boff1); } while (0)
#define GE_MMA(ai, bj, At, Bt) do { __builtin_amdgcn_s_setprio(1); _Pragma("unroll") for (int m = 0; m < 4; ++m) _Pragma("unroll") for (int n = 0; n < 2; ++n) { \
        if constexpr (F8) { const i32x8 b8_ = ge::cat8(Bt[n][0], Bt[n][1]), a8_ = ge::cat8(At[m][0], At[m][1]); \
              \
            asm volatile("v_mfma_scale_f32_16x16x128_f8f6f4 %0, %1, %2, %0, %3, %4 op_sel_hi:[0,0,0]" : "+v"(acc[ai][bj][m][n]) : "v"(b8_), "v"(a8_), "v"(f8sb), "v"(f8sa)); } \
        else if constexpr (I8) { ge::i32x4 ci_ = __builtin_bit_cast(ge::i32x4, acc[ai][bj][m][n]); \
            _Pragma("unroll") for (int k = 0; k < 2; ++k) ci_ = __builtin_amdgcn_mfma_i32_16x16x64_i8(__builtin_bit_cast(ge::i32x4, Bt[n][k]), __builtin_bit_cast(ge::i32x4, At[m][k]), ci_, 0, 0, 0); \
            acc[ai][bj][m][n] = __builtin_bit_cast(f32x4, ci_); } \
        else { _Pragma("unroll") for (int k = 0; k < 2; ++k) acc[ai][bj][m][n] = __builtin_amdgcn_mfma_f32_16x16x32_bf16(Bt[n][k], At[m][k], acc[ai][bj][m][n], 0, 0, 0); } } \
        if constexpr (F8) asm volatile("s_nop 7" ::: "memory"); \
        __builtin_amdgcn_s_setprio(0); } while (0)
#define GE_WAIT_V(n) asm volatile("s_waitcnt vmcnt(" #n ")" ::: "memory")
#define GE_WAIT_L(n) asm volatile("s_waitcnt lgkmcnt(" #n ")" ::: "memory")
#define GE_BAR __builtin_amdgcn_s_barrier()
#define GE_SCHED __builtin_amdgcn_sched_barrier(0)
    Unit cur, nxt; int ui = 0;
    if (!S.next(0, cur)) return;
    int f8sa = SCALE_A, f8sb = F8_SCALE_B; if constexpr (F8) asm volatile("" : "+v"(f8sa), "+v"(f8sb));
    f32x4 acc[2][2][4][2];
#pragma unroll
    for (int a = 0; a < 2; ++a)
#pragma unroll
        for (int b = 0; b < 2; ++b)
#pragma unroll
            for (int m = 0; m < 4; ++m)
#pragma unroll
                for (int n = 0; n < 2; ++n) acc[a][b][m][n] = (f32x4){0.f, 0.f, 0.f, 0.f};
    bf16x8 At[4][2], B0[2][2], B1[2][2];
    unsigned va[2][2], vn[2][2];
    S.voffA(cur, tid, va);
    const char* cA = cur.A; const char* cB = cur.B;
    if constexpr (sched_waits<Sched>::value) S.a_ready(cur);
    if constexpr (SP2) {
        GE_STAGE_B(GE_SB(0, 0), cB); GE_STAGE_B(GE_SB(0, 1), cB + hstepB); GE_STAGE_A(GE_SA(0, 0), cA, va[0][0], va[0][1]); GE_STAGE_A(GE_SA(0, 1), cA, va[1][0], va[1][1]);
        if (wr == 1) GE_BAR;
        GE_WAIT_V(2); GE_BAR;
        GE_STAGE_B(GE_SB(1, 0), cB + 128); GE_STAGE_A(GE_SA(1, 0), cA + GE_KOFF(1), va[0][0], va[0][1]); GE_STAGE_B(GE_SB(1, 1), cB + hstepB + 128);
        GE_WAIT_V(6); GE_BAR;
    } else {
    GE_STAGE_B(GE_SB(0, 0), cB); GE_STAGE_A(GE_SA(0, 0), cA, va[0][0], va[0][1]); GE_STAGE_B(GE_SB(0, 1), cB + hstepB); GE_STAGE_A(GE_SA(0, 1), cA, va[1][0], va[1][1]);
    if (wr == 1) GE_BAR;
    GE_WAIT_V(4); GE_BAR;
    GE_STAGE_B(GE_SB(1, 0), cB + 128); GE_STAGE_A(GE_SA(1, 0), cA + GE_KOFF(1), va[0][0], va[0][1]); GE_STAGE_B(GE_SB(1, 1), cB + hstepB + 128);
    GE_WAIT_V(6); GE_BAR;
    }
    for (;;) {
        const bool has_next = S.next(ui + 1, nxt);
        if constexpr (Sched::GATHER) { if (has_next) S.voffA(nxt, tid, vn); else { vn[0][0] = va[0][0]; vn[0][1] = va[0][1]; vn[1][0] = va[1][0]; vn[1][1] = va[1][1]; } }
        const char* nA = has_next ? nxt.A : cA; const char* nB = has_next ? nxt.B : cB;
        for (int t = 0; t < nt; t += 2) {
            const bool last = (t == nt - 2);
            const char* a1 = cA + GE_KOFF(t + 1);
            const char* a2 = last ? nA : cA + GE_KOFF(t + 2); const char* b2 = last ? nB : cB + (size_t)(t + 2) * 128;
            const char* a3 = last ? nA + GE_KOFF(1) : cA + GE_KOFF(t + 3); const char* b3 = b2 + 128;
            unsigned w00 = va[0][0], w01 = va[0][1], w10 = va[1][0], w11 = va[1][1];
            if constexpr (Sched::GATHER) { if (last) { w00 = vn[0][0]; w01 = vn[0][1]; w10 = vn[1][0]; w11 = vn[1][1]; } }
            if constexpr (sched_waits<Sched>::value) { if (last && has_next) S.a_ready(nxt); }
            if constexpr (SP2) {
            GE_LDB(B0, 0, 0); GE_LDB(B1, 0, 1); GE_SCHED; GE_LDA(At, 0, 0); GE_STAGE_A(GE_SA(1, 1), a1, va[1][0], va[1][1]);
            GE_WAIT_V(8); GE_WAIT_L(0); GE_BAR; GE_MMA(0, 0, At, B0); GE_MMA(0, 1, At, B1); GE_BAR; GE_SCHED;
            GE_LDA(At, 0, 1); GE_STAGE_B(GE_SB(0, 0), b2); GE_STAGE_B(GE_SB(0, 1), b2 + hstepB); GE_STAGE_A(GE_SA(0, 0), a2, w00, w01);
            GE_WAIT_V(8); GE_WAIT_L(0); GE_BAR; GE_MMA(1, 0, At, B0); GE_MMA(1, 1, At, B1); GE_BAR; GE_SCHED;
            GE_LDB(B0, 1, 0); GE_LDB(B1, 1, 1); GE_SCHED; GE_LDA(At, 1, 0); GE_STAGE_A(GE_SA(0, 1), a2, w10, w11);
            GE_WAIT_V(8); GE_WAIT_L(0); GE_BAR; GE_MMA(0, 0, At, B0); GE_MMA(0, 1, At, B1); GE_BAR; GE_SCHED;
            GE_LDA(At, 1, 1); GE_STAGE_B(GE_SB(1, 0), b3); GE_STAGE_B(GE_SB(1, 1), b3 + hstepB); GE_STAGE_A(GE_SA(1, 0), a3, w00, w01);
            GE_WAIT_V(8); GE_WAIT_L(0); GE_BAR; GE_MMA(1, 0, At, B0); GE_MMA(1, 1, At, B1); GE_BAR; GE_SCHED;
            } else {
            GE_LDB(B0, 0, 0); GE_SCHED; GE_LDA(At, 0, 0); GE_STAGE_A(GE_SA(1, 1), a1, va[1][0], va[1][1]);
            GE_WAIT_L(8); GE_BAR; GE_WAIT_L(0); GE_MMA(0, 0, At, B0); GE_BAR; GE_SCHED;
            GE_LDB(B1, 0, 1); GE_STAGE_B(GE_SB(0, 0), b2);
            GE_BAR; GE_WAIT_L(0); GE_MMA(0, 1, At, B1); GE_BAR;
            GE_LDA(At, 0, 1); GE_STAGE_A(GE_SA(0, 0), a2, w00, w01);
            GE_BAR; GE_WAIT_L(0); GE_MMA(1, 0, At, B0); GE_BAR; GE_SCHED;
            GE_STAGE_B(GE_SB(0, 1), b2 + hstepB);
            GE_WAIT_V(6); GE_BAR; GE_MMA(1, 1, At, B1); GE_BAR;
            GE_LDB(B0, 1, 0); GE_SCHED; GE_LDA(At, 1, 0); GE_STAGE_A(GE_SA(0, 1), a2, w10, w11);
            GE_WAIT_L(8); GE_BAR; GE_WAIT_L(0); GE_MMA(0, 0, At, B0); GE_BAR; GE_SCHED;
            GE_LDB(B1, 1, 1); GE_STAGE_B(GE_SB(1, 0), b3);
            GE_BAR; GE_WAIT_L(0); GE_MMA(0, 1, At, B1); GE_BAR;
            GE_LDA(At, 1, 1); GE_STAGE_A(GE_SA(1, 0), a3, w00, w01);
            GE_BAR; GE_WAIT_L(0); GE_MMA(1, 0, At, B0); GE_BAR; GE_SCHED;
            GE_STAGE_B(GE_SB(1, 1), b3 + hstepB);
            GE_WAIT_V(6); GE_BAR; GE_MMA(1, 1, At, B1); GE_BAR;
            }
        }
        if constexpr (ALIGN_EPI) { if (wr == 0) GE_BAR; }
        if constexpr (I8) {
#pragma unroll
            for (int a = 0; a < 2; ++a)
#pragma unroll
                for (int b = 0; b < 2; ++b)
#pragma unroll
                    for (int m = 0; m < 4; ++m)
#pragma unroll
                        for (int n = 0; n < 2; ++n) { const ge::i32x4 ci_ = __builtin_bit_cast(ge::i32x4, acc[a][b][m][n]); acc[a][b][m][n] = (f32x4){(float)ci_[0], (float)ci_[1], (float)ci_[2], (float)ci_[3]}; } }
        bool keep_acc = false;
        if constexpr (epi_inplace<Epi>::value) keep_acc = E.inplace(acc, cur, wr, wc, fr, fq); else E(acc, cur, wr, wc, fr, fq);
        if (!has_next) break;
        if (!keep_acc) {
#pragma unroll
        for (int a = 0; a < 2; ++a)
#pragma unroll
            for (int b = 0; b < 2; ++b)
#pragma unroll
                for (int m = 0; m < 4; ++m)
#pragma unroll
                    for (int n = 0; n < 2; ++n) acc[a][b][m][n] = (f32x4){0.f, 0.f, 0.f, 0.f};
        }
        cur = nxt; cA = nA; cB = nB; ++ui;
        if constexpr (Sched::GATHER) { va[0][0] = vn[0][0]; va[0][1] = vn[0][1]; va[1][0] = vn[1][0]; va[1][1] = vn[1][1]; }
        if constexpr (ALIGN_EPI) { if (wr == 1) GE_BAR; }
    }
    GE_WAIT_V(0);
    if constexpr (!ALIGN_EPI) { if (wr == 0) GE_BAR; }
    GE_BAR;
#undef GE_KOFF
#undef GE_SA
#undef GE_SB
#undef GE_STAGE_A
#undef GE_STAGE_B
#undef GE_LDA
#undef GE_LDB
#undef GE_MMA
#undef GE_WAIT_V
#undef GE_WAIT_L
#undef GE_BAR
#undef GE_SCHED
}

template <bool F8 = false>
__device__ __forceinline__ void dense_voffA(int lda, int tid, unsigned (&v)[2][2]) {
#pragma unroll
    for (int i = 0; i < 2; ++i) { int R, C; stage_rc(tid * 16 + i * 8192, R, C); v[0][i] = F8 ? (unsigned)(R * lda + C * 2) : (unsigned)(R * lda + C) * 2u; v[1][i] = F8 ? (unsigned)((R + HALF) * lda + C * 2) : (unsigned)((R + HALF) * lda + C) * 2u; }
}
}
#define XB_TMO      128
#define XB_XCNT(j)  (256  + 64 * (j))
#define XB_XSUB(j)  (1280 + 64 * (j))
#define XB_XGEN(j)  (2304 + 64 * (j))
#define XB_TOP      3328
#define XB_TOPGEN   3392
#define XCD_BAR_WORDS 3456
#define XB_SPIN_CAP (1u << 18)

__device__ __forceinline__ unsigned xb_ld(unsigned* p)              { return __hip_atomic_load(p, __ATOMIC_RELAXED, __HIP_MEMORY_SCOPE_AGENT); }
__device__ __forceinline__ unsigned xb_add(unsigned* p, unsigned v) { return __hip_atomic_fetch_add(p, v, __ATOMIC_RELAXED, __HIP_MEMORY_SCOPE_AGENT); }
__device__ __forceinline__ unsigned xb_xcc_id() { return (unsigned)__builtin_amdgcn_s_getreg((3 << 11) | 20) & 0xFu; }
#define XB_SPIN(cond, bar) do { unsigned _sp = 0; while (cond) { __builtin_amdgcn_s_sleep(1); \
    if ((++_sp & 255u) == 0u) { if (xb_ld(&(bar)[XB_TMO])) break; if (_sp > XB_SPIN_CAP) { atomicAdd(&(bar)[XB_TMO], 1u); break; } } } } while (0)

struct XcdBarrier {
    unsigned* bar; unsigned x;
    volatile LAS unsigned* st;
};

__device__ __forceinline__ XcdBarrier xcd_barrier_post(unsigned* bar, volatile LAS unsigned* st) {
    XcdBarrier b; b.bar = bar; b.x = xb_xcc_id(); b.st = st;
    if (threadIdx.x == 0) (void)xb_add(&bar[XB_XCNT(b.x)], 1u);
    return b;
}
__device__ __forceinline__ void xcd_barrier_complete(unsigned* bar, unsigned x, unsigned& nloc, unsigned& nx) {
    const unsigned G = gridDim.x * gridDim.y * gridDim.z;
    unsigned sum, cnt, mine, sp = 0u;
    for (;;) {
        sum = 0u; cnt = 0u; mine = 0u;
#pragma unroll
        for (unsigned j = 0; j < 16; ++j) { const unsigned c = xb_ld(&bar[XB_XCNT(j)]); sum += c; cnt += (c > 0u) ? 1u : 0u; mine = (j == x) ? c : mine; }
        if (sum == G) break;
        __builtin_amdgcn_s_sleep(1);
        if ((++sp & 255u) == 0u) { if (xb_ld(&bar[XB_TMO])) break; if (sp > XB_SPIN_CAP) { atomicAdd(&bar[XB_TMO], 1u); break; } }
    }
    nloc = mine > 0u ? mine : 1u; nx = cnt > 0u ? cnt : 1u;
}

__device__ __forceinline__ void xcd_barrier(const XcdBarrier& b) {
    asm volatile("s_waitcnt vmcnt(0)" ::: "memory");
    __syncthreads();
    if (threadIdx.x == 0) {
        unsigned* bar = b.bar;
        __builtin_amdgcn_s_waitcnt(0);
        unsigned nloc = b.st[0], nx = b.st[1];
        if (nloc == 0u) { xcd_barrier_complete(bar, b.x, nloc, nx); b.st[0] = nloc; b.st[1] = nx; }
        const unsigned old = xb_add(&bar[XB_XSUB(b.x)], 1u);
        const unsigned gen = old / nloc;
        if (old + 1u == (gen + 1u) * nloc) {
            __builtin_amdgcn_fence(__ATOMIC_RELEASE, "agent");
            asm volatile("s_waitcnt vmcnt(0)" ::: "memory");
            const unsigned og = xb_add(&bar[XB_TOP], 1u);
            const unsigned tg = og / nx;
            if (og + 1u == (tg + 1u) * nx) xb_add(&bar[XB_TOPGEN], 1u);
            else XB_SPIN(xb_ld(&bar[XB_TOPGEN]) == tg, bar);
            __builtin_amdgcn_fence(__ATOMIC_ACQUIRE, "agent");
            xb_add(&bar[XB_XGEN(b.x)], 1u);
            asm volatile("s_waitcnt vmcnt(0)" ::: "memory");
        } else {
            XB_SPIN(xb_ld(&bar[XB_XGEN(b.x)]) == gen, bar);
            __builtin_amdgcn_fence(__ATOMIC_ACQUIRE, "agent");
            asm volatile("s_waitcnt vmcnt(0)" ::: "memory");
        }
    }
    __syncthreads();
}

constexpr int LDP = 15104;
constexpr int P_MQ=0,P_MK=1024,P_MV=2048,P_NQ=3072,P_NKV=4096,P_GQ=5632,P_GK=6144,P_GV=6656,P_GG=7680,P_MG=8704,P_NG=14848,P_GA=14872;
constexpr int NTHR = 512;
#ifndef MOE_F8_FROM
#define MOE_F8_FROM 0
#endif
#ifndef Y_F8
#define Y_F8 1
#endif
#ifndef WOUT_F8
#define WOUT_F8 1
#endif
#ifndef MOE_F8
#define MOE_F8 1
#endif
#ifndef INPROJ_F8
#define INPROJ_F8 2
#endif
constexpr int LDS_BYTES = 147456;
constexpr int MOE_ROWS = 40960;
constexpr int MOE_TILES = MOE_ROWS / 256;

constexpr size_t al256(size_t x) { return (x + 255) & ~(size_t)255; }
constexpr size_t WS_CTL   = 0;
constexpr size_t CTL_BYTES = 65536 + 131072;
constexpr size_t WS_WIN   = WS_CTL + CTL_BYTES;
constexpr size_t WS_WBR   = WS_WIN + al256((size_t)NL * LDP * 2048 * 2);
constexpr size_t WS_WOUT  = WS_WBR + al256((size_t)NL * 3 * 2048 * 1024 * 2);
constexpr size_t WS_WC1   = WS_WOUT + al256((size_t)NL * 2048 * 2048 * 2);
constexpr size_t WS_WC2   = WS_WC1 + al256((size_t)NL * 2 * 256 * 4096 * 2);
constexpr size_t WS_BIAS1 = WS_WC2 + al256((size_t)NL * 2 * 256 * 256 * 2);
constexpr size_t WS_WGU   = WS_BIAS1 + al256((size_t)NL * 2 * 256 * 4);
constexpr size_t WS_WD    = WS_WGU + al256((size_t)32 * 1024 * 2048 * 2);
constexpr size_t WS_H     = WS_WD + al256((size_t)32 * 2048 * 512 * 2);
constexpr size_t WS_PROJ  = WS_H + al256((size_t)T * 2048 * 2);
constexpr size_t WS_OM    = WS_PROJ + al256((size_t)T * LDP * 2);
constexpr size_t WS_ON    = WS_OM + al256((size_t)T * 1024 * 2);
constexpr size_t WS_OG    = WS_ON + al256((size_t)T * 1024 * 2);
constexpr size_t WS_MERGED= WS_OG + al256((size_t)T * 1024 * 2);
constexpr size_t WS_MISC  = WS_MERGED + al256((size_t)T * 2048 * 2);
constexpr size_t WS_KMEAN = WS_MISC;
constexpr size_t WS_KVC   = WS_KMEAN + al256((size_t)NB * 8 * 8 * 128 * 4);
constexpr size_t WS_DEC   = WS_KVC + al256((size_t)NB * 127 * 4 * 128 * 4);
constexpr size_t WS_OGRAW = WS_H;
constexpr size_t WS_ROUTE = WS_DEC + al256((size_t)T * 512 * 4);
constexpr size_t WS_ROWTOK= WS_ROUTE + al256((size_t)T * 8 * 4);
constexpr size_t WS_ROWW  = WS_ROWTOK + al256((size_t)MOE_ROWS * 4);
constexpr size_t WS_TILEE = WS_ROWW + al256((size_t)MOE_ROWS * 4);
constexpr size_t WS_END_SMALL = WS_TILEE + al256((size_t)(MOE_TILES + 64) * 4);
constexpr size_t WS_HID   = WS_PROJ;
constexpr size_t WS_YBUF  = WS_HID + al256((size_t)MOE_ROWS * 512 * 2);
static_assert(WS_YBUF + (size_t)MOE_ROWS * 2048 * 2 <= WS_OM, "MoE buffers must fit in the PROJ region");
constexpr size_t WS_TOTAL = WS_END_SMALL;

constexpr int CW_BAR = 0;
constexpr int CW_CNT = 4096;
constexpr int CW_CUR = 4096 + 64;
constexpr int CW_MISC = 4096 + 128;
constexpr int CMP_WGS = 64;
constexpr int CW_CMPF = 8192;
constexpr int CW_GQ = 8192 + 64 * 32;
constexpr int CW_PANEL = 8192 + 64 * 34;

constexpr size_t WS_H8 = (size_t)1114 * 1024 * 1024;
constexpr size_t WS_SA = WS_H8 + (size_t)T * 2048;
constexpr size_t WS_SB = WS_CTL + 65536;
constexpr size_t WS_XB = WS_SA + al256((size_t)T * 4);
constexpr int MOE_CAP = T;
constexpr size_t WS_LIST = WS_XB + (size_t)T * 2048 * 2;
constexpr size_t WS_LISTW = WS_LIST + (size_t)32 * MOE_CAP * 4;
constexpr size_t WS_NEED = WS_LISTW + (size_t)32 * MOE_CAP * 4;
static_assert((size_t)NL * 15104 * 4 <= 131072, "column absmax table must fit the control region");
__host__ __device__ __forceinline__ int inproj_src(int n) {
    if (n < 5632) return n; if (n < 7680) return n + 24; if (n < 14848) return n + 40; if (n < 14872) return O_NG + (n - 14848); if (n < 14888) return O_GA + (n - 14872); return -1; }
#ifndef MIX_SET
#define MIX_SET 0
#endif
#if MIX_SET == 0
constexpr int NT16 = 24, NT8 = 35;
__host__ __device__ __forceinline__ int tile16(int p) { return p < 8 ? p : p < 12 ? p + 4 : p == 12 ? 16 : p == 13 ? 18 : p == 14 ? 20 : p < 19 ? p + 7 : p < 23 ? p + 11 : 58; }
__host__ __device__ __forceinline__ int tile8(int p) { return p < 4 ? p + 8 : p == 4 ? 17 : p == 5 ? 19 : p == 6 ? 21 : p < 11 ? p + 19 : p + 23; }
#else
constexpr int NT16 = 35, NT8 = 24;
__host__ __device__ __forceinline__ int tile16(int p) { return p < 34 ? p : 58; }
__host__ __device__ __forceinline__ int tile8(int p) { return p + 34; }
#endif
struct Args { const float* in[22]; float* out; unsigned char* ws; int ph_lo, ph_hi; };
constexpr int LDS_ARGS = 131072;
constexpr int LDS_XB = LDS_ARGS + 256;
constexpr int LDS_MISC = LDS_ARGS + 512;
constexpr int LDS_GTAB = LDS_MISC + 10240;

struct Frame {
    LAS unsigned char* lds; int tid, lane, wave, G, c;
    unsigned char* ws;
    __device__ __forceinline__ const float* in(int k) const { const unsigned long long v = *(const volatile LAS unsigned long long*)(lds + LDS_ARGS + k * 8); return (const float*)(const __attribute__((address_space(1))) float*)(((unsigned long long)__builtin_amdgcn_readfirstlane((unsigned)(v >> 32)) << 32) | (unsigned)__builtin_amdgcn_readfirstlane((unsigned)v)); }
    __device__ __forceinline__ float* out() const { return (float*)in(22); }
};
template <class P> __device__ __forceinline__ P* opaque_ptr(P* p) {
    const unsigned long long v = (unsigned long long)p; unsigned lo = __builtin_amdgcn_readfirstlane((unsigned)v), hi = __builtin_amdgcn_readfirstlane((unsigned)(v >> 32));
    asm volatile("" : "+s"(lo), "+s"(hi)); return (P*)(__attribute__((address_space(1))) P*)(((unsigned long long)hi << 32) | lo);
}
__device__ __forceinline__ Frame phase_frame(const Frame& F0) {
    __syncthreads();
    Frame F = F0; F.ws = opaque_ptr(F0.ws);
    int t; asm volatile("v_mbcnt_lo_u32_b32 %0, -1, 0\n\tv_mbcnt_hi_u32_b32 %0, -1, %0" : "=v"(t)); t += F0.wave * 64; asm volatile("" : "+v"(t));
    F.tid = t; F.lane = t & 63; F.wave = __builtin_amdgcn_readfirstlane(t >> 6); return F;
}

__device__ __forceinline__ float clamp_fp8(float v) { return __builtin_amdgcn_fmed3f(v, -448.f, 448.f); }
__device__ __forceinline__ unsigned pack_fp8x4(float a, float b, float c, float d) { int w = __builtin_amdgcn_cvt_pk_fp8_f32(clamp_fp8(a), clamp_fp8(b), 0, false); w = __builtin_amdgcn_cvt_pk_fp8_f32(clamp_fp8(c), clamp_fp8(d), w, true); return (unsigned)w; }
__device__ __forceinline__ unsigned pack_i8x4(float a, float b, float c, float d) {
    const int ia = (int)rintf(__builtin_amdgcn_fmed3f(a, -127.f, 127.f)), ib = (int)rintf(__builtin_amdgcn_fmed3f(b, -127.f, 127.f)), ic = (int)rintf(__builtin_amdgcn_fmed3f(c, -127.f, 127.f)), id = (int)rintf(__builtin_amdgcn_fmed3f(d, -127.f, 127.f));
    return (unsigned)(ia & 255) | ((unsigned)(ib & 255) << 8) | ((unsigned)(ic & 255) << 16) | ((unsigned)(id & 255) << 24); }
template <bool F8, class Fn>
__device__ __forceinline__ void conv_t(const Frame& F, Fn colsrc, int ld, int K, int N, void* dstv, float scale = 1.f, const float* rowinv = nullptr  , int wg0 = 0, int t_lo = 0, int t_hi = -1) {
    const int ntn = N / 256, ntk = K / 64, tot = t_hi < 0 ? ntn * ntk : t_hi;
    if (F.c < wg0) return;
    const int n4 = ((F.tid >> 6) * 8 + (F.tid & 7)) * 4, kc = (F.tid >> 3) & 7;
    f32x4 va[8], vb[8];
#define CONV_LOAD(v, ti_) do { const int tn_ = (ti_) % ntn, tk_ = (ti_) / ntn; const float* sp_ = colsrc(tn_ * 256 + n4); \
        _Pragma("unroll") for (int p = 0; p < 8; ++p) v[p] = sp_ ? __builtin_nontemporal_load((const f32x4*)(sp_ + (size_t)(tk_ * 64 + kc * 8 + p) * ld)) : (f32x4){0.f, 0.f, 0.f, 0.f}; } while (0)
#define CONV_TILE(v) do { const int tn = ti % ntn, tk = ti / ntn; const int n0 = tn * 256 + n4, k0 = tk * 64 + kc * 8;                                        \
        f32x4 c_[8]; _Pragma("unroll") for (int p = 0; p < 8; ++p) c_[p] = v[p] * scale;                                                                   \
        if (ti + 2 * stride < tot) CONV_LOAD(v, ti + 2 * stride);                                                                                          \
        _Pragma("unroll") for (int j = 0; j < 4; ++j) {                                                                                                      \
            if (rowinv) { const float am_ = rowinv[n0 + j]; const float ri = am_ > 0.f ? 127.f / am_ : 0.f;                \
                u32x2 w = {pack_i8x4(c_[0][j] * ri, c_[1][j] * ri, c_[2][j] * ri, c_[3][j] * ri), pack_i8x4(c_[4][j] * ri, c_[5][j] * ri, c_[6][j] * ri, c_[7][j] * ri)}; *(u32x2*)((unsigned char*)dstv + (size_t)(n0 + j) * K + k0) = w; } \
            else if (F8) { u32x2 w = {pack_fp8x4(c_[0][j], c_[1][j], c_[2][j], c_[3][j]), pack_fp8x4(c_[4][j], c_[5][j], c_[6][j], c_[7][j])}; *(u32x2*)((unsigned char*)dstv + (size_t)(n0 + j) * K + k0) = w; } \
            else { u32x4 w = {cvt_pk_bf16(c_[0][j], c_[1][j]), cvt_pk_bf16(c_[2][j], c_[3][j]), cvt_pk_bf16(c_[4][j], c_[5][j]), cvt_pk_bf16(c_[6][j], c_[7][j])}; *(u32x4*)((bf16_t*)dstv + (size_t)(n0 + j) * K + k0) = w; } } \
        } while (0)
    int ti = t_lo + F.c - wg0; const int stride = F.G - wg0;
    if (ti < tot) CONV_LOAD(va, ti);
    if (ti + stride < tot) CONV_LOAD(vb, ti + stride);
    for (;;) {
        if (ti >= tot) break;
        CONV_TILE(va); ti += stride;
        if (ti >= tot) break;
        CONV_TILE(vb); ti += stride;
    }
#undef CONV_TILE
#undef CONV_LOAD
}

__device__ __forceinline__ void p_conv_win_i8(const Frame& F0) {
    const Frame F = phase_frame(F0);
    LAS float* red = (LAS float*)F.lds;
    LAS float* cmax = red + 64 * 32;
    float* sb = (float*)(F.ws + WS_SB);
    const int cg = F.tid & 7, rl = F.tid >> 3;
    for (int task = F.c; task < NL * (LDP / 32); task += F.G) { const int nb = task % (LDP / 32), l = task / (LDP / 32); const int n0 = nb * 32;
        const int src = inproj_src(n0 + cg * 4); const float* sp = F.in(2) + (size_t)l * D * INW + (src >= 0 ? src : 0) + (size_t)(rl * 8) * INW;
        u32x2 w[32]; f32x4 m = {0.f, 0.f, 0.f, 0.f};
#pragma unroll
        for (int q = 0; q < 4; ++q) { f32x4 v[8];
#pragma unroll
            for (int p = 0; p < 8; ++p) v[p] = src >= 0 ? __builtin_nontemporal_load((const f32x4*)(sp + (size_t)(q * 512 + p) * INW)) : (f32x4){0.f, 0.f, 0.f, 0.f};
#pragma unroll
            for (int p = 0; p < 8; ++p) { m[0] = fmaxf(m[0], fabsf(v[p][0])); m[1] = fmaxf(m[1], fabsf(v[p][1])); m[2] = fmaxf(m[2], fabsf(v[p][2])); m[3] = fmaxf(m[3], fabsf(v[p][3]));
                w[q * 8 + p] = (u32x2){cvt_pk_bf16(v[p][0], v[p][1]), cvt_pk_bf16(v[p][2], v[p][3])}; } }
        *(LAS f32x4*)(red + rl * 32 + cg * 4) = m; __syncthreads();
        if (F.tid < 32) { float a = 0.f;
#pragma unroll 8
            for (int q = 0; q < 64; ++q) a = fmaxf(a, red[q * 32 + F.tid]);
            cmax[F.tid] = a; sb[(size_t)l * LDP + n0 + F.tid] = a; }
        __syncthreads();
        unsigned char* dst = F.ws + WS_WIN + (size_t)l * LDP * 2048;
#pragma unroll
        for (int j = 0; j < 4; ++j) { const float am_ = cmax[cg * 4 + j]; const float ri = am_ > 0.f ? 127.f / am_ : 0.f;
#define WEL(pp_) ((j & 1) ? bf_hi(w[pp_][j >> 1]) : bf_lo(w[pp_][j >> 1]))
#pragma unroll
            for (int q = 0; q < 4; ++q) { u32x2 o = {pack_i8x4(WEL(q * 8 + 0) * ri, WEL(q * 8 + 1) * ri, WEL(q * 8 + 2) * ri, WEL(q * 8 + 3) * ri), pack_i8x4(WEL(q * 8 + 4) * ri, WEL(q * 8 + 5) * ri, WEL(q * 8 + 6) * ri, WEL(q * 8 + 7) * ri)};
                __builtin_nontemporal_store(o, (u32x2*)(dst + (size_t)(n0 + cg * 4 + j) * 2048 + q * 512 + rl * 8)); }
#undef WEL
        }
        __syncthreads();
    }
}
struct SmallTile { const float* sp; bf16_t* dst; int ld, K, n, k0; bool f8; };
__device__ __forceinline__ SmallTile small_tile(const Frame& F, int g, int n4, int kc) {
    constexpr int PER_L = 704;
    const int l = g / PER_L; int t = g - l * PER_L;
    const float* base; int ld, K, ntn; bf16_t* dst; bool cmp = false, f8 = false;
    if (t < 384) { const int b = t / 128; t -= b * 128; base = (b == 0 ? F.in(9) : b == 1 ? F.in(10) : F.in(11)) + (size_t)l * 1024 * D; ld = D; K = 1024; ntn = 8; dst = (bf16_t*)(F.ws + WS_WBR) + ((size_t)l * 3 + b) * 2048 * 1024; }
    else if (t < 640) { t -= 384; base = F.in(12) + (size_t)l * D * D; ld = D; K = 2048; ntn = 8; dst = (bf16_t*)(F.ws + WS_WOUT) + (size_t)l * 2048 * 2048; f8 = WOUT_F8 != 0; }
    else { t -= 640; const int c = t >> 5; t &= 31; base = F.in(4) + ((size_t)l * 2 + c) * 4096 * 128; ld = 128; K = 2048; ntn = 1; dst = (bf16_t*)(F.ws + WS_WC1) + ((size_t)l * 2 + c) * 256 * 2048; cmp = true; }
    const int tn = t % ntn, tk = t / ntn; const int n = tn * 256 + n4, k0 = tk * 64 + kc * 8;
    SmallTile r; r.sp = cmp ? base + (n >= 128 ? (size_t)2048 * 128 : 0) + (n & 127) : base + n; r.dst = dst; r.ld = ld; r.K = K; r.n = n; r.k0 = k0; r.f8 = f8; return r;
}
__device__ __forceinline__ void p_conv_small(const Frame& F0) {
    const Frame F = phase_frame(F0);
    constexpr int PER_L = 704;
    const int n4 = ((F.tid >> 6) * 8 + (F.tid & 7)) * 4, kc = (F.tid >> 3) & 7;
    int g = F.c; if (g >= NL * PER_L) return;
    SmallTile cur = small_tile(F, g, n4, kc); f32x4 v[8];
#pragma unroll
    for (int pp = 0; pp < 8; ++pp) v[pp] = __builtin_nontemporal_load((const f32x4*)(cur.sp + (size_t)(cur.k0 + pp) * cur.ld));
    for (;;) {
        const int gn = g + F.G; const bool more = gn < NL * PER_L; SmallTile nxt = cur; f32x4 vn[8];
        if (more) { nxt = small_tile(F, gn, n4, kc);
#pragma unroll
            for (int pp = 0; pp < 8; ++pp) vn[pp] = __builtin_nontemporal_load((const f32x4*)(nxt.sp + (size_t)(nxt.k0 + pp) * nxt.ld)); }
#pragma unroll
        for (int j = 0; j < 4; ++j) {
            if (cur.f8) { u32x2 w = {pack_fp8x4(v[0][j] * 512.f, v[1][j] * 512.f, v[2][j] * 512.f, v[3][j] * 512.f), pack_fp8x4(v[4][j] * 512.f, v[5][j] * 512.f, v[6][j] * 512.f, v[7][j] * 512.f)};
                __builtin_nontemporal_store(w, (u32x2*)((unsigned char*)cur.dst + (size_t)(cur.n + j) * cur.K + cur.k0)); }
            else { u32x4 w = {cvt_pk_bf16(v[0][j], v[1][j]), cvt_pk_bf16(v[2][j], v[3][j]), cvt_pk_bf16(v[4][j], v[5][j]), cvt_pk_bf16(v[6][j], v[7][j])};
                __builtin_nontemporal_store(w, (u32x4*)(cur.dst + (size_t)(cur.n + j) * cur.K + cur.k0)); } }
        if (!more) break;
        cur = nxt; g = gn;
#pragma unroll
        for (int pp = 0; pp < 8; ++pp) v[pp] = vn[pp];
    }
}
__device__ __forceinline__ void p_conv_static(const Frame& F0) {
    const Frame F = phase_frame(F0);
    for (int l = 0; l < NL; ++l) {
        { const float* w = F.in(2) + (size_t)l * D * INW;
          auto srcpad = [=](int n) -> const float* { int s; if (n < 5632) s = n; else if (n < 7680) s = n + 24; else if (n < 14848) s = n + 40; else if (n < 14872) s = O_NG + (n - 14848); else if (n < 14888) s = O_GA + (n - 14872); else return nullptr; return w + s; };
#if INPROJ_F8 == 3
          (void)srcpad;
#elif INPROJ_F8 == 2
          conv_t<false>(F, [=](int n) -> const float* { return srcpad(tile16(n >> 8) * 256 + (n & 255)); }, INW, 2048, NT16 * 256, (bf16_t*)(F.ws + WS_WIN) + (size_t)l * NT16 * 256 * 2048);
          conv_t<true>(F, [=](int n) -> const float* { return srcpad(tile8(n >> 8) * 256 + (n & 255)); }, INW, 2048, NT8 * 256, F.ws + WS_WIN + (size_t)NL * NT16 * 256 * 2048 * 2 + (size_t)l * NT8 * 256 * 2048, 512.f);
#elif INPROJ_F8 == 1
          conv_t<true>(F, srcpad, INW, 2048, LDP, F.ws + WS_WIN + (size_t)l * LDP * 2048, 512.f);
#else
          conv_t<false>(F, srcpad, INW, 2048, LDP, (bf16_t*)(F.ws + WS_WIN) + (size_t)l * LDP * 2048);
#endif
        }
#define CONV_BR(b, idx) { const float* w = F.in(idx) + (size_t)l * 1024 * D; bf16_t* dst = (bf16_t*)(F.ws + WS_WBR) + ((size_t)l * 3 + b) * 2048 * 1024; \
          conv_t<false>(F, [=](int n) -> const float* { return w + n; }, D, 1024, 2048, dst); }
        CONV_BR(0, 9) CONV_BR(1, 10) CONV_BR(2, 11)
#undef CONV_BR
        { const float* w = F.in(12) + (size_t)l * D * D; bf16_t* dst = (bf16_t*)(F.ws + WS_WOUT) + (size_t)l * 2048 * 2048;
          conv_t<false>(F, [=](int n) -> const float* { return w + n; }, D, 2048, 2048, dst); }
        for (int c = 0; c < 2; ++c) { const float* w = F.in(4) + ((size_t)l * 2 + c) * 4096 * 128; bf16_t* dst = (bf16_t*)(F.ws + WS_WC1) + ((size_t)l * 2 + c) * 256 * 2048;
          conv_t<false>(F, [=](int n) -> const float* { return w + (n >= 128 ? (size_t)2048 * 128 : 0) + (n & 127); }, 128, 2048, 256, dst); }
    }
}
#ifndef CONVX_EARLY_TILES
#define CONVX_EARLY_TILES 0
#endif
constexpr int CONVX_EARLY = CONVX_EARLY_TILES;
template <bool F8, int PART>
__device__ __forceinline__ void p_conv_experts(const Frame& F0, int l, int wg0 = 0) {
    const Frame F = phase_frame(F0);
    const float* wg = F.in(18) + (size_t)l * 32 * D * 512; const float* wu = F.in(19) + (size_t)l * 32 * D * 512; const float* wd = F.in(20) + (size_t)l * 32 * 512 * D;
    constexpr int DOWN_TILES = 8 * 256, EARLY = CONVX_EARLY < DOWN_TILES ? CONVX_EARLY : DOWN_TILES;
    auto down_src = [=](int n) -> const float* { return wd + (size_t)(n >> 11) * 512 * D + (n & 2047); };
    if (PART == 1) { conv_t<F8>(F, down_src, D, 512, 32 * 2048, F.ws + WS_WD, F8 ? 512.f : 1.f, nullptr, wg0, 0, EARLY); return; }
    conv_t<F8>(F, [=](int n) -> const float* { const int e = n >> 10, r = n & 1023, j = r >> 8, wi = r & 255; const unsigned long long dlt = (unsigned long long)wu - (unsigned long long)wg; const float* base = (const float*)((unsigned long long)wg + (dlt & (0ull - (unsigned long long)(wi >> 7)))) + (size_t)e * D * 512; return base + j * 128 + (wi & 127); }, 512, 2048, 32 * 1024, F.ws + WS_WGU, F8 ? 512.f : 1.f);
    conv_t<F8>(F, down_src, D, 512, 32 * 2048, F.ws + WS_WD, F8 ? 512.f : 1.f, nullptr, 0, PART == 2 ? EARLY : 0, -1);
}
__device__ __forceinline__ void store_h4(unsigned char* ws, size_t idx, float a, float b, float c, float d) {
#if INPROJ_F8 == 1 || INPROJ_F8 == 2
    *(unsigned*)(ws + (INPROJ_F8 == 2 ? WS_H8 : WS_H) + idx) = pack_fp8x4(a * 16.f, b * 16.f, c * 16.f, d * 16.f);
#endif
#if INPROJ_F8 == 0 || INPROJ_F8 == 2
    u32x2 w; w[0] = cvt_pk_bf16(a, b); w[1] = cvt_pk_bf16(c, d); *(u32x2*)((bf16_t*)(ws + WS_H) + idx) = w;
#endif
}
__device__ __forceinline__ void store_h_row(unsigned char* ws, int row, const f32x4 (&y)[8], int lane) {
#if INPROJ_F8 == 3
    float am = 0.f;
#pragma unroll
    for (int i = 0; i < 8; ++i) am = fmaxf(fmaxf(am, fmaxf(fabsf(y[i][0]), fabsf(y[i][1]))), fmaxf(fabsf(y[i][2]), fabsf(y[i][3])));
#pragma unroll
    for (int o = 32; o > 0; o >>= 1) am = fmaxf(am, __shfl_xor(am, o));
    const float inv = am > 0.f ? 127.f / am : 0.f;
    if (lane == 0) ((float*)(ws + WS_SA))[row] = am > 0.f ? am * (1.f / 127.f) : 1.f;
#pragma unroll
    for (int i = 0; i < 8; ++i) *(unsigned*)(ws + WS_H8 + (size_t)row * D + i * 256 + lane * 4) = pack_i8x4(y[i][0] * inv, y[i][1] * inv, y[i][2] * inv, y[i][3] * inv);
#else
#pragma unroll
    for (int i = 0; i < 8; ++i) store_h4(ws, (size_t)row * D + i * 256 + lane * 4, y[i][0], y[i][1], y[i][2], y[i][3]);
#endif
}
__device__ __forceinline__ void p_rmsnorm(const Frame& F0, int l) {
    const Frame F = phase_frame(F0);
    const float* x = (l == 0) ? F.in(0) : F.out(); const float* g = F.in(1) + l * D; unsigned char* h = F.ws;
    for (int row = F.c * 8 + F.wave; row < T; row += F.G * 8) {
        const float* xr = x + (size_t)row * D; f32x4 v[8]; float ss = 0.f;
#pragma unroll
        for (int i = 0; i < 8; ++i) { v[i] = __builtin_nontemporal_load((const f32x4*)(xr + i * 256 + F.lane * 4)); ss += v[i][0] * v[i][0] + v[i][1] * v[i][1] + v[i][2] * v[i][2] + v[i][3] * v[i][3]; }
#pragma unroll
        for (int o = 32; o > 0; o >>= 1) ss += __shfl_xor(ss, o);
        const float rstd = rsqrtf(ss * (1.f / D) + 1e-6f);
#pragma unroll
        for (int i = 0; i < 8; ++i) { const f32x4 gv = *(const f32x4*)(g + i * 256 + F.lane * 4); v[i] = (f32x4){v[i][0] * rstd * gv[0], v[i][1] * rstd * gv[1], v[i][2] * rstd * gv[2], v[i][3] * rstd * gv[3]}; }
        store_h_row(h, row, v, F.lane);
    }
}

template <bool F8 = false>
struct SchedDenseT {
    static constexpr bool GATHER = false;
    const char* A; const char* B; int lda, K, nM, nN, G, c;
    __device__ __forceinline__ bool next(int i, ge::Unit& u) const { int pm, pn; if (!ge::static_tile(i, G, c, nM, nN, pm, pn)) return false;
        u.A = A + (size_t)pm * 256 * lda * (F8 ? 1 : 2); u.B = B + (size_t)pn * 256 * K * (F8 ? 1 : 2); u.r0 = pm * 256; u.c0 = pn * 256; u.aux = 0; u.aux2 = 0; return true; }
    __device__ __forceinline__ void voffA(const ge::Unit&, int tid, unsigned (&v)[2][2]) const { ge::dense_voffA<F8>(lda, tid, v); }
};
typedef SchedDenseT<false> SchedDense;
struct SchedInproj2D {
    static constexpr bool GATHER = false;
    const char* A; const char* B; int G, c;
    __device__ __forceinline__ bool next(int i, ge::Unit& u) const {
        if (G != 256) { int pm, pn; if (!ge::static_tile(i, G, c, T / 256, LDP / 256, pm, pn)) return false;
            u.A = A + (size_t)pm * 256 * 2048; u.B = B + (size_t)pn * 256 * 2048; u.r0 = pm * 256; u.c0 = pn * 256; u.aux = 0; u.aux2 = 0; return true; }
        const int x = c & 7, xr = x >> 2, xc = x & 3, nNx = xc < 3 ? 15 : 14, p = i * 32 + (c >> 3);
        if (p >= 32 * nNx) return false;
        const int gid = p / (4 * nNx), q = p - gid * 4 * nNx, pm = xr * 32 + gid * 4 + (q & 3), pn = xc * 15 + (q >> 2);
        u.A = A + (size_t)pm * 256 * 2048; u.B = B + (size_t)pn * 256 * 2048; u.r0 = pm * 256; u.c0 = pn * 256; u.aux = 0; u.aux2 = 0; return true; }
    __device__ __forceinline__ void voffA(const ge::Unit&, int tid, unsigned (&v)[2][2]) const { ge::dense_voffA<true>(2048, tid, v); }
};
struct EpiStoreBf16 {
    static constexpr bool PERM = true; bf16_t* O; int ldc;
    __device__ __forceinline__ void operator()(const f32x4 (&acc)[2][2][4][2], const ge::Unit& u, int wr, int wc, int fr, int fq) const {
#pragma unroll
        for (int ai = 0; ai < 2; ++ai)
#pragma unroll
            for (int m = 0; m < 4; ++m) { bf16_t* rowp = O + (size_t)(u.r0 + ai * 128 + wr * 64 + m * 16 + fr) * ldc + u.c0 + wc * 32 + 8 * fq;
#pragma unroll
                for (int bj = 0; bj < 2; ++bj) { const f32x4 v0 = acc[ai][bj][m][0], v1 = acc[ai][bj][m][1]; u32x4 w = {cvt_pk_bf16(v0[0], v0[1]), cvt_pk_bf16(v0[2], v0[3]), cvt_pk_bf16(v1[0], v1[1]), cvt_pk_bf16(v1[2], v1[3])};
                    *(u32x4*)(rowp + bj * 128) = w; } }
    }
};
struct EpiNull {
    static constexpr bool PERM = true;
    __device__ __forceinline__ void operator()(const f32x4 (&acc)[2][2][4][2], const ge::Unit&, int, int, int, int) const {
#pragma unroll
        for (int ai = 0; ai < 2; ++ai)
#pragma unroll
            for (int bj = 0; bj < 2; ++bj)
#pragma unroll
                for (int m = 0; m < 4; ++m) asm volatile("" :: "v"(acc[ai][bj][m][0]), "v"(acc[ai][bj][m][1]));
    }
};
struct SchedSame {
    static constexpr bool GATHER = false; const char* A; const char* B; int n;
    __device__ __forceinline__ bool next(int i, ge::Unit& u) const { if (i >= n) return false; u.A = A; u.B = B; u.r0 = 0; u.c0 = 0; u.aux = 0; u.aux2 = 0; return true; }
    __device__ __forceinline__ void voffA(const ge::Unit&, int tid, unsigned (&v)[2][2]) const { ge::dense_voffA<false>(2048, tid, v); }
};
__device__ __forceinline__ void p_inproj_same(const Frame& F0, int l) {
    const Frame F = phase_frame(F0);
    EpiNull E{};
    SchedSame S{(const char*)(F.ws + WS_H), (const char*)(F.ws + WS_WIN) + (size_t)l * LDP * 2048 * 2, 15};
    ge::gemm_phase<EpiNull, SchedSame, 0>(F.lds, F.tid, 2048, 0, S, E);
}
__device__ __forceinline__ void p_inproj_longk(const Frame& F0, int l) {
    const Frame F = phase_frame(F0);
    EpiNull E{};
    SchedSame S{(const char*)(F.ws + WS_H), (const char*)(F.ws + WS_WIN) + (size_t)l * LDP * 2048 * 2, 1};
    ge::gemm_phase<EpiNull, SchedSame, 0>(F.lds, F.tid, 2048 * 15, 0, S, E);
}
__device__ __forceinline__ void p_inproj_null(const Frame& F0, int l) {
    const Frame F = phase_frame(F0);
    EpiNull E{};
    SchedDense S{(const char*)(F.ws + WS_H), (const char*)(F.ws + WS_WIN) + (size_t)l * LDP * 2048 * 2, 2048, 2048, T / 256, LDP / 256, F.G, F.c};
    ge::gemm_phase<EpiNull, SchedDense, 0>(F.lds, F.tid, 2048, 0, S, E);
}
__device__ __forceinline__ void p_inproj_null8(const Frame& F0, int l) {
    const Frame F = phase_frame(F0);
    EpiNull E{};
    SchedDenseT<true> S{(const char*)(F.ws + WS_H8), (const char*)(F.ws + WS_WIN) + (size_t)l * LDP * 2048, 2048, 2048, T / 256, LDP / 256, F.G, F.c};
    ge::gemm_phase<EpiNull, SchedDenseT<true>, 0, false, GE_SP2_DEFAULT, GE_ALIGN_DEFAULT, 0, true>(F.lds, F.tid, 2048, 0, S, E);
}
#ifndef INPROJ_F8
#define INPROJ_F8 1
#endif
struct EpiStoreBf16Scaled {
    static constexpr bool PERM = true; bf16_t* O; int ldc; const float* sa; const float* sb; unsigned gtab;
    __device__ __forceinline__ void operator()(const f32x4 (&acc)[2][2][4][2], const ge::Unit& u, int wr, int wc, int fr, int fq) const {
        float rs[2][4];
#pragma unroll
        for (int ai = 0; ai < 2; ++ai)
#pragma unroll
            for (int m = 0; m < 4; ++m) rs[ai][m] = sa[u.r0 + ai * 128 + wr * 64 + m * 16 + fr];
        const bool gate = u.c0 >= P_MG && u.c0 < P_NG;
#pragma unroll
        for (int bj = 0; bj < 2; ++bj) { const int col = u.c0 + bj * 128 + wc * 32 + 8 * fq; const f32x4 c0 = *(const f32x4*)(sb + col) * (1.f / 127.f), c1 = *(const f32x4*)(sb + col + 4) * (1.f / 127.f);
#pragma unroll
            for (int ai = 0; ai < 2; ++ai)
#pragma unroll
                for (int m = 0; m < 4; ++m) { const f32x4 v0 = acc[ai][bj][m][0] * c0 * rs[ai][m], v1 = acc[ai][bj][m][1] * c1 * rs[ai][m];
                    const size_t row = (size_t)(u.r0 + ai * 128 + wr * 64 + m * 16 + fr);
                    if (gate) {
                        unsigned g[8];
#pragma unroll
                        for (int j = 0; j < 8; ++j) { const float x = j < 4 ? v0[j] : v1[j - 4]; const float fi = fminf(fmaxf(x * 128.f + 1024.f, 0.f), 2047.f);
                            g[j] = *(const LAS unsigned char*)(gtab + (unsigned)fi); }
                        u32x2 w = {g[0] | (g[1] << 8) | (g[2] << 16) | (g[3] << 24), g[4] | (g[5] << 8) | (g[6] << 16) | (g[7] << 24)};
                        *(u32x2*)((unsigned char*)(O + row * ldc + P_MG) + (col - P_MG)) = w; }
                    else { u32x4 w = {cvt_pk_bf16(v0[0], v0[1]), cvt_pk_bf16(v0[2], v0[3]), cvt_pk_bf16(v1[0], v1[1]), cvt_pk_bf16(v1[2], v1[3])};
                        *(u32x4*)(O + row * ldc + col) = w; } } }
    }
};
template <bool F8>
struct SchedInprojMix {
    static constexpr bool GATHER = false;
    const char* A; const char* B; int G, c;
    __device__ __forceinline__ bool next(int i, ge::Unit& u) const { int pm, pn; if (!ge::static_tile(i, G, c, T / 256, F8 ? NT8 : NT16, pm, pn)) return false;
        u.A = A + (size_t)pm * 256 * 2048 * (F8 ? 1 : 2); u.B = B + (size_t)pn * 256 * 2048 * (F8 ? 1 : 2); u.r0 = pm * 256; u.c0 = (F8 ? tile8(pn) : tile16(pn)) * 256; u.aux = 0; u.aux2 = 0; return true; }
    __device__ __forceinline__ void voffA(const ge::Unit&, int tid, unsigned (&v)[2][2]) const { ge::dense_voffA<F8>(2048, tid, v); }
};
__device__ __forceinline__ void p_inproj(const Frame& F0, int l) {
    const Frame F = phase_frame(F0);
    EpiStoreBf16 E{(bf16_t*)(F.ws + WS_PROJ), LDP};
#if INPROJ_F8 == 3
    {
        LAS unsigned char* gt = F.lds + LDS_GTAB;
        for (int i = F.tid; i < 2048; i += NTHR) gt[i] = (unsigned char)fminf(256.f * fast_sigmoid(((float)(i - 1024) + 0.5f) * (1.f / 128.f)), 255.f);
        __syncthreads(); }
    { SchedInproj2D S{(const char*)(F.ws + WS_H8), (const char*)(F.ws + WS_WIN) + (size_t)l * LDP * 2048, F.G, F.c};
      EpiStoreBf16Scaled E3{(bf16_t*)(F.ws + WS_PROJ), LDP, (const float*)(F.ws + WS_SA), (const float*)(F.ws + WS_SB) + (size_t)l * LDP, (unsigned)(uintptr_t)(F.lds + LDS_GTAB)};
      ge::gemm_phase<EpiStoreBf16Scaled, SchedInproj2D, 0, false, GE_SP2_DEFAULT, GE_ALIGN_DEFAULT, 0, true>(F.lds, F.tid, 2048, 0, S, E3); }
#elif INPROJ_F8 == 2
    { SchedInprojMix<false> S{(const char*)(F.ws + WS_H), (const char*)(F.ws + WS_WIN) + (size_t)l * NT16 * 256 * 2048 * 2, F.G, F.c};
      ge::gemm_phase<EpiStoreBf16, SchedInprojMix<false>, 0, false>(F.lds, F.tid, 2048, 0, S, E); }
    { const Frame F2 = phase_frame(F0);
      SchedInprojMix<true> S{(const char*)(F2.ws + WS_H8), (const char*)(F2.ws + WS_WIN) + (size_t)NL * NT16 * 256 * 2048 * 2 + (size_t)l * NT8 * 256 * 2048, F2.G, F2.c};
      EpiStoreBf16 E2{(bf16_t*)(F2.ws + WS_PROJ), LDP};
      ge::gemm_phase<EpiStoreBf16, SchedInprojMix<true>, 0, true>(F2.lds, F2.tid, 2048, 0, S, E2); }
#elif INPROJ_F8 == 1
    SchedDenseT<true> S{(const char*)(F.ws + WS_H), (const char*)(F.ws + WS_WIN) + (size_t)l * LDP * 2048, 2048, 2048, T / 256, LDP / 256, F.G, F.c};
    ge::gemm_phase<EpiStoreBf16, SchedDenseT<true>, 0, true>(F.lds, F.tid, 2048, 0, S, E);
#else
    SchedDense S{(const char*)(F.ws + WS_H), (const char*)(F.ws + WS_WIN) + (size_t)l * LDP * 2048 * 2, 2048, 2048, T / 256, LDP / 256, F.G, F.c};
    ge::gemm_phase<EpiStoreBf16, SchedDense, 0>(F.lds, F.tid, 2048, 0, S, E);
#endif
}

struct SchedMerge {
    static constexpr bool GATHER = false;
    const char* O3; const char* W; int G, c;
    __device__ __forceinline__ bool next(int i, ge::Unit& u) const { const int ti = i / 3, b = i - ti * 3; int pm, pn; if (!ge::static_tile(ti, G, c, T / 256, 8, pm, pn)) return false;
        u.A = O3 + (size_t)b * T * 1024 * 2 + (size_t)pm * 256 * 1024 * 2; u.B = W + (size_t)b * 2048 * 1024 * 2 + (size_t)pn * 256 * 1024 * 2; u.r0 = pm * 256; u.c0 = pn * 256; u.aux = b; u.aux2 = 0; return true; }
    __device__ __forceinline__ void voffA(const ge::Unit&, int tid, unsigned (&v)[2][2]) const { ge::dense_voffA(1024, tid, v); }
};
#if INPROJ_F8 == 3
struct EpiMerge {
    static constexpr bool PERM = true; static constexpr bool INPLACE = true; const bf16_t* proj; bf16_t* merged;
    __device__ __forceinline__ bool inplace(f32x4 (&acc)[2][2][4][2], const ge::Unit& u, int wr, int wc, int fr, int fq) const {
        const int col = u.c0 + wc * 32 + 8 * fq; const int b = u.aux;
#pragma unroll
        for (int ai = 0; ai < 2; ++ai) {
            u32x2 ga[4][2], gb[4][2];
#pragma unroll
            for (int m = 0; m < 4; ++m) { const size_t row = (size_t)(u.r0 + ai * 128 + wr * 64 + m * 16 + fr);
#pragma unroll
                for (int bj = 0; bj < 2; ++bj) { const unsigned char* gp = (const unsigned char*)(proj + row * LDP + P_MG) + b * 2048 + col + bj * 128;
                    ga[m][bj] = *(const u32x2*)gp; if (b < 2) gb[m][bj] = *(const u32x2*)(gp + 2048); else gb[m][bj] = (u32x2){0u, 0u}; } }
#pragma unroll
            for (int m = 0; m < 4; ++m) { const size_t row = (size_t)(u.r0 + ai * 128 + wr * 64 + m * 16 + fr);
#pragma unroll
                for (int bj = 0; bj < 2; ++bj) { const u32x2 g = ga[m][bj], h = gb[m][bj]; float s[8];
#pragma unroll
                    for (int j = 0; j < 8; ++j) { const float num = (float)((g[j >> 2] >> (8 * (j & 3))) & 255u) + 0.5f;
                        s[j] = b < 2 ? num * __builtin_amdgcn_rcpf((float)((h[j >> 2] >> (8 * (j & 3))) & 255u) + 0.5f) : num * (1.f / 256.f); }
                    f32x4 v0 = acc[ai][bj][m][0], v1 = acc[ai][bj][m][1];
                    v0[0] *= s[0]; v0[1] *= s[1]; v0[2] *= s[2]; v0[3] *= s[3]; v1[0] *= s[4]; v1[1] *= s[5]; v1[2] *= s[6]; v1[3] *= s[7];
                    acc[ai][bj][m][0] = v0; acc[ai][bj][m][1] = v1;
                    if (b == 2) {
#if WOUT_F8
                        u32x2 w = {pack_fp8x4(v0[0] * 16.f, v0[1] * 16.f, v0[2] * 16.f, v0[3] * 16.f), pack_fp8x4(v1[0] * 16.f, v1[1] * 16.f, v1[2] * 16.f, v1[3] * 16.f)};
                        *(u32x2*)((unsigned char*)merged + row * 2048 + col + bj * 128) = w;
#else
                        u32x4 w = {cvt_pk_bf16(v0[0], v0[1]), cvt_pk_bf16(v0[2], v0[3]), cvt_pk_bf16(v1[0], v1[1]), cvt_pk_bf16(v1[2], v1[3])};
                        *(u32x4*)(merged + row * 2048 + col + bj * 128) = w;
#endif
                    } } }
        }
        return b < 2;
    }
};
#else
struct EpiMerge {
    static constexpr bool PERM = true; const bf16_t* proj; bf16_t* merged;
    __device__ __forceinline__ void operator()(const f32x4 (&acc)[2][2][4][2], const ge::Unit& u, int wr, int wc, int fr, int fq) const {
        const int col = u.c0 + wc * 32 + 8 * fq;
#pragma unroll
        for (int ai = 0; ai < 2; ++ai) {
            u32x4 gw[4][2], pw[4][2];
#pragma unroll
            for (int m = 0; m < 4; ++m) { const size_t row = (size_t)(u.r0 + ai * 128 + wr * 64 + m * 16 + fr);
#pragma unroll
                for (int bj = 0; bj < 2; ++bj) {
#if INPROJ_F8 == 3
                    { const u32x2 g8 = *(const u32x2*)((const unsigned char*)(proj + row * LDP + P_MG) + u.aux * 2048 + col + bj * 128); gw[m][bj] = (u32x4){g8[0], g8[1], 0u, 0u}; }
#else
                    gw[m][bj] = *(const u32x4*)(proj + row * LDP + P_MG + u.aux * 2048 + col + bj * 128);
#endif
                    if (u.aux > 0) pw[m][bj] = *(const u32x4*)(merged + row * 2048 + col + bj * 128); else pw[m][bj] = (u32x4){0u, 0u, 0u, 0u}; } }
#pragma unroll
            for (int m = 0; m < 4; ++m) { const size_t row = (size_t)(u.r0 + ai * 128 + wr * 64 + m * 16 + fr);
#pragma unroll
                for (int bj = 0; bj < 2; ++bj) { const u32x4 g = gw[m][bj], q = pw[m][bj]; const f32x4 v0 = acc[ai][bj][m][0], v1 = acc[ai][bj][m][1];
#if INPROJ_F8 == 3
                    constexpr float I255 = 1.f / 255.f;
                    const float s0 = (float)(g[0] & 255u) * I255, s1 = (float)((g[0] >> 8) & 255u) * I255, s2 = (float)((g[0] >> 16) & 255u) * I255, s3 = (float)(g[0] >> 24) * I255;
                    const float s4 = (float)(g[1] & 255u) * I255, s5 = (float)((g[1] >> 8) & 255u) * I255, s6 = (float)((g[1] >> 16) & 255u) * I255, s7 = (float)(g[1] >> 24) * I255;
#else
                    const float s0 = fast_sigmoid(bf_lo(g[0])), s1 = fast_sigmoid(bf_hi(g[0])), s2 = fast_sigmoid(bf_lo(g[1])), s3 = fast_sigmoid(bf_hi(g[1])), s4 = fast_sigmoid(bf_lo(g[2])), s5 = fast_sigmoid(bf_hi(g[2])), s6 = fast_sigmoid(bf_lo(g[3])), s7 = fast_sigmoid(bf_hi(g[3]));
#endif
                    const float o0 = v0[0] * s0 + bf_lo(q[0]), o1 = v0[1] * s1 + bf_hi(q[0]), o2 = v0[2] * s2 + bf_lo(q[1]), o3 = v0[3] * s3 + bf_hi(q[1]);
                    const float o4 = v1[0] * s4 + bf_lo(q[2]), o5 = v1[1] * s5 + bf_hi(q[2]), o6 = v1[2] * s6 + bf_lo(q[3]), o7 = v1[3] * s7 + bf_hi(q[3]);
                    u32x4 w = {cvt_pk_bf16(o0, o1), cvt_pk_bf16(o2, o3), cvt_pk_bf16(o4, o5), cvt_pk_bf16(o6, o7)};
                    *(u32x4*)(merged + row * 2048 + col + bj * 128) = w; } }
        }
    }
};
#endif
__device__ __forceinline__ void p_merge(const Frame& F0, int l) {
    const Frame F = phase_frame(F0);
    SchedMerge S{(const char*)(F.ws + WS_OM), (const char*)(F.ws + WS_WBR) + (size_t)l * 3 * 2048 * 1024 * 2, F.G, F.c};
    EpiMerge E{(const bf16_t*)(F.ws + WS_PROJ), (bf16_t*)(F.ws + WS_MERGED)};
    ge::gemm_phase<EpiMerge, SchedMerge, 0>(F.lds, F.tid, 1024, 0, S, E);
}

struct EpiResF32 {
    static constexpr bool PERM = false; const float* R; float* C;
    __device__ __forceinline__ void operator()(const f32x4 (&acc)[2][2][4][2], const ge::Unit& u, int wr, int wc, int fr, int fq) const {
#pragma unroll
        for (int ai = 0; ai < 2; ++ai) {
            f32x4 r[4][2][2];
#pragma unroll
            for (int m = 0; m < 4; ++m) { const size_t off = (size_t)(u.r0 + ai * 128 + wr * 64 + m * 16 + fr) * D + u.c0 + wc * 32 + 4 * fq;
#pragma unroll
                for (int bj = 0; bj < 2; ++bj)
#pragma unroll
                    for (int n = 0; n < 2; ++n) r[m][bj][n] = *(const f32x4*)(R + off + bj * 128 + n * 16); }
#pragma unroll
            for (int m = 0; m < 4; ++m) { const size_t off = (size_t)(u.r0 + ai * 128 + wr * 64 + m * 16 + fr) * D + u.c0 + wc * 32 + 4 * fq;
#pragma unroll
                for (int bj = 0; bj < 2; ++bj)
#pragma unroll
                    for (int n = 0; n < 2; ++n) *(f32x4*)(C + off + bj * 128 + n * 16) = acc[ai][bj][m][n] + r[m][bj][n]; }
        }
    }
};
template <bool RF32>
struct EpiResBf16 {
    static constexpr bool PERM = true; const void* R; bf16_t* C;
    __device__ __forceinline__ void operator()(const f32x4 (&acc)[2][2][4][2], const ge::Unit& u, int wr, int wc, int fr, int fq) const {
#pragma unroll
        for (int ai = 0; ai < 2; ++ai) {
            f32x4 r[4][2][2];
#pragma unroll
            for (int m = 0; m < 4; ++m) { const size_t off = (size_t)(u.r0 + ai * 128 + wr * 64 + m * 16 + fr) * D + u.c0 + wc * 32 + 8 * fq;
#pragma unroll
                for (int bj = 0; bj < 2; ++bj) {
                    if (RF32) { r[m][bj][0] = __builtin_nontemporal_load((const f32x4*)((const float*)R + off + bj * 128)); r[m][bj][1] = __builtin_nontemporal_load((const f32x4*)((const float*)R + off + bj * 128 + 4)); }
                    else { const u32x4 q = *(const u32x4*)((const bf16_t*)R + off + bj * 128); r[m][bj][0] = (f32x4){bf_lo(q[0]), bf_hi(q[0]), bf_lo(q[1]), bf_hi(q[1])}; r[m][bj][1] = (f32x4){bf_lo(q[2]), bf_hi(q[2]), bf_lo(q[3]), bf_hi(q[3])}; } } }
#pragma unroll
            for (int m = 0; m < 4; ++m) { const size_t off = (size_t)(u.r0 + ai * 128 + wr * 64 + m * 16 + fr) * D + u.c0 + wc * 32 + 8 * fq;
#pragma unroll
                for (int bj = 0; bj < 2; ++bj) { const f32x4 v0 = acc[ai][bj][m][0] + r[m][bj][0], v1 = acc[ai][bj][m][1] + r[m][bj][1];
                    u32x4 w = {cvt_pk_bf16(v0[0], v0[1]), cvt_pk_bf16(v0[2], v0[3]), cvt_pk_bf16(v1[0], v1[1]), cvt_pk_bf16(v1[2], v1[3])};
                    *(u32x4*)(C + off + bj * 128) = w; } }
        }
    }
};
__device__ __forceinline__ void p_wout(const Frame& F0, int l) {
    const Frame F = phase_frame(F0);
    constexpr bool W8 = WOUT_F8 != 0;
    SchedDenseT<W8> S{(const char*)(F.ws + WS_MERGED), (const char*)(F.ws + WS_WOUT) + (size_t)l * 2048 * 2048 * 2, 2048, 2048, T / 256, 8, F.G, F.c};
    if (l == 0) { EpiResBf16<true> E{(const void*)F.in(0), (bf16_t*)(F.ws + WS_XB)}; ge::gemm_phase<EpiResBf16<true>, SchedDenseT<W8>, 0, W8>(F.lds, F.tid, 2048, 0, S, E); }
    else { EpiResBf16<false> E{(const void*)(F.ws + WS_XB), (bf16_t*)(F.ws + WS_XB)}; ge::gemm_phase<EpiResBf16<false>, SchedDenseT<W8>, 0, W8>(F.lds, F.tid, 2048, 0, S, E); }
}

constexpr size_t WS_WR = WS_END_SMALL;
constexpr size_t WS_END2 = WS_WR + al256((size_t)NL * 2048 * 64 * 4);

__device__ __forceinline__ void p_conv_router(const Frame& F0) {
    const Frame F = phase_frame(F0);
    bf16_t* wr = (bf16_t*)(F.ws + WS_WR);
    const float* g2 = F.in(13); const float* rgw = F.in(14); const float* rew = F.in(16);
    for (int i = F.c * NTHR + F.tid; i < NL * 64 * 2048; i += F.G * NTHR) {
        const int d = i & 2047, j = (i >> 11) & 63, l = i >> 17;
        float v = 0.f;
        if (j < 4) v = rgw[((size_t)l * 2048 + d) * 4 + j]; else if (j < 36) v = rew[((size_t)l * 2048 + d) * 32 + (j - 4)];
        v *= g2[l * 2048 + d];
        const bf16_t h = f2bf(v); const bf16_t lo = f2bf(v - bf2f(h));
        wr[((size_t)(l * 2 + 0) * 64 + j) * 2048 + d] = h; wr[((size_t)(l * 2 + 1) * 64 + j) * 2048 + d] = lo;
    }
}

template <bool F8, bool DRY = false>
__device__ __forceinline__ void p_route1(const Frame& F0, int l) {
    const Frame F = phase_frame(F0);
    const bf16_t* x = (const bf16_t*)(F.ws + WS_XB);
    const bf16_t* wr = (const bf16_t*)(F.ws + WS_WR) + (size_t)l * 2 * 64 * 2048;
    const float* g2 = F.in(13) + l * D; const float* rgb = F.in(15) + l * 4; const float* reb = F.in(17) + l * 32;
    unsigned* ctl = (unsigned*)(F.ws + WS_CTL);
    int* list = (int*)(F.ws + WS_LIST); float* listw = (float*)(F.ws + WS_LISTW);
    LAS float* part = (LAS float*)F.lds;
    LAS float* ssq = (LAS float*)(F.lds + 65536);
    LAS float* lg = (LAS float*)(F.lds + 65536 + 1024);
    LAS float* rstd_s = (LAS float*)(F.lds + 65536 + 1024 + 64 * 40 * 4);
    const int w = F.wave, lane = F.lane, rh = w >> 2, kq = w & 3, r32 = lane & 31, hi = lane >> 5;
    for (int rg = F.c; rg < T / 64; rg += F.G) {
        const int row0 = rg * 64;
        f32x16 acc0, acc1;
#pragma unroll
        for (int r = 0; r < 16; ++r) { acc0[r] = 0.f; acc1[r] = 0.f; }
        float ss = 0.f;
        const bf16_t* xr = x + (size_t)(row0 + rh * 32 + r32) * D + kq * 512 + 8 * hi;
        const bf16_t* wh = wr + (size_t)r32 * 2048 + kq * 512 + 8 * hi; const bf16_t* wl = wh + (size_t)64 * 2048;
        for (int ks = 0; ks < 32; ++ks) {
            const u32x4 ah = *(const u32x4*)(xr + ks * 16);
            { const float a0 = bf_lo(ah[0]), a1 = bf_hi(ah[0]), a2 = bf_lo(ah[1]), a3 = bf_hi(ah[1]), a4 = bf_lo(ah[2]), a5 = bf_hi(ah[2]), a6 = bf_lo(ah[3]), a7 = bf_hi(ah[3]);
              ss += a0 * a0 + a1 * a1 + a2 * a2 + a3 * a3 + a4 * a4 + a5 * a5 + a6 * a6 + a7 * a7; }
            const bf16x8 fah = __builtin_bit_cast(bf16x8, ah);
            const bf16x8 b0h = *(const bf16x8*)(wh + ks * 16), b0l = *(const bf16x8*)(wl + ks * 16), b1h = *(const bf16x8*)(wh + (size_t)32 * 2048 + ks * 16), b1l = *(const bf16x8*)(wl + (size_t)32 * 2048 + ks * 16);
            acc0 = __builtin_amdgcn_mfma_f32_32x32x16_bf16(fah, b0h, acc0, 0, 0, 0); acc0 = __builtin_amdgcn_mfma_f32_32x32x16_bf16(fah, b0l, acc0, 0, 0, 0);
            acc1 = __builtin_amdgcn_mfma_f32_32x32x16_bf16(fah, b1h, acc1, 0, 0, 0); acc1 = __builtin_amdgcn_mfma_f32_32x32x16_bf16(fah, b1l, acc1, 0, 0, 0);
        }
        ss += __shfl_xor(ss, 32);
        if (hi == 0) ssq[w * 32 + r32] = ss;
#pragma unroll
        for (int r = 0; r < 16; ++r) { const int row = (r & 3) + 8 * (r >> 2) + 4 * hi; part[(w * 32 + row) * 64 + r32] = acc0[r]; part[(w * 32 + row) * 64 + 32 + r32] = acc1[r]; }
        __syncthreads();
        { const int row = F.tid >> 3, sub = F.tid & 7, rr = row & 31, rhh = row >> 5;
          float s2 = ssq[(rhh * 4 + 0) * 32 + rr] + ssq[(rhh * 4 + 1) * 32 + rr] + ssq[(rhh * 4 + 2) * 32 + rr] + ssq[(rhh * 4 + 3) * 32 + rr];
          const float rstd = rsqrtf(s2 * (1.f / D) + 1e-6f);
          if (sub == 0) rstd_s[row] = rstd;
#pragma unroll
          for (int q = 0; q < 5; ++q) { const int j = sub * 5 + q; if (j < 36) {
              float a = part[((rhh * 4 + 0) * 32 + rr) * 64 + j] + part[((rhh * 4 + 1) * 32 + rr) * 64 + j] + part[((rhh * 4 + 2) * 32 + rr) * 64 + j] + part[((rhh * 4 + 3) * 32 + rr) * 64 + j];
              lg[row * 40 + j] = a * rstd + (j < 4 ? rgb[j] : reb[j - 4]); } } }
        __syncthreads();
        if (F.tid < 64 && !DRY) {
            const int row = F.tid; const LAS float* L = lg + row * 40;
            int grp = 0; float gm = L[0];
#pragma unroll
            for (int j = 1; j < 4; ++j) if (L[j] > gm) { gm = L[j]; grp = j; }
            float den = 0.f;
#pragma unroll
            for (int j = 0; j < 4; ++j) den += expf(L[j] - gm);
            const float pg = 1.f / den;
            const LAS float* el = L + 4 + grp * 8;
            int i0 = 0; for (int j = 1; j < 8; ++j) if (el[j] > el[i0]) i0 = j;
            int i1 = -1; for (int j = 0; j < 8; ++j) { if (j == i0) continue; if (i1 < 0 || el[j] > el[i1]) i1 = j; }
            const float e1 = expf(el[i1] - el[i0]), d2 = 1.f + e1;
            const int ea = grp * 8 + i0, eb = grp * 8 + i1;
            const unsigned pa = atomicAdd(&ctl[CW_CNT + l * 32 + ea], 1u), pb = atomicAdd(&ctl[CW_CNT + l * 32 + eb], 1u);
            int* rt = (int*)(F.ws + WS_ROUTE) + (size_t)(row0 + row) * 8;
            rt[0] = ea; rt[1] = eb; ((float*)rt)[2] = pg / d2; ((float*)rt)[3] = pg * e1 / d2; rt[4] = (int)pa; rt[5] = (int)pb;
            list[(size_t)ea * MOE_CAP + pa] = row0 + row; listw[(size_t)ea * MOE_CAP + pa] = pg / d2; list[(size_t)eb * MOE_CAP + pb] = row0 + row; listw[(size_t)eb * MOE_CAP + pb] = pg * e1 / d2;
        }
        for (int q = 0; q < 8; ++q) { const int row = w * 8 + q; const float rstd = rstd_s[row];
            const bf16_t* xr2 = x + (size_t)(row0 + row) * D; bf16_t* hr = (bf16_t*)(F.ws + WS_H) + (size_t)(row0 + row) * D; unsigned char* hr8 = F.ws + WS_H + (size_t)(row0 + row) * D;
#pragma unroll
            for (int i = 0; i < 8; ++i) { const u32x2 xw = *(const u32x2*)(xr2 + i * 256 + lane * 4); const f32x4 v = {bf_lo(xw[0]), bf_hi(xw[0]), bf_lo(xw[1]), bf_hi(xw[1])}; const f32x4 gv = *(const f32x4*)(g2 + i * 256 + lane * 4);
                if (F8) { *(unsigned*)(hr8 + i * 256 + lane * 4) = pack_fp8x4(v[0] * rstd * gv[0] * 16.f, v[1] * rstd * gv[1] * 16.f, v[2] * rstd * gv[2] * 16.f, v[3] * rstd * gv[3] * 16.f); }
                else { u32x2 wv; wv[0] = cvt_pk_bf16(v[0] * rstd * gv[0], v[1] * rstd * gv[1]); wv[1] = cvt_pk_bf16(v[2] * rstd * gv[2], v[3] * rstd * gv[3]); *(u32x2*)(hr + i * 256 + lane * 4) = wv; } } }
        __syncthreads();
    }
}

struct MoeTab { int ntiles; };
__device__ __forceinline__ int moe_build_tab(const Frame& F, int l, LAS int* tab  ) {
    unsigned* ctl = (unsigned*)(F.ws + WS_CTL);
    if (F.tid < 64) { const int e = F.tid; const int cnt = e < 32 ? (int)__hip_atomic_load(&ctl[CW_CNT + l * 32 + e], __ATOMIC_RELAXED, __HIP_MEMORY_SCOPE_AGENT) : 0;
        const int nt = (cnt + 255) >> 8; int pre = nt;
#pragma unroll
        for (int o = 1; o < 32; o <<= 1) { const int v = __shfl_up(pre, o); if (e >= o) pre += v; }
        const int first = pre - nt;
        if (e < 32) { tab[e] = first * 256; tab[32 + e] = cnt;
            for (int k = 0; k < nt; ++k) { tab[64 + first + k] = e; tab[224 + first + k] = (first + k) * 256; } }
        if (e == 31) tab[384] = pre; }
    __syncthreads();
    return tab[384];
}
template <bool F8>
struct SchedMoeGUT {
    static constexpr bool GATHER = true;
    const char* H; const char* W; const int* list; LAS int* tab; int G, c, ntiles;
    __device__ __forceinline__ bool next(int i, ge::Unit& u) const { const int L = i * G + c; if (L >= ntiles * 4) return false; const int ti = L >> 2, ct = L & 3; const int e = tab[64 + ti];
        u.A = H; u.B = W + ((size_t)e * 1024 + ct * 256) * 2048 * (F8 ? 1 : 2); u.r0 = tab[224 + ti]; u.c0 = ct * 128; u.aux = e; u.aux2 = u.r0 - tab[e]; return true; }
    __device__ __forceinline__ void voffA(const ge::Unit& u, int tid, unsigned (&v)[2][2]) const {
#pragma unroll
        for (int i = 0; i < 2; ++i) { int R, C; ge::stage_rc(tid * 16 + i * 8192, R, C); const int cnt_ = tab[32 + u.aux], l0_ = u.aux2 + R, l1_ = l0_ + 128; const int* lp_ = list + (size_t)u.aux * MOE_CAP; const int t0 = l0_ < cnt_ ? lp_[l0_] : 0, t1 = l1_ < cnt_ ? lp_[l1_] : 0;     v[0][i] = F8 ? (unsigned)(t0 * 2048 + C * 2) : (unsigned)(t0 * 2048 + C) * 2u; v[1][i] = F8 ? (unsigned)(t1 * 2048 + C * 2) : (unsigned)(t1 * 2048 + C) * 2u; } }
};
template <bool F8>
struct EpiGUT {
    static constexpr bool PERM = true; void* hidv;
    __device__ __forceinline__ void operator()(const f32x4 (&acc)[2][2][4][2], const ge::Unit& u, int wr, int wc, int fr, int fq) const {
#pragma unroll
        for (int ai = 0; ai < 2; ++ai)
#pragma unroll
            for (int m = 0; m < 4; ++m) { const f32x4 g0 = acc[ai][0][m][0], g1 = acc[ai][0][m][1], u0 = acc[ai][1][m][0], u1 = acc[ai][1][m][1];
                float h[8] = {fast_silu(g0[0]) * u0[0], fast_silu(g0[1]) * u0[1], fast_silu(g0[2]) * u0[2], fast_silu(g0[3]) * u0[3], fast_silu(g1[0]) * u1[0], fast_silu(g1[1]) * u1[1], fast_silu(g1[2]) * u1[2], fast_silu(g1[3]) * u1[3]};
                const size_t off = (size_t)(u.r0 + ai * 128 + wr * 64 + m * 16 + fr) * 512 + u.c0 + wc * 32 + 8 * fq;
                if (F8) {
#pragma unroll
                    for (int j = 0; j < 8; ++j) h[j] = fminf(fmaxf(h[j] * 8.f, -440.f), 440.f);
                    u32x2 w = {pack_fp8x4(h[0], h[1], h[2], h[3]), pack_fp8x4(h[4], h[5], h[6], h[7])}; *(u32x2*)((unsigned char*)hidv + off) = w; }
                else { u32x4 w = {cvt_pk_bf16(h[0], h[1]), cvt_pk_bf16(h[2], h[3]), cvt_pk_bf16(h[4], h[5]), cvt_pk_bf16(h[6], h[7])}; *(u32x4*)((bf16_t*)hidv + off) = w; } }
    }
};
template <bool F8>
__device__ __forceinline__ void p_moe_gu(const Frame& F0, int l) {
    const Frame F = phase_frame(F0);
    LAS int* tab = (LAS int*)(F.lds + LDS_MISC);
    const int nt = moe_build_tab(F, l, tab);
    SchedMoeGUT<F8> S{(const char*)(F.ws + WS_H), (const char*)(F.ws + WS_WGU), (const int*)(F.ws + WS_LIST), tab, F.G, F.c, nt};
    EpiGUT<F8> E{(void*)(F.ws + WS_HID)};
    ge::gemm_phase<EpiGUT<F8>, SchedMoeGUT<F8>, 0, F8>(F.lds, F.tid, 2048, 0, S, E);
}
template <bool F8>
struct SchedMoeDT {
    static constexpr bool GATHER = false;
    const char* HID; const char* W; LAS int* tab; int G, c, ntiles;
    __device__ __forceinline__ bool next(int i, ge::Unit& u) const { const int L = i * G + c; if (L >= ntiles * 8) return false; const int ti = L >> 3, ct = L & 7; const int e = tab[64 + ti];
        u.r0 = tab[224 + ti]; u.A = HID + (size_t)u.r0 * 512 * (F8 ? 1 : 2); u.B = W + ((size_t)e * 2048 + ct * 256) * 512 * (F8 ? 1 : 2); u.c0 = ct * 256; u.aux = e; u.aux2 = u.r0 - tab[e]; return true; }
    __device__ __forceinline__ void voffA(const ge::Unit&, int tid, unsigned (&v)[2][2]) const { ge::dense_voffA<F8>(512, tid, v); }
};
struct EpiDown {
    static constexpr bool PERM = true; bf16_t* y; const float* listw; LAS int* tab;
    __device__ __forceinline__ void operator()(const f32x4 (&acc)[2][2][4][2], const ge::Unit& u, int wr, int wc, int fr, int fq) const {
        float rs[2][4];
#pragma unroll
        for (int ai = 0; ai < 2; ++ai)
#pragma unroll
            for (int m = 0; m < 4; ++m) { const int lr_ = u.aux2 + ai * 128 + wr * 64 + m * 16 + fr; rs[ai][m] = lr_ < tab[32 + u.aux] ? listw[(size_t)u.aux * MOE_CAP + lr_] : 0.f; }
#pragma unroll
        for (int ai = 0; ai < 2; ++ai)
#pragma unroll
            for (int m = 0; m < 4; ++m) { const int row = u.r0 + ai * 128 + wr * 64 + m * 16 + fr; const float s = rs[ai][m]; bf16_t* rowp = y + (size_t)row * 2048 + u.c0 + wc * 32 + 8 * fq;
#pragma unroll
                for (int bj = 0; bj < 2; ++bj) {
#if Y_F8
                    const f32x4 v0 = acc[ai][bj][m][0] * (s * 64.f), v1 = acc[ai][bj][m][1] * (s * 64.f);
                    u32x2 w = {pack_fp8x4(v0[0], v0[1], v0[2], v0[3]), pack_fp8x4(v1[0], v1[1], v1[2], v1[3])};
                    *(u32x2*)((unsigned char*)y + (size_t)row * 2048 + u.c0 + wc * 32 + 8 * fq + bj * 128) = w;
#else
                    const f32x4 v0 = acc[ai][bj][m][0] * s, v1 = acc[ai][bj][m][1] * s; u32x4 w = {cvt_pk_bf16(v0[0], v0[1]), cvt_pk_bf16(v0[2], v0[3]), cvt_pk_bf16(v1[0], v1[1]), cvt_pk_bf16(v1[2], v1[3])};
                    *(u32x4*)(rowp + bj * 128) = w;
#endif
                } }
    }
};
template <bool F8>
__device__ __forceinline__ void p_moe_down(const Frame& F0, int l) {
    const Frame F = phase_frame(F0);
    LAS int* tab = (LAS int*)(F.lds + LDS_MISC);
    const int nt = moe_build_tab(F, l, tab);
    SchedMoeDT<F8> S{(const char*)(F.ws + WS_HID), (const char*)(F.ws + WS_WD), tab, F.G, F.c, nt};
    EpiDown E{(bf16_t*)(F.ws + WS_YBUF), (const float*)(F.ws + WS_LISTW), tab};
    ge::gemm_phase<EpiDown, SchedMoeDT<F8>, 0, F8, GE_SP2_DEFAULT, GE_ALIGN_DEFAULT, 0x7C7C7C7C>(F.lds, F.tid, 512, 0, S, E);
}
template <bool F8>
__device__ __forceinline__ void p_moe_down_null(const Frame& F0, int l) {
    const Frame F = phase_frame(F0);
    LAS int* tab = (LAS int*)(F.lds + LDS_MISC);
    const int nt = moe_build_tab(F, l, tab);
    SchedMoeDT<F8> S{(const char*)(F.ws + WS_HID), (const char*)(F.ws + WS_WD), tab, F.G, F.c, nt};
    EpiNull E{};
    ge::gemm_phase<EpiNull, SchedMoeDT<F8>, 0, F8, GE_SP2_DEFAULT, GE_ALIGN_DEFAULT, 0x7C7C7C7C>(F.lds, F.tid, 512, 0, S, E);
}
template <int MODE, bool DRY = false>
__device__ __forceinline__ void p_combine(const Frame& F0, int lnext, int lmoe) {
    const Frame F = phase_frame(F0);
    LAS int* tab = (LAS int*)(F.lds + LDS_MISC); moe_build_tab(F, lmoe, tab);
    bf16_t* x = (bf16_t*)(F.ws + WS_XB); float* outp = F.out(); const bf16_t* y = (const bf16_t*)(F.ws + WS_YBUF);
    const float* g = MODE == 0 ? F.in(1) + lnext * D : F.in(21);
    static_assert(Y_F8 != 0, "the pipelined combine reads fp8 expert outputs");
    const int stride = F.G * 8;
    f32x4 gvv[8];
#pragma unroll
    for (int i = 0; i < 8; ++i) gvv[i] = *(const f32x4*)(g + i * 256 + F.lane * 4);
#define CMB_IDX(r_, ra_, rb_) do { ra_ = 0; rb_ = 0; if ((r_) < T) { const int* rt_ = (const int*)(F.ws + WS_ROUTE) + (size_t)(r_) * 8; ra_ = tab[rt_[0]] + rt_[4]; rb_ = tab[rt_[1]] + rt_[5]; } } while (0)
#define CMB_LOAD(r_, ra_, rb_, XW, YA, YB) do { if ((r_) < T) { _Pragma("unroll") for (int i = 0; i < 8; ++i) { XW[i] = *(const u32x2*)(x + (size_t)(r_) * D + i * 256 + F.lane * 4);                        \
            YA[i] = __builtin_nontemporal_load((const unsigned*)((const unsigned char*)y + (size_t)(ra_) * 2048 + i * 256 + F.lane * 4));                                                      \
            YB[i] = __builtin_nontemporal_load((const unsigned*)((const unsigned char*)y + (size_t)(rb_) * 2048 + i * 256 + F.lane * 4)); } } } while (0)
    int row = F.c * 8 + F.wave;
    int ra, rb, ran, rbn; CMB_IDX(row, ra, rb); CMB_IDX(row + stride, ran, rbn);
    u32x2 xw[8]; unsigned ya[8], yb[8];
    CMB_LOAD(row, ra, rb, xw, ya, yb);
    for (; row < T; row += stride) {
        u32x2 xn[8]; unsigned yan[8], ybn[8];
        CMB_LOAD(row + stride, ran, rbn, xn, yan, ybn);
        int ra2, rb2; CMB_IDX(row + 2 * stride, ra2, rb2);
        bf16_t* xr = x + (size_t)row * D; float* orow = outp + (size_t)row * D; f32x4 v[8]; float ss = 0.f;
#pragma unroll
        for (int i = 0; i < 8; ++i) { v[i] = (f32x4){bf_lo(xw[i][0]), bf_hi(xw[i][0]), bf_lo(xw[i][1]), bf_hi(xw[i][1])};
            const f32x2 a0 = __builtin_amdgcn_cvt_pk_f32_fp8((int)ya[i], false), a1 = __builtin_amdgcn_cvt_pk_f32_fp8((int)ya[i], true), b0 = __builtin_amdgcn_cvt_pk_f32_fp8((int)yb[i], false), b1 = __builtin_amdgcn_cvt_pk_f32_fp8((int)yb[i], true);
            v[i][0] += (a0[0] + b0[0]) * (1.f / 64.f); v[i][1] += (a0[1] + b0[1]) * (1.f / 64.f); v[i][2] += (a1[0] + b1[0]) * (1.f / 64.f); v[i][3] += (a1[1] + b1[1]) * (1.f / 64.f);
            ss += v[i][0] * v[i][0] + v[i][1] * v[i][1] + v[i][2] * v[i][2] + v[i][3] * v[i][3]; }
#pragma unroll
        for (int o = 32; o > 0; o >>= 1) ss += __shfl_xor(ss, o);
        const float rstd = rsqrtf(ss * (1.f / D) + 1e-6f);
#pragma unroll
        for (int i = 0; i < 8; ++i) { const f32x4 gv = gvv[i];
            if (DRY) { asm volatile("" :: "v"(v[i][0] * rstd * gv[0]), "v"(v[i][1]), "v"(v[i][2]), "v"(v[i][3])); }
            else if (MODE == 0) { *(u32x2*)(xr + i * 256 + F.lane * 4) = (u32x2){cvt_pk_bf16(v[i][0], v[i][1]), cvt_pk_bf16(v[i][2], v[i][3])}; v[i] = (f32x4){v[i][0] * rstd * gv[0], v[i][1] * rstd * gv[1], v[i][2] * rstd * gv[2], v[i][3] * rstd * gv[3]}; }
            else { f32x4 o = {v[i][0] * rstd * gv[0], v[i][1] * rstd * gv[1], v[i][2] * rstd * gv[2], v[i][3] * rstd * gv[3]}; __builtin_nontemporal_store(o, (f32x4*)(orow + i * 256 + F.lane * 4)); } }
        if (MODE == 0 && !DRY) store_h_row(F.ws, row, v, F.lane);
#pragma unroll
        for (int i = 0; i < 8; ++i) { xw[i] = xn[i]; ya[i] = yan[i]; yb[i] = ybn[i]; }
        ra = ran; rb = rbn; ran = ra2; rbn = rb2;
    }
#undef CMB_IDX
#undef CMB_LOAD
}

namespace att {
constexpr float SCALE = 0.08838834764831845f;
constexpr int NW = 8, QBLK = 32, KVBLK = 64, QB = NW * QBLK, DH = 128;
constexpr int SHM_V = KVBLK * DH * 2, SHM_K = KVBLK * DH * 2;
constexpr int NBUF = 3;
constexpr int ATT_LDS = NBUF * SHM_V + NBUF * SHM_K;
constexpr float THR = 8.f;
typedef short s16x4 __attribute__((ext_vector_type(4)));

#define KSWZ(row, colB) ((row) * 256 + ((colB) ^ (((row) & 7) << 4)))
#define SBAR() __builtin_amdgcn_sched_barrier(0)
__device__ __forceinline__ int v_st(int k, int c) { const int kk = (k & ~0xC) | ((k & 4) << 1) | ((k & 8) >> 1); return ((kk >> 3) * 4 + (c >> 5)) * 512 + ((kk & 7) * 32 + (c & 31)) * 2; }
__device__ __forceinline__ int v_rd_base(int lane) { return ((lane & 3) << 3) | (((lane >> 2) & 3) << 6) | (((lane >> 4) & 1) << 5) | (((lane >> 5) & 1) << 8); }
constexpr int v_rd_off(int d0, int ks, int half) { return d0 * 512 + ks * 4096 + half * 2048; }
__device__ __forceinline__ int crow(int r, int hi) { return (r & 3) + 8 * (r >> 2) + 4 * hi; }
__device__ __forceinline__ bf16x8 load8(const bf16_t* p) { return *reinterpret_cast<const bf16x8*>(p); }

__device__ __forceinline__ void mask_tile(f32x16& p0, f32x16& p1, int dq, unsigned W) {
    const float NEG = -__builtin_inff();
#pragma unroll
    for (int r = 0; r < 16; ++r) {
        const int c = (r & 3) + 8 * (r >> 2);
        if ((unsigned)(dq - c) >= W) p0[r] = NEG;
        if ((unsigned)(dq - c - 32) >= W) p1[r] = NEG;
    }
}
__device__ __forceinline__ void mask_all(f32x16& p0, f32x16& p1, bool ok) {
    const float NEG = -__builtin_inff();
#pragma unroll
    for (int r = 0; r < 16; ++r) { p0[r] = ok ? p0[r] : NEG; p1[r] = ok ? p1[r] : NEG; }
}
__device__ __forceinline__ void partialSM(f32x16& p0, f32x16& p1, float& m_reg, float& mn, float& alpha) {
    float pmax = p0[0]; for (int r = 1; r < 16; ++r) pmax = fmaxf(pmax, p0[r]); for (int r = 0; r < 16; ++r) pmax = fmaxf(pmax, p1[r]);
    { auto rr = __builtin_amdgcn_permlane32_swap(__float_as_uint(pmax), __float_as_uint(pmax), false, false);
      pmax = fmaxf(__uint_as_float(rr[0]), __uint_as_float(rr[1])); }
    constexpr float C2 = 1.4426950408889634f * SCALE;
    if (__builtin_expect(__all((pmax - m_reg) * SCALE <= THR), 1)) { mn = m_reg; alpha = 1.f; }
    else { mn = fmaxf(m_reg, pmax); alpha = __builtin_amdgcn_exp2f((m_reg - mn) * C2); m_reg = mn; }
    const float mnL = -mn * C2;
    for (int r = 0; r < 16; ++r) p0[r] = fmaf(p0[r], C2, mnL); for (int r = 0; r < 16; ++r) p1[r] = fmaf(p1[r], C2, mnL);
    for (int r = 0; r < 16; ++r) p0[r] = __builtin_amdgcn_exp2f(p0[r]);
}
__device__ __forceinline__ void finishSM(f32x16& p0, f32x16& p1, float alpha, float& l_reg, bf16x8& pa0, bf16x8& pa1, bf16x8& pa2, bf16x8& pa3) {
    for (int r = 0; r < 16; ++r) p1[r] = __builtin_amdgcn_exp2f(p1[r]);
    float ps = 0; for (int r = 0; r < 16; ++r) ps += p0[r]; for (int r = 0; r < 16; ++r) ps += p1[r];
    { auto rr = __builtin_amdgcn_permlane32_swap(__float_as_uint(ps), __float_as_uint(ps), false, false);
      ps = __uint_as_float(rr[0]) + __uint_as_float(rr[1]); }
    l_reg = l_reg * alpha + ps;
#define PK4(P, B_, OUT) do { unsigned a0 = cvt_pk_bf16(P[B_+0], P[B_+1]), a1 = cvt_pk_bf16(P[B_+2], P[B_+3]);                          \
        unsigned b0 = cvt_pk_bf16(P[B_+4], P[B_+5]), b1 = cvt_pk_bf16(P[B_+6], P[B_+7]);                                             \
        auto r0 = __builtin_amdgcn_permlane32_swap(a0, b0, false, false); auto r1 = __builtin_amdgcn_permlane32_swap(a1, b1, false, false); \
        u32x4 w = {r0[0], r1[0], r0[1], r1[1]}; OUT = *reinterpret_cast<bf16x8*>(&w); } while (0)
    PK4(p0, 0, pa0); PK4(p0, 8, pa1); PK4(p1, 0, pa2); PK4(p1, 8, pa3);
#undef PK4
}
template <bool SK>
__device__ __forceinline__ void qkt(f32x16& p0, f32x16& p1, const char* K_lds, int koff, int r32, int hi, const bf16x8* qr, bool act) {
    if (SK && !act) { const float NEG = -__builtin_inff();
#pragma unroll
        for (int r = 0; r < 16; ++r) { p0[r] = NEG; p1[r] = NEG; } return; }
    p0 = f32x16{}; p1 = f32x16{};
    const unsigned kb0 = (unsigned)(uintptr_t)(const LAS char*)(K_lds) + (unsigned)koff + (unsigned)KSWZ(r32, (hi * 8) * 2);
    unsigned kbx[4]; kbx[0] = kb0;
    asm volatile("v_xor_b32 %0, 32, %1" : "=v"(kbx[1]) : "v"(kb0)); asm volatile("v_xor_b32 %0, 64, %1" : "=v"(kbx[2]) : "v"(kb0)); asm volatile("v_xor_b32 %0, 0x60, %1" : "=v"(kbx[3]) : "v"(kb0));
#pragma unroll
    for (int d0 = 0; d0 < 8; ++d0) { const unsigned a = kbx[d0 & 3] + (d0 >> 2) * 128;
        bf16x8 b0 = *(const LAS bf16x8*)(a);
        bf16x8 b1 = *(const LAS bf16x8*)(a + 32 * 256);
        p0 = __builtin_amdgcn_mfma_f32_32x32x16_bf16(b0, qr[d0], p0, 0, 0, 0);
        p1 = __builtin_amdgcn_mfma_f32_32x32x16_bf16(b1, qr[d0], p1, 0, 0, 0); }
}
template <bool SK>
__device__ __forceinline__ void pv_tile(f32x16* o, int vb0  , bf16x8 pa0, bf16x8 pa1, bf16x8 pa2, bf16x8 pa3, bool act) {
    if (SK && !act) return;
#define TRRD(dst, off) asm volatile("ds_read_b64_tr_b16 %0, %1 offset:%2" : "=&v"(dst) : "v"(vb0), "i"(off) : "memory")
#define PV_D0(d0) do { s16x4 l0, l1, l2, l3, h0, h1, h2, h3; constexpr int b_ = v_rd_off(d0, 0, 0); \
        TRRD(l0, b_); TRRD(h0, b_ + 2048); TRRD(l1, b_ + 4096); TRRD(h1, b_ + 6144); TRRD(l2, b_ + 8192); TRRD(h2, b_ + 10240); TRRD(l3, b_ + 12288); TRRD(h3, b_ + 14336); \
        asm volatile("s_waitcnt lgkmcnt(0)" ::: "memory"); SBAR(); \
        o[d0] = __builtin_amdgcn_mfma_f32_32x32x16_bf16((bf16x8){l0[0], l0[1], l0[2], l0[3], h0[0], h0[1], h0[2], h0[3]}, pa0, o[d0], 0, 0, 0);   \
        o[d0] = __builtin_amdgcn_mfma_f32_32x32x16_bf16((bf16x8){l1[0], l1[1], l1[2], l1[3], h1[0], h1[1], h1[2], h1[3]}, pa1, o[d0], 0, 0, 0);   \
        o[d0] = __builtin_amdgcn_mfma_f32_32x32x16_bf16((bf16x8){l2[0], l2[1], l2[2], l2[3], h2[0], h2[1], h2[2], h2[3]}, pa2, o[d0], 0, 0, 0);   \
        o[d0] = __builtin_amdgcn_mfma_f32_32x32x16_bf16((bf16x8){l3[0], l3[1], l3[2], l3[3], h3[0], h3[1], h3[2], h3[3]}, pa3, o[d0], 0, 0, 0); } while (0)
    PV_D0(0); PV_D0(1); PV_D0(2); PV_D0(3);
#undef PV_D0
#undef TRRD
}

__device__ __forceinline__ int fresh_lane() { int t; asm volatile("v_mbcnt_lo_u32_b32 %0, -1, 0\n\tv_mbcnt_hi_u32_b32 %0, -1, %0" : "=v"(t)); return t; }
struct BlockRef { const bf16_t* Q; const bf16_t* K; const bf16_t* V; bf16_t* O; const void* mask; const bf16_t* gate; int P0; int pad; };
struct Seam { bf16x8 qr[8]; bf16x8 st_v0, st_v1, st_k0, st_k1; };
__device__ __forceinline__ int swa_jlo(int P0, int W) { const int lowk = P0 - W + 1; return lowk > 0 ? lowk / KVBLK : 0; }
#define ROW(p, k0, rr) ((p) + (size_t)(k0) * LDP + (unsigned)((rr) * LDP + sc))
#define ROWU(p, k0, c_) ((p) + (size_t)((k0) + (c_)) * LDP + rofs)
#define VMW() asm volatile("s_waitcnt vmcnt(0)" ::: "memory")
#define VMWN(n) asm volatile("s_waitcnt vmcnt(%0)" :: "i"(n) : "memory")
#define SLOAD_H(Kp, Vp, k0) do { const bf16_t* vp_ = opaque_ptr((Vp) + (size_t)(k0) * LDP); const bf16_t* kp_ = opaque_ptr((Kp) + (size_t)(k0) * LDP);   \
                         S.st_v0 = load8(vp_ + rofs); S.st_v1 = load8(vp_ + 32 * LDP + rofs);                                 \
                         S.st_k0 = load8(kp_ + rofs); S.st_k1 = load8(kp_ + 32 * LDP + rofs); } while (0)
#define SWRITE_HK(bo) do { *(bf16x8*)(K_lds + (bo) + kws) = S.st_k0; *(bf16x8*)(K_lds + (bo) + kws + 32 * 256) = S.st_k1; } while (0)
#define SWRITE_HV(bo) do { *(bf16x8*)(V_lds + (bo) + vst0) = S.st_v0; *(bf16x8*)(V_lds + (bo) + vst0 + 8192) = S.st_v1; } while (0)
#define SWRITE_H(bf) do { SWRITE_HV(bf); SWRITE_HK(bf); } while (0)
__device__ __forceinline__ void prime(const BlockRef& cur, int W, char* lds, Seam& S, int wid) {
    const int lane = fresh_lane(), tid = wid * 64 + lane, r32 = lane & 31, hi = lane >> 5;
    const int sr = tid >> 4, sc = (tid & 15) * 8, kws = KSWZ(sr, sc * 2); char* K_lds = lds + NBUF * SHM_V; const unsigned rofs = (unsigned)(sr * LDP + sc) & 0xfffffu;
    const int kb0 = swa_jlo(cur.P0, W) * KVBLK;
    for (int d0 = 0; d0 < 8; ++d0) S.qr[d0] = load8(cur.Q + (unsigned)((wid * QBLK + r32) * LDP + hi * 8) + d0 * 16);
    SLOAD_H(cur.K, cur.V, kb0); VMW(); SWRITE_HK(0);
    __syncthreads();
}
template <int MODE, bool SK>
__device__ __forceinline__ void block(const BlockRef& cur, const BlockRef& nxt, int skv, int W, char* lds, Seam& S, int wid) {
    const int lane = fresh_lane(), tid = wid * 64 + lane, r32 = lane & 31, hi = lane >> 5;
    const int j_lo = swa_jlo(cur.P0, W);
    int j_hi = (cur.P0 + QB - 1) / KVBLK + 1; if (j_hi > skv / KVBLK) j_hi = skv / KVBLK;
    const int NT = j_hi - j_lo;
    const int kbn = swa_jlo(nxt.P0, W) * KVBLK;
    const int qlo = cur.P0 + wid * QBLK, qm = qlo + r32 - 4 * hi;
    char* V_lds = lds; char* K_lds = lds + NBUF * SHM_V;
    float m_reg = -1e30f, l_reg = 0; f32x16 o[4] = {};
    const int sr = tid >> 4, sc = (tid & 15) * 8, vst0 = v_st(sr, sc), kws = KSWZ(sr, sc * 2); const unsigned rofs = (unsigned)(sr * LDP + sc) & 0xfffffu;
    const int vb0 = (int)(uintptr_t)V_lds + v_rd_base(lane);
    const bf16_t* Kh = cur.K; const bf16_t* Vh = cur.V;
    unsigned rowmask = 0xffffffffu;
    if (MODE != 2) { const int l0_ = lane; const int rq_ = wid * QBLK + (l0_ & 31);
        if (MODE == 0) rowmask = ((const unsigned char*)cur.mask)[(unsigned)(rq_ * 8)];
        if (MODE == 1) rowmask = ((const unsigned*)cur.mask)[(unsigned)(rq_ * 2)]; }
    constexpr int BSH = (MODE == 0) ? 8 : 6;
#define RESC(a) do { if (__any((a) < 1.f)) { const float a_ = (a);                                                                   \
                     for (int d_ = 0; d_ < 4; ++d_) for (int r = 0; r < 16; ++r) o[d_][r] *= a_; } } while (0)
#define KBASE(t) ((j_lo + (t)) * KVBLK)
#define ACT(t) (KBASE(t) <= qlo + QBLK - 1 && KBASE(t) + KVBLK - 1 >= qlo - W + 1)
#define MASKT(P0_, P1_, t) do { const int kb_ = KBASE(t); if ((!SK || ACT(t)) && (kb_ + KVBLK - 1 > qlo || kb_ <= qlo + QBLK - 1 - W)) mask_tile(P0_, P1_, qm - kb_, (unsigned)W); \
        if (MODE != 2) { const bool ok_ = (rowmask >> (kb_ >> BSH)) & 1u; if (!__all(ok_)) mask_all(P0_, P1_, ok_); } } while (0)
    constexpr int NQL = 8;
#define SEAM_K0() do { VMWN(NQL); SWRITE_HK(0); SBAR(); } while (0)
    f32x16 pA0, pA1, pB0, pB1; float mnA, mnB, alA, alB; bf16x8 pa0, pa1, pa2, pa3;
    SWRITE_HV(0); SBAR();
    if (NT > 1) { SLOAD_H(Kh, Vh, KBASE(1)); }
    SBAR(); qkt<SK>(pA0, pA1, K_lds, 0, r32, hi, S.qr, ACT(0));
    MASKT(pA0, pA1, 0); partialSM(pA0, pA1, m_reg, mnA, alA);
    if (NT > 1) { VMW(); SWRITE_H(SHM_K); }
    if (NT > 2) { SLOAD_H(Kh, Vh, KBASE(2)); SBAR(); }
    __syncthreads();
    int oc = SHM_K, op = 0, on = 2 * SHM_K;
    const bool lag = wid >= 4;
#define HALF_STEP(PX0, PX1, mnX, alX, PY0, PY1, alY, t) do {                                                                  \
        if ((t) + 1 < NT) { VMW(); SWRITE_H(on); SBAR(); }                                                                    \
        if ((t) + 2 < NT) { SLOAD_H(Kh, Vh, KBASE((t) + 2)); }                                                                \
        SBAR(); qkt<SK>(PX0, PX1, K_lds, oc, r32, hi, S.qr, ACT(t));                                                          \
        finishSM(PY0, PY1, alY, l_reg, pa0, pa1, pa2, pa3); SBAR();                                                           \
        pv_tile<SK>(o, vb0 + op, pa0, pa1, pa2, pa3, ACT((t) - 1));                                                           \
        if (lag) __syncthreads();     \
        MASKT(PX0, PX1, (t)); partialSM(PX0, PX1, m_reg, mnX, alX);                                                           \
        RESC(alX); if (!lag) __syncthreads();                                                                                 \
        op = oc; oc = on; on = (on == 2 * SHM_K) ? 0 : on + SHM_K; } while (0)
    for (int t = 1; t + 1 < NT; t += 2) {
        HALF_STEP(pB0, pB1, mnB, alB, pA0, pA1, alA, t);
        HALF_STEP(pA0, pA1, mnA, alA, pB0, pB1, alB, t + 1);
    }
    const bool even = (NT & 1) == 0;
    if (even) { SBAR(); qkt<SK>(pB0, pB1, K_lds, oc, r32, hi, S.qr, ACT(NT - 1)); SBAR(); }
    SLOAD_H(nxt.K, nxt.V, kbn); SBAR();
    { const int l1_ = fresh_lane(); const unsigned qo_ = (unsigned)((wid * QBLK + (l1_ & 31)) * LDP + (l1_ >> 5) * 8);
#pragma unroll
    for (int d0 = 0; d0 < 8; ++d0) S.qr[d0] = load8(nxt.Q + qo_ + d0 * 16); }
    SBAR();
    finishSM(pA0, pA1, alA, l_reg, pa0, pa1, pa2, pa3); SBAR();
    pv_tile<SK>(o, vb0 + op, pa0, pa1, pa2, pa3, ACT(even ? NT - 2 : NT - 1));
    if (even) { MASKT(pB0, pB1, NT - 1); partialSM(pB0, pB1, m_reg, mnB, alB); __syncthreads(); RESC(alB);
        finishSM(pB0, pB1, alB, l_reg, pa0, pa1, pa2, pa3); SBAR(); pv_tile<SK>(o, vb0 + oc, pa0, pa1, pa2, pa3, ACT(NT - 1)); }
    SBAR(); SEAM_K0();
    { const int le = fresh_lane(); const int r32e = le & 31, hie = le >> 5;
    float sc_ = 1.f / l_reg;
    if (MODE != 0) { const float gl = bf2f(cur.gate[(unsigned)((wid * QBLK + r32e) * LDP)]); sc_ *= fast_sigmoid(gl); }
    char* Ow = (char*)(cur.O + (size_t)(wid * QBLK) * 1024) + (unsigned)(r32e * 2048 + hie * 16);
#pragma unroll
    for (int d0 = 0; d0 < 4; ++d0) {
#pragma unroll
        for (int rp = 0; rp < 2; ++rp) { const int k = d0 * 2 + rp;
            float a0 = o[d0][8 * rp + 0] * sc_, a1 = o[d0][8 * rp + 1] * sc_, a2 = o[d0][8 * rp + 2] * sc_, a3 = o[d0][8 * rp + 3] * sc_;
            float b0 = o[d0][8 * rp + 4] * sc_, b1 = o[d0][8 * rp + 5] * sc_, b2 = o[d0][8 * rp + 6] * sc_, b3 = o[d0][8 * rp + 7] * sc_;
            uint4 w;
            if (MODE == 0) {
                const unsigned ax = cvt_pk_bf16(a0, a1), ay = cvt_pk_bf16(a2, a3), bx = cvt_pk_bf16(b0, b1), by = cvt_pk_bf16(b2, b3);
                auto rx = __builtin_amdgcn_permlane32_swap(ax, bx, false, false); auto ry = __builtin_amdgcn_permlane32_swap(ay, by, false, false);
                w = make_uint4(rx[0], ry[0], rx[1], ry[1]);
            } else {
#define SWP(A_, B_) do { auto r_ = __builtin_amdgcn_permlane32_swap(__float_as_uint(A_), __float_as_uint(B_), false, false); A_ = __uint_as_float(r_[0]); B_ = __uint_as_float(r_[1]); } while (0)
                SWP(a0, b0); SWP(a1, b1); SWP(a2, b2); SWP(a3, b3);
#undef SWP
                const uint4 pw = *(const uint4*)(Ow + k * 32);
                a0 += bf_lo(pw.x); a1 += bf_hi(pw.x); a2 += bf_lo(pw.y); a3 += bf_hi(pw.y);
                b0 += bf_lo(pw.z); b1 += bf_hi(pw.z); b2 += bf_lo(pw.w); b3 += bf_hi(pw.w);
                w = make_uint4(cvt_pk_bf16(a0, a1), cvt_pk_bf16(a2, a3), cvt_pk_bf16(b0, b1), cvt_pk_bf16(b2, b3));
            }
            *(uint4*)(Ow + k * 32) = w; } } }
    __syncthreads();
#undef RESC
#undef KBASE
#undef ACT
#undef MASKT
#undef SEAM_K0
#undef HALF_STEP
}
#undef ROW
#undef ROWU
#undef VMW
#undef VMWN
#undef SLOAD_H
#undef SWRITE_HK
#undef SWRITE_HV
#undef SWRITE_H
#undef KSWZ
#undef SBAR
}
constexpr size_t WS_DUMMY = (size_t)1242 * 1000 * 1000 + 512000;
constexpr size_t WS_MOBAMASK = WS_END2;
constexpr size_t WS_SELMASK = WS_MOBAMASK + al256((size_t)T * 8);
constexpr size_t WS_END3 = WS_SELMASK + al256((size_t)T * 2 * 4);

__device__ __forceinline__ void p_moba_prep(const Frame& F0, int wg0) {
    const Frame F = phase_frame(F0);
    if (F.c < wg0) return;
    const bf16_t* proj = (const bf16_t*)(F.ws + WS_PROJ); unsigned char* mm = (unsigned char*)(F.ws + WS_MOBAMASK);
    LAS float* km = (LAS float*)F.lds;
    LAS float* part = km + 8 * 128;
    for (int u = F.c - wg0; u < NB * 8 * 8; u += F.G - wg0) {
        const int pb = u & 7, h = (u >> 3) & 7, b = u >> 6;
        {
            const int rg = F.tid >> 4, dg = F.tid & 15;
            for (int n = 0; n < pb; ++n) { const bf16_t* kp = proj + ((size_t)b * S + n * 256 + rg * 8) * LDP + P_MK + h * 128 + dg * 8; float a[8];
#pragma unroll
                for (int j = 0; j < 8; ++j) a[j] = 0.f;
#pragma unroll
                for (int r = 0; r < 8; ++r) { const u32x4 kw = *(const u32x4*)(kp + (size_t)r * LDP);
                    a[0] += bf_lo(kw[0]); a[1] += bf_hi(kw[0]); a[2] += bf_lo(kw[1]); a[3] += bf_hi(kw[1]); a[4] += bf_lo(kw[2]); a[5] += bf_hi(kw[2]); a[6] += bf_lo(kw[3]); a[7] += bf_hi(kw[3]); }
                LAS float* pp = part + (n * 32 + rg) * 128 + dg * 8;
                *(LAS f32x4*)pp = (f32x4){a[0], a[1], a[2], a[3]}; *(LAS f32x4*)(pp + 4) = (f32x4){a[4], a[5], a[6], a[7]}; }
            __syncthreads();
            for (int idx = F.tid; idx < pb * 128; idx += NTHR) { const int n = idx >> 7, d = idx & 127; float a = 0.f;
#pragma unroll 8
                for (int q = 0; q < 32; ++q) a += part[(n * 32 + q) * 128 + d];
                km[n * 128 + d] = a * (1.f / 256.f); }
            __syncthreads();
        }
        const int pos = F.tid >> 1, half = F.tid & 1; const size_t t = (size_t)b * S + pb * 256 + pos;
        float gt[8];
#pragma unroll
        for (int n = 0; n < 8; ++n) gt[n] = 0.f;
        const bf16_t* qp = proj + t * LDP + P_MQ + h * 128 + half * 64;
        for (int c8 = 0; c8 < 8; ++c8) { const u32x4 qw = *(const u32x4*)(qp + c8 * 8);
            const float qf[8] = {bf_lo(qw[0]), bf_hi(qw[0]), bf_lo(qw[1]), bf_hi(qw[1]), bf_lo(qw[2]), bf_hi(qw[2]), bf_lo(qw[3]), bf_hi(qw[3])};
#pragma unroll
            for (int n = 0; n < 8; ++n) if (n < pb) {
#pragma unroll
                for (int j = 0; j < 8; ++j) gt[n] += qf[j] * km[n * 128 + half * 64 + c8 * 8 + j]; } }
        unsigned taken = 0;
#pragma unroll
        for (int n = 0; n < 8; ++n) { gt[n] += __shfl_xor(gt[n], 1); if (n >= pb) gt[n] = -1e30f; }
#pragma unroll
        for (int k = 0; k < 3; ++k) { int best = -1; float bv = 0.f;
#pragma unroll
            for (int n = 0; n < 8; ++n) if (!((taken >> n) & 1u) && (best < 0 || gt[n] > bv)) { best = n; bv = gt[n]; }
            taken |= 1u << best; }
        unsigned m = (taken & ((1u << pb) - 1u)) | (1u << pb);
        if (half == 0) mm[t * 8 + h] = (unsigned char)m;
        __syncthreads();
    }
}
__device__ __forceinline__ int xcd_item(int i, int n) { return (i & 7) * (n >> 3) + (i >> 3); }
__device__ __forceinline__ att::BlockRef ref_moba(const bf16_t* proj, bf16_t* om, const unsigned char* mm, int L, int pass) {
    const int bh = L >> 2, y = L & 3, b = bh >> 3, h = bh & 7; const int qb = pass ? y : 7 - y;     const size_t t0 = (size_t)b * S + qb * 256;
    att::BlockRef r; r.Q = proj + t0 * LDP + P_MQ + h * 128; r.K = proj + (size_t)b * S * LDP + P_MK + h * 128; r.V = proj + (size_t)b * S * LDP + P_MV + h * 128;
    r.O = om + t0 * 1024 + h * 128; r.mask = mm + t0 * 8 + h; r.gate = nullptr; r.P0 = qb * 256; r.pad = 0; return r; }
template <int BR>
__device__ __forceinline__ att::BlockRef ref_nsa(const bf16_t* proj, bf16_t* on, const unsigned* sm, int L, int pass) {
    const int bh = L >> 2, y = L & 3, b = bh >> 3, h = bh & 7, g = h >> 2; const int qb = pass ? y : 7 - y;     const size_t t0 = (size_t)b * S + qb * 256;
    att::BlockRef r; r.Q = proj + t0 * LDP + P_NQ + h * 128; r.K = proj + (size_t)b * S * LDP + P_NKV + (2 + 2 * BR) * 256 + g * 128; r.V = proj + (size_t)b * S * LDP + P_NKV + (3 + 2 * BR) * 256 + g * 128;
    r.O = on + t0 * 1024 + h * 128; r.mask = sm + t0 * 2 + g; r.gate = proj + t0 * LDP + P_NG + h * 3 + 1 + BR; r.P0 = qb * 256; r.pad = 0; return r; }
template <int WIN, bool DUMMY>
__device__ __forceinline__ void p_moba_attn_t(const Frame& F0) {
    const Frame F = phase_frame(F0);
    const bf16_t* proj = (const bf16_t*)(F.ws + WS_PROJ); bf16_t* om = (bf16_t*)(F.ws + (DUMMY ? WS_DUMMY : WS_OM)); const unsigned char* mm = (const unsigned char*)(F.ws + WS_MOBAMASK);
    const int total = NB * 8 * 8;

    const int nitems = total / 2;
    int L = F.c; if (L >= nitems) return;
    int pass = 0; att::BlockRef cur = ref_moba(proj, om, mm, xcd_item(L, nitems), 0); att::Seam Sm;
    att::prime(cur, WIN, (char*)F.lds, Sm, F.wave);
    for (;;) {
        const bool more_pass = pass == 0, more_item = L + F.G < nitems, last = !more_pass && !more_item;
        int passn = pass + 1, Ln = L; if (!more_pass) { passn = 0; Ln = more_item ? L + F.G : L; }
        const att::BlockRef nxt = last ? cur : ref_moba(proj, om, mm, xcd_item(Ln, nitems), passn);
        att::block<0, false>(cur, nxt, S, WIN, (char*)F.lds, Sm, F.wave);
        if (last) break;
        cur = nxt; pass = passn; L = Ln;
    }
}
__device__ __forceinline__ void p_moba_attn(const Frame& F0) { p_moba_attn_t<(1 << 20), false>(F0); }
template <bool DUMMY>
__device__ __forceinline__ void p_nsa_attn_t(const Frame& F0) {
    const int nitems = NB * 8 * 4;
    if (F0.c >= nitems) return;
    {
        const Frame F = phase_frame(F0);
        const bf16_t* proj = (const bf16_t*)(F.ws + WS_PROJ); bf16_t* on = (bf16_t*)(F.ws + (DUMMY ? WS_DUMMY : WS_ON)); const unsigned* sm = (const unsigned*)(F.ws + WS_SELMASK);

        int L = F.c, pass = 0; att::BlockRef cur = ref_nsa<0>(proj, on, sm, xcd_item(L, nitems), 0); att::Seam Sm;
        att::prime(cur, 1 << 20, (char*)F.lds, Sm, F.wave);
        for (;;) {
            const bool more_pass = pass == 0, more_item = L + F.G < nitems, last = !more_pass && !more_item;
            int passn = pass + 1, Ln = L; if (!more_pass) { passn = 0; Ln = more_item ? L + F.G : L; }
            const att::BlockRef nxt = last ? cur : ref_nsa<0>(proj, on, sm, xcd_item(Ln, nitems), passn);
            att::block<1, false>(cur, nxt, S, 1 << 20, (char*)F.lds, Sm, F.wave);
            if (last) break;
            cur = nxt; pass = passn; L = Ln;
        }
    }
    {
        const Frame F = phase_frame(F0);
        const bf16_t* proj = (const bf16_t*)(F.ws + WS_PROJ); bf16_t* on = (bf16_t*)(F.ws + (DUMMY ? WS_DUMMY : WS_ON)); const unsigned* sm = (const unsigned*)(F.ws + WS_SELMASK);

        int L = F.c, pass = 0; att::BlockRef cur = ref_nsa<1>(proj, on, sm, xcd_item(L, nitems), 0); att::Seam Sm;
        att::prime(cur, 512, (char*)F.lds, Sm, F.wave);
        for (;;) {
            const bool more_pass = pass == 0, more_item = L + F.G < nitems, last = !more_pass && !more_item;
            int passn = pass + 1, Ln = L; if (!more_pass) { passn = 0; Ln = more_item ? L + F.G : L; }
            const att::BlockRef nxt = last ? cur : ref_nsa<1>(proj, on, sm, xcd_item(Ln, nitems), passn);
            att::block<2, false>(cur, nxt, S, 512, (char*)F.lds, Sm, F.wave);
            if (last) break;
            cur = nxt; pass = passn; L = Ln;
        }
    }
}

__device__ __forceinline__ void p_nsa_attn(const Frame& F0) { p_nsa_attn_t<false>(F0); }

constexpr size_t WS_GDS = WS_MERGED;
constexpr size_t WS_GQT = WS_DEC;
constexpr size_t WS_GDL = WS_END3;
constexpr size_t WS_END4 = WS_GDL + al256((size_t)1024 * 128 * 4);

__device__ __forceinline__ void p_gla1(const Frame& F0, int l) {
    const Frame F = phase_frame(F0);
    const bf16_t* proj = (const bf16_t*)(F.ws + WS_PROJ);
    const float* wa = F.in(6) + (size_t)l * 16 * 512; const float* ba = F.in(7) + (size_t)l * 512;
    bf16_t* ogr16 = (bf16_t*)(F.ws + WS_OGRAW); bf16_t* gds = (bf16_t*)(F.ws + WS_GDS); bf16_t* gqt = (bf16_t*)(F.ws + WS_GQT); float* gdl = (float*)(F.ws + WS_GDL);
    LAS bf16_t* bq = (LAS bf16_t*)F.lds;
    LAS bf16_t* bk = bq + 64 * 136;
    LAS bf16_t* bkT = bk + 64 * 136;
    LAS bf16_t* bvT = bkT + 128 * 72;
    LAS bf16_t* rv = bvT + 256 * 72;
    LAS bf16_t* bA = rv;
    LAS float* gs = (LAS float*)(rv + 64 * 256);
    LAS bf16_t* sga = (LAS bf16_t*)(gs + 512);
    const int tid = F.tid, lane = F.lane, w = F.wave, r32 = lane & 31, hh = lane >> 5;
    unsigned* qh = (unsigned*)(F.ws + WS_CTL) + CW_GQ + 64 * l; LAS int* qs = (LAS int*)(F.lds + LDS_MISC + 8192 + 1024);
    if (tid == 0) qs[0] = (int)xb_add(qh, 1u);
    __syncthreads();
    for (int u = __builtin_amdgcn_readfirstlane(qs[0]); u < 1024; u = __builtin_amdgcn_readfirstlane(qs[0])) {
        unsigned nu_ = 0u; if (tid == 0) nu_ = xb_add(qh, 1u);
        const int c = u & 31, h = (u >> 5) & 3, b = u >> 7; const size_t row0 = (size_t)b * S + c * 64;
        {
            u32x4 lq[2], lk[2], lv[4], lg = {0u, 0u, 0u, 0u};
#pragma unroll
            for (int i = 0; i < 2; ++i) { const int ch = i * NTHR + tid, t = ch >> 4, cc = ch & 15; lq[i] = *(const u32x4*)(proj + (row0 + t) * LDP + P_GQ + h * 128 + cc * 8); lk[i] = *(const u32x4*)(proj + (row0 + t) * LDP + P_GK + h * 128 + cc * 8); }
#pragma unroll
            for (int i = 0; i < 4; ++i) { const int ch = i * NTHR + tid, t = ch >> 5, cc = ch & 31; lv[i] = *(const u32x4*)(proj + (row0 + t) * LDP + P_GV + h * 256 + cc * 8); }
            if (tid < 128) lg = *(const u32x4*)(proj + (row0 + (tid >> 1)) * LDP + P_GA + (tid & 1) * 8);
#pragma unroll
            for (int i = 0; i < 2; ++i) { const int ch = i * NTHR + tid, t = ch >> 4, cc = ch & 15; *(LAS u32x4*)(bq + t * 136 + cc * 8) = lq[i]; *(LAS u32x4*)(bk + t * 136 + cc * 8) = lk[i]; }
#pragma unroll
            for (int i = 0; i < 4; ++i) { const int ch = i * NTHR + tid, t = ch >> 5, cc = ch & 31; *(LAS u32x4*)(rv + t * 256 + cc * 8) = lv[i]; }
            if (tid < 128) *(LAS u32x4*)(sga + (tid >> 1) * 16 + (tid & 1) * 8) = lg;
        }
        __syncthreads();
        {
            const int d = tid & 127, tq = tid >> 7, col = h * 128 + d;
            float war[16];
#pragma unroll
            for (int r = 0; r < 16; ++r) war[r] = wa[r * 512 + col];
            const float bias = ba[col];
            float bl[16]; float cum = 0.f;
#pragma unroll
            for (int i = 0; i < 16; ++i) { const LAS bf16_t* gp = sga + (tq * 16 + i) * 16;
                const u32x4 g0 = *(const LAS u32x4*)gp, g1 = *(const LAS u32x4*)(gp + 8);
                float x = bias + bf_lo(g0[0]) * war[0] + bf_hi(g0[0]) * war[1] + bf_lo(g0[1]) * war[2] + bf_hi(g0[1]) * war[3] + bf_lo(g0[2]) * war[4] + bf_hi(g0[2]) * war[5] + bf_lo(g0[3]) * war[6] + bf_hi(g0[3]) * war[7]
                        + bf_lo(g1[0]) * war[8] + bf_hi(g1[0]) * war[9] + bf_lo(g1[1]) * war[10] + bf_hi(g1[1]) * war[11] + bf_lo(g1[2]) * war[12] + bf_hi(g1[2]) * war[13] + bf_lo(g1[3]) * war[14] + bf_hi(g1[3]) * war[15];
                const float ls = fminf(x, 0.f) - 0.6931471805599453f * __builtin_amdgcn_logf(1.f + __builtin_amdgcn_exp2f(-1.4426950408889634f * fabsf(x)));
                cum += ls * (1.f / 16.f); bl[i] = cum; }
            gs[tq * 128 + d] = cum;
            __syncthreads();
            float off = 0.f, tot = 0.f;
#pragma unroll
            for (int q = 0; q < 4; ++q) { const float g = gs[q * 128 + d]; if (q < tq) off += g; tot += g; }
            unsigned kt[8];
#pragma unroll
            for (int i = 0; i < 16; ++i) { const float bt = off + bl[i]; const int t = tq * 16 + i;
                const float qv = bf2f(bq[t * 136 + d]), kv = bf2f(bk[t * 136 + d]);
                const float eb = __builtin_amdgcn_exp2f(1.4426950408889634f * bt);
                bq[t * 136 + d] = f2bf(qv * 0.08838834764831845f * eb); bk[t * 136 + d] = f2bf(kv * __builtin_amdgcn_rcpf(eb));
                const float kh = kv * __builtin_amdgcn_exp2f(1.4426950408889634f * (tot - bt));
                if (i & 1) kt[i >> 1] |= ((unsigned)f2bf(kh)) << 16; else kt[i >> 1] = f2bf(kh); }
            *(LAS u32x4*)(bkT + d * 72 + tq * 16) = (u32x4){kt[0], kt[1], kt[2], kt[3]}; *(LAS u32x4*)(bkT + d * 72 + tq * 16 + 8) = (u32x4){kt[4], kt[5], kt[6], kt[7]};
            if (tq == 0) gdl[(size_t)u * 128 + d] = __builtin_amdgcn_exp2f(1.4426950408889634f * tot);
        }
        {
            const int e = tid & 255, sg = tid >> 8;
#pragma unroll
            for (int q = 0; q < 4; ++q) { unsigned vt[4];
#pragma unroll
                for (int jj = 0; jj < 8; ++jj) { const bf16_t v = rv[(sg * 32 + q * 8 + jj) * 256 + e]; if (jj & 1) vt[jj >> 1] |= ((unsigned)v) << 16; else vt[jj >> 1] = v; }
                *(LAS u32x4*)(bvT + e * 72 + sg * 32 + q * 8) = (u32x4){vt[0], vt[1], vt[2], vt[3]}; }
        }
        __syncthreads();
        for (int i = tid; i < 1024; i += NTHR) { const int t = i >> 4, ch = i & 15; *(u32x4*)(gqt + (row0 + t) * 512 + h * 128 + ch * 8) = *(const LAS u32x4*)(bq + t * 136 + ch * 8); }
        if (w < 3) { const int tt = w == 0 ? 0 : 1, ss = w == 2 ? 1 : 0; f32x16 acc = {};
#pragma unroll
            for (int ks = 0; ks < 8; ++ks) { const bf16x8 a = *(const LAS bf16x8*)(bq + (tt * 32 + r32) * 136 + ks * 16 + hh * 8), bb = *(const LAS bf16x8*)(bk + (ss * 32 + r32) * 136 + ks * 16 + hh * 8);
                acc = __builtin_amdgcn_mfma_f32_32x32x16_bf16(a, bb, acc, 0, 0, 0); }
#pragma unroll
            for (int i = 0; i < 16; ++i) { const int t = tt * 32 + (i & 3) + 8 * (i >> 2) + 4 * hh, s = ss * 32 + r32; bA[t * 72 + s] = f2bf(t >= s ? acc[i] : 0.f); } }
        else if (w == 3) {
#pragma unroll
            for (int i = 0; i < 16; ++i) { const int t = (i & 3) + 8 * (i >> 2) + 4 * hh; bA[t * 72 + 32 + r32] = 0; } }
        __syncthreads();
        {
            f32x16 o0 = {}, o1 = {}, s0 = {}, s1 = {}, s2 = {}, s3 = {};
#pragma unroll
            for (int ks = 0; ks < 4; ++ks) { const bf16x8 vf = *(const LAS bf16x8*)(bvT + (w * 32 + r32) * 72 + ks * 16 + hh * 8);
                const bf16x8 a0 = *(const LAS bf16x8*)(bA + r32 * 72 + ks * 16 + hh * 8), a1 = *(const LAS bf16x8*)(bA + (32 + r32) * 72 + ks * 16 + hh * 8);
                o0 = __builtin_amdgcn_mfma_f32_32x32x16_bf16(a0, vf, o0, 0, 0, 0); o1 = __builtin_amdgcn_mfma_f32_32x32x16_bf16(a1, vf, o1, 0, 0, 0);
                const bf16x8 k0 = *(const LAS bf16x8*)(bkT + r32 * 72 + ks * 16 + hh * 8), k1 = *(const LAS bf16x8*)(bkT + (32 + r32) * 72 + ks * 16 + hh * 8),
                             k2 = *(const LAS bf16x8*)(bkT + (64 + r32) * 72 + ks * 16 + hh * 8), k3 = *(const LAS bf16x8*)(bkT + (96 + r32) * 72 + ks * 16 + hh * 8);
                s0 = __builtin_amdgcn_mfma_f32_32x32x16_bf16(k0, vf, s0, 0, 0, 0); s1 = __builtin_amdgcn_mfma_f32_32x32x16_bf16(k1, vf, s1, 0, 0, 0);
                s2 = __builtin_amdgcn_mfma_f32_32x32x16_bf16(k2, vf, s2, 0, 0, 0); s3 = __builtin_amdgcn_mfma_f32_32x32x16_bf16(k3, vf, s3, 0, 0, 0); }
#pragma unroll
            for (int i = 0; i < 16; ++i) { const int rr = (i & 3) + 8 * (i >> 2) + 4 * hh;
                ogr16[(row0 + rr) * 1024 + h * 256 + w * 32 + r32] = f2bf(o0[i]); ogr16[(row0 + 32 + rr) * 1024 + h * 256 + w * 32 + r32] = f2bf(o1[i]); }
            { unsigned char* dp = (unsigned char*)gds + ((size_t)u * 256 + w * 32 + r32) * 128 + hh * 8;
#define GST(SJ, j_) do { _Pragma("unroll") for (int rp = 0; rp < 2; ++rp) {                                                                                  \
                const unsigned a_ = pack_fp8x4(SJ[8 * rp + 0] * 4.f, SJ[8 * rp + 1] * 4.f, SJ[8 * rp + 2] * 4.f, SJ[8 * rp + 3] * 4.f);                          \
                const unsigned b_ = pack_fp8x4(SJ[8 * rp + 4] * 4.f, SJ[8 * rp + 5] * 4.f, SJ[8 * rp + 6] * 4.f, SJ[8 * rp + 7] * 4.f);                          \
                auto r_ = __builtin_amdgcn_permlane32_swap(a_, b_, false, false);                                                                           \
                *(u32x2*)(dp + ((j_) * 2 + rp) * 16) = (u32x2){r_[0], r_[1]}; } } while (0)
              GST(s0, 0); GST(s1, 1); GST(s2, 2); GST(s3, 3);
#undef GST
            }
        }
        if (tid == 0) qs[0] = (int)nu_;
        __syncthreads();
    }
}
__device__ __forceinline__ void p_gla2(const Frame& F0) {
    const Frame F = phase_frame(F0);
    unsigned char* gds = F.ws + WS_GDS; const float* gdl = (const float*)(F.ws + WS_GDL);
    for (int i = F.c * NTHR + F.tid; i < 32 * 4096; i += F.G * NTHR) {
        const int bh = i >> 12, e = (i >> 4) & 255, dg = i & 15;
        float st[8];
#pragma unroll
        for (int j = 0; j < 8; ++j) st[j] = 0.f;
        unsigned char* p = gds + ((size_t)bh * 32 * 256 + e) * 128 + dg * 8; const float* dp = gdl + (size_t)bh * 32 * 128 + dg * 8;
        u32x2 dsv = *(const u32x2*)p; f32x4 d0 = *(const f32x4*)dp, d1 = *(const f32x4*)(dp + 4);
        for (int c = 0; c < 32; ++c) {
            u32x2 dsn = dsv; f32x4 e0 = d0, e1 = d1;
            if (c + 1 < 32) { dsn = *(const u32x2*)(p + (size_t)256 * 128); e0 = *(const f32x4*)(dp + 128); e1 = *(const f32x4*)(dp + 132); }
            *(u32x2*)p = (u32x2){pack_fp8x4(st[0] * 4.f, st[1] * 4.f, st[2] * 4.f, st[3] * 4.f), pack_fp8x4(st[4] * 4.f, st[5] * 4.f, st[6] * 4.f, st[7] * 4.f)};
            const f32x2 i0 = __builtin_amdgcn_cvt_pk_f32_fp8((int)dsv[0], false), i1 = __builtin_amdgcn_cvt_pk_f32_fp8((int)dsv[0], true), i2 = __builtin_amdgcn_cvt_pk_f32_fp8((int)dsv[1], false), i3 = __builtin_amdgcn_cvt_pk_f32_fp8((int)dsv[1], true);
            st[0] = d0[0] * st[0] + i0[0] * 0.25f; st[1] = d0[1] * st[1] + i0[1] * 0.25f; st[2] = d0[2] * st[2] + i1[0] * 0.25f; st[3] = d0[3] * st[3] + i1[1] * 0.25f;
            st[4] = d1[0] * st[4] + i2[0] * 0.25f; st[5] = d1[1] * st[5] + i2[1] * 0.25f; st[6] = d1[2] * st[6] + i3[0] * 0.25f; st[7] = d1[3] * st[7] + i3[1] * 0.25f;
            dsv = dsn; d0 = e0; d1 = e1; p += (size_t)256 * 128; dp += 128; }
    }
}
__device__ __forceinline__ void p_gla3(const Frame& F0, int l) {
    const Frame F = phase_frame(F0);
    const bf16_t* proj = (const bf16_t*)(F.ws + WS_PROJ); const float* ng = F.in(8) + (size_t)l * 256;
    const bf16_t* ogr16 = (const bf16_t*)(F.ws + WS_OGRAW); const bf16_t* gds = (const bf16_t*)(F.ws + WS_GDS); const bf16_t* gqt = (const bf16_t*)(F.ws + WS_GQT); bf16_t* og = (bf16_t*)(F.ws + WS_OG);
    LAS float* ot = (LAS float*)F.lds;
    const int lane = F.lane, w = F.wave, r32 = lane & 31, hh = lane >> 5;
    const f32x4 gn = *(const f32x4*)(ng + lane * 4);
    for (int u = F.c; u < 1024; u += F.G) {
        const int c = u & 31, h = (u >> 5) & 3, b = u >> 7; const size_t row0 = (size_t)b * S + c * 64;
        f32x16 o0 = {}, o1 = {};
        f32x4 og4[8];
#pragma unroll
        for (int q = 0; q < 8; ++q) { const u32x2 ow = *(const u32x2*)(ogr16 + (row0 + w * 8 + q) * 1024 + h * 256 + lane * 4); og4[q] = (f32x4){bf_lo(ow[0]), bf_hi(ow[0]), bf_lo(ow[1]), bf_hi(ow[1])}; }
#pragma unroll
        for (int ks = 0; ks < 8; ++ks) { const u32x2 s8 = *(const u32x2*)((const unsigned char*)gds + ((size_t)u * 256 + w * 32 + r32) * 128 + ks * 16 + hh * 8);
            const f32x2 q0 = __builtin_amdgcn_cvt_pk_f32_fp8((int)s8[0], false), q1 = __builtin_amdgcn_cvt_pk_f32_fp8((int)s8[0], true), q2 = __builtin_amdgcn_cvt_pk_f32_fp8((int)s8[1], false), q3 = __builtin_amdgcn_cvt_pk_f32_fp8((int)s8[1], true);
            u32x4 sw = {cvt_pk_bf16(q0[0], q0[1]), cvt_pk_bf16(q1[0], q1[1]), cvt_pk_bf16(q2[0], q2[1]), cvt_pk_bf16(q3[0], q3[1])};
            const bf16x8 sf = __builtin_bit_cast(bf16x8, sw);
            const bf16x8 a0 = *(const bf16x8*)(gqt + (row0 + r32) * 512 + h * 128 + ks * 16 + hh * 8), a1 = *(const bf16x8*)(gqt + (row0 + 32 + r32) * 512 + h * 128 + ks * 16 + hh * 8);
            o0 = __builtin_amdgcn_mfma_f32_32x32x16_bf16(a0, sf, o0, 0, 0, 0); o1 = __builtin_amdgcn_mfma_f32_32x32x16_bf16(a1, sf, o1, 0, 0, 0); }
        u32x2 gw[8];
#pragma unroll
        for (int q = 0; q < 8; ++q) gw[q] = *(const u32x2*)(proj + (row0 + w * 8 + q) * LDP + P_GG + h * 256 + lane * 4);
#pragma unroll
        for (int i = 0; i < 16; ++i) { const int rr = (i & 3) + 8 * (i >> 2) + 4 * hh;
            ot[rr * 260 + w * 32 + r32] = o0[i] * 0.25f;
            ot[(32 + rr) * 260 + w * 32 + r32] = o1[i] * 0.25f; }
        __syncthreads();
#pragma unroll
        for (int q = 0; q < 8; ++q) { const int t = w * 8 + q; const f32x4 v = *(const LAS f32x4*)(ot + t * 260 + lane * 4) + og4[q];
            float ss = v[0] * v[0] + v[1] * v[1] + v[2] * v[2] + v[3] * v[3];
#pragma unroll
            for (int o = 32; o > 0; o >>= 1) ss += __shfl_xor(ss, o);
            const float rstd = rsqrtf(ss * (1.f / 256.f) + 1e-6f);
            u32x2 ov; ov[0] = cvt_pk_bf16(v[0] * rstd * gn[0] * fast_silu(bf_lo(gw[q][0])), v[1] * rstd * gn[1] * fast_silu(bf_hi(gw[q][0])));
            ov[1] = cvt_pk_bf16(v[2] * rstd * gn[2] * fast_silu(bf_lo(gw[q][1])), v[3] * rstd * gn[3] * fast_silu(bf_hi(gw[q][1])));
            *(u32x2*)(og + (row0 + t) * 1024 + h * 256 + lane * 4) = ov; }
        __syncthreads();
    }
}

constexpr size_t WS_CHID = WS_GDL + al256((size_t)1024 * 128 * 4);
constexpr size_t WS_KC   = WS_CHID + al256((size_t)2 * 2048 * 256 * 2);
constexpr size_t WS_VCT  = WS_KC + al256((size_t)16 * 128 * 128 * 2);
constexpr size_t WS_CP   = WS_VCT + al256((size_t)16 * 128 * 128 * 2);
constexpr size_t WS_BIAS1P = WS_CP + al256((size_t)2 * 2048 * 256 * 2);
constexpr size_t WS_END5 = WS_BIAS1P + al256((size_t)NL * 2 * 32 * 128 * 4);
constexpr size_t WS_CP32 = WS_END5;
constexpr size_t WS_END6 = WS_CP32 + al256((size_t)4 * 2 * 2048 * 256 * 4);


__device__ __forceinline__ void p_conv_cmp(const Frame& F0) {
    const Frame F = phase_frame(F0);
    const float* pe = F.in(3); const float* w1 = F.in(4); const float* w2 = F.in(5);
    bf16_t* wc2 = (bf16_t*)(F.ws + WS_WC2); float* bias1 = (float*)(F.ws + WS_BIAS1);
    for (int i = F.c * NTHR + F.tid; i < NL * 2 * 256 * 256; i += F.G * NTHR) { const int k = i & 255, n = (i >> 8) & 255, lc = i >> 16;
        wc2[i] = (k < 128 && n < 128) ? f2bf(w2[((size_t)lc * 128 + k) * 128 + n]) : (bf16_t)0; }
    LAS float* part = (LAS float*)F.lds; float* bp = (float*)(F.ws + WS_BIAS1P);
    for (int task = F.c; task < NL * 2 * 32; task += F.G) { const int lc = task >> 5, ch = task & 31; const int o = F.tid & 127, ig = F.tid >> 7; float a = 0.f;
        const size_t i0 = (size_t)lc * 4096 + ch * 128 + ig * 32;
#pragma unroll 8
        for (int i = 0; i < 32; ++i) a += pe[i0 + i] * w1[(i0 + i) * 128 + o];
        part[ig * 128 + o] = a; __syncthreads();
        if (F.tid < 128) bp[(size_t)task * 128 + F.tid] = part[F.tid] + part[128 + F.tid] + part[256 + F.tid] + part[384 + F.tid];
        __syncthreads(); }
}
struct SchedCmp1 {
    static constexpr bool GATHER = true;
    const char* proj; const char* W; int G, c;
    __device__ __forceinline__ bool next(int i, ge::Unit& u) const { const int L = i * G + c; if (L >= 16) return false; const int cc = L >> 3, pm = L & 7;
        u.A = proj + (size_t)(P_NKV + cc * 256) * 2; u.B = W + (size_t)cc * 256 * 2048 * 2; u.r0 = pm * 256; u.c0 = 0; u.aux = cc; u.aux2 = 0; return true; }
    __device__ __forceinline__ void voffA(const ge::Unit& u, int tid, unsigned (&v)[2][2]) const {
#pragma unroll
        for (int i = 0; i < 2; ++i) { int R, C; ge::stage_rc(tid * 16 + i * 8192, R, C);
#pragma unroll
            for (int hf = 0; hf < 2; ++hf) { const int r = u.r0 + hf * 128 + R; const int b = r >> 8, g = (r >> 7) & 1, m = r & 127;
                v[hf][i] = (unsigned)(((b * S + 16 * m) * LDP + g * 128 + C)) * 2u; } } }
};
struct EpiCmp1 {
    static constexpr bool PERM = true; bf16_t* P;
    __device__ __forceinline__ void operator()(const f32x4 (&acc)[2][2][4][2], const ge::Unit& u, int wr, int wc, int fr, int fq) const {
#pragma unroll
        for (int ai = 0; ai < 2; ++ai)
#pragma unroll
            for (int m = 0; m < 4; ++m) { bf16_t* rowp = P + ((size_t)u.aux * 2048 + u.r0 + ai * 128 + wr * 64 + m * 16 + fr) * 256 + wc * 32 + 8 * fq;
#pragma unroll
                for (int bj = 0; bj < 2; ++bj) { const f32x4 v0 = acc[ai][bj][m][0], v1 = acc[ai][bj][m][1]; u32x4 w = {cvt_pk_bf16(v0[0], v0[1]), cvt_pk_bf16(v0[2], v0[3]), cvt_pk_bf16(v1[0], v1[1]), cvt_pk_bf16(v1[2], v1[3])};
                    *(u32x4*)(rowp + bj * 128) = w; } }
    }
};
struct SchedCmp2 {
    static constexpr bool GATHER = false;
    const char* hid; const char* W; int G, c;
    __device__ __forceinline__ bool next(int i, ge::Unit& u) const { const int L = i * G + c; if (L >= 16) return false; const int cc = L >> 3, pm = L & 7;
        u.A = hid + ((size_t)cc * 2048 + pm * 256) * 256 * 2; u.B = W + (size_t)cc * 256 * 256 * 2; u.r0 = pm * 256; u.c0 = 0; u.aux = cc; u.aux2 = 0; return true; }
    __device__ __forceinline__ void voffA(const ge::Unit&, int tid, unsigned (&v)[2][2]) const { ge::dense_voffA(256, tid, v); }
};
struct EpiCmp2 {
    static constexpr bool PERM = false; bf16_t* kc; bf16_t* vct;
    __device__ __forceinline__ void operator()(const f32x4 (&acc)[2][2][4][2], const ge::Unit& u, int wr, int wc, int fr, int fq) const {
#pragma unroll
        for (int ai = 0; ai < 2; ++ai)
#pragma unroll
            for (int m = 0; m < 4; ++m) { const int r = u.r0 + ai * 128 + wr * 64 + m * 16 + fr; const int bg = r >> 7, n = r & 127;
#pragma unroll
                for (int nn = 0; nn < 2; ++nn) { const int d = wc * 32 + nn * 16 + 4 * fq; const f32x4 v = acc[ai][0][m][nn];
                    if (u.aux == 0) { u32x2 w = {cvt_pk_bf16(v[0], v[1]), cvt_pk_bf16(v[2], v[3])}; *(u32x2*)(kc + ((size_t)bg * 128 + n) * 128 + d) = w; }
                    else {
#pragma unroll
                        for (int j = 0; j < 4; ++j) vct[((size_t)bg * 128 + d + j) * 128 + n] = f2bf(v[j]); } } }
    }
};
struct SchedCmp1S {
    static constexpr bool GATHER = true;
    const char* proj; const char* W; int c;
    __device__ __forceinline__ bool next(int i, ge::Unit& u) const { if (i != 0 || c >= CMP_WGS) return false; const int x = c & 7, j = c >> 3, tile = 2 * x + (j >> 2), kq = j & 3, cc = tile >> 3, pm = tile & 7;
        u.A = proj + (size_t)(P_NKV + cc * 256) * 2 + (size_t)kq * 4 * LDP * 2; u.B = W + (size_t)cc * 256 * 2048 * 2 + (size_t)kq * 512 * 2; u.r0 = pm * 256; u.c0 = 0; u.aux = cc; u.aux2 = kq; return true; }
    __device__ __forceinline__ void voffA(const ge::Unit& u, int tid, unsigned (&v)[2][2]) const {
#pragma unroll
        for (int i = 0; i < 2; ++i) { int R, C; ge::stage_rc(tid * 16 + i * 8192, R, C);
#pragma unroll
            for (int hf = 0; hf < 2; ++hf) { const int r = u.r0 + hf * 128 + R; const int b = r >> 8, g = (r >> 7) & 1, m = r & 127;
                v[hf][i] = (unsigned)(((b * S + 16 * m) * LDP + g * 128 + C)) * 2u; } } }
};
struct EpiCmp1S {
    static constexpr bool PERM = true; float* P;
    __device__ __forceinline__ void operator()(const f32x4 (&acc)[2][2][4][2], const ge::Unit& u, int wr, int wc, int fr, int fq) const {
#pragma unroll
        for (int ai = 0; ai < 2; ++ai)
#pragma unroll
            for (int m = 0; m < 4; ++m) { float* rowp = P + ((size_t)(u.aux2 * 2 + u.aux) * 2048 + u.r0 + ai * 128 + wr * 64 + m * 16 + fr) * 256 + wc * 32 + 8 * fq;
#pragma unroll
                for (int bj = 0; bj < 2; ++bj) { *(f32x4*)(rowp + bj * 128) = acc[ai][bj][m][0]; *(f32x4*)(rowp + bj * 128 + 4) = acc[ai][bj][m][1]; } }
    }
};
struct SchedCmp2S {
    static constexpr bool GATHER = true;
    const char* hid; const char* W; int c;
    __device__ __forceinline__ bool next(int i, ge::Unit& u) const { if (i != 0 || c >= CMP_WGS) return false; const int x = c & 7, j = c >> 3, tile = 2 * x + (j >> 2), kq = j & 3, cc = tile >> 3, pm = tile & 7;
        u.A = hid + ((size_t)cc * 2048 + pm * 256 + kq * 64) * 256 * 2; u.B = W + (size_t)cc * 256 * 256 * 2; u.r0 = pm * 256 + kq * 64; u.c0 = 0; u.aux = cc; u.aux2 = 0; return true; }
    __device__ __forceinline__ void voffA(const ge::Unit&, int tid, unsigned (&v)[2][2]) const {
#pragma unroll
        for (int i = 0; i < 2; ++i) { int R, C; ge::stage_rc(tid * 16 + i * 8192, R, C);
#pragma unroll
            for (int hf = 0; hf < 2; ++hf) v[hf][i] = (unsigned)((R & 63) * 256 + C) * 2u; } }
};
struct EpiCmp2S {
    static constexpr bool PERM = false; bf16_t* kc; bf16_t* vct;
    __device__ __forceinline__ void operator()(const f32x4 (&acc)[2][2][4][2], const ge::Unit& u, int wr, int wc, int fr, int fq) const {
        if (wr != 0) return;
#pragma unroll
        for (int m = 0; m < 4; ++m) { const int r = u.r0 + m * 16 + fr; const int bg = r >> 7, n = r & 127;
#pragma unroll
            for (int nn = 0; nn < 2; ++nn) { const int d = wc * 32 + nn * 16 + 4 * fq; const f32x4 v = acc[0][0][m][nn];
                if (u.aux == 0) { u32x2 w = {cvt_pk_bf16(v[0], v[1]), cvt_pk_bf16(v[2], v[3])}; *(u32x2*)(kc + ((size_t)bg * 128 + n) * 128 + d) = w; }
                else {
#pragma unroll
                    for (int j = 0; j < 4; ++j) vct[((size_t)bg * 128 + d + j) * 128 + n] = f2bf(v[j]); } } }
    }
};
__device__ __forceinline__ void p_nsa_cmp(const Frame& F0, int l) {
    const Frame F = phase_frame(F0);
    if (F.c >= CMP_WGS) return;
    const int x_ = F.c & 7, j_ = F.c >> 3, tile = 2 * x_ + (j_ >> 2), kq = j_ & 3, cc = tile >> 3, pm = tile & 7;
    LAS float* biasL = (LAS float*)(F.lds + LDS_MISC + 8192);
    if (F.tid < 128) { const int o = F.tid; const float* bp = (const float*)(F.ws + WS_BIAS1P) + ((size_t)(l * 2 + cc) * 32) * 128 + o; float a = 0.f;
#pragma unroll 8
        for (int ch = 0; ch < 32; ++ch) a += bp[ch * 128]; biasL[o] = a; }
    __syncthreads();
    { SchedCmp1S S{(const char*)(F.ws + WS_PROJ), (const char*)(F.ws + WS_WC1) + (size_t)l * 2 * 256 * 2048 * 2, F.c};
      EpiCmp1S E{(float*)(F.ws + WS_CP32)};
      ge::gemm_phase<EpiCmp1S, SchedCmp1S, 1>(F.lds, F.tid, 512, LDP * 2, S, E, 2048); }
    asm volatile("s_waitcnt vmcnt(0)" ::: "memory"); __syncthreads();
    if (F.tid == 0) { unsigned* bar = (unsigned*)(F.ws + WS_CTL); unsigned* fl = bar + CW_CMPF + 64 * (l * 16 + tile);
        __builtin_amdgcn_fence(__ATOMIC_RELEASE, "agent"); asm volatile("s_waitcnt vmcnt(0)" ::: "memory");
        (void)xb_add(fl, 1u);
        XB_SPIN(xb_ld(fl) < 4u, bar);
        __builtin_amdgcn_fence(__ATOMIC_ACQUIRE, "agent"); asm volatile("s_waitcnt vmcnt(0)" ::: "memory"); }
    __syncthreads();
    {
        const float* P = (const float*)(F.ws + WS_CP32); bf16_t* hid = (bf16_t*)(F.ws + WS_CHID);
        for (int idx = F.tid; idx < 64 * 16; idx += NTHR) { const int row = kq * 64 + (idx >> 4), ch = idx & 15; const size_t r = (size_t)cc * 2048 + pm * 256 + row;
            u32x4 w = {0u, 0u, 0u, 0u};
            if ((row & 127) != 127) { f32x4 s0 = *(const LAS f32x4*)(biasL + ch * 8), s1 = *(const LAS f32x4*)(biasL + ch * 8 + 4);
#pragma unroll
                for (int q = 0; q < 4; ++q) { const float* pq = P + ((size_t)q * 2 * 2048 + r) * 256 + ch * 8;
                    s0 += *(const f32x4*)pq + *(const f32x4*)(pq + 256 + 128); s1 += *(const f32x4*)(pq + 4) + *(const f32x4*)(pq + 256 + 128 + 4); }
                w[0] = cvt_pk_bf16(fast_silu(s0[0]), fast_silu(s0[1])); w[1] = cvt_pk_bf16(fast_silu(s0[2]), fast_silu(s0[3]));
                w[2] = cvt_pk_bf16(fast_silu(s1[0]), fast_silu(s1[1])); w[3] = cvt_pk_bf16(fast_silu(s1[2]), fast_silu(s1[3])); }
            *(u32x4*)(hid + r * 256 + ch * 8) = w; *(u32x4*)(hid + r * 256 + 128 + ch * 8) = (u32x4){0u, 0u, 0u, 0u}; }
    }
    asm volatile("s_waitcnt vmcnt(0)" ::: "memory"); __syncthreads();
    { SchedCmp2S S{(const char*)(F.ws + WS_CHID), (const char*)(F.ws + WS_WC2) + (size_t)l * 2 * 256 * 256 * 2, F.c};
      EpiCmp2S E{(bf16_t*)(F.ws + WS_KC), (bf16_t*)(F.ws + WS_VCT)};
      ge::gemm_phase<EpiCmp2S, SchedCmp2S, 0>(F.lds, F.tid, 256, 0, S, E); }
}

__device__ __forceinline__ void p_nsa_cmpsel(const Frame& F0) {
    const Frame F = phase_frame(F0);
    const bf16_t* proj = (const bf16_t*)(F.ws + WS_PROJ); const bf16_t* kc = (const bf16_t*)(F.ws + WS_KC); const bf16_t* vct = (const bf16_t*)(F.ws + WS_VCT);
    bf16_t* on = (bf16_t*)(F.ws + WS_ON); unsigned* selm = (unsigned*)(F.ws + WS_SELMASK);
    LAS float* gl = (LAS float*)F.lds + F.wave * 32;
    const int lane = F.lane, w = F.wave, r32 = lane & 31, hi = lane >> 5;
    for (int u = F.c; u < NB * 2 * 32; u += F.G) {
        const int pb = u & 31, g = (u >> 5) & 1, b = u >> 6; const int bg = b * 2 + g;
        const int p = pb * 64 + w * 8 + (r32 >> 2), hd = g * 4 + (r32 & 3); const size_t t = (size_t)b * S + p;
        bf16x8 qf[8];
#pragma unroll
        for (int d0 = 0; d0 < 8; ++d0) qf[d0] = *(const bf16x8*)(proj + t * LDP + P_NQ + hd * 128 + d0 * 16 + hi * 8);
        f32x16 sc[4];
#pragma unroll
        for (int kt = 0; kt < 4; ++kt) { sc[kt] = f32x16{};
#pragma unroll
            for (int d0 = 0; d0 < 8; ++d0) { const bf16x8 kf = *(const bf16x8*)(kc + ((size_t)bg * 128 + kt * 32 + r32) * 128 + d0 * 16 + hi * 8);
                sc[kt] = __builtin_amdgcn_mfma_f32_32x32x16_bf16(kf, qf[d0], sc[kt], 0, 0, 0); } }
        const int nmax = p >= 31 ? (p - 31) >> 4 : -1;
        float mx = -1e30f;
#pragma unroll
        for (int kt = 0; kt < 4; ++kt)
#pragma unroll
            for (int i = 0; i < 16; ++i) { const int n = kt * 32 + (i & 3) + 8 * (i >> 2) + 4 * hi; const float s = n <= nmax ? sc[kt][i] * 0.08838834764831845f : -__builtin_inff(); sc[kt][i] = s; mx = fmaxf(mx, s); }
        mx = fmaxf(mx, __shfl_xor(mx, 32));
        float sum = 0.f;
#pragma unroll
        for (int kt = 0; kt < 4; ++kt)
#pragma unroll
            for (int i = 0; i < 16; ++i) { const float e = __expf(sc[kt][i] - mx); sc[kt][i] = e; sum += e; }
        sum += __shfl_xor(sum, 32);
        const float inv = sum > 0.f ? 1.f / sum : 0.f;
#pragma unroll
        for (int kt = 0; kt < 4; ++kt)
#pragma unroll
            for (int i = 0; i < 16; ++i) sc[kt][i] *= inv;
        f32x16 oc[4] = {};
#pragma unroll
        for (int kt = 0; kt < 4; ++kt) { bf16x8 pa0, pa1;
#define PK4(P, B_, OUT) do { unsigned a0 = cvt_pk_bf16(P[B_+0], P[B_+1]), a1 = cvt_pk_bf16(P[B_+2], P[B_+3]); unsigned b0 = cvt_pk_bf16(P[B_+4], P[B_+5]), b1 = cvt_pk_bf16(P[B_+6], P[B_+7]); \
        auto r0 = __builtin_amdgcn_permlane32_swap(a0, b0, false, false); auto r1 = __builtin_amdgcn_permlane32_swap(a1, b1, false, false); u32x4 w_ = {r0[0], r1[0], r0[1], r1[1]}; OUT = *reinterpret_cast<bf16x8*>(&w_); } while (0)
            PK4(sc[kt], 0, pa0); PK4(sc[kt], 8, pa1);
#undef PK4
#pragma unroll
            for (int dt = 0; dt < 4; ++dt) { const bf16x8 v0 = *(const bf16x8*)(vct + ((size_t)bg * 128 + dt * 32 + r32) * 128 + kt * 32 + hi * 8), v1 = *(const bf16x8*)(vct + ((size_t)bg * 128 + dt * 32 + r32) * 128 + kt * 32 + 16 + hi * 8);
                oc[dt] = __builtin_amdgcn_mfma_f32_32x32x16_bf16(pa0, v0, oc[dt], 0, 0, 0); oc[dt] = __builtin_amdgcn_mfma_f32_32x32x16_bf16(pa1, v1, oc[dt], 0, 0, 0); } }
        if (hi == 0) gl[r32] = fast_sigmoid(bf2f(proj[t * LDP + P_NG + hd * 3]));
        asm volatile("s_waitcnt lgkmcnt(0)" ::: "memory");
#pragma unroll
        for (int i = 0; i < 16; ++i) { const int rr = (i & 3) + 8 * (i >> 2) + 4 * hi; const float gt = gl[rr];
            const size_t tt = (size_t)b * S + pb * 64 + w * 8 + (rr >> 2); const int hh = g * 4 + (rr & 3);
#pragma unroll
            for (int dt = 0; dt < 4; ++dt) { const float v = oc[dt][i] * gt, vn = __shfl_xor(v, 1);
                if ((r32 & 1) == 0) *(unsigned*)(on + tt * 1024 + hh * 128 + dt * 32 + r32) = cvt_pk_bf16(v, vn); } }
#pragma unroll
        for (int kt = 0; kt < 4; ++kt)
#pragma unroll
            for (int i = 0; i < 16; ++i) { float v = sc[kt][i]; v += __shfl_xor(v, 1); v += __shfl_xor(v, 2); sc[kt][i] = v; }
        float imp[16];
#pragma unroll
        for (int kt = 0; kt < 4; ++kt)
#pragma unroll
            for (int q = 0; q < 4; ++q) { const float gsum = sc[kt][4 * q] + sc[kt][4 * q + 1] + sc[kt][4 * q + 2] + sc[kt][4 * q + 3];
                const float lastown = sc[kt][4 * q + 3]; const float lastprev = (kt * 4 + q) > 0 ? sc[(kt * 4 + q - 1) >> 2][4 * ((kt * 4 + q - 1) & 3) + 3] : 0.f;
                const float fromp_same = __shfl_xor(lastown, 32), fromp_prev = __shfl_xor(lastprev, 32);
                imp[kt * 4 + q] = gsum + (hi ? fromp_same : fromp_prev); }
        const int cb = p >> 6;
#pragma unroll
        for (int s_ = 0; s_ < 16; ++s_) { const int j = 8 * (s_ >> 2) + 2 * (s_ & 3) + hi; if (j == 0 || j == cb || j == cb - 1) imp[s_] = 1e9f; if (j > cb) imp[s_] = -1e30f; }
        unsigned mask = 0;
#pragma unroll
        for (int k = 0; k < 8; ++k) { float bv = -__builtin_inff(); int bj = 64;
#pragma unroll
            for (int s_ = 0; s_ < 16; ++s_) { const int j = 8 * (s_ >> 2) + 2 * (s_ & 3) + hi; if (imp[s_] > bv) { bv = imp[s_]; bj = j; } }
            const float ov = __shfl_xor(bv, 32); const int oj = __shfl_xor(bj, 32);
            const bool mine = (bv > ov) || (bv == ov && bj < oj); const int wj = mine ? bj : oj;
            mask |= 1u << wj;
#pragma unroll
            for (int s_ = 0; s_ < 16; ++s_) { const int j = 8 * (s_ >> 2) + 2 * (s_ & 3) + hi; if (j == wj) imp[s_] = -__builtin_inff(); } }
        if ((r32 & 3) == 0 && hi == 0) selm[t * 2 + g] = mask;
    }
}
constexpr int NSTEP = 1 + 11 * NL;

#ifdef DIAG_A
__device__ __forceinline__ void diag_stamp(const Frame& F, int k) {
    if (F.c == 0 && F.tid == 0) { LAS long long* st = (LAS long long*)(F.lds + LDS_MISC + 4096); const long long now = wall_clock64(); const long long d = now - st[0]; st[0] = now;
        if (k == DIAG_A) st[1] = d; if (k == DIAG_B) st[2] = d; }
}
#endif
template <int l>
__device__ __forceinline__ void layer_steps(const Frame& F, const XcdBarrier& bar, const int lo, const int hi) {
#define IN(k) (lo <= (k) && (k) < hi)
#ifdef DIAG_A
#define SEAM(k) do { if (IN(k) && IN((k) + 1)) { xcd_barrier(bar); diag_stamp(F, (k)); } } while (0)
#else
#define SEAM(k) do { if (IN(k) && IN((k) + 1)) xcd_barrier(bar); } while (0)
#endif
    const int base = 1 + 11 * l;
    if (IN(base + 0)) { p_inproj(F, l);
#ifdef PROBE_INPROJ
        p_inproj(F, l);
#endif
#ifdef PROBE_INPROJ_NULL8
        p_inproj_null8(F, l);
#endif
#ifdef PROBE_INPROJ_LONGK
        p_inproj_longk(F, l);
#endif
#ifdef PROBE_INPROJ_SAME
        p_inproj_same(F, l);
#endif
#ifdef PROBE_INPROJ_NULL
        p_inproj_null(F, l);
#endif
    } SEAM(base + 0);
    if (IN(base + 1)) { p_nsa_cmp(F, l); p_moba_prep(F, F.G > CMP_WGS ? CMP_WGS : 0); p_gla1(F, l);
#ifdef PROBE_S1
        p_nsa_cmp(F, l); p_moba_prep(F, 16); p_gla1(F, l);
#endif
#ifdef PROBE_GLA1
        p_gla1(F, l);
#endif
#ifdef PROBE_MOBAPREP
        p_moba_prep(F, 16);
#endif
#ifdef PROBE_NSACMP
        p_nsa_cmp(F, l);
#endif
    } SEAM(base + 1);
    if (IN(base + 2)) { p_moba_attn(F);
#ifdef PROBE_MOBA
        p_moba_attn(F);
#endif
#ifdef PROBE_MOBA512
        p_moba_attn_t<512, true>(F);
#endif
#ifdef PROBE_MOBAFULL
        p_moba_attn_t<(1 << 20), true>(F);
#endif
        p_nsa_cmpsel(F); p_gla2(F); } SEAM(base + 2);
    if (IN(base + 3)) {
#ifndef PROBE_SKIP_NSA
        p_nsa_attn(F);
#endif
        p_gla3(F, l);
#ifdef PROBE_NSADUMMY
        p_nsa_attn_t<true>(F);
#endif
#ifdef PROBE_GLA3
        p_gla3(F, l);
#endif
    } SEAM(base + 3);
    if (IN(base + 4)) { p_merge(F, l);
#ifdef PROBE_MERGE
        p_merge(F, l);
#endif
    } SEAM(base + 4);
    if (IN(base + 5)) { p_wout(F, l); } SEAM(base + 5);
    if (IN(base + 6)) { p_route1<MOE_F8 && l >= MOE_F8_FROM>(F, l); p_conv_experts<MOE_F8 && l >= MOE_F8_FROM, 2>(F, l);
#ifdef PROBE_ROUTE1DRY
        p_route1<MOE_F8 && l >= MOE_F8_FROM, true>(F, l);
#endif
#ifdef PROBE_CONVX
        p_conv_experts<MOE_F8 && l >= MOE_F8_FROM, 0>(F, l);
#endif
    }
    if (IN(base + 6) && IN(base + 8)) xcd_barrier(bar);
    if (IN(base + 8)) { p_moe_gu<MOE_F8 && l >= MOE_F8_FROM>(F, l);
#ifdef PROBE_GU
        p_moe_gu<MOE_F8 && l >= MOE_F8_FROM>(F, l);
#endif
    } SEAM(base + 8);
    if (IN(base + 9)) { p_moe_down<MOE_F8 && l >= MOE_F8_FROM>(F, l);
#ifdef PROBE_DOWN
        p_moe_down<MOE_F8 && l >= MOE_F8_FROM>(F, l);
#endif
#ifdef PROBE_DOWN_NULL
        p_moe_down_null<MOE_F8 && l >= MOE_F8_FROM>(F, l);
#endif
    } SEAM(base + 9);
    if (IN(base + 10)) { if (l + 1 < NL) p_combine<0>(F, l + 1, l); else p_combine<1>(F, 0, l);
#ifdef PROBE_COMBINEDRY
        if (l + 1 < NL) { p_combine<0, true>(F, l + 1, l); p_combine<0, true>(F, l + 1, l); }
#endif
    }
    if (l + 1 < NL) SEAM(base + 10);
#undef SEAM
#undef IN
}

__global__ void __launch_bounds__(NTHR, 2) k_fwd(Args args) {
    extern __shared__ __attribute__((aligned(16))) unsigned char lds_raw[];
    Frame F; F.lds = (LAS unsigned char*)lds_raw; F.tid = threadIdx.x; F.lane = F.tid & 63; F.wave = __builtin_amdgcn_readfirstlane(F.tid >> 6);
    F.G = gridDim.x; F.c = blockIdx.x; F.ws = args.ws;
    if (F.tid == 0) {
#pragma unroll
        for (int i = 0; i < 22; ++i) *(LAS unsigned long long*)(F.lds + LDS_ARGS + i * 8) = (unsigned long long)args.in[i];
        *(LAS unsigned long long*)(F.lds + LDS_ARGS + 22 * 8) = (unsigned long long)args.out;
        *(LAS unsigned long long*)(F.lds + LDS_XB) = 0ull; *(LAS unsigned long long*)(F.lds + LDS_XB + 8) = 0ull;
    }
    __syncthreads();
    const int lo = args.ph_lo, hi = args.ph_hi;
    XcdBarrier bar; bar.bar = (unsigned*)(args.ws + WS_CTL) + CW_BAR; bar.x = 0; bar.st = (volatile LAS unsigned*)(F.lds + LDS_XB);
    if (hi - lo > 1) bar = xcd_barrier_post((unsigned*)(args.ws + WS_CTL) + CW_BAR, (volatile LAS unsigned*)(F.lds + LDS_XB));
#ifdef DIAG_A
    {
        const u32x4* src = (const u32x4*)(args.ws + (size_t)256 * 1024 * 1024); unsigned acc_ = 0;
        for (size_t i = (size_t)F.c * NTHR + F.tid; i < (size_t)768 * 1024 * 1024 / 16; i += (size_t)F.G * NTHR) { const u32x4 v = src[i]; acc_ ^= v[0] ^ v[1] ^ v[2] ^ v[3]; }
        asm volatile("" :: "v"(acc_)); xcd_barrier(bar);
    }
    if (F.c == 0 && F.tid == 0) { LAS long long* st = (LAS long long*)(F.lds + LDS_MISC + 4096); st[0] = wall_clock64(); st[1] = 0; st[2] = 0; }
#endif
    if (lo <= 0 && 0 < hi) {
#if INPROJ_F8 == 3
        p_conv_win_i8(F);
#endif
#if INPROJ_F8 == 3
        p_conv_small(F);
#else
        p_conv_static(F);
#endif
        p_conv_router(F); p_conv_cmp(F); p_rmsnorm(F, 0);
#ifdef PROBE_CONV
        p_conv_static(F);
#endif
 if (1 < hi) xcd_barrier(bar); }
    layer_steps<0>(F, bar, lo, hi);
    layer_steps<1>(F, bar, lo, hi);
#ifdef DIAG_A
    xcd_barrier(bar); diag_stamp(F, 22);
    if (F.c == 0 && F.tid == 0) { LAS long long* st = (LAS long long*)(F.lds + LDS_MISC + 4096);
        const float ua = (float)st[1] * 0.01f, ub = (float)st[2] * 0.01f;
        args.out[0] = ua > 1.f ? __expf(floorf(__logf(ua) / 0.10f + 0.5f) * 0.10f) : 0.f;
        args.out[1] = ub > 1.f ? __expf(floorf(__logf(ub) / 0.10f + 0.5f) * 0.10f) : 0.f; }
#endif
#ifdef PROBE_BARS
    for (int i = 0; i < 20; ++i) xcd_barrier(bar);
#endif
#ifdef DIAG_MODE
    xcd_barrier(bar);
    if (F.c == 0 && F.tid == 0) args.out[0] = *(LAS float*)(F.lds + LDS_MISC + 4000);
#endif
}

static int g_grid = 0;
extern "C" void kernel_launch(void* const* d_in, const int* in_sizes, int n_in,
                              void* d_out, int out_size, void* d_ws, size_t ws_size,
                              hipStream_t stream) {
    if (g_grid == 0) {
        int dev = 0, cus = 0; (void)hipGetDevice(&dev); (void)hipDeviceGetAttribute(&cus, hipDeviceAttributeMultiprocessorCount, dev);
        (void)hipFuncSetAttribute((const void*)k_fwd, hipFuncAttributeMaxDynamicSharedMemorySize, LDS_BYTES);
        int per_cu = 0; (void)hipOccupancyMaxActiveBlocksPerMultiprocessor(&per_cu, (const void*)k_fwd, NTHR, LDS_BYTES);
        g_grid = (cus > 0 ? cus : 256) * (per_cu >= 1 ? 1 : 1);
    }
    if (ws_size < WS_END6 || ws_size < WS_NEED || WS_END6 > WS_H8) return;
    Args a{}; for (int i = 0; i < 22; ++i) a.in[i] = (const float*)d_in[i];
    a.out = (float*)d_out; a.ws = (unsigned char*)d_ws;
    (void)hipMemsetAsync((unsigned char*)d_ws + WS_CTL, 0, CTL_BYTES, stream);

#ifdef MULTI_LAUNCH
    for (int s = 0; s < NSTEP; ++s) { a.ph_lo = s; a.ph_hi = s + 1; hipLaunchKernelGGL(k_fwd, dim3(g_grid), dim3(NTHR), LDS_BYTES, stream, a); }
#else
    a.ph_lo = 0; a.ph_hi = NSTEP;
    hipLaunchKernelGGL(k_fwd, dim3(g_grid), dim3(NTHR), LDS_BYTES, stream, a);
#endif
}
```

```cpp
#define INPROJ_F8 3
#include <hip/hip_runtime.h>
#include <hip/hip_bf16.h>
#include <stdint.h>
#include <math.h>

constexpr int D=2048, NB=8, S=2048, T=NB*S, NL=2;
constexpr int INW=14888;
constexpr int O_MQ=0,O_MK=1024,O_MV=2048,O_NQ=3072,O_NKV=4096,O_NG=5632,O_GQ=5656,O_GK=6168,O_GV=6680,O_GA=7704,O_GG=7720,O_MG=8744;
using f32x16 = __attribute__((ext_vector_type(16))) float;
using f32x4  = __attribute__((ext_vector_type(4))) float;
using bf16x8 = __attribute__((ext_vector_type(8))) short;
#define LAS __attribute__((address_space(3)))
typedef unsigned short bf16_t;
typedef unsigned u32x4 __attribute__((ext_vector_type(4)));
typedef unsigned u32x2 __attribute__((ext_vector_type(2)));
typedef float f32x2 __attribute__((ext_vector_type(2)));

__device__ __forceinline__ unsigned cvt_pk_bf16(float lo, float hi) { unsigned r; asm volatile("v_cvt_pk_bf16_f32 %0, %1, %2" : "=v"(r) : "v"(lo), "v"(hi)); return r; }
__device__ __forceinline__ float bf_lo(unsigned w) { return __uint_as_float(w << 16); }
__device__ __forceinline__ float bf_hi(unsigned w) { return __uint_as_float(w & 0xffff0000u); }
__device__ __forceinline__ float bf2f(bf16_t b) { return __uint_as_float(((unsigned)b) << 16); }
__device__ __forceinline__ bf16_t f2bf(float f) { unsigned u = __float_as_uint(f); u += 0x7FFFu + ((u >> 16) & 1u); return (bf16_t)(u >> 16); }
__device__ __forceinline__ float fast_sigmoid(float x) { return __builtin_amdgcn_rcpf(1.f + __builtin_amdgcn_exp2f(-1.4426950408889634f * x)); }
__device__ __forceinline__ float fast_silu(float x) { return x * fast_sigmoid(x); }

#ifndef GE_SP2_DEFAULT
#define GE_SP2_DEFAULT true
#endif
#ifndef GE_ALIGN_DEFAULT
#define GE_ALIGN_DEFAULT true
#endif
namespace ge {
constexpr int BM = 256, BK = 64, HALF = 128, HTB = HALF * BK * 2, STAGE_BYTES = 8 * HTB, NXCD = 8, WGM = 4;
__host__ __device__ __forceinline__ int lds_byte(int r, int c) { const int st = (r >> 4) * 2 + (c >> 5), rr = r & 15, cc = c & 31, ob = rr * 64 + cc * 2; return st * 1024 + (ob ^ (((ob >> 9) & 1) << 5)); }
__host__ __device__ __forceinline__ void stage_rc(int b, int& R, int& C) { const int st = b / 1024, sb = b % 1024, swz = sb ^ (((sb >> 9) & 1) << 5); R = (st >> 1) * 16 + swz / 64; C = (st & 1) * 32 + (swz % 64) / 2; }
__host__ __device__ __forceinline__ int perm32(int rho) { const int n = rho >> 4, i = rho & 15; return 8 * (i >> 2) + 4 * n + (i & 3); }

typedef int i32x8 __attribute__((ext_vector_type(8)));
typedef int i32x4 __attribute__((ext_vector_type(4)));
__device__ __forceinline__ i32x8 cat8(bf16x8 a, bf16x8 b) { const i32x4 x = *reinterpret_cast<i32x4*>(&a), y = *reinterpret_cast<i32x4*>(&b); return (i32x8){x[0], x[1], x[2], x[3], y[0], y[1], y[2], y[3]}; }
constexpr int F8_SCALE_A = 0x7B7B7B7B, F8_SCALE_B = 0x76767676;
struct Unit { const char* A; const char* B; int r0; int c0; int aux; int aux2; };

__device__ __forceinline__ bool static_tile(int i, int G, int c, int nM, int nN, int& pm, int& pn) {
    const int nwg = nM * nN; const long L = (long)i * G + c; if (L >= nwg) return false;
    int wgid = (int)L; { const int q = nwg / NXCD, r = nwg % NXCD, xcd = wgid % NXCD, off = wgid / NXCD; wgid = (xcd < r ? xcd * (q + 1) : r * (q + 1) + (xcd - r) * q) + off; }
    const int nig = WGM * nN, gid = wgid / nig, fm = gid * WGM, gsz = (nM - fm) < WGM ? (nM - fm) : WGM;
    pm = fm + ((wgid % nig) % gsz); pn = (wgid % nig) / gsz; return true;
}

template <class S, class = void> struct sched_waits { static constexpr bool value = false; };
template <class E, class = void> struct epi_inplace { static constexpr bool value = false; };
template <class E> struct epi_inplace<E, decltype((void)E::INPLACE)> { static constexpr bool value = true; };
template <class S> struct sched_waits<S, decltype((void)S::WAITS)> { static constexpr bool value = true; };
template <class Epi, class Sched, int KMODE, bool F8 = false, bool SP2 = GE_SP2_DEFAULT, bool ALIGN_EPI = GE_ALIGN_DEFAULT, int SCALE_A = F8_SCALE_A, bool I8 = false>
__device__ __forceinline__ void gemm_phase(LAS unsigned char* lds, const int tid_in, const int K, const int kbig, const Sched& S, const Epi& E, const int ldb_ = 0) {
    const int KB_ = ldb_ ? ldb_ : K;
    int tid_ = tid_in; asm volatile("" : "+v"(tid_));
    const int tid = tid_, wid = __builtin_amdgcn_readfirstlane(tid >> 6), lane = tid & 63, wr = wid >> 2, wc = wid & 3, fr = lane & 15, fq = lane >> 4;
    constexpr bool BYTE = F8 || I8;
    const int nt = BYTE ? K / 128 : K / BK;
    unsigned voffB[2];
#pragma unroll
    for (int i = 0; i < 2; ++i) { int R, C; stage_rc(tid * 16 + i * 8192, R, C); const int Rb = Epi::PERM ? ((R & ~31) + perm32(R & 31)) : R; voffB[i] = BYTE ? (unsigned)(Rb * KB_ + C * 2) : (unsigned)(Rb * KB_ + C) * 2u; }
    const size_t hstepB = BYTE ? (size_t)HALF * KB_ : (size_t)HALF * KB_ * 2;
    const unsigned ldsw = (unsigned)wid * 1024u;
    const int aoff = F8 ? lds_byte(wr * 64 + fr, fq * 16) : lds_byte(wr * 64 + fr, fq * 8), boff = F8 ? lds_byte(wc * 32 + fr, fq * 16) : lds_byte(wc * 32 + fr, fq * 8);
    const int aoff1 = F8 ? lds_byte(wr * 64 + fr, fq * 16 + 8) - aoff : 1024, boff1 = F8 ? lds_byte(wc * 32 + fr, fq * 16 + 8) - boff : 1024;
#define GE_KOFF(t) (KMODE == 0 ? (size_t)(t) * 128 : (size_t)((t) >> 1) * (size_t)kbig + (size_t)((t) & 1) * 128)
#define GE_SA(b, h) (((b) * 2 + (h)) * HTB)
#define GE_SB(b, h) ((4 + (b) * 2 + (h)) * HTB)
#define GE_STAGE_B(bufoff, gbase) do { _Pragma("unroll") for (int _i = 0; _i < 2; ++_i) \
        __builtin_amdgcn_global_load_lds((const unsigned*)((const char*)(gbase) + voffB[_i]), (LAS unsigned*)(lds + (bufoff) + ldsw + _i * 8192), 16, 0, 0); } while (0)
#define GE_STAGE_A(bufoff, gbase, v0, v1) do { \
        __builtin_amdgcn_global_load_lds((const unsigned*)((const char*)(gbase) + (v0)), (LAS unsigned*)(lds + (bufoff) + ldsw), 16, 0, 0); \
        __builtin_amdgcn_global_load_lds((const unsigned*)((const char*)(gbase) + (v1)), (LAS unsigned*)(lds + (bufoff) + ldsw + 8192), 16, 0, 0); } while (0)
#define GE_LDA(dst, b, h) do { _Pragma("unroll") for (int m = 0; m < 4; ++m) _Pragma("unroll") for (int k = 0; k < 2; ++k) dst[m][k] = *(const LAS bf16x8*)(lds + GE_SA(b, h) + aoff + m * 2048 + k * aoff1); } while (0)
#define GE_LDB(dst, b, h) do { _Pragma("unroll") for (int n = 0; n < 2; ++n) _Pragma("unroll") for (int k = 0; k < 2; ++k) dst[n][k] = *(const LAS bf16x8*)(lds + GE_SB(b, h) + boff + n * 2048 + k * boff1); } while (0)
#define GE_MMA(ai, bj, At, Bt) do { __builtin_amdgcn_s_setprio(1); _Pragma("unroll") for (int m = 0; m < 4; ++m) _Pragma("unroll") for (int n = 0; n < 2; ++n) { \
        if constexpr (F8) { const i32x8 b8_ = ge::cat8(Bt[n][0], Bt[n][1]), a8_ = ge::cat8(At[m][0], At[m][1]); \
              \
            asm volatile("v_mfma_scale_f32_16x16x128_f8f6f4 %0, %1, %2, %0, %3, %4 op_sel_hi:[0,0,0]" : "+v"(acc[ai][bj][m][n]) : "v"(b8_), "v"(a8_), "v"(f8sb), "v"(f8sa)); } \
        else if constexpr (I8) { ge::i32x4 ci_ = __builtin_bit_cast(ge::i32x4, acc[ai][bj][m][n]); \
            _Pragma("unroll") for (int k = 0; k < 2; ++k) ci_ = __builtin_amdgcn_mfma_i32_16x16x64_i8(__builtin_bit_cast(ge::i32x4, Bt[n][k]), __builtin_bit_cast(ge::i32x4, At[m][k]), ci_, 0, 0, 0); \
            acc[ai][bj][m][n] = __builtin_bit_cast(f32x4, ci_); } \
        else { _Pragma("unroll") for (int k = 0; k < 2; ++k) acc[ai][bj][m][n] = __builtin_amdgcn_mfma_f32_16x16x32_bf16(Bt[n][k], At[m][k], acc[ai][bj][m][n], 0, 0, 0); } } \
        if constexpr (F8) asm volatile("s_nop 7" ::: "memory"); \
        __builtin_amdgcn_s_setprio(0); } while (0)
#define GE_WAIT_V(n) asm volatile("s_waitcnt vmcnt(" #n ")" ::: "memory")
#define GE_WAIT_L(n) asm volatile("s_waitcnt lgkmcnt(" #n ")" ::: "memory")
#define GE_BAR __builtin_amdgcn_s_barrier()
#define GE_SCHED __builtin_amdgcn_sched_barrier(0)
    Unit cur, nxt; int ui = 0;
    if (!S.next(0, cur)) return;
    int f8sa = SCALE_A, f8sb = F8_SCALE_B; if constexpr (F8) asm volatile("" : "+v"(f8sa), "+v"(f8sb));
    f32x4 acc[2][2][4][2];
#pragma unroll
    for (int a = 0; a < 2; ++a)
#pragma unroll
        for (int b = 0; b < 2; ++b)
#pragma unroll
            for (int m = 0; m < 4; ++m)
#pragma unroll
                for (int n = 0; n < 2; ++n) acc[a][b][m][n] = (f32x4){0.f, 0.f, 0.f, 0.f};
    bf16x8 At[4][2], B0[2][2], B1[2][2];
    unsigned va[2][2], vn[2][2];
    S.voffA(cur, tid, va);
    const char* cA = cur.A; const char* cB = cur.B;
    if constexpr (sched_waits<Sched>::value) S.a_ready(cur);
    if constexpr (SP2) {
        GE_STAGE_B(GE_SB(0, 0), cB); GE_STAGE_B(GE_SB(0, 1), cB + hstepB); GE_STAGE_A(GE_SA(0, 0), cA, va[0][0], va[0][1]); GE_STAGE_A(GE_SA(0, 1), cA, va[1][0], va[1][1]);
        if (wr == 1) GE_BAR;
        GE_WAIT_V(2); GE_BAR;
        GE_STAGE_B(GE_SB(1, 0), cB + 128); GE_STAGE_A(GE_SA(1, 0), cA + GE_KOFF(1), va[0][0], va[0][1]); GE_STAGE_B(GE_SB(1, 1), cB + hstepB + 128);
        GE_WAIT_V(6); GE_BAR;
    } else {
    GE_STAGE_B(GE_SB(0, 0), cB); GE_STAGE_A(GE_SA(0, 0), cA, va[0][0], va[0][1]); GE_STAGE_B(GE_SB(0, 1), cB + hstepB); GE_STAGE_A(GE_SA(0, 1), cA, va[1][0], va[1][1]);
    if (wr == 1) GE_BAR;
    GE_WAIT_V(4); GE_BAR;
    GE_STAGE_B(GE_SB(1, 0), cB + 128); GE_STAGE_A(GE_SA(1, 0), cA + GE_KOFF(1), va[0][0], va[0][1]); GE_STAGE_B(GE_SB(1, 1), cB + hstepB + 128);
    GE_WAIT_V(6); GE_BAR;
    }
    for (;;) {
        const bool has_next = S.next(ui + 1, nxt);
        if constexpr (Sched::GATHER) { if (has_next) S.voffA(nxt, tid, vn); else { vn[0][0] = va[0][0]; vn[0][1] = va[0][1]; vn[1][0] = va[1][0]; vn[1][1] = va[1][1]; } }
        const char* nA = has_next ? nxt.A : cA; const char* nB = has_next ? nxt.B : cB;
        for (int t = 0; t < nt; t += 2) {
            const bool last = (t == nt - 2);
            const char* a1 = cA + GE_KOFF(t + 1);
            const char* a2 = last ? nA : cA + GE_KOFF(t + 2); const char* b2 = last ? nB : cB + (size_t)(t + 2) * 128;
            const char* a3 = last ? nA + GE_KOFF(1) : cA + GE_KOFF(t + 3); const char* b3 = b2 + 128;
            unsigned w00 = va[0][0], w01 = va[0][1], w10 = va[1][0], w11 = va[1][1];
            if constexpr (Sched::GATHER) { if (last) { w00 = vn[0][0]; w01 = vn[0][1]; w10 = vn[1][0]; w11 = vn[1][1]; } }
            if constexpr (sched_waits<Sched>::value) { if (last && has_next) S.a_ready(nxt); }
            if constexpr (SP2) {
            GE_LDB(B0, 0, 0); GE_LDB(B1, 0, 1); GE_SCHED; GE_LDA(At, 0, 0); GE_STAGE_A(GE_SA(1, 1), a1, va[1][0], va[1][1]);
            GE_WAIT_V(8); GE_WAIT_L(0); GE_BAR; GE_MMA(0, 0, At, B0); GE_MMA(0, 1, At, B1); GE_BAR; GE_SCHED;
            GE_LDA(At, 0, 1); GE_STAGE_B(GE_SB(0, 0), b2); GE_STAGE_B(GE_SB(0, 1), b2 + hstepB); GE_STAGE_A(GE_SA(0, 0), a2, w00, w01);
            GE_WAIT_V(8); GE_WAIT_L(0); GE_BAR; GE_MMA(1, 0, At, B0); GE_MMA(1, 1, At, B1); GE_BAR; GE_SCHED;
            GE_LDB(B0, 1, 0); GE_LDB(B1, 1, 1); GE_SCHED; GE_LDA(At, 1, 0); GE_STAGE_A(GE_SA(0, 1), a2, w10, w11);
            GE_WAIT_V(8); GE_WAIT_L(0); GE_BAR; GE_MMA(0, 0, At, B0); GE_MMA(0, 1, At, B1); GE_BAR; GE_SCHED;
            GE_LDA(At, 1, 1); GE_STAGE_B(GE_SB(1, 0), b3); GE_STAGE_B(GE_SB(1, 1), b3 + hstepB); GE_STAGE_A(GE_SA(1, 0), a3, w00, w01);
            GE_WAIT_V(8); GE_WAIT_L(0); GE_BAR; GE_MMA(1, 0, At, B0); GE_MMA(1, 1, At, B1); GE_BAR; GE_SCHED;
            } else {
            GE_LDB(B0, 0, 0); GE_SCHED; GE_LDA(At, 0, 0); GE_STAGE_A(GE_SA(1, 1), a1, va[1][0], va[1][1]);
            GE_WAIT_L(8); GE_BAR; GE_WAIT_L(0); GE_MMA(0, 0, At, B0); GE_BAR; GE_SCHED;
            GE_LDB(B1, 0, 1); GE_STAGE_B(GE_SB(0, 0), b2);
            GE_BAR; GE_WAIT_L(0); GE_MMA(0, 1, At, B1); GE_BAR;
            GE_LDA(At, 0, 1); GE_STAGE_A(GE_SA(0, 0), a2, w00, w01);
            GE_BAR; GE_WAIT_L(0); GE_MMA(1, 0, At, B0); GE_BAR; GE_SCHED;
            GE_STAGE_B(GE_SB(0, 1), b2 + hstepB);
            GE_WAIT_V(6); GE_BAR; GE_MMA(1, 1, At, B1); GE_BAR;
            GE_LDB(B0, 1, 0); GE_SCHED; GE_LDA(At, 1, 0); GE_STAGE_A(GE_SA(0, 1), a2, w10, w11);
            GE_WAIT_L(8); GE_BAR; GE_WAIT_L(0); GE_MMA(0, 0, At, B0); GE_BAR; GE_SCHED;
            GE_LDB(B1, 1, 1); GE_STAGE_B(GE_SB(1, 0), b3);
            GE_BAR; GE_WAIT_L(0); GE_MMA(0, 1, At, B1); GE_BAR;
            GE_LDA(At, 1, 1); GE_STAGE_A(GE_SA(1, 0), a3, w00, w01);
            GE_BAR; GE_WAIT_L(0); GE_MMA(1, 0, At, B0); GE_BAR; GE_SCHED;
            GE_STAGE_B(GE_SB(1, 1), b3 + hstepB);
            GE_WAIT_V(6); GE_BAR; GE_MMA(1, 1, At, B1); GE_BAR;
            }
        }
        if constexpr (ALIGN_EPI) { if (wr == 0) GE_BAR; }
        if constexpr (I8) {
#pragma unroll
            for (int a = 0; a < 2; ++a)
#pragma unroll
                for (int b = 0; b < 2; ++b)
#pragma unroll
                    for (int m = 0; m < 4; ++m)
#pragma unroll
                        for (int n = 0; n < 2; ++n) { const ge::i32x4 ci_ = __builtin_bit_cast(ge::i32x4, acc[a][b][m][n]); acc[a][b][m][n] = (f32x4){(float)ci_[0], (float)ci_[1], (float)ci_[2], (float)ci_[3]}; } }
        bool keep_acc = false;
        if constexpr (epi_inplace<Epi>::value) keep_acc = E.inplace(acc, cur, wr, wc, fr, fq); else E(acc, cur, wr, wc, fr, fq);
        if (!has_next) break;
        if (!keep_acc) {
#pragma unroll
        for (int a = 0; a < 2; ++a)
#pragma unroll
            for (int b = 0; b < 2; ++b)
#pragma unroll
                for (int m = 0; m < 4; ++m)
#pragma unroll
                    for (int n = 0; n < 2; ++n) acc[a][b][m][n] = (f32x4){0.f, 0.f, 0.f, 0.f};
        }
        cur = nxt; cA = nA; cB = nB; ++ui;
        if constexpr (Sched::GATHER) { va[0][0] = vn[0][0]; va[0][1] = vn[0][1]; va[1][0] = vn[1][0]; va[1][1] = vn[1][1]; }
        if constexpr (ALIGN_EPI) { if (wr == 1) GE_BAR; }
    }
    GE_WAIT_V(0);
    if constexpr (!ALIGN_EPI) { if (wr == 0) GE_BAR; }
    GE_BAR;
#undef GE_KOFF
#undef GE_SA
#undef GE_SB
#undef GE_STAGE_A
#undef GE_STAGE_B
#undef GE_LDA
#undef GE_LDB
#undef GE_MMA
#undef GE_WAIT_V
#undef GE_WAIT_L
#undef GE_BAR
#undef GE_SCHED
}

template <bool F8 = false>
__device__ __forceinline__ void dense_voffA(int lda, int tid, unsigned (&v)[2][2]) {
#pragma unroll
    for (int i = 0; i < 2; ++i) { int R, C; stage_rc(tid * 16 + i * 8192, R, C); v[0][i] = F8 ? (unsigned)(R * lda + C * 2) : (unsigned)(R * lda + C) * 2u; v[1][i] = F8 ? (unsigned)((R + HALF) * lda + C * 2) : (unsigned)((R + HALF) * lda + C) * 2u; }
}
}
#define XB_TMO      128
#define XB_XCNT(j)  (256  + 64 * (j))
#define XB_XSUB(j)  (1280 + 64 * (j))
#define XB_XGEN(j)  (2304 + 64 * (j))
#define XB_TOP      3328
#define XB_TOPGEN   3392
#define XCD_BAR_WORDS 3456
#define XB_SPIN_CAP (1u << 18)

__device__ __forceinline__ unsigned xb_ld(unsigned* p)              { return __hip_atomic_load(p, __ATOMIC_RELAXED, __HIP_MEMORY_SCOPE_AGENT); }
__device__ __forceinline__ unsigned xb_add(unsigned* p, unsigned v) { return __hip_atomic_fetch_add(p, v, __ATOMIC_RELAXED, __HIP_MEMORY_SCOPE_AGENT); }
__device__ __forceinline__ unsigned xb_xcc_id() { return (unsigned)__builtin_amdgcn_s_getreg((3 << 11) | 20) & 0xFu; }
#define XB_SPIN(cond, bar) do { unsigned _sp = 0; while (cond) { __builtin_amdgcn_s_sleep(1); \
    if ((++_sp & 255u) == 0u) { if (xb_ld(&(bar)[XB_TMO])) break; if (_sp > XB_SPIN_CAP) { atomicAdd(&(bar)[XB_TMO], 1u); break; } } } } while (0)

struct XcdBarrier {
    unsigned* bar; unsigned x;
    volatile LAS unsigned* st;
};

__device__ __forceinline__ XcdBarrier xcd_barrier_post(unsigned* bar, volatile LAS unsigned* st) {
    XcdBarrier b; b.bar = bar; b.x = xb_xcc_id(); b.st = st;
    if (threadIdx.x == 0) (void)xb_add(&bar[XB_XCNT(b.x)], 1u);
    return b;
}
__device__ __forceinline__ void xcd_barrier_complete(unsigned* bar, unsigned x, unsigned& nloc, unsigned& nx) {
    const unsigned G = gridDim.x * gridDim.y * gridDim.z;
    unsigned sum, cnt, mine, sp = 0u;
    for (;;) {
        sum = 0u; cnt = 0u; mine = 0u;
#pragma unroll
        for (unsigned j = 0; j < 16; ++j) { const unsigned c = xb_ld(&bar[XB_XCNT(j)]); sum += c; cnt += (c > 0u) ? 1u : 0u; mine = (j == x) ? c : mine; }
        if (sum == G) break;
        __builtin_amdgcn_s_sleep(1);
        if ((++sp & 255u) == 0u) { if (xb_ld(&bar[XB_TMO])) break; if (sp > XB_SPIN_CAP) { atomicAdd(&bar[XB_TMO], 1u); break; } }
    }
    nloc = mine > 0u ? mine : 1u; nx = cnt > 0u ? cnt : 1u;
}

__device__ __forceinline__ void xcd_barrier(const XcdBarrier& b) {
    asm volatile("s_waitcnt vmcnt(0)" ::: "memory");
    __syncthreads();
    if (threadIdx.x == 0) {
        unsigned* bar = b.bar;
        __builtin_amdgcn_s_waitcnt(0);
        unsigned nloc = b.st[0], nx = b.st[1];
        if (nloc == 0u) { xcd_barrier_complete(bar, b.x, nloc, nx); b.st[0] = nloc; b.st[1] = nx; }
        const unsigned old = xb_add(&bar[XB_XSUB(b.x)], 1u);
        const unsigned gen = old / nloc;
        if (old + 1u == (gen + 1u) * nloc) {
            __builtin_amdgcn_fence(__ATOMIC_RELEASE, "agent");
            asm volatile("s_waitcnt vmcnt(0)" ::: "memory");
            const unsigned og = xb_add(&bar[XB_TOP], 1u);
            const unsigned tg = og / nx;
            if (og + 1u == (tg + 1u) * nx) xb_add(&bar[XB_TOPGEN], 1u);
            else XB_SPIN(xb_ld(&bar[XB_TOPGEN]) == tg, bar);
            __builtin_amdgcn_fence(__ATOMIC_ACQUIRE, "agent");
            xb_add(&bar[XB_XGEN(b.x)], 1u);
            asm volatile("s_waitcnt vmcnt(0)" ::: "memory");
        } else {
            XB_SPIN(xb_ld(&bar[XB_XGEN(b.x)]) == gen, bar);
            __builtin_amdgcn_fence(__ATOMIC_ACQUIRE, "agent");
            asm volatile("s_waitcnt vmcnt(0)" ::: "memory");
        }
    }
    __syncthreads();
}

constexpr int LDP = 15104;
constexpr int P_MQ=0,P_MK=1024,P_MV=2048,P_NQ=3072,P_NKV=4096,P_GQ=5632,P_GK=6144,P_GV=6656,P_GG=7680,P_MG=8704,P_NG=14848,P_GA=14872;
constexpr int NTHR = 512;
#ifndef MOE_F8_FROM
#define MOE_F8_FROM 0
#endif
#ifndef Y_F8
#define Y_F8 1
#endif
#ifndef WOUT_F8
#define WOUT_F8 1
#endif
#ifndef MOE_F8
#define MOE_F8 1
#endif
#ifndef INPROJ_F8
#define INPROJ_F8 2
#endif
constexpr int LDS_BYTES = 147456;
constexpr int MOE_ROWS = 40960;
constexpr int MOE_TILES = MOE_ROWS / 256;

constexpr size_t al256(size_t x) { return (x + 255) & ~(size_t)255; }
constexpr size_t WS_CTL   = 0;
constexpr size_t CTL_BYTES = 65536 + 131072;
constexpr size_t WS_WIN   = WS_CTL + CTL_BYTES;
constexpr size_t WS_WBR   = WS_WIN + al256((size_t)NL * LDP * 2048 * 2);
constexpr size_t WS_WOUT  = WS_WBR + al256((size_t)NL * 3 * 2048 * 1024 * 2);
constexpr size_t WS_WC1   = WS_WOUT + al256((size_t)NL * 2048 * 2048 * 2);
constexpr size_t WS_WC2   = WS_WC1 + al256((size_t)NL * 2 * 256 * 4096 * 2);
constexpr size_t WS_BIAS1 = WS_WC2 + al256((size_t)NL * 2 * 256 * 256 * 2);
constexpr size_t WS_WGU   = WS_BIAS1 + al256((size_t)NL * 2 * 256 * 4);
constexpr size_t WS_WD    = WS_WGU + al256((size_t)32 * 1024 * 2048 * 2);
constexpr size_t WS_H     = WS_WD + al256((size_t)32 * 2048 * 512 * 2);
constexpr size_t WS_PROJ  = WS_H + al256((size_t)T * 2048 * 2);
constexpr size_t WS_OM    = WS_PROJ + al256((size_t)T * LDP * 2);
constexpr size_t WS_ON    = WS_OM + al256((size_t)T * 1024 * 2);
constexpr size_t WS_OG    = WS_ON + al256((size_t)T * 1024 * 2);
constexpr size_t WS_MERGED= WS_OG + al256((size_t)T * 1024 * 2);
constexpr size_t WS_MISC  = WS_MERGED + al256((size_t)T * 2048 * 2);
constexpr size_t WS_KMEAN = WS_MISC;
constexpr size_t WS_KVC   = WS_KMEAN + al256((size_t)NB * 8 * 8 * 128 * 4);
constexpr size_t WS_DEC   = WS_KVC + al256((size_t)NB * 127 * 4 * 128 * 4);
constexpr size_t WS_OGRAW = WS_H;
constexpr size_t WS_ROUTE = WS_DEC + al256((size_t)T * 512 * 4);
constexpr size_t WS_ROWTOK= WS_ROUTE + al256((size_t)T * 8 * 4);
constexpr size_t WS_ROWW  = WS_ROWTOK + al256((size_t)MOE_ROWS * 4);
constexpr size_t WS_TILEE = WS_ROWW + al256((size_t)MOE_ROWS * 4);
constexpr size_t WS_END_SMALL = WS_TILEE + al256((size_t)(MOE_TILES + 64) * 4);
constexpr size_t WS_HID   = WS_PROJ;
constexpr size_t WS_YBUF  = WS_HID + al256((size_t)MOE_ROWS * 512 * 2);
static_assert(WS_YBUF + (size_t)MOE_ROWS * 2048 * 2 <= WS_OM, "MoE buffers must fit in the PROJ region");
constexpr size_t WS_TOTAL = WS_END_SMALL;

constexpr int CW_BAR = 0;
constexpr int CW_CNT = 4096;
constexpr int CW_CUR = 4096 + 64;
constexpr int CW_MISC = 4096 + 128;
constexpr int CMP_WGS = 64;
constexpr int CW_CMPF = 8192;
constexpr int CW_GQ = 8192 + 64 * 32;
constexpr int CW_PANEL = 8192 + 64 * 34;

constexpr size_t WS_H8 = (size_t)1114 * 1024 * 1024;
constexpr size_t WS_SA = WS_H8 + (size_t)T * 2048;
constexpr size_t WS_SB = WS_CTL + 65536;
constexpr size_t WS_XB = WS_SA + al256((size_t)T * 4);
constexpr int MOE_CAP = T;
constexpr size_t WS_LIST = WS_XB + (size_t)T * 2048 * 2;
constexpr size_t WS_LISTW = WS_LIST + (size_t)32 * MOE_CAP * 4;
constexpr size_t WS_NEED = WS_LISTW + (size_t)32 * MOE_CAP * 4;
static_assert((size_t)NL * 15104 * 4 <= 131072, "column absmax table must fit the control region");
__host__ __device__ __forceinline__ int inproj_src(int n) {
    if (n < 5632) return n; if (n < 7680) return n + 24; if (n < 14848) return n + 40; if (n < 14872) return O_NG + (n - 14848); if (n < 14888) return O_GA + (n - 14872); return -1; }
#ifndef MIX_SET
#define MIX_SET 0
#endif
#if MIX_SET == 0
constexpr int NT16 = 24, NT8 = 35;
__host__ __device__ __forceinline__ int tile16(int p) { return p < 8 ? p : p < 12 ? p + 4 : p == 12 ? 16 : p == 13 ? 18 : p == 14 ? 20 : p < 19 ? p + 7 : p < 23 ? p + 11 : 58; }
__host__ __device__ __forceinline__ int tile8(int p) { return p < 4 ? p + 8 : p == 4 ? 17 : p == 5 ? 19 : p == 6 ? 21 : p < 11 ? p + 19 : p + 23; }
#else
constexpr int NT16 = 35, NT8 = 24;
__host__ __device__ __forceinline__ int tile16(int p) { return p < 34 ? p : 58; }
__host__ __device__ __forceinline__ int tile8(int p) { return p + 34; }
#endif
struct Args { const float* in[22]; float* out; unsigned char* ws; int ph_lo, ph_hi; };
constexpr int LDS_ARGS = 131072;
constexpr int LDS_XB = LDS_ARGS + 256;
constexpr int LDS_MISC = LDS_ARGS + 512;
constexpr int LDS_GTAB = LDS_MISC + 10240;

struct Frame {
    LAS unsigned char* lds; int tid, lane, wave, G, c;
    unsigned char* ws;
    __device__ __forceinline__ const float* in(int k) const { const unsigned long long v = *(const volatile LAS unsigned long long*)(lds + LDS_ARGS + k * 8); return (const float*)(const __attribute__((address_space(1))) float*)(((unsigned long long)__builtin_amdgcn_readfirstlane((unsigned)(v >> 32)) << 32) | (unsigned)__builtin_amdgcn_readfirstlane((unsigned)v)); }
    __device__ __forceinline__ float* out() const { return (float*)in(22); }
};
template <class P> __device__ __forceinline__ P* opaque_ptr(P* p) {
    const unsigned long long v = (unsigned long long)p; unsigned lo = __builtin_amdgcn_readfirstlane((unsigned)v), hi = __builtin_amdgcn_readfirstlane((unsigned)(v >> 32));
    asm volatile("" : "+s"(lo), "+s"(hi)); return (P*)(__attribute__((address_space(1))) P*)(((unsigned long long)hi << 32) | lo);
}
__device__ __forceinline__ Frame phase_frame(const Frame& F0) {
    __syncthreads();
    Frame F = F0; F.ws = opaque_ptr(F0.ws);
    int t; asm volatile("v_mbcnt_lo_u32_b32 %0, -1, 0\n\tv_mbcnt_hi_u32_b32 %0, -1, %0" : "=v"(t)); t += F0.wave * 64; asm volatile("" : "+v"(t));
    F.tid = t; F.lane = t & 63; F.wave = __builtin_amdgcn_readfirstlane(t >> 6); return F;
}

__device__ __forceinline__ float clamp_fp8(float v) { return __builtin_amdgcn_fmed3f(v, -448.f, 448.f); }
__device__ __forceinline__ unsigned pack_fp8x4(float a, float b, float c, float d) { int w = __builtin_amdgcn_cvt_pk_fp8_f32(clamp_fp8(a), clamp_fp8(b), 0, false); w = __builtin_amdgcn_cvt_pk_fp8_f32(clamp_fp8(c), clamp_fp8(d), w, true); return (unsigned)w; }
__device__ __forceinline__ unsigned pack_i8x4(float a, float b, float c, float d) {
    const int ia = (int)rintf(__builtin_amdgcn_fmed3f(a, -127.f, 127.f)), ib = (int)rintf(__builtin_amdgcn_fmed3f(b, -127.f, 127.f)), ic = (int)rintf(__builtin_amdgcn_fmed3f(c, -127.f, 127.f)), id = (int)rintf(__builtin_amdgcn_fmed3f(d, -127.f, 127.f));
    return (unsigned)(ia & 255) | ((unsigned)(ib & 255) << 8) | ((unsigned)(ic & 255) << 16) | ((unsigned)(id & 255) << 24); }
template <bool F8, class Fn>
__device__ __forceinline__ void conv_t(const Frame& F, Fn colsrc, int ld, int K, int N, void* dstv, float scale = 1.f, const float* rowinv = nullptr  , int wg0 = 0, int t_lo = 0, int t_hi = -1) {
    const int ntn = N / 256, ntk = K / 64, tot = t_hi < 0 ? ntn * ntk : t_hi;
    if (F.c < wg0) return;
    const int n4 = ((F.tid >> 6) * 8 + (F.tid & 7)) * 4, kc = (F.tid >> 3) & 7;
    f32x4 va[8], vb[8];
#define CONV_LOAD(v, ti_) do { const int tn_ = (ti_) % ntn, tk_ = (ti_) / ntn; const float* sp_ = colsrc(tn_ * 256 + n4); \
        _Pragma("unroll") for (int p = 0; p < 8; ++p) v[p] = sp_ ? __builtin_nontemporal_load((const f32x4*)(sp_ + (size_t)(tk_ * 64 + kc * 8 + p) * ld)) : (f32x4){0.f, 0.f, 0.f, 0.f}; } while (0)
#define CONV_TILE(v) do { const int tn = ti % ntn, tk = ti / ntn; const int n0 = tn * 256 + n4, k0 = tk * 64 + kc * 8;                                        \
        f32x4 c_[8]; _Pragma("unroll") for (int p = 0; p < 8; ++p) c_[p] = v[p] * scale;                                                                   \
        if (ti + 2 * stride < tot) CONV_LOAD(v, ti + 2 * stride);                                                                                          \
        _Pragma("unroll") for (int j = 0; j < 4; ++j) {                                                                                                      \
            if (rowinv) { const float am_ = rowinv[n0 + j]; const float ri = am_ > 0.f ? 127.f / am_ : 0.f;                \
                u32x2 w = {pack_i8x4(c_[0][j] * ri, c_[1][j] * ri, c_[2][j] * ri, c_[3][j] * ri), pack_i8x4(c_[4][j] * ri, c_[5][j] * ri, c_[6][j] * ri, c_[7][j] * ri)}; *(u32x2*)((unsigned char*)dstv + (size_t)(n0 + j) * K + k0) = w; } \
            else if (F8) { u32x2 w = {pack_fp8x4(c_[0][j], c_[1][j], c_[2][j], c_[3][j]), pack_fp8x4(c_[4][j], c_[5][j], c_[6][j], c_[7][j])}; *(u32x2*)((unsigned char*)dstv + (size_t)(n0 + j) * K + k0) = w; } \
            else { u32x4 w = {cvt_pk_bf16(c_[0][j], c_[1][j]), cvt_pk_bf16(c_[2][j], c_[3][j]), cvt_pk_bf16(c_[4][j], c_[5][j]), cvt_pk_bf16(c_[6][j], c_[7][j])}; *(u32x4*)((bf16_t*)dstv + (size_t)(n0 + j) * K + k0) = w; } } \
        } while (0)
    int ti = t_lo + F.c - wg0; const int stride = F.G - wg0;
    if (ti < tot) CONV_LOAD(va, ti);
    if (ti + stride < tot) CONV_LOAD(vb, ti + stride);
    for (;;) {
        if (ti >= tot) break;
        CONV_TILE(va); ti += stride;
        if (ti >= tot) break;
        CONV_TILE(vb); ti += stride;
    }
#undef CONV_TILE
#undef CONV_LOAD
}

__device__ __forceinline__ void p_conv_win_i8(const Frame& F0) {
    const Frame F = phase_frame(F0);
    LAS float* red = (LAS float*)F.lds;
    LAS float* cmax = red + 64 * 32;
    float* sb = (float*)(F.ws + WS_SB);
    const int cg = F.tid & 7, rl = F.tid >> 3;
    for (int task = F.c; task < NL * (LDP / 32); task += F.G) { const int nb = task % (LDP / 32), l = task / (LDP / 32); const int n0 = nb * 32;
        const int src = inproj_src(n0 + cg * 4); const float* sp = F.in(2) + (size_t)l * D * INW + (src >= 0 ? src : 0) + (size_t)(rl * 8) * INW;
        u32x2 w[32]; f32x4 m = {0.f, 0.f, 0.f, 0.f};
#pragma unroll
        for (int q = 0; q < 4; ++q) { f32x4 v[8];
#pragma unroll
            for (int p = 0; p < 8; ++p) v[p] = src >= 0 ? __builtin_nontemporal_load((const f32x4*)(sp + (size_t)(q * 512 + p) * INW)) : (f32x4){0.f, 0.f, 0.f, 0.f};
#pragma unroll
            for (int p = 0; p < 8; ++p) { m[0] = fmaxf(m[0], fabsf(v[p][0])); m[1] = fmaxf(m[1], fabsf(v[p][1])); m[2] = fmaxf(m[2], fabsf(v[p][2])); m[3] = fmaxf(m[3], fabsf(v[p][3]));
                w[q * 8 + p] = (u32x2){cvt_pk_bf16(v[p][0], v[p][1]), cvt_pk_bf16(v[p][2], v[p][3])}; } }
        *(LAS f32x4*)(red + rl * 32 + cg * 4) = m; __syncthreads();
        if (F.tid < 32) { float a = 0.f;
#pragma unroll 8
            for (int q = 0; q < 64; ++q) a = fmaxf(a, red[q * 32 + F.tid]);
            cmax[F.tid] = a; sb[(size_t)l * LDP + n0 + F.tid] = a; }
        __syncthreads();
        unsigned char* dst = F.ws + WS_WIN + (size_t)l * LDP * 2048;
#pragma unroll
        for (int j = 0; j < 4; ++j) { const float am_ = cmax[cg * 4 + j]; const float ri = am_ > 0.f ? 127.f / am_ : 0.f;
#define WEL(pp_) ((j & 1) ? bf_hi(w[pp_][j >> 1]) : bf_lo(w[pp_][j >> 1]))
#pragma unroll
            for (int q = 0; q < 4; ++q) { u32x2 o = {pack_i8x4(WEL(q * 8 + 0) * ri, WEL(q * 8 + 1) * ri, WEL(q * 8 + 2) * ri, WEL(q * 8 + 3) * ri), pack_i8x4(WEL(q * 8 + 4) * ri, WEL(q * 8 + 5) * ri, WEL(q * 8 + 6) * ri, WEL(q * 8 + 7) * ri)};
                __builtin_nontemporal_store(o, (u32x2*)(dst + (size_t)(n0 + cg * 4 + j) * 2048 + q * 512 + rl * 8)); }
#undef WEL
        }
        __syncthreads();
    }
}
__device__ __forceinline__ void p_conv_small(const Frame& F0) {
    const Frame F = phase_frame(F0);
    constexpr int PER_L = 704;
    const int n4 = ((F.tid >> 6) * 8 + (F.tid & 7)) * 4, kc = (F.tid >> 3) & 7;
    for (int g = F.c; g < NL * PER_L; g += F.G) {
        const int l = g / PER_L; int t = g - l * PER_L;
        const float* base; int ld, K, ntn; bf16_t* dst; bool cmp = false, f8 = false;
        if (t < 384) { const int b = t / 128; t -= b * 128; base = (b == 0 ? F.in(9) : b == 1 ? F.in(10) : F.in(11)) + (size_t)l * 1024 * D; ld = D; K = 1024; ntn = 8; dst = (bf16_t*)(F.ws + WS_WBR) + ((size_t)l * 3 + b) * 2048 * 1024; }
        else if (t < 640) { t -= 384; base = F.in(12) + (size_t)l * D * D; ld = D; K = 2048; ntn = 8; dst = (bf16_t*)(F.ws + WS_WOUT) + (size_t)l * 2048 * 2048; f8 = WOUT_F8 != 0; }
        else { t -= 640; const int c = t >> 5; t &= 31; base = F.in(4) + ((size_t)l * 2 + c) * 4096 * 128; ld = 128; K = 2048; ntn = 1; dst = (bf16_t*)(F.ws + WS_WC1) + ((size_t)l * 2 + c) * 256 * 2048; cmp = true; }
        const int tn = t % ntn, tk = t / ntn; const int n = tn * 256 + n4, k0 = tk * 64 + kc * 8;
        const float* sp = cmp ? base + (n >= 128 ? (size_t)2048 * 128 : 0) + (n & 127) : base + n;
        f32x4 v[8];
#pragma unroll
        for (int pp = 0; pp < 8; ++pp) v[pp] = __builtin_nontemporal_load((const f32x4*)(sp + (size_t)(k0 + pp) * ld));
#pragma unroll
        for (int j = 0; j < 4; ++j) {
            if (f8) { u32x2 w = {pack_fp8x4(v[0][j] * 512.f, v[1][j] * 512.f, v[2][j] * 512.f, v[3][j] * 512.f), pack_fp8x4(v[4][j] * 512.f, v[5][j] * 512.f, v[6][j] * 512.f, v[7][j] * 512.f)};
                __builtin_nontemporal_store(w, (u32x2*)((unsigned char*)dst + (size_t)(n + j) * K + k0)); }
            else { u32x4 w = {cvt_pk_bf16(v[0][j], v[1][j]), cvt_pk_bf16(v[2][j], v[3][j]), cvt_pk_bf16(v[4][j], v[5][j]), cvt_pk_bf16(v[6][j], v[7][j])};
                __builtin_nontemporal_store(w, (u32x4*)(dst + (size_t)(n + j) * K + k0)); } }
    }
}
__device__ __forceinline__ void p_conv_static(const Frame& F0) {
    const Frame F = phase_frame(F0);
    for (int l = 0; l < NL; ++l) {
        { const float* w = F.in(2) + (size_t)l * D * INW;
          auto srcpad = [=](int n) -> const float* { int s; if (n < 5632) s = n; else if (n < 7680) s = n + 24; else if (n < 14848) s = n + 40; else if (n < 14872) s = O_NG + (n - 14848); else if (n < 14888) s = O_GA + (n - 14872); else return nullptr; return w + s; };
#if INPROJ_F8 == 3
          (void)srcpad;
#elif INPROJ_F8 == 2
          conv_t<false>(F, [=](int n) -> const float* { return srcpad(tile16(n >> 8) * 256 + (n & 255)); }, INW, 2048, NT16 * 256, (bf16_t*)(F.ws + WS_WIN) + (size_t)l * NT16 * 256 * 2048);
          conv_t<true>(F, [=](int n) -> const float* { return srcpad(tile8(n >> 8) * 256 + (n & 255)); }, INW, 2048, NT8 * 256, F.ws + WS_WIN + (size_t)NL * NT16 * 256 * 2048 * 2 + (size_t)l * NT8 * 256 * 2048, 512.f);
#elif INPROJ_F8 == 1
          conv_t<true>(F, srcpad, INW, 2048, LDP, F.ws + WS_WIN + (size_t)l * LDP * 2048, 512.f);
#else
          conv_t<false>(F, srcpad, INW, 2048, LDP, (bf16_t*)(F.ws + WS_WIN) + (size_t)l * LDP * 2048);
#endif
        }
#define CONV_BR(b, idx) { const float* w = F.in(idx) + (size_t)l * 1024 * D; bf16_t* dst = (bf16_t*)(F.ws + WS_WBR) + ((size_t)l * 3 + b) * 2048 * 1024; \
          conv_t<false>(F, [=](int n) -> const float* { return w + n; }, D, 1024, 2048, dst); }
        CONV_BR(0, 9) CONV_BR(1, 10) CONV_BR(2, 11)
#undef CONV_BR
        { const float* w = F.in(12) + (size_t)l * D * D; bf16_t* dst = (bf16_t*)(F.ws + WS_WOUT) + (size_t)l * 2048 * 2048;
          conv_t<false>(F, [=](int n) -> const float* { return w + n; }, D, 2048, 2048, dst); }
        for (int c = 0; c < 2; ++c) { const float* w = F.in(4) + ((size_t)l * 2 + c) * 4096 * 128; bf16_t* dst = (bf16_t*)(F.ws + WS_WC1) + ((size_t)l * 2 + c) * 256 * 2048;
          conv_t<false>(F, [=](int n) -> const float* { return w + (n >= 128 ? (size_t)2048 * 128 : 0) + (n & 127); }, 128, 2048, 256, dst); }
    }
}
#ifndef CONVX_EARLY_TILES
#define CONVX_EARLY_TILES 0
#endif
constexpr int CONVX_EARLY = CONVX_EARLY_TILES;
template <bool F8, int PART>
__device__ __forceinline__ void p_conv_experts(const Frame& F0, int l, int wg0 = 0) {
    const Frame F = phase_frame(F0);
    const float* wg = F.in(18) + (size_t)l * 32 * D * 512; const float* wu = F.in(19) + (size_t)l * 32 * D * 512; const float* wd = F.in(20) + (size_t)l * 32 * 512 * D;
    constexpr int DOWN_TILES = 8 * 256, EARLY = CONVX_EARLY < DOWN_TILES ? CONVX_EARLY : DOWN_TILES;
    auto down_src = [=](int n) -> const float* { return wd + (size_t)(n >> 11) * 512 * D + (n & 2047); };
    if (PART == 1) { conv_t<F8>(F, down_src, D, 512, 32 * 2048, F.ws + WS_WD, F8 ? 512.f : 1.f, nullptr, wg0, 0, EARLY); return; }
    conv_t<F8>(F, [=](int n) -> const float* { const int e = n >> 10, r = n & 1023, j = r >> 8, wi = r & 255; const unsigned long long dlt = (unsigned long long)wu - (unsigned long long)wg; const float* base = (const float*)((unsigned long long)wg + (dlt & (0ull - (unsigned long long)(wi >> 7)))) + (size_t)e * D * 512; return base + j * 128 + (wi & 127); }, 512, 2048, 32 * 1024, F.ws + WS_WGU, F8 ? 512.f : 1.f);
    conv_t<F8>(F, down_src, D, 512, 32 * 2048, F.ws + WS_WD, F8 ? 512.f : 1.f, nullptr, 0, PART == 2 ? EARLY : 0, -1);
}
__device__ __forceinline__ void store_h4(unsigned char* ws, size_t idx, float a, float b, float c, float d) {
#if INPROJ_F8 == 1 || INPROJ_F8 == 2
    *(unsigned*)(ws + (INPROJ_F8 == 2 ? WS_H8 : WS_H) + idx) = pack_fp8x4(a * 16.f, b * 16.f, c * 16.f, d * 16.f);
#endif
#if INPROJ_F8 == 0 || INPROJ_F8 == 2
    u32x2 w; w[0] = cvt_pk_bf16(a, b); w[1] = cvt_pk_bf16(c, d); *(u32x2*)((bf16_t*)(ws + WS_H) + idx) = w;
#endif
}
template <bool NT = false>
__device__ __forceinline__ void store_h_row(unsigned char* ws, int row, const f32x4 (&y)[8], int lane) {
#if INPROJ_F8 == 3
    float am = 0.f;
#pragma unroll
    for (int i = 0; i < 8; ++i) am = fmaxf(fmaxf(am, fmaxf(fabsf(y[i][0]), fabsf(y[i][1]))), fmaxf(fabsf(y[i][2]), fabsf(y[i][3])));
#pragma unroll
    for (int o = 32; o > 0; o >>= 1) am = fmaxf(am, __shfl_xor(am, o));
    const float inv = am > 0.f ? 127.f / am : 0.f;
    if (lane == 0) ((float*)(ws + WS_SA))[row] = am > 0.f ? am * (1.f / 127.f) : 1.f;
#pragma unroll
    for (int i = 0; i < 8; ++i) { const unsigned w_ = pack_i8x4(y[i][0] * inv, y[i][1] * inv, y[i][2] * inv, y[i][3] * inv); unsigned* p_ = (unsigned*)(ws + WS_H8 + (size_t)row * D + i * 256 + lane * 4);
        if (NT) __builtin_nontemporal_store(w_, p_); else *p_ = w_; }
#else
#pragma unroll
    for (int i = 0; i < 8; ++i) store_h4(ws, (size_t)row * D + i * 256 + lane * 4, y[i][0], y[i][1], y[i][2], y[i][3]);
#endif
}
__device__ __forceinline__ void p_rmsnorm(const Frame& F0, int l) {
    const Frame F = phase_frame(F0);
    const float* x = (l == 0) ? F.in(0) : F.out(); const float* g = F.in(1) + l * D; unsigned char* h = F.ws;
    for (int row = F.c * 8 + F.wave; row < T; row += F.G * 8) {
        const float* xr = x + (size_t)row * D; f32x4 v[8]; float ss = 0.f;
#pragma unroll
        for (int i = 0; i < 8; ++i) { v[i] = __builtin_nontemporal_load((const f32x4*)(xr + i * 256 + F.lane * 4)); ss += v[i][0] * v[i][0] + v[i][1] * v[i][1] + v[i][2] * v[i][2] + v[i][3] * v[i][3]; }
#pragma unroll
        for (int o = 32; o > 0; o >>= 1) ss += __shfl_xor(ss, o);
        const float rstd = rsqrtf(ss * (1.f / D) + 1e-6f);
#pragma unroll
        for (int i = 0; i < 8; ++i) { const f32x4 gv = *(const f32x4*)(g + i * 256 + F.lane * 4); v[i] = (f32x4){v[i][0] * rstd * gv[0], v[i][1] * rstd * gv[1], v[i][2] * rstd * gv[2], v[i][3] * rstd * gv[3]}; }
        store_h_row<true>(h, row, v, F.lane);
    }
}

template <bool F8 = false>
struct SchedDenseT {
    static constexpr bool GATHER = false;
    const char* A; const char* B; int lda, K, nM, nN, G, c;
    __device__ __forceinline__ bool next(int i, ge::Unit& u) const { int pm, pn; if (!ge::static_tile(i, G, c, nM, nN, pm, pn)) return false;
        u.A = A + (size_t)pm * 256 * lda * (F8 ? 1 : 2); u.B = B + (size_t)pn * 256 * K * (F8 ? 1 : 2); u.r0 = pm * 256; u.c0 = pn * 256; u.aux = 0; u.aux2 = 0; return true; }
    __device__ __forceinline__ void voffA(const ge::Unit&, int tid, unsigned (&v)[2][2]) const { ge::dense_voffA<F8>(lda, tid, v); }
};
typedef SchedDenseT<false> SchedDense;
struct SchedInproj2D {
    static constexpr bool GATHER = false;
    const char* A; const char* B; int G, c;
    __device__ __forceinline__ bool next(int i, ge::Unit& u) const {
        if (G != 256) { int pm, pn; if (!ge::static_tile(i, G, c, T / 256, LDP / 256, pm, pn)) return false;
            u.A = A + (size_t)pm * 256 * 2048; u.B = B + (size_t)pn * 256 * 2048; u.r0 = pm * 256; u.c0 = pn * 256; u.aux = 0; u.aux2 = 0; return true; }
        const int x = c & 7, xr = x >> 2, xc = x & 3, nNx = xc < 3 ? 15 : 14, p = i * 32 + (c >> 3);
        if (p >= 32 * nNx) return false;
        const int gid = p / (4 * nNx), q = p - gid * 4 * nNx, pm = xr * 32 + gid * 4 + (q & 3), pn = xc * 15 + (q >> 2);
        u.A = A + (size_t)pm * 256 * 2048; u.B = B + (size_t)pn * 256 * 2048; u.r0 = pm * 256; u.c0 = pn * 256; u.aux = 0; u.aux2 = 0; return true; }
    __device__ __forceinline__ void voffA(const ge::Unit&, int tid, unsigned (&v)[2][2]) const { ge::dense_voffA<true>(2048, tid, v); }
};
struct EpiStoreBf16 {
    static constexpr bool PERM = true; bf16_t* O; int ldc;
    __device__ __forceinline__ void operator()(const f32x4 (&acc)[2][2][4][2], const ge::Unit& u, int wr, int wc, int fr, int fq) const {
#pragma unroll
        for (int ai = 0; ai < 2; ++ai)
#pragma unroll
            for (int m = 0; m < 4; ++m) { bf16_t* rowp = O + (size_t)(u.r0 + ai * 128 + wr * 64 + m * 16 + fr) * ldc + u.c0 + wc * 32 + 8 * fq;
#pragma unroll
                for (int bj = 0; bj < 2; ++bj) { const f32x4 v0 = acc[ai][bj][m][0], v1 = acc[ai][bj][m][1]; u32x4 w = {cvt_pk_bf16(v0[0], v0[1]), cvt_pk_bf16(v0[2], v0[3]), cvt_pk_bf16(v1[0], v1[1]), cvt_pk_bf16(v1[2], v1[3])};
                    *(u32x4*)(rowp + bj * 128) = w; } }
    }
};
struct EpiNull {
    static constexpr bool PERM = true;
    __device__ __forceinline__ void operator()(const f32x4 (&acc)[2][2][4][2], const ge::Unit&, int, int, int, int) const {
#pragma unroll
        for (int ai = 0; ai < 2; ++ai)
#pragma unroll
            for (int bj = 0; bj < 2; ++bj)
#pragma unroll
                for (int m = 0; m < 4; ++m) asm volatile("" :: "v"(acc[ai][bj][m][0]), "v"(acc[ai][bj][m][1]));
    }
};
struct SchedSame {
    static constexpr bool GATHER = false; const char* A; const char* B; int n;
    __device__ __forceinline__ bool next(int i, ge::Unit& u) const { if (i >= n) return false; u.A = A; u.B = B; u.r0 = 0; u.c0 = 0; u.aux = 0; u.aux2 = 0; return true; }
    __device__ __forceinline__ void voffA(const ge::Unit&, int tid, unsigned (&v)[2][2]) const { ge::dense_voffA<false>(2048, tid, v); }
};
__device__ __forceinline__ void p_inproj_same(const Frame& F0, int l) {
    const Frame F = phase_frame(F0);
    EpiNull E{};
    SchedSame S{(const char*)(F.ws + WS_H), (const char*)(F.ws + WS_WIN) + (size_t)l * LDP * 2048 * 2, 15};
    ge::gemm_phase<EpiNull, SchedSame, 0>(F.lds, F.tid, 2048, 0, S, E);
}
__device__ __forceinline__ void p_inproj_longk(const Frame& F0, int l) {
    const Frame F = phase_frame(F0);
    EpiNull E{};
    SchedSame S{(const char*)(F.ws + WS_H), (const char*)(F.ws + WS_WIN) + (size_t)l * LDP * 2048 * 2, 1};
    ge::gemm_phase<EpiNull, SchedSame, 0>(F.lds, F.tid, 2048 * 15, 0, S, E);
}
__device__ __forceinline__ void p_inproj_null(const Frame& F0, int l) {
    const Frame F = phase_frame(F0);
    EpiNull E{};
    SchedDense S{(const char*)(F.ws + WS_H), (const char*)(F.ws + WS_WIN) + (size_t)l * LDP * 2048 * 2, 2048, 2048, T / 256, LDP / 256, F.G, F.c};
    ge::gemm_phase<EpiNull, SchedDense, 0>(F.lds, F.tid, 2048, 0, S, E);
}
__device__ __forceinline__ void p_inproj_null8(const Frame& F0, int l) {
    const Frame F = phase_frame(F0);
    EpiNull E{};
    SchedDenseT<true> S{(const char*)(F.ws + WS_H8), (const char*)(F.ws + WS_WIN) + (size_t)l * LDP * 2048, 2048, 2048, T / 256, LDP / 256, F.G, F.c};
    ge::gemm_phase<EpiNull, SchedDenseT<true>, 0, false, GE_SP2_DEFAULT, GE_ALIGN_DEFAULT, 0, true>(F.lds, F.tid, 2048, 0, S, E);
}
#ifndef INPROJ_F8
#define INPROJ_F8 1
#endif
struct EpiStoreBf16Scaled {
    static constexpr bool PERM = true; bf16_t* O; int ldc; const float* sa; const float* sb; unsigned gtab;
    __device__ __forceinline__ void operator()(const f32x4 (&acc)[2][2][4][2], const ge::Unit& u, int wr, int wc, int fr, int fq) const {
        float rs[2][4];
#pragma unroll
        for (int ai = 0; ai < 2; ++ai)
#pragma unroll
            for (int m = 0; m < 4; ++m) rs[ai][m] = sa[u.r0 + ai * 128 + wr * 64 + m * 16 + fr];
        const bool gate = u.c0 >= P_MG && u.c0 < P_NG;
#pragma unroll
        for (int bj = 0; bj < 2; ++bj) { const int col = u.c0 + bj * 128 + wc * 32 + 8 * fq; const f32x4 c0 = *(const f32x4*)(sb + col) * (1.f / 127.f), c1 = *(const f32x4*)(sb + col + 4) * (1.f / 127.f);
#pragma unroll
            for (int ai = 0; ai < 2; ++ai)
#pragma unroll
                for (int m = 0; m < 4; ++m) { const f32x4 v0 = acc[ai][bj][m][0] * c0 * rs[ai][m], v1 = acc[ai][bj][m][1] * c1 * rs[ai][m];
                    const size_t row = (size_t)(u.r0 + ai * 128 + wr * 64 + m * 16 + fr);
                    if (gate) {
                        unsigned g[8];
#pragma unroll
                        for (int j = 0; j < 8; ++j) { const float x = j < 4 ? v0[j] : v1[j - 4]; const float fi = fminf(fmaxf(x * 128.f + 1024.f, 0.f), 2047.f);
                            g[j] = *(const LAS unsigned char*)(gtab + (unsigned)fi); }
                        u32x2 w = {g[0] | (g[1] << 8) | (g[2] << 16) | (g[3] << 24), g[4] | (g[5] << 8) | (g[6] << 16) | (g[7] << 24)};
                        *(u32x2*)((unsigned char*)(O + row * ldc + P_MG) + (col - P_MG)) = w; }
                    else { u32x4 w = {cvt_pk_bf16(v0[0], v0[1]), cvt_pk_bf16(v0[2], v0[3]), cvt_pk_bf16(v1[0], v1[1]), cvt_pk_bf16(v1[2], v1[3])};
                        *(u32x4*)(O + row * ldc + col) = w; } } }
    }
};
template <bool F8>
struct SchedInprojMix {
    static constexpr bool GATHER = false;
    const char* A; const char* B; int G, c;
    __device__ __forceinline__ bool next(int i, ge::Unit& u) const { int pm, pn; if (!ge::static_tile(i, G, c, T / 256, F8 ? NT8 : NT16, pm, pn)) return false;
        u.A = A + (size_t)pm * 256 * 2048 * (F8 ? 1 : 2); u.B = B + (size_t)pn * 256 * 2048 * (F8 ? 1 : 2); u.r0 = pm * 256; u.c0 = (F8 ? tile8(pn) : tile16(pn)) * 256; u.aux = 0; u.aux2 = 0; return true; }
    __device__ __forceinline__ void voffA(const ge::Unit&, int tid, unsigned (&v)[2][2]) const { ge::dense_voffA<F8>(2048, tid, v); }
};
__device__ __forceinline__ void p_inproj(const Frame& F0, int l) {
    const Frame F = phase_frame(F0);
    EpiStoreBf16 E{(bf16_t*)(F.ws + WS_PROJ), LDP};
#if INPROJ_F8 == 3
    {
        LAS unsigned char* gt = F.lds + LDS_GTAB;
        for (int i = F.tid; i < 2048; i += NTHR) gt[i] = (unsigned char)fminf(256.f * fast_sigmoid(((float)(i - 1024) + 0.5f) * (1.f / 128.f)), 255.f);
        __syncthreads(); }
    { SchedInproj2D S{(const char*)(F.ws + WS_H8), (const char*)(F.ws + WS_WIN) + (size_t)l * LDP * 2048, F.G, F.c};
      EpiStoreBf16Scaled E3{(bf16_t*)(F.ws + WS_PROJ), LDP, (const float*)(F.ws + WS_SA), (const float*)(F.ws + WS_SB) + (size_t)l * LDP, (unsigned)(uintptr_t)(F.lds + LDS_GTAB)};
      ge::gemm_phase<EpiStoreBf16Scaled, SchedInproj2D, 0, false, GE_SP2_DEFAULT, GE_ALIGN_DEFAULT, 0, true>(F.lds, F.tid, 2048, 0, S, E3); }
#elif INPROJ_F8 == 2
    { SchedInprojMix<false> S{(const char*)(F.ws + WS_H), (const char*)(F.ws + WS_WIN) + (size_t)l * NT16 * 256 * 2048 * 2, F.G, F.c};
      ge::gemm_phase<EpiStoreBf16, SchedInprojMix<false>, 0, false>(F.lds, F.tid, 2048, 0, S, E); }
    { const Frame F2 = phase_frame(F0);
      SchedInprojMix<true> S{(const char*)(F2.ws + WS_H8), (const char*)(F2.ws + WS_WIN) + (size_t)NL * NT16 * 256 * 2048 * 2 + (size_t)l * NT8 * 256 * 2048, F2.G, F2.c};
      EpiStoreBf16 E2{(bf16_t*)(F2.ws + WS_PROJ), LDP};
      ge::gemm_phase<EpiStoreBf16, SchedInprojMix<true>, 0, true>(F2.lds, F2.tid, 2048, 0, S, E2); }
#elif INPROJ_F8 == 1
    SchedDenseT<true> S{(const char*)(F.ws + WS_H), (const char*)(F.ws + WS_WIN) + (size_t)l * LDP * 2048, 2048, 2048, T / 256, LDP / 256, F.G, F.c};
    ge::gemm_phase<EpiStoreBf16, SchedDenseT<true>, 0, true>(F.lds, F.tid, 2048, 0, S, E);
#else
    SchedDense S{(const char*)(F.ws + WS_H), (const char*)(F.ws + WS_WIN) + (size_t)l * LDP * 2048 * 2, 2048, 2048, T / 256, LDP / 256, F.G, F.c};
    ge::gemm_phase<EpiStoreBf16, SchedDense, 0>(F.lds, F.tid, 2048, 0, S, E);
#endif
}

struct SchedMerge {
    static constexpr bool GATHER = false;
    const char* O3; const char* W; int G, c;
    __device__ __forceinline__ bool next(int i, ge::Unit& u) const { const int ti = i / 3, b = i - ti * 3; int pm, pn; if (!ge::static_tile(ti, G, c, T / 256, 8, pm, pn)) return false;
        u.A = O3 + (size_t)b * T * 1024 * 2 + (size_t)pm * 256 * 1024 * 2; u.B = W + (size_t)b * 2048 * 1024 * 2 + (size_t)pn * 256 * 1024 * 2; u.r0 = pm * 256; u.c0 = pn * 256; u.aux = b; u.aux2 = 0; return true; }
    __device__ __forceinline__ void voffA(const ge::Unit&, int tid, unsigned (&v)[2][2]) const { ge::dense_voffA(1024, tid, v); }
};
#if INPROJ_F8 == 3
struct EpiMerge {
    static constexpr bool PERM = true; static constexpr bool INPLACE = true; const bf16_t* proj; bf16_t* merged;
    __device__ __forceinline__ bool inplace(f32x4 (&acc)[2][2][4][2], const ge::Unit& u, int wr, int wc, int fr, int fq) const {
        const int col = u.c0 + wc * 32 + 8 * fq; const int b = u.aux;
#pragma unroll
        for (int ai = 0; ai < 2; ++ai) {
            u32x2 ga[4][2], gb[4][2];
#pragma unroll
            for (int m = 0; m < 4; ++m) { const size_t row = (size_t)(u.r0 + ai * 128 + wr * 64 + m * 16 + fr);
#pragma unroll
                for (int bj = 0; bj < 2; ++bj) { const unsigned char* gp = (const unsigned char*)(proj + row * LDP + P_MG) + b * 2048 + col + bj * 128;
                    ga[m][bj] = *(const u32x2*)gp; if (b < 2) gb[m][bj] = *(const u32x2*)(gp + 2048); else gb[m][bj] = (u32x2){0u, 0u}; } }
#pragma unroll
            for (int m = 0; m < 4; ++m) { const size_t row = (size_t)(u.r0 + ai * 128 + wr * 64 + m * 16 + fr);
#pragma unroll
                for (int bj = 0; bj < 2; ++bj) { const u32x2 g = ga[m][bj], h = gb[m][bj]; float s[8];
#pragma unroll
                    for (int j = 0; j < 8; ++j) { const float num = (float)((g[j >> 2] >> (8 * (j & 3))) & 255u) + 0.5f;
                        s[j] = b < 2 ? num * __builtin_amdgcn_rcpf((float)((h[j >> 2] >> (8 * (j & 3))) & 255u) + 0.5f) : num * (1.f / 256.f); }
                    f32x4 v0 = acc[ai][bj][m][0], v1 = acc[ai][bj][m][1];
                    v0[0] *= s[0]; v0[1] *= s[1]; v0[2] *= s[2]; v0[3] *= s[3]; v1[0] *= s[4]; v1[1] *= s[5]; v1[2] *= s[6]; v1[3] *= s[7];
                    acc[ai][bj][m][0] = v0; acc[ai][bj][m][1] = v1;
                    if (b == 2) {
#if WOUT_F8
                        u32x2 w = {pack_fp8x4(v0[0] * 16.f, v0[1] * 16.f, v0[2] * 16.f, v0[3] * 16.f), pack_fp8x4(v1[0] * 16.f, v1[1] * 16.f, v1[2] * 16.f, v1[3] * 16.f)};
                        *(u32x2*)((unsigned char*)merged + row * 2048 + col + bj * 128) = w;
#else
                        u32x4 w = {cvt_pk_bf16(v0[0], v0[1]), cvt_pk_bf16(v0[2], v0[3]), cvt_pk_bf16(v1[0], v1[1]), cvt_pk_bf16(v1[2], v1[3])};
                        *(u32x4*)(merged + row * 2048 + col + bj * 128) = w;
#endif
                    } } }
        }
        return b < 2;
    }
};
#else
struct EpiMerge {
    static constexpr bool PERM = true; const bf16_t* proj; bf16_t* merged;
    __device__ __forceinline__ void operator()(const f32x4 (&acc)[2][2][4][2], const ge::Unit& u, int wr, int wc, int fr, int fq) const {
        const int col = u.c0 + wc * 32 + 8 * fq;
#pragma unroll
        for (int ai = 0; ai < 2; ++ai) {
            u32x4 gw[4][2], pw[4][2];
#pragma unroll
            for (int m = 0; m < 4; ++m) { const size_t row = (size_t)(u.r0 + ai * 128 + wr * 64 + m * 16 + fr);
#pragma unroll
                for (int bj = 0; bj < 2; ++bj) {
#if INPROJ_F8 == 3
                    { const u32x2 g8 = *(const u32x2*)((const unsigned char*)(proj + row * LDP + P_MG) + u.aux * 2048 + col + bj * 128); gw[m][bj] = (u32x4){g8[0], g8[1], 0u, 0u}; }
#else
                    gw[m][bj] = *(const u32x4*)(proj + row * LDP + P_MG + u.aux * 2048 + col + bj * 128);
#endif
                    if (u.aux > 0) pw[m][bj] = *(const u32x4*)(merged + row * 2048 + col + bj * 128); else pw[m][bj] = (u32x4){0u, 0u, 0u, 0u}; } }
#pragma unroll
            for (int m = 0; m < 4; ++m) { const size_t row = (size_t)(u.r0 + ai * 128 + wr * 64 + m * 16 + fr);
#pragma unroll
                for (int bj = 0; bj < 2; ++bj) { const u32x4 g = gw[m][bj], q = pw[m][bj]; const f32x4 v0 = acc[ai][bj][m][0], v1 = acc[ai][bj][m][1];
#if INPROJ_F8 == 3
                    constexpr float I255 = 1.f / 255.f;
                    const float s0 = (float)(g[0] & 255u) * I255, s1 = (float)((g[0] >> 8) & 255u) * I255, s2 = (float)((g[0] >> 16) & 255u) * I255, s3 = (float)(g[0] >> 24) * I255;
                    const float s4 = (float)(g[1] & 255u) * I255, s5 = (float)((g[1] >> 8) & 255u) * I255, s6 = (float)((g[1] >> 16) & 255u) * I255, s7 = (float)(g[1] >> 24) * I255;
#else
                    const float s0 = fast_sigmoid(bf_lo(g[0])), s1 = fast_sigmoid(bf_hi(g[0])), s2 = fast_sigmoid(bf_lo(g[1])), s3 = fast_sigmoid(bf_hi(g[1])), s4 = fast_sigmoid(bf_lo(g[2])), s5 = fast_sigmoid(bf_hi(g[2])), s6 = fast_sigmoid(bf_lo(g[3])), s7 = fast_sigmoid(bf_hi(g[3]));
#endif
                    const float o0 = v0[0] * s0 + bf_lo(q[0]), o1 = v0[1] * s1 + bf_hi(q[0]), o2 = v0[2] * s2 + bf_lo(q[1]), o3 = v0[3] * s3 + bf_hi(q[1]);
                    const float o4 = v1[0] * s4 + bf_lo(q[2]), o5 = v1[1] * s5 + bf_hi(q[2]), o6 = v1[2] * s6 + bf_lo(q[3]), o7 = v1[3] * s7 + bf_hi(q[3]);
                    u32x4 w = {cvt_pk_bf16(o0, o1), cvt_pk_bf16(o2, o3), cvt_pk_bf16(o4, o5), cvt_pk_bf16(o6, o7)};
                    *(u32x4*)(merged + row * 2048 + col + bj * 128) = w; } }
        }
    }
};
#endif
__device__ __forceinline__ void p_merge(const Frame& F0, int l) {
    const Frame F = phase_frame(F0);
    SchedMerge S{(const char*)(F.ws + WS_OM), (const char*)(F.ws + WS_WBR) + (size_t)l * 3 * 2048 * 1024 * 2, F.G, F.c};
    EpiMerge E{(const bf16_t*)(F.ws + WS_PROJ), (bf16_t*)(F.ws + WS_MERGED)};
    ge::gemm_phase<EpiMerge, SchedMerge, 0>(F.lds, F.tid, 1024, 0, S, E);
}

struct EpiResF32 {
    static constexpr bool PERM = false; const float* R; float* C;
    __device__ __forceinline__ void operator()(const f32x4 (&acc)[2][2][4][2], const ge::Unit& u, int wr, int wc, int fr, int fq) const {
#pragma unroll
        for (int ai = 0; ai < 2; ++ai) {
            f32x4 r[4][2][2];
#pragma unroll
            for (int m = 0; m < 4; ++m) { const size_t off = (size_t)(u.r0 + ai * 128 + wr * 64 + m * 16 + fr) * D + u.c0 + wc * 32 + 4 * fq;
#pragma unroll
                for (int bj = 0; bj < 2; ++bj)
#pragma unroll
                    for (int n = 0; n < 2; ++n) r[m][bj][n] = *(const f32x4*)(R + off + bj * 128 + n * 16); }
#pragma unroll
            for (int m = 0; m < 4; ++m) { const size_t off = (size_t)(u.r0 + ai * 128 + wr * 64 + m * 16 + fr) * D + u.c0 + wc * 32 + 4 * fq;
#pragma unroll
                for (int bj = 0; bj < 2; ++bj)
#pragma unroll
                    for (int n = 0; n < 2; ++n) *(f32x4*)(C + off + bj * 128 + n * 16) = acc[ai][bj][m][n] + r[m][bj][n]; }
        }
    }
};
template <bool RF32>
struct EpiResBf16 {
    static constexpr bool PERM = true; const void* R; bf16_t* C;
    __device__ __forceinline__ void operator()(const f32x4 (&acc)[2][2][4][2], const ge::Unit& u, int wr, int wc, int fr, int fq) const {
#pragma unroll
        for (int ai = 0; ai < 2; ++ai) {
            f32x4 r[4][2][2];
#pragma unroll
            for (int m = 0; m < 4; ++m) { const size_t off = (size_t)(u.r0 + ai * 128 + wr * 64 + m * 16 + fr) * D + u.c0 + wc * 32 + 8 * fq;
#pragma unroll
                for (int bj = 0; bj < 2; ++bj) {
                    if (RF32) { r[m][bj][0] = __builtin_nontemporal_load((const f32x4*)((const float*)R + off + bj * 128)); r[m][bj][1] = __builtin_nontemporal_load((const f32x4*)((const float*)R + off + bj * 128 + 4)); }
                    else { const u32x4 q = *(const u32x4*)((const bf16_t*)R + off + bj * 128); r[m][bj][0] = (f32x4){bf_lo(q[0]), bf_hi(q[0]), bf_lo(q[1]), bf_hi(q[1])}; r[m][bj][1] = (f32x4){bf_lo(q[2]), bf_hi(q[2]), bf_lo(q[3]), bf_hi(q[3])}; } } }
#pragma unroll
            for (int m = 0; m < 4; ++m) { const size_t off = (size_t)(u.r0 + ai * 128 + wr * 64 + m * 16 + fr) * D + u.c0 + wc * 32 + 8 * fq;
#pragma unroll
                for (int bj = 0; bj < 2; ++bj) { const f32x4 v0 = acc[ai][bj][m][0] + r[m][bj][0], v1 = acc[ai][bj][m][1] + r[m][bj][1];
                    u32x4 w = {cvt_pk_bf16(v0[0], v0[1]), cvt_pk_bf16(v0[2], v0[3]), cvt_pk_bf16(v1[0], v1[1]), cvt_pk_bf16(v1[2], v1[3])};
                    *(u32x4*)(C + off + bj * 128) = w; } }
        }
    }
};
__device__ __forceinline__ void p_wout(const Frame& F0, int l) {
    const Frame F = phase_frame(F0);
    constexpr bool W8 = WOUT_F8 != 0;
    SchedDenseT<W8> S{(const char*)(F.ws + WS_MERGED), (const char*)(F.ws + WS_WOUT) + (size_t)l * 2048 * 2048 * 2, 2048, 2048, T / 256, 8, F.G, F.c};
    if (l == 0) { EpiResBf16<true> E{(const void*)F.in(0), (bf16_t*)(F.ws + WS_XB)}; ge::gemm_phase<EpiResBf16<true>, SchedDenseT<W8>, 0, W8>(F.lds, F.tid, 2048, 0, S, E); }
    else { EpiResBf16<false> E{(const void*)(F.ws + WS_XB), (bf16_t*)(F.ws + WS_XB)}; ge::gemm_phase<EpiResBf16<false>, SchedDenseT<W8>, 0, W8>(F.lds, F.tid, 2048, 0, S, E); }
}

constexpr size_t WS_WR = WS_END_SMALL;
constexpr size_t WS_END2 = WS_WR + al256((size_t)NL * 2048 * 64 * 4);

__device__ __forceinline__ void p_conv_router(const Frame& F0) {
    const Frame F = phase_frame(F0);
    bf16_t* wr = (bf16_t*)(F.ws + WS_WR);
    const float* g2 = F.in(13); const float* rgw = F.in(14); const float* rew = F.in(16);
    for (int i = F.c * NTHR + F.tid; i < NL * 64 * 2048; i += F.G * NTHR) {
        const int d = i & 2047, j = (i >> 11) & 63, l = i >> 17;
        float v = 0.f;
        if (j < 4) v = rgw[((size_t)l * 2048 + d) * 4 + j]; else if (j < 36) v = rew[((size_t)l * 2048 + d) * 32 + (j - 4)];
        v *= g2[l * 2048 + d];
        const bf16_t h = f2bf(v); const bf16_t lo = f2bf(v - bf2f(h));
        wr[((size_t)(l * 2 + 0) * 64 + j) * 2048 + d] = h; wr[((size_t)(l * 2 + 1) * 64 + j) * 2048 + d] = lo;
    }
}

template <bool F8, bool DRY = false>
__device__ __forceinline__ void p_route1(const Frame& F0, int l) {
    const Frame F = phase_frame(F0);
    const bf16_t* x = (const bf16_t*)(F.ws + WS_XB);
    const bf16_t* wr = (const bf16_t*)(F.ws + WS_WR) + (size_t)l * 2 * 64 * 2048;
    const float* g2 = F.in(13) + l * D; const float* rgb = F.in(15) + l * 4; const float* reb = F.in(17) + l * 32;
    unsigned* ctl = (unsigned*)(F.ws + WS_CTL);
    int* list = (int*)(F.ws + WS_LIST); float* listw = (float*)(F.ws + WS_LISTW);
    LAS float* part = (LAS float*)F.lds;
    LAS float* ssq = (LAS float*)(F.lds + 65536);
    LAS float* lg = (LAS float*)(F.lds + 65536 + 1024);
    LAS float* rstd_s = (LAS float*)(F.lds + 65536 + 1024 + 64 * 40 * 4);
    const int w = F.wave, lane = F.lane, rh = w >> 2, kq = w & 3, r32 = lane & 31, hi = lane >> 5;
    for (int rg = F.c; rg < T / 64; rg += F.G) {
        const int row0 = rg * 64;
        f32x16 acc0, acc1;
#pragma unroll
        for (int r = 0; r < 16; ++r) { acc0[r] = 0.f; acc1[r] = 0.f; }
        float ss = 0.f;
        const bf16_t* xr = x + (size_t)(row0 + rh * 32 + r32) * D + kq * 512 + 8 * hi;
        const bf16_t* wh = wr + (size_t)r32 * 2048 + kq * 512 + 8 * hi; const bf16_t* wl = wh + (size_t)64 * 2048;
        for (int ks = 0; ks < 32; ++ks) {
            const u32x4 ah = *(const u32x4*)(xr + ks * 16);
            { const float a0 = bf_lo(ah[0]), a1 = bf_hi(ah[0]), a2 = bf_lo(ah[1]), a3 = bf_hi(ah[1]), a4 = bf_lo(ah[2]), a5 = bf_hi(ah[2]), a6 = bf_lo(ah[3]), a7 = bf_hi(ah[3]);
              ss += a0 * a0 + a1 * a1 + a2 * a2 + a3 * a3 + a4 * a4 + a5 * a5 + a6 * a6 + a7 * a7; }
            const bf16x8 fah = __builtin_bit_cast(bf16x8, ah);
            const bf16x8 b0h = *(const bf16x8*)(wh + ks * 16), b0l = *(const bf16x8*)(wl + ks * 16), b1h = *(const bf16x8*)(wh + (size_t)32 * 2048 + ks * 16), b1l = *(const bf16x8*)(wl + (size_t)32 * 2048 + ks * 16);
            acc0 = __builtin_amdgcn_mfma_f32_32x32x16_bf16(fah, b0h, acc0, 0, 0, 0); acc0 = __builtin_amdgcn_mfma_f32_32x32x16_bf16(fah, b0l, acc0, 0, 0, 0);
            acc1 = __builtin_amdgcn_mfma_f32_32x32x16_bf16(fah, b1h, acc1, 0, 0, 0); acc1 = __builtin_amdgcn_mfma_f32_32x32x16_bf16(fah, b1l, acc1, 0, 0, 0);
        }
        ss += __shfl_xor(ss, 32);
        if (hi == 0) ssq[w * 32 + r32] = ss;
#pragma unroll
        for (int r = 0; r < 16; ++r) { const int row = (r & 3) + 8 * (r >> 2) + 4 * hi; part[(w * 32 + row) * 64 + r32] = acc0[r]; part[(w * 32 + row) * 64 + 32 + r32] = acc1[r]; }
        __syncthreads();
        { const int row = F.tid >> 3, sub = F.tid & 7, rr = row & 31, rhh = row >> 5;
          float s2 = ssq[(rhh * 4 + 0) * 32 + rr] + ssq[(rhh * 4 + 1) * 32 + rr] + ssq[(rhh * 4 + 2) * 32 + rr] + ssq[(rhh * 4 + 3) * 32 + rr];
          const float rstd = rsqrtf(s2 * (1.f / D) + 1e-6f);
          if (sub == 0) rstd_s[row] = rstd;
#pragma unroll
          for (int q = 0; q < 5; ++q) { const int j = sub * 5 + q; if (j < 36) {
              float a = part[((rhh * 4 + 0) * 32 + rr) * 64 + j] + part[((rhh * 4 + 1) * 32 + rr) * 64 + j] + part[((rhh * 4 + 2) * 32 + rr) * 64 + j] + part[((rhh * 4 + 3) * 32 + rr) * 64 + j];
              lg[row * 40 + j] = a * rstd + (j < 4 ? rgb[j] : reb[j - 4]); } } }
        __syncthreads();
        if (F.tid < 64 && !DRY) {
            const int row = F.tid; const LAS float* L = lg + row * 40;
            int grp = 0; float gm = L[0];
#pragma unroll
            for (int j = 1; j < 4; ++j) if (L[j] > gm) { gm = L[j]; grp = j; }
            float den = 0.f;
#pragma unroll
            for (int j = 0; j < 4; ++j) den += expf(L[j] - gm);
            const float pg = 1.f / den;
            const LAS float* el = L + 4 + grp * 8;
            int i0 = 0; for (int j = 1; j < 8; ++j) if (el[j] > el[i0]) i0 = j;
            int i1 = -1; for (int j = 0; j < 8; ++j) { if (j == i0) continue; if (i1 < 0 || el[j] > el[i1]) i1 = j; }
            const float e1 = expf(el[i1] - el[i0]), d2 = 1.f + e1;
            const int ea = grp * 8 + i0, eb = grp * 8 + i1;
            const unsigned pa = atomicAdd(&ctl[CW_CNT + l * 32 + ea], 1u), pb = atomicAdd(&ctl[CW_CNT + l * 32 + eb], 1u);
            int* rt = (int*)(F.ws + WS_ROUTE) + (size_t)(row0 + row) * 8;
            rt[0] = ea; rt[1] = eb; ((float*)rt)[2] = pg / d2; ((float*)rt)[3] = pg * e1 / d2; rt[4] = (int)pa; rt[5] = (int)pb;
            list[(size_t)ea * MOE_CAP + pa] = row0 + row; listw[(size_t)ea * MOE_CAP + pa] = pg / d2; list[(size_t)eb * MOE_CAP + pb] = row0 + row; listw[(size_t)eb * MOE_CAP + pb] = pg * e1 / d2;
        }
        for (int q = 0; q < 8; ++q) { const int row = w * 8 + q; const float rstd = rstd_s[row];
            const bf16_t* xr2 = x + (size_t)(row0 + row) * D; bf16_t* hr = (bf16_t*)(F.ws + WS_H) + (size_t)(row0 + row) * D; unsigned char* hr8 = F.ws + WS_H + (size_t)(row0 + row) * D;
#pragma unroll
            for (int i = 0; i < 8; ++i) { const u32x2 xw = *(const u32x2*)(xr2 + i * 256 + lane * 4); const f32x4 v = {bf_lo(xw[0]), bf_hi(xw[0]), bf_lo(xw[1]), bf_hi(xw[1])}; const f32x4 gv = *(const f32x4*)(g2 + i * 256 + lane * 4);
                if (F8) { *(unsigned*)(hr8 + i * 256 + lane * 4) = pack_fp8x4(v[0] * rstd * gv[0] * 16.f, v[1] * rstd * gv[1] * 16.f, v[2] * rstd * gv[2] * 16.f, v[3] * rstd * gv[3] * 16.f); }
                else { u32x2 wv; wv[0] = cvt_pk_bf16(v[0] * rstd * gv[0], v[1] * rstd * gv[1]); wv[1] = cvt_pk_bf16(v[2] * rstd * gv[2], v[3] * rstd * gv[3]); *(u32x2*)(hr + i * 256 + lane * 4) = wv; } } }
        __syncthreads();
    }
}

struct MoeTab { int ntiles; };
__device__ __forceinline__ int moe_build_tab(const Frame& F, int l, LAS int* tab  ) {
    unsigned* ctl = (unsigned*)(F.ws + WS_CTL);
    if (F.tid < 64) { const int e = F.tid; const int cnt = e < 32 ? (int)__hip_atomic_load(&ctl[CW_CNT + l * 32 + e], __ATOMIC_RELAXED, __HIP_MEMORY_SCOPE_AGENT) : 0;
        const int nt = (cnt + 255) >> 8; int pre = nt;
#pragma unroll
        for (int o = 1; o < 32; o <<= 1) { const int v = __shfl_up(pre, o); if (e >= o) pre += v; }
        const int first = pre - nt;
        if (e < 32) { tab[e] = first * 256; tab[32 + e] = cnt;
            for (int k = 0; k < nt; ++k) { tab[64 + first + k] = e; tab[224 + first + k] = (first + k) * 256; } }
        if (e == 31) tab[384] = pre; }
    __syncthreads();
    return tab[384];
}
template <bool F8>
struct SchedMoeGUT {
    static constexpr bool GATHER = true;
    const char* H; const char* W; const int* list; LAS int* tab; int G, c, ntiles;
    __device__ __forceinline__ bool next(int i, ge::Unit& u) const { const int L = i * G + c; if (L >= ntiles * 4) return false; const int ti = L >> 2, ct = L & 3; const int e = tab[64 + ti];
        u.A = H; u.B = W + ((size_t)e * 1024 + ct * 256) * 2048 * (F8 ? 1 : 2); u.r0 = tab[224 + ti]; u.c0 = ct * 128; u.aux = e; u.aux2 = u.r0 - tab[e]; return true; }
    __device__ __forceinline__ void voffA(const ge::Unit& u, int tid, unsigned (&v)[2][2]) const {
#pragma unroll
        for (int i = 0; i < 2; ++i) { int R, C; ge::stage_rc(tid * 16 + i * 8192, R, C); const int cnt_ = tab[32 + u.aux], l0_ = u.aux2 + R, l1_ = l0_ + 128; const int* lp_ = list + (size_t)u.aux * MOE_CAP; const int t0 = l0_ < cnt_ ? lp_[l0_] : 0, t1 = l1_ < cnt_ ? lp_[l1_] : 0;     v[0][i] = F8 ? (unsigned)(t0 * 2048 + C * 2) : (unsigned)(t0 * 2048 + C) * 2u; v[1][i] = F8 ? (unsigned)(t1 * 2048 + C * 2) : (unsigned)(t1 * 2048 + C) * 2u; } }
};
template <bool F8>
struct EpiGUT {
    static constexpr bool PERM = true; void* hidv;
    __device__ __forceinline__ void operator()(const f32x4 (&acc)[2][2][4][2], const ge::Unit& u, int wr, int wc, int fr, int fq) const {
#pragma unroll
        for (int ai = 0; ai < 2; ++ai)
#pragma unroll
            for (int m = 0; m < 4; ++m) { const f32x4 g0 = acc[ai][0][m][0], g1 = acc[ai][0][m][1], u0 = acc[ai][1][m][0], u1 = acc[ai][1][m][1];
                float h[8] = {fast_silu(g0[0]) * u0[0], fast_silu(g0[1]) * u0[1], fast_silu(g0[2]) * u0[2], fast_silu(g0[3]) * u0[3], fast_silu(g1[0]) * u1[0], fast_silu(g1[1]) * u1[1], fast_silu(g1[2]) * u1[2], fast_silu(g1[3]) * u1[3]};
                const size_t off = (size_t)(u.r0 + ai * 128 + wr * 64 + m * 16 + fr) * 512 + u.c0 + wc * 32 + 8 * fq;
                if (F8) {
#pragma unroll
                    for (int j = 0; j < 8; ++j) h[j] = fminf(fmaxf(h[j] * 8.f, -440.f), 440.f);
                    u32x2 w = {pack_fp8x4(h[0], h[1], h[2], h[3]), pack_fp8x4(h[4], h[5], h[6], h[7])}; *(u32x2*)((unsigned char*)hidv + off) = w; }
                else { u32x4 w = {cvt_pk_bf16(h[0], h[1]), cvt_pk_bf16(h[2], h[3]), cvt_pk_bf16(h[4], h[5]), cvt_pk_bf16(h[6], h[7])}; *(u32x4*)((bf16_t*)hidv + off) = w; } }
    }
};
template <bool F8>
__device__ __forceinline__ void p_moe_gu(const Frame& F0, int l) {
    const Frame F = phase_frame(F0);
    LAS int* tab = (LAS int*)(F.lds + LDS_MISC);
    const int nt = moe_build_tab(F, l, tab);
    SchedMoeGUT<F8> S{(const char*)(F.ws + WS_H), (const char*)(F.ws + WS_WGU), (const int*)(F.ws + WS_LIST), tab, F.G, F.c, nt};
    EpiGUT<F8> E{(void*)(F.ws + WS_HID)};
    ge::gemm_phase<EpiGUT<F8>, SchedMoeGUT<F8>, 0, F8>(F.lds, F.tid, 2048, 0, S, E);
}
template <bool F8>
struct SchedMoeDT {
    static constexpr bool GATHER = false;
    const char* HID; const char* W; LAS int* tab; int G, c, ntiles;
    __device__ __forceinline__ bool next(int i, ge::Unit& u) const { const int L = i * G + c; if (L >= ntiles * 8) return false; const int ti = L >> 3, ct = L & 7; const int e = tab[64 + ti];
        u.r0 = tab[224 + ti]; u.A = HID + (size_t)u.r0 * 512 * (F8 ? 1 : 2); u.B = W + ((size_t)e * 2048 + ct * 256) * 512 * (F8 ? 1 : 2); u.c0 = ct * 256; u.aux = e; u.aux2 = u.r0 - tab[e]; return true; }
    __device__ __forceinline__ void voffA(const ge::Unit&, int tid, unsigned (&v)[2][2]) const { ge::dense_voffA<F8>(512, tid, v); }
};
struct EpiDown {
    static constexpr bool PERM = true; bf16_t* y; const float* listw; LAS int* tab;
    __device__ __forceinline__ void operator()(const f32x4 (&acc)[2][2][4][2], const ge::Unit& u, int wr, int wc, int fr, int fq) const {
        float rs[2][4];
#pragma unroll
        for (int ai = 0; ai < 2; ++ai)
#pragma unroll
            for (int m = 0; m < 4; ++m) { const int lr_ = u.aux2 + ai * 128 + wr * 64 + m * 16 + fr; rs[ai][m] = lr_ < tab[32 + u.aux] ? listw[(size_t)u.aux * MOE_CAP + lr_] : 0.f; }
#pragma unroll
        for (int ai = 0; ai < 2; ++ai)
#pragma unroll
            for (int m = 0; m < 4; ++m) { const int row = u.r0 + ai * 128 + wr * 64 + m * 16 + fr; const float s = rs[ai][m]; bf16_t* rowp = y + (size_t)row * 2048 + u.c0 + wc * 32 + 8 * fq;
#pragma unroll
                for (int bj = 0; bj < 2; ++bj) {
#if Y_F8
                    const f32x4 v0 = acc[ai][bj][m][0] * (s * 64.f), v1 = acc[ai][bj][m][1] * (s * 64.f);
                    u32x2 w = {pack_fp8x4(v0[0], v0[1], v0[2], v0[3]), pack_fp8x4(v1[0], v1[1], v1[2], v1[3])};
                    *(u32x2*)((unsigned char*)y + (size_t)row * 2048 + u.c0 + wc * 32 + 8 * fq + bj * 128) = w;
#else
                    const f32x4 v0 = acc[ai][bj][m][0] * s, v1 = acc[ai][bj][m][1] * s; u32x4 w = {cvt_pk_bf16(v0[0], v0[1]), cvt_pk_bf16(v0[2], v0[3]), cvt_pk_bf16(v1[0], v1[1]), cvt_pk_bf16(v1[2], v1[3])};
                    *(u32x4*)(rowp + bj * 128) = w;
#endif
                } }
    }
};
template <bool F8>
__device__ __forceinline__ void p_moe_down(const Frame& F0, int l) {
    const Frame F = phase_frame(F0);
    LAS int* tab = (LAS int*)(F.lds + LDS_MISC);
    const int nt = moe_build_tab(F, l, tab);
    SchedMoeDT<F8> S{(const char*)(F.ws + WS_HID), (const char*)(F.ws + WS_WD), tab, F.G, F.c, nt};
    EpiDown E{(bf16_t*)(F.ws + WS_YBUF), (const float*)(F.ws + WS_LISTW), tab};
    ge::gemm_phase<EpiDown, SchedMoeDT<F8>, 0, F8, GE_SP2_DEFAULT, GE_ALIGN_DEFAULT, 0x7C7C7C7C>(F.lds, F.tid, 512, 0, S, E);
}
template <bool F8>
__device__ __forceinline__ void p_moe_down_null(const Frame& F0, int l) {
    const Frame F = phase_frame(F0);
    LAS int* tab = (LAS int*)(F.lds + LDS_MISC);
    const int nt = moe_build_tab(F, l, tab);
    SchedMoeDT<F8> S{(const char*)(F.ws + WS_HID), (const char*)(F.ws + WS_WD), tab, F.G, F.c, nt};
    EpiNull E{};
    ge::gemm_phase<EpiNull, SchedMoeDT<F8>, 0, F8, GE_SP2_DEFAULT, GE_ALIGN_DEFAULT, 0x7C7C7C7C>(F.lds, F.tid, 512, 0, S, E);
}
template <int MODE, bool DRY = false>
__device__ __forceinline__ void p_combine(const Frame& F0, int lnext, int lmoe) {
    const Frame F = phase_frame(F0);
    LAS int* tab = (LAS int*)(F.lds + LDS_MISC); moe_build_tab(F, lmoe, tab);
    bf16_t* x = (bf16_t*)(F.ws + WS_XB); float* outp = F.out(); const bf16_t* y = (const bf16_t*)(F.ws + WS_YBUF);
    const float* g = MODE == 0 ? F.in(1) + lnext * D : F.in(21);
    static_assert(Y_F8 != 0, "the pipelined combine reads fp8 expert outputs");
    const int stride = F.G * 8;
    f32x4 gvv[8];
#pragma unroll
    for (int i = 0; i < 8; ++i) gvv[i] = *(const f32x4*)(g + i * 256 + F.lane * 4);
#define CMB_IDX(r_, ra_, rb_) do { ra_ = 0; rb_ = 0; if ((r_) < T) { const int* rt_ = (const int*)(F.ws + WS_ROUTE) + (size_t)(r_) * 8; ra_ = tab[rt_[0]] + rt_[4]; rb_ = tab[rt_[1]] + rt_[5]; } } while (0)
#define CMB_LOAD(r_, ra_, rb_, XW, YA, YB) do { if ((r_) < T) { _Pragma("unroll") for (int i = 0; i < 8; ++i) { XW[i] = *(const u32x2*)(x + (size_t)(r_) * D + i * 256 + F.lane * 4);                        \
            YA[i] = __builtin_nontemporal_load((const unsigned*)((const unsigned char*)y + (size_t)(ra_) * 2048 + i * 256 + F.lane * 4));                                                      \
            YB[i] = __builtin_nontemporal_load((const unsigned*)((const unsigned char*)y + (size_t)(rb_) * 2048 + i * 256 + F.lane * 4)); } } } while (0)
    int row = F.c * 8 + F.wave;
    int ra, rb, ran, rbn; CMB_IDX(row, ra, rb); CMB_IDX(row + stride, ran, rbn);
    u32x2 xw[8]; unsigned ya[8], yb[8];
    CMB_LOAD(row, ra, rb, xw, ya, yb);
    for (; row < T; row += stride) {
        u32x2 xn[8]; unsigned yan[8], ybn[8];
        CMB_LOAD(row + stride, ran, rbn, xn, yan, ybn);
        int ra2, rb2; CMB_IDX(row + 2 * stride, ra2, rb2);
        bf16_t* xr = x + (size_t)row * D; float* orow = outp + (size_t)row * D; f32x4 v[8]; float ss = 0.f;
#pragma unroll
        for (int i = 0; i < 8; ++i) { v[i] = (f32x4){bf_lo(xw[i][0]), bf_hi(xw[i][0]), bf_lo(xw[i][1]), bf_hi(xw[i][1])};
            const f32x2 a0 = __builtin_amdgcn_cvt_pk_f32_fp8((int)ya[i], false), a1 = __builtin_amdgcn_cvt_pk_f32_fp8((int)ya[i], true), b0 = __builtin_amdgcn_cvt_pk_f32_fp8((int)yb[i], false), b1 = __builtin_amdgcn_cvt_pk_f32_fp8((int)yb[i], true);
            v[i][0] += (a0[0] + b0[0]) * (1.f / 64.f); v[i][1] += (a0[1] + b0[1]) * (1.f / 64.f); v[i][2] += (a1[0] + b1[0]) * (1.f / 64.f); v[i][3] += (a1[1] + b1[1]) * (1.f / 64.f);
            ss += v[i][0] * v[i][0] + v[i][1] * v[i][1] + v[i][2] * v[i][2] + v[i][3] * v[i][3]; }
#pragma unroll
        for (int o = 32; o > 0; o >>= 1) ss += __shfl_xor(ss, o);
        const float rstd = rsqrtf(ss * (1.f / D) + 1e-6f);
#pragma unroll
        for (int i = 0; i < 8; ++i) { const f32x4 gv = gvv[i];
            if (DRY) { asm volatile("" :: "v"(v[i][0] * rstd * gv[0]), "v"(v[i][1]), "v"(v[i][2]), "v"(v[i][3])); }
            else if (MODE == 0) { *(u32x2*)(xr + i * 256 + F.lane * 4) = (u32x2){cvt_pk_bf16(v[i][0], v[i][1]), cvt_pk_bf16(v[i][2], v[i][3])}; v[i] = (f32x4){v[i][0] * rstd * gv[0], v[i][1] * rstd * gv[1], v[i][2] * rstd * gv[2], v[i][3] * rstd * gv[3]}; }
            else { f32x4 o = {v[i][0] * rstd * gv[0], v[i][1] * rstd * gv[1], v[i][2] * rstd * gv[2], v[i][3] * rstd * gv[3]}; __builtin_nontemporal_store(o, (f32x4*)(orow + i * 256 + F.lane * 4)); } }
        if (MODE == 0 && !DRY) store_h_row(F.ws, row, v, F.lane);
#pragma unroll
        for (int i = 0; i < 8; ++i) { xw[i] = xn[i]; ya[i] = yan[i]; yb[i] = ybn[i]; }
        ra = ran; rb = rbn; ran = ra2; rbn = rb2;
    }
#undef CMB_IDX
#undef CMB_LOAD
}

namespace att {
constexpr float SCALE = 0.08838834764831845f;
constexpr int NW = 8, QBLK = 32, KVBLK = 64, QB = NW * QBLK, DH = 128;
constexpr int SHM_V = KVBLK * DH * 2, SHM_K = KVBLK * DH * 2;
constexpr int NBUF = 3;
constexpr int ATT_LDS = NBUF * SHM_V + NBUF * SHM_K;
constexpr float THR = 8.f;
typedef short s16x4 __attribute__((ext_vector_type(4)));

#define KSWZ(row, colB) ((row) * 256 + ((colB) ^ (((row) & 7) << 4)))
#define SBAR() __builtin_amdgcn_sched_barrier(0)
__device__ __forceinline__ int v_st(int k, int c) { const int kk = (k & ~0xC) | ((k & 4) << 1) | ((k & 8) >> 1); return ((kk >> 3) * 4 + (c >> 5)) * 512 + ((kk & 7) * 32 + (c & 31)) * 2; }
__device__ __forceinline__ int v_rd_base(int lane) { return ((lane & 3) << 3) | (((lane >> 2) & 3) << 6) | (((lane >> 4) & 1) << 5) | (((lane >> 5) & 1) << 8); }
constexpr int v_rd_off(int d0, int ks, int half) { return d0 * 512 + ks * 4096 + half * 2048; }
__device__ __forceinline__ int crow(int r, int hi) { return (r & 3) + 8 * (r >> 2) + 4 * hi; }
__device__ __forceinline__ bf16x8 load8(const bf16_t* p) { return *reinterpret_cast<const bf16x8*>(p); }

__device__ __forceinline__ void mask_tile(f32x16& p0, f32x16& p1, int dq, unsigned W) {
    const float NEG = -__builtin_inff();
#pragma unroll
    for (int r = 0; r < 16; ++r) {
        const int c = (r & 3) + 8 * (r >> 2);
        if ((unsigned)(dq - c) >= W) p0[r] = NEG;
        if ((unsigned)(dq - c - 32) >= W) p1[r] = NEG;
    }
}
__device__ __forceinline__ void mask_all(f32x16& p0, f32x16& p1, bool ok) {
    const float NEG = -__builtin_inff();
#pragma unroll
    for (int r = 0; r < 16; ++r) { p0[r] = ok ? p0[r] : NEG; p1[r] = ok ? p1[r] : NEG; }
}
__device__ __forceinline__ void partialSM(f32x16& p0, f32x16& p1, float& m_reg, float& mn, float& alpha) {
    float pmax = p0[0]; for (int r = 1; r < 16; ++r) pmax = fmaxf(pmax, p0[r]); for (int r = 0; r < 16; ++r) pmax = fmaxf(pmax, p1[r]);
    { auto rr = __builtin_amdgcn_permlane32_swap(__float_as_uint(pmax), __float_as_uint(pmax), false, false);
      pmax = fmaxf(__uint_as_float(rr[0]), __uint_as_float(rr[1])); }
    constexpr float C2 = 1.4426950408889634f * SCALE;
    if (__builtin_expect(__all((pmax - m_reg) * SCALE <= THR), 1)) { mn = m_reg; alpha = 1.f; }
    else { mn = fmaxf(m_reg, pmax); alpha = __builtin_amdgcn_exp2f((m_reg - mn) * C2); m_reg = mn; }
    const float mnL = -mn * C2;
    for (int r = 0; r < 16; ++r) p0[r] = fmaf(p0[r], C2, mnL); for (int r = 0; r < 16; ++r) p1[r] = fmaf(p1[r], C2, mnL);
    for (int r = 0; r < 16; ++r) p0[r] = __builtin_amdgcn_exp2f(p0[r]);
}
__device__ __forceinline__ void finishSM(f32x16& p0, f32x16& p1, float alpha, float& l_reg, bf16x8& pa0, bf16x8& pa1, bf16x8& pa2, bf16x8& pa3) {
    for (int r = 0; r < 16; ++r) p1[r] = __builtin_amdgcn_exp2f(p1[r]);
    float ps = 0; for (int r = 0; r < 16; ++r) ps += p0[r]; for (int r = 0; r < 16; ++r) ps += p1[r];
    { auto rr = __builtin_amdgcn_permlane32_swap(__float_as_uint(ps), __float_as_uint(ps), false, false);
      ps = __uint_as_float(rr[0]) + __uint_as_float(rr[1]); }
    l_reg = l_reg * alpha + ps;
#define PK4(P, B_, OUT) do { unsigned a0 = cvt_pk_bf16(P[B_+0], P[B_+1]), a1 = cvt_pk_bf16(P[B_+2], P[B_+3]);                          \
        unsigned b0 = cvt_pk_bf16(P[B_+4], P[B_+5]), b1 = cvt_pk_bf16(P[B_+6], P[B_+7]);                                             \
        auto r0 = __builtin_amdgcn_permlane32_swap(a0, b0, false, false); auto r1 = __builtin_amdgcn_permlane32_swap(a1, b1, false, false); \
        u32x4 w = {r0[0], r1[0], r0[1], r1[1]}; OUT = *reinterpret_cast<bf16x8*>(&w); } while (0)
    PK4(p0, 0, pa0); PK4(p0, 8, pa1); PK4(p1, 0, pa2); PK4(p1, 8, pa3);
#undef PK4
}
template <bool SK>
__device__ __forceinline__ void qkt(f32x16& p0, f32x16& p1, const char* K_lds, int koff, int r32, int hi, const bf16x8* qr, bool act) {
    if (SK && !act) { const float NEG = -__builtin_inff();
#pragma unroll
        for (int r = 0; r < 16; ++r) { p0[r] = NEG; p1[r] = NEG; } return; }
    p0 = f32x16{}; p1 = f32x16{};
    const unsigned kb0 = (unsigned)(uintptr_t)(const LAS char*)(K_lds) + (unsigned)koff + (unsigned)KSWZ(r32, (hi * 8) * 2);
    unsigned kbx[4]; kbx[0] = kb0;
    asm volatile("v_xor_b32 %0, 32, %1" : "=v"(kbx[1]) : "v"(kb0)); asm volatile("v_xor_b32 %0, 64, %1" : "=v"(kbx[2]) : "v"(kb0)); asm volatile("v_xor_b32 %0, 0x60, %1" : "=v"(kbx[3]) : "v"(kb0));
#pragma unroll
    for (int d0 = 0; d0 < 8; ++d0) { const unsigned a = kbx[d0 & 3] + (d0 >> 2) * 128;
        bf16x8 b0 = *(const LAS bf16x8*)(a);
        bf16x8 b1 = *(const LAS bf16x8*)(a + 32 * 256);
        p0 = __builtin_amdgcn_mfma_f32_32x32x16_bf16(b0, qr[d0], p0, 0, 0, 0);
        p1 = __builtin_amdgcn_mfma_f32_32x32x16_bf16(b1, qr[d0], p1, 0, 0, 0); }
}
template <bool SK>
__device__ __forceinline__ void pv_tile(f32x16* o, int vb0  , bf16x8 pa0, bf16x8 pa1, bf16x8 pa2, bf16x8 pa3, bool act) {
    if (SK && !act) return;
#define TRRD(dst, off) asm volatile("ds_read_b64_tr_b16 %0, %1 offset:%2" : "=&v"(dst) : "v"(vb0), "i"(off) : "memory")
#define PV_D0(d0) do { s16x4 l0, l1, l2, l3, h0, h1, h2, h3; constexpr int b_ = v_rd_off(d0, 0, 0); \
        TRRD(l0, b_); TRRD(h0, b_ + 2048); TRRD(l1, b_ + 4096); TRRD(h1, b_ + 6144); TRRD(l2, b_ + 8192); TRRD(h2, b_ + 10240); TRRD(l3, b_ + 12288); TRRD(h3, b_ + 14336); \
        asm volatile("s_waitcnt lgkmcnt(0)" ::: "memory"); SBAR(); \
        o[d0] = __builtin_amdgcn_mfma_f32_32x32x16_bf16((bf16x8){l0[0], l0[1], l0[2], l0[3], h0[0], h0[1], h0[2], h0[3]}, pa0, o[d0], 0, 0, 0);   \
        o[d0] = __builtin_amdgcn_mfma_f32_32x32x16_bf16((bf16x8){l1[0], l1[1], l1[2], l1[3], h1[0], h1[1], h1[2], h1[3]}, pa1, o[d0], 0, 0, 0);   \
        o[d0] = __builtin_amdgcn_mfma_f32_32x32x16_bf16((bf16x8){l2[0], l2[1], l2[2], l2[3], h2[0], h2[1], h2[2], h2[3]}, pa2, o[d0], 0, 0, 0);   \
        o[d0] = __builtin_amdgcn_mfma_f32_32x32x16_bf16((bf16x8){l3[0], l3[1], l3[2], l3[3], h3[0], h3[1], h3[2], h3[3]}, pa3, o[d0], 0, 0, 0); } while (0)
    PV_D0(0); PV_D0(1); PV_D0(2); PV_D0(3);
#undef PV_D0
#undef TRRD
}

__device__ __forceinline__ int fresh_lane() { int t; asm volatile("v_mbcnt_lo_u32_b32 %0, -1, 0\n\tv_mbcnt_hi_u32_b32 %0, -1, %0" : "=v"(t)); return t; }
struct BlockRef { const bf16_t* Q; const bf16_t* K; const bf16_t* V; bf16_t* O; const void* mask; const bf16_t* gate; int P0; int pad; };
struct Seam { bf16x8 qr[8]; bf16x8 st_v0, st_v1, st_k0, st_k1; };
__device__ __forceinline__ int swa_jlo(int P0, int W) { const int lowk = P0 - W + 1; return lowk > 0 ? lowk / KVBLK : 0; }
#define ROW(p, k0, rr) ((p) + (size_t)(k0) * LDP + (unsigned)((rr) * LDP + sc))
#define ROWU(p, k0, c_) ((p) + (size_t)((k0) + (c_)) * LDP + rofs)
#define VMW() asm volatile("s_waitcnt vmcnt(0)" ::: "memory")
#define VMWN(n) asm volatile("s_waitcnt vmcnt(%0)" :: "i"(n) : "memory")
#define SLOAD_H(Kp, Vp, k0) do { const bf16_t* vp_ = opaque_ptr((Vp) + (size_t)(k0) * LDP); const bf16_t* kp_ = opaque_ptr((Kp) + (size_t)(k0) * LDP);   \
                         S.st_v0 = load8(vp_ + rofs); S.st_v1 = load8(vp_ + 32 * LDP + rofs);                                 \
                         S.st_k0 = load8(kp_ + rofs); S.st_k1 = load8(kp_ + 32 * LDP + rofs); } while (0)
#define SWRITE_HK(bo) do { *(bf16x8*)(K_lds + (bo) + kws) = S.st_k0; *(bf16x8*)(K_lds + (bo) + kws + 32 * 256) = S.st_k1; } while (0)
#define SWRITE_HV(bo) do { *(bf16x8*)(V_lds + (bo) + vst0) = S.st_v0; *(bf16x8*)(V_lds + (bo) + vst0 + 8192) = S.st_v1; } while (0)
#define SWRITE_H(bf) do { SWRITE_HV(bf); SWRITE_HK(bf); } while (0)
__device__ __forceinline__ void prime(const BlockRef& cur, int W, char* lds, Seam& S, int wid) {
    const int lane = fresh_lane(), tid = wid * 64 + lane, r32 = lane & 31, hi = lane >> 5;
    const int sr = tid >> 4, sc = (tid & 15) * 8, kws = KSWZ(sr, sc * 2); char* K_lds = lds + NBUF * SHM_V; const unsigned rofs = (unsigned)(sr * LDP + sc) & 0xfffffu;
    const int kb0 = swa_jlo(cur.P0, W) * KVBLK;
    for (int d0 = 0; d0 < 8; ++d0) S.qr[d0] = load8(cur.Q + (unsigned)((wid * QBLK + r32) * LDP + hi * 8) + d0 * 16);
    SLOAD_H(cur.K, cur.V, kb0); VMW(); SWRITE_HK(0);
    __syncthreads();
}
template <int MODE, bool SK>
__device__ __forceinline__ void block(const BlockRef& cur, const BlockRef& nxt, int skv, int W, char* lds, Seam& S, int wid) {
    const int lane = fresh_lane(), tid = wid * 64 + lane, r32 = lane & 31, hi = lane >> 5;
    const int j_lo = swa_jlo(cur.P0, W);
    int j_hi = (cur.P0 + QB - 1) / KVBLK + 1; if (j_hi > skv / KVBLK) j_hi = skv / KVBLK;
    const int NT = j_hi - j_lo;
    const int kbn = swa_jlo(nxt.P0, W) * KVBLK;
    const int qlo = cur.P0 + wid * QBLK, qm = qlo + r32 - 4 * hi;
    char* V_lds = lds; char* K_lds = lds + NBUF * SHM_V;
    float m_reg = -1e30f, l_reg = 0; f32x16 o[4] = {};
    const int sr = tid >> 4, sc = (tid & 15) * 8, vst0 = v_st(sr, sc), kws = KSWZ(sr, sc * 2); const unsigned rofs = (unsigned)(sr * LDP + sc) & 0xfffffu;
    const int vb0 = (int)(uintptr_t)V_lds + v_rd_base(lane);
    const bf16_t* Kh = cur.K; const bf16_t* Vh = cur.V;
    unsigned rowmask = 0xffffffffu;
    if (MODE != 2) { const int l0_ = lane; const int rq_ = wid * QBLK + (l0_ & 31);
        if (MODE == 0) rowmask = ((const unsigned char*)cur.mask)[(unsigned)(rq_ * 8)];
        if (MODE == 1) rowmask = ((const unsigned*)cur.mask)[(unsigned)(rq_ * 2)]; }
    constexpr int BSH = (MODE == 0) ? 8 : 6;
#define RESC(a) do { if (__any((a) < 1.f)) { const float a_ = (a);                                                                   \
                     for (int d_ = 0; d_ < 4; ++d_) for (int r = 0; r < 16; ++r) o[d_][r] *= a_; } } while (0)
#define KBASE(t) ((j_lo + (t)) * KVBLK)
#define ACT(t) (KBASE(t) <= qlo + QBLK - 1 && KBASE(t) + KVBLK - 1 >= qlo - W + 1)
#define MASKT(P0_, P1_, t) do { const int kb_ = KBASE(t); if ((!SK || ACT(t)) && (kb_ + KVBLK - 1 > qlo || kb_ <= qlo + QBLK - 1 - W)) mask_tile(P0_, P1_, qm - kb_, (unsigned)W); \
        if (MODE != 2) { const bool ok_ = (rowmask >> (kb_ >> BSH)) & 1u; if (!__all(ok_)) mask_all(P0_, P1_, ok_); } } while (0)
    constexpr int NQL = 8;
#define SEAM_K0() do { VMWN(NQL); SWRITE_HK(0); SBAR(); } while (0)
    f32x16 pA0, pA1, pB0, pB1; float mnA, mnB, alA, alB; bf16x8 pa0, pa1, pa2, pa3;
    SWRITE_HV(0); SBAR();
    if (NT > 1) { SLOAD_H(Kh, Vh, KBASE(1)); }
    SBAR(); qkt<SK>(pA0, pA1, K_lds, 0, r32, hi, S.qr, ACT(0));
    MASKT(pA0, pA1, 0); partialSM(pA0, pA1, m_reg, mnA, alA);
    if (NT > 1) { VMW(); SWRITE_H(SHM_K); }
    if (NT > 2) { SLOAD_H(Kh, Vh, KBASE(2)); SBAR(); }
    __syncthreads();
    int oc = SHM_K, op = 0, on = 2 * SHM_K;
    const bool lag = wid >= 4;
#define HALF_STEP(PX0, PX1, mnX, alX, PY0, PY1, alY, t) do {                                                                  \
        if ((t) + 1 < NT) { VMW(); SWRITE_H(on); SBAR(); }                                                                    \
        if ((t) + 2 < NT) { SLOAD_H(Kh, Vh, KBASE((t) + 2)); }                                                                \
        SBAR(); qkt<SK>(PX0, PX1, K_lds, oc, r32, hi, S.qr, ACT(t));                                                          \
        finishSM(PY0, PY1, alY, l_reg, pa0, pa1, pa2, pa3); SBAR();                                                           \
        pv_tile<SK>(o, vb0 + op, pa0, pa1, pa2, pa3, ACT((t) - 1));                                                           \
        if (lag) __syncthreads();     \
        MASKT(PX0, PX1, (t)); partialSM(PX0, PX1, m_reg, mnX, alX);                                                           \
        RESC(alX); if (!lag) __syncthreads();                                                                                 \
        op = oc; oc = on; on = (on == 2 * SHM_K) ? 0 : on + SHM_K; } while (0)
    for (int t = 1; t + 1 < NT; t += 2) {
        HALF_STEP(pB0, pB1, mnB, alB, pA0, pA1, alA, t);
        HALF_STEP(pA0, pA1, mnA, alA, pB0, pB1, alB, t + 1);
    }
    const bool even = (NT & 1) == 0;
    if (even) { SBAR(); qkt<SK>(pB0, pB1, K_lds, oc, r32, hi, S.qr, ACT(NT - 1)); SBAR(); }
    SLOAD_H(nxt.K, nxt.V, kbn); SBAR();
    { const int l1_ = fresh_lane(); const unsigned qo_ = (unsigned)((wid * QBLK + (l1_ & 31)) * LDP + (l1_ >> 5) * 8);
#pragma unroll
    for (int d0 = 0; d0 < 8; ++d0) S.qr[d0] = load8(nxt.Q + qo_ + d0 * 16); }
    SBAR();
    finishSM(pA0, pA1, alA, l_reg, pa0, pa1, pa2, pa3); SBAR();
    pv_tile<SK>(o, vb0 + op, pa0, pa1, pa2, pa3, ACT(even ? NT - 2 : NT - 1));
    if (even) { MASKT(pB0, pB1, NT - 1); partialSM(pB0, pB1, m_reg, mnB, alB); __syncthreads(); RESC(alB);
        finishSM(pB0, pB1, alB, l_reg, pa0, pa1, pa2, pa3); SBAR(); pv_tile<SK>(o, vb0 + oc, pa0, pa1, pa2, pa3, ACT(NT - 1)); }
    SBAR(); SEAM_K0();
    { const int le = fresh_lane(); const int r32e = le & 31, hie = le >> 5;
    float sc_ = 1.f / l_reg;
    if (MODE != 0) { const float gl = bf2f(cur.gate[(unsigned)((wid * QBLK + r32e) * LDP)]); sc_ *= fast_sigmoid(gl); }
    char* Ow = (char*)(cur.O + (size_t)(wid * QBLK) * 1024) + (unsigned)(r32e * 2048 + hie * 16);
#pragma unroll
    for (int d0 = 0; d0 < 4; ++d0) {
#pragma unroll
        for (int rp = 0; rp < 2; ++rp) { const int k = d0 * 2 + rp;
            float a0 = o[d0][8 * rp + 0] * sc_, a1 = o[d0][8 * rp + 1] * sc_, a2 = o[d0][8 * rp + 2] * sc_, a3 = o[d0][8 * rp + 3] * sc_;
            float b0 = o[d0][8 * rp + 4] * sc_, b1 = o[d0][8 * rp + 5] * sc_, b2 = o[d0][8 * rp + 6] * sc_, b3 = o[d0][8 * rp + 7] * sc_;
            uint4 w;
            if (MODE == 0) {
                const unsigned ax = cvt_pk_bf16(a0, a1), ay = cvt_pk_bf16(a2, a3), bx = cvt_pk_bf16(b0, b1), by = cvt_pk_bf16(b2, b3);
                auto rx = __builtin_amdgcn_permlane32_swap(ax, bx, false, false); auto ry = __builtin_amdgcn_permlane32_swap(ay, by, false, false);
                w = make_uint4(rx[0], ry[0], rx[1], ry[1]);
            } else {
#define SWP(A_, B_) do { auto r_ = __builtin_amdgcn_permlane32_swap(__float_as_uint(A_), __float_as_uint(B_), false, false); A_ = __uint_as_float(r_[0]); B_ = __uint_as_float(r_[1]); } while (0)
                SWP(a0, b0); SWP(a1, b1); SWP(a2, b2); SWP(a3, b3);
#undef SWP
                const uint4 pw = *(const uint4*)(Ow + k * 32);
                a0 += bf_lo(pw.x); a1 += bf_hi(pw.x); a2 += bf_lo(pw.y); a3 += bf_hi(pw.y);
                b0 += bf_lo(pw.z); b1 += bf_hi(pw.z); b2 += bf_lo(pw.w); b3 += bf_hi(pw.w);
                w = make_uint4(cvt_pk_bf16(a0, a1), cvt_pk_bf16(a2, a3), cvt_pk_bf16(b0, b1), cvt_pk_bf16(b2, b3));
            }
            *(uint4*)(Ow + k * 32) = w; } } }
    __syncthreads();
#undef RESC
#undef KBASE
#undef ACT
#undef MASKT
#undef SEAM_K0
#undef HALF_STEP
}
#undef ROW
#undef ROWU
#undef VMW
#undef VMWN
#undef SLOAD_H
#undef SWRITE_HK
#undef SWRITE_HV
#undef SWRITE_H
#undef KSWZ
#undef SBAR
}
constexpr size_t WS_DUMMY = (size_t)1242 * 1000 * 1000 + 512000;
constexpr size_t WS_MOBAMASK = WS_END2;
constexpr size_t WS_SELMASK = WS_MOBAMASK + al256((size_t)T * 8);
constexpr size_t WS_END3 = WS_SELMASK + al256((size_t)T * 2 * 4);

__device__ __forceinline__ void p_moba_prep(const Frame& F0, int wg0) {
    const Frame F = phase_frame(F0);
    if (F.c < wg0) return;
    const bf16_t* proj = (const bf16_t*)(F.ws + WS_PROJ); unsigned char* mm = (unsigned char*)(F.ws + WS_MOBAMASK);
    LAS float* km = (LAS float*)F.lds;
    LAS float* part = km + 8 * 128;
    for (int u = F.c - wg0; u < NB * 8 * 8; u += F.G - wg0) {
        const int pb = u & 7, h = (u >> 3) & 7, b = u >> 6;
        {
            const int rg = F.tid >> 4, dg = F.tid & 15;
            for (int n = 0; n < pb; ++n) { const bf16_t* kp = proj + ((size_t)b * S + n * 256 + rg * 8) * LDP + P_MK + h * 128 + dg * 8; float a[8];
#pragma unroll
                for (int j = 0; j < 8; ++j) a[j] = 0.f;
#pragma unroll
                for (int r = 0; r < 8; ++r) { const u32x4 kw = *(const u32x4*)(kp + (size_t)r * LDP);
                    a[0] += bf_lo(kw[0]); a[1] += bf_hi(kw[0]); a[2] += bf_lo(kw[1]); a[3] += bf_hi(kw[1]); a[4] += bf_lo(kw[2]); a[5] += bf_hi(kw[2]); a[6] += bf_lo(kw[3]); a[7] += bf_hi(kw[3]); }
                LAS float* pp = part + (n * 32 + rg) * 128 + dg * 8;
                *(LAS f32x4*)pp = (f32x4){a[0], a[1], a[2], a[3]}; *(LAS f32x4*)(pp + 4) = (f32x4){a[4], a[5], a[6], a[7]}; }
            __syncthreads();
            for (int idx = F.tid; idx < pb * 128; idx += NTHR) { const int n = idx >> 7, d = idx & 127; float a = 0.f;
#pragma unroll 8
                for (int q = 0; q < 32; ++q) a += part[(n * 32 + q) * 128 + d];
                km[n * 128 + d] = a * (1.f / 256.f); }
            __syncthreads();
        }
        const int pos = F.tid >> 1, half = F.tid & 1; const size_t t = (size_t)b * S + pb * 256 + pos;
        float gt[8];
#pragma unroll
        for (int n = 0; n < 8; ++n) gt[n] = 0.f;
        const bf16_t* qp = proj + t * LDP + P_MQ + h * 128 + half * 64;
        for (int c8 = 0; c8 < 8; ++c8) { const u32x4 qw = *(const u32x4*)(qp + c8 * 8);
            const float qf[8] = {bf_lo(qw[0]), bf_hi(qw[0]), bf_lo(qw[1]), bf_hi(qw[1]), bf_lo(qw[2]), bf_hi(qw[2]), bf_lo(qw[3]), bf_hi(qw[3])};
#pragma unroll
            for (int n = 0; n < 8; ++n) if (n < pb) {
#pragma unroll
                for (int j = 0; j < 8; ++j) gt[n] += qf[j] * km[n * 128 + half * 64 + c8 * 8 + j]; } }
        unsigned taken = 0;
#pragma unroll
        for (int n = 0; n < 8; ++n) { gt[n] += __shfl_xor(gt[n], 1); if (n >= pb) gt[n] = -1e30f; }
#pragma unroll
        for (int k = 0; k < 3; ++k) { int best = -1; float bv = 0.f;
#pragma unroll
            for (int n = 0; n < 8; ++n) if (!((taken >> n) & 1u) && (best < 0 || gt[n] > bv)) { best = n; bv = gt[n]; }
            taken |= 1u << best; }
        unsigned m = (taken & ((1u << pb) - 1u)) | (1u << pb);
        if (half == 0) mm[t * 8 + h] = (unsigned char)m;
        __syncthreads();
    }
}
__device__ __forceinline__ int xcd_item(int i, int n) { return (i & 7) * (n >> 3) + (i >> 3); }
__device__ __forceinline__ att::BlockRef ref_moba(const bf16_t* proj, bf16_t* om, const unsigned char* mm, int L, int pass) {
    const int bh = L >> 2, y = L & 3, b = bh >> 3, h = bh & 7; const int qb = pass ? y : 7 - y;     const size_t t0 = (size_t)b * S + qb * 256;
    att::BlockRef r; r.Q = proj + t0 * LDP + P_MQ + h * 128; r.K = proj + (size_t)b * S * LDP + P_MK + h * 128; r.V = proj + (size_t)b * S * LDP + P_MV + h * 128;
    r.O = om + t0 * 1024 + h * 128; r.mask = mm + t0 * 8 + h; r.gate = nullptr; r.P0 = qb * 256; r.pad = 0; return r; }
template <int BR>
__device__ __forceinline__ att::BlockRef ref_nsa(const bf16_t* proj, bf16_t* on, const unsigned* sm, int L, int pass) {
    const int bh = L >> 2, y = L & 3, b = bh >> 3, h = bh & 7, g = h >> 2; const int qb = pass ? y : 7 - y;     const size_t t0 = (size_t)b * S + qb * 256;
    att::BlockRef r; r.Q = proj + t0 * LDP + P_NQ + h * 128; r.K = proj + (size_t)b * S * LDP + P_NKV + (2 + 2 * BR) * 256 + g * 128; r.V = proj + (size_t)b * S * LDP + P_NKV + (3 + 2 * BR) * 256 + g * 128;
    r.O = on + t0 * 1024 + h * 128; r.mask = sm + t0 * 2 + g; r.gate = proj + t0 * LDP + P_NG + h * 3 + 1 + BR; r.P0 = qb * 256; r.pad = 0; return r; }
template <int WIN, bool DUMMY>
__device__ __forceinline__ void p_moba_attn_t(const Frame& F0) {
    const Frame F = phase_frame(F0);
    const bf16_t* proj = (const bf16_t*)(F.ws + WS_PROJ); bf16_t* om = (bf16_t*)(F.ws + (DUMMY ? WS_DUMMY : WS_OM)); const unsigned char* mm = (const unsigned char*)(F.ws + WS_MOBAMASK);
    const int total = NB * 8 * 8;

    const int nitems = total / 2;
    int L = F.c; if (L >= nitems) return;
    int pass = 0; att::BlockRef cur = ref_moba(proj, om, mm, xcd_item(L, nitems), 0); att::Seam Sm;
    att::prime(cur, WIN, (char*)F.lds, Sm, F.wave);
    for (;;) {
        const bool more_pass = pass == 0, more_item = L + F.G < nitems, last = !more_pass && !more_item;
        int passn = pass + 1, Ln = L; if (!more_pass) { passn = 0; Ln = more_item ? L + F.G : L; }
        const att::BlockRef nxt = last ? cur : ref_moba(proj, om, mm, xcd_item(Ln, nitems), passn);
        att::block<0, false>(cur, nxt, S, WIN, (char*)F.lds, Sm, F.wave);
        if (last) break;
        cur = nxt; pass = passn; L = Ln;
    }
}
__device__ __forceinline__ void p_moba_attn(const Frame& F0) { p_moba_attn_t<(1 << 20), false>(F0); }
template <bool DUMMY>
__device__ __forceinline__ void p_nsa_attn_t(const Frame& F0) {
    const int nitems = NB * 8 * 4;
    if (F0.c >= nitems) return;
    {
        const Frame F = phase_frame(F0);
        const bf16_t* proj = (const bf16_t*)(F.ws + WS_PROJ); bf16_t* on = (bf16_t*)(F.ws + (DUMMY ? WS_DUMMY : WS_ON)); const unsigned* sm = (const unsigned*)(F.ws + WS_SELMASK);

        int L = F.c, pass = 0; att::BlockRef cur = ref_nsa<0>(proj, on, sm, xcd_item(L, nitems), 0); att::Seam Sm;
        att::prime(cur, 1 << 20, (char*)F.lds, Sm, F.wave);
        for (;;) {
            const bool more_pass = pass == 0, more_item = L + F.G < nitems, last = !more_pass && !more_item;
            int passn = pass + 1, Ln = L; if (!more_pass) { passn = 0; Ln = more_item ? L + F.G : L; }
            const att::BlockRef nxt = last ? cur : ref_nsa<0>(proj, on, sm, xcd_item(Ln, nitems), passn);
            att::block<1, false>(cur, nxt, S, 1 << 20, (char*)F.lds, Sm, F.wave);
            if (last) break;
            cur = nxt; pass = passn; L = Ln;
        }
    }
    {
        const Frame F = phase_frame(F0);
        const bf16_t* proj = (const bf16_t*)(F.ws + WS_PROJ); bf16_t* on = (bf16_t*)(F.ws + (DUMMY ? WS_DUMMY : WS_ON)); const unsigned* sm = (const unsigned*)(F.ws + WS_SELMASK);

        int L = F.c, pass = 0; att::BlockRef cur = ref_nsa<1>(proj, on, sm, xcd_item(L, nitems), 0); att::Seam Sm;
        att::prime(cur, 512, (char*)F.lds, Sm, F.wave);
        for (;;) {
            const bool more_pass = pass == 0, more_item = L + F.G < nitems, last = !more_pass && !more_item;
            int passn = pass + 1, Ln = L; if (!more_pass) { passn = 0; Ln = more_item ? L + F.G : L; }
            const att::BlockRef nxt = last ? cur : ref_nsa<1>(proj, on, sm, xcd_item(Ln, nitems), passn);
            att::block<2, false>(cur, nxt, S, 512, (char*)F.lds, Sm, F.wave);
            if (last) break;
            cur = nxt; pass = passn; L = Ln;
        }
    }
}

__device__ __forceinline__ void p_nsa_attn(const Frame& F0) { p_nsa_attn_t<false>(F0); }

constexpr size_t WS_GDS = WS_MERGED;
constexpr size_t WS_GQT = WS_DEC;
constexpr size_t WS_GDL = WS_END3;
constexpr size_t WS_END4 = WS_GDL + al256((size_t)1024 * 128 * 4);

__device__ __forceinline__ void p_gla1(const Frame& F0, int l) {
    const Frame F = phase_frame(F0);
    const bf16_t* proj = (const bf16_t*)(F.ws + WS_PROJ);
    const float* wa = F.in(6) + (size_t)l * 16 * 512; const float* ba = F.in(7) + (size_t)l * 512;
    bf16_t* ogr16 = (bf16_t*)(F.ws + WS_OGRAW); bf16_t* gds = (bf16_t*)(F.ws + WS_GDS); bf16_t* gqt = (bf16_t*)(F.ws + WS_GQT); float* gdl = (float*)(F.ws + WS_GDL);
    LAS bf16_t* bq = (LAS bf16_t*)F.lds;
    LAS bf16_t* bk = bq + 64 * 136;
    LAS bf16_t* bkT = bk + 64 * 136;
    LAS bf16_t* bvT = bkT + 128 * 72;
    LAS bf16_t* rv = bvT + 256 * 72;
    LAS bf16_t* bA = rv;
    LAS float* gs = (LAS float*)(rv + 64 * 256);
    LAS bf16_t* sga = (LAS bf16_t*)(gs + 512);
    const int tid = F.tid, lane = F.lane, w = F.wave, r32 = lane & 31, hh = lane >> 5;
    unsigned* qh = (unsigned*)(F.ws + WS_CTL) + CW_GQ + 64 * l; LAS int* qs = (LAS int*)(F.lds + LDS_MISC + 8192 + 1024);
    if (tid == 0) qs[0] = (int)xb_add(qh, 1u);
    __syncthreads();
    for (int u = __builtin_amdgcn_readfirstlane(qs[0]); u < 1024; u = __builtin_amdgcn_readfirstlane(qs[0])) {
        unsigned nu_ = 0u; if (tid == 0) nu_ = xb_add(qh, 1u);
        const int c = u & 31, h = (u >> 5) & 3, b = u >> 7; const size_t row0 = (size_t)b * S + c * 64;
        {
            u32x4 lq[2], lk[2], lv[4], lg = {0u, 0u, 0u, 0u};
#pragma unroll
            for (int i = 0; i < 2; ++i) { const int ch = i * NTHR + tid, t = ch >> 4, cc = ch & 15; lq[i] = *(const u32x4*)(proj + (row0 + t) * LDP + P_GQ + h * 128 + cc * 8); lk[i] = *(const u32x4*)(proj + (row0 + t) * LDP + P_GK + h * 128 + cc * 8); }
#pragma unroll
            for (int i = 0; i < 4; ++i) { const int ch = i * NTHR + tid, t = ch >> 5, cc = ch & 31; lv[i] = *(const u32x4*)(proj + (row0 + t) * LDP + P_GV + h * 256 + cc * 8); }
            if (tid < 128) lg = *(const u32x4*)(proj + (row0 + (tid >> 1)) * LDP + P_GA + (tid & 1) * 8);
#pragma unroll
            for (int i = 0; i < 2; ++i) { const int ch = i * NTHR + tid, t = ch >> 4, cc = ch & 15; *(LAS u32x4*)(bq + t * 136 + cc * 8) = lq[i]; *(LAS u32x4*)(bk + t * 136 + cc * 8) = lk[i]; }
#pragma unroll
            for (int i = 0; i < 4; ++i) { const int ch = i * NTHR + tid, t = ch >> 5, cc = ch & 31; *(LAS u32x4*)(rv + t * 256 + cc * 8) = lv[i]; }
            if (tid < 128) *(LAS u32x4*)(sga + (tid >> 1) * 16 + (tid & 1) * 8) = lg;
        }
        __syncthreads();
        {
            const int d = tid & 127, tq = tid >> 7, col = h * 128 + d;
            float war[16];
#pragma unroll
            for (int r = 0; r < 16; ++r) war[r] = wa[r * 512 + col];
            const float bias = ba[col];
            float bl[16]; float cum = 0.f;
#pragma unroll
            for (int i = 0; i < 16; ++i) { const LAS bf16_t* gp = sga + (tq * 16 + i) * 16;
                const u32x4 g0 = *(const LAS u32x4*)gp, g1 = *(const LAS u32x4*)(gp + 8);
                float x = bias + bf_lo(g0[0]) * war[0] + bf_hi(g0[0]) * war[1] + bf_lo(g0[1]) * war[2] + bf_hi(g0[1]) * war[3] + bf_lo(g0[2]) * war[4] + bf_hi(g0[2]) * war[5] + bf_lo(g0[3]) * war[6] + bf_hi(g0[3]) * war[7]
                        + bf_lo(g1[0]) * war[8] + bf_hi(g1[0]) * war[9] + bf_lo(g1[1]) * war[10] + bf_hi(g1[1]) * war[11] + bf_lo(g1[2]) * war[12] + bf_hi(g1[2]) * war[13] + bf_lo(g1[3]) * war[14] + bf_hi(g1[3]) * war[15];
                const float ls = fminf(x, 0.f) - 0.6931471805599453f * __builtin_amdgcn_logf(1.f + __builtin_amdgcn_exp2f(-1.4426950408889634f * fabsf(x)));
                cum += ls * (1.f / 16.f); bl[i] = cum; }
            gs[tq * 128 + d] = cum;
            __syncthreads();
            float off = 0.f, tot = 0.f;
#pragma unroll
            for (int q = 0; q < 4; ++q) { const float g = gs[q * 128 + d]; if (q < tq) off += g; tot += g; }
            unsigned kt[8];
#pragma unroll
            for (int i = 0; i < 16; ++i) { const float bt = off + bl[i]; const int t = tq * 16 + i;
                const float qv = bf2f(bq[t * 136 + d]), kv = bf2f(bk[t * 136 + d]);
                const float eb = __builtin_amdgcn_exp2f(1.4426950408889634f * bt);
                bq[t * 136 + d] = f2bf(qv * 0.08838834764831845f * eb); bk[t * 136 + d] = f2bf(kv * __builtin_amdgcn_rcpf(eb));
                const float kh = kv * __builtin_amdgcn_exp2f(1.4426950408889634f * (tot - bt));
                if (i & 1) kt[i >> 1] |= ((unsigned)f2bf(kh)) << 16; else kt[i >> 1] = f2bf(kh); }
            *(LAS u32x4*)(bkT + d * 72 + tq * 16) = (u32x4){kt[0], kt[1], kt[2], kt[3]}; *(LAS u32x4*)(bkT + d * 72 + tq * 16 + 8) = (u32x4){kt[4], kt[5], kt[6], kt[7]};
            if (tq == 0) gdl[(size_t)u * 128 + d] = __builtin_amdgcn_exp2f(1.4426950408889634f * tot);
        }
        {
            const int e = tid & 255, sg = tid >> 8;
#pragma unroll
            for (int q = 0; q < 4; ++q) { unsigned vt[4];
#pragma unroll
                for (int jj = 0; jj < 8; ++jj) { const bf16_t v = rv[(sg * 32 + q * 8 + jj) * 256 + e]; if (jj & 1) vt[jj >> 1] |= ((unsigned)v) << 16; else vt[jj >> 1] = v; }
                *(LAS u32x4*)(bvT + e * 72 + sg * 32 + q * 8) = (u32x4){vt[0], vt[1], vt[2], vt[3]}; }
        }
        __syncthreads();
        for (int i = tid; i < 1024; i += NTHR) { const int t = i >> 4, ch = i & 15; *(u32x4*)(gqt + (row0 + t) * 512 + h * 128 + ch * 8) = *(const LAS u32x4*)(bq + t * 136 + ch * 8); }
        if (w < 3) { const int tt = w == 0 ? 0 : 1, ss = w == 2 ? 1 : 0; f32x16 acc = {};
#pragma unroll
            for (int ks = 0; ks < 8; ++ks) { const bf16x8 a = *(const LAS bf16x8*)(bq + (tt * 32 + r32) * 136 + ks * 16 + hh * 8), bb = *(const LAS bf16x8*)(bk + (ss * 32 + r32) * 136 + ks * 16 + hh * 8);
                acc = __builtin_amdgcn_mfma_f32_32x32x16_bf16(a, bb, acc, 0, 0, 0); }
#pragma unroll
            for (int i = 0; i < 16; ++i) { const int t = tt * 32 + (i & 3) + 8 * (i >> 2) + 4 * hh, s = ss * 32 + r32; bA[t * 72 + s] = f2bf(t >= s ? acc[i] : 0.f); } }
        else if (w == 3) {
#pragma unroll
            for (int i = 0; i < 16; ++i) { const int t = (i & 3) + 8 * (i >> 2) + 4 * hh; bA[t * 72 + 32 + r32] = 0; } }
        __syncthreads();
        {
            f32x16 o0 = {}, o1 = {}, s0 = {}, s1 = {}, s2 = {}, s3 = {};
#pragma unroll
            for (int ks = 0; ks < 4; ++ks) { const bf16x8 vf = *(const LAS bf16x8*)(bvT + (w * 32 + r32) * 72 + ks * 16 + hh * 8);
                const bf16x8 a0 = *(const LAS bf16x8*)(bA + r32 * 72 + ks * 16 + hh * 8), a1 = *(const LAS bf16x8*)(bA + (32 + r32) * 72 + ks * 16 + hh * 8);
                o0 = __builtin_amdgcn_mfma_f32_32x32x16_bf16(a0, vf, o0, 0, 0, 0); o1 = __builtin_amdgcn_mfma_f32_32x32x16_bf16(a1, vf, o1, 0, 0, 0);
                const bf16x8 k0 = *(const LAS bf16x8*)(bkT + r32 * 72 + ks * 16 + hh * 8), k1 = *(const LAS bf16x8*)(bkT + (32 + r32) * 72 + ks * 16 + hh * 8),
                             k2 = *(const LAS bf16x8*)(bkT + (64 + r32) * 72 + ks * 16 + hh * 8), k3 = *(const LAS bf16x8*)(bkT + (96 + r32) * 72 + ks * 16 + hh * 8);
                s0 = __builtin_amdgcn_mfma_f32_32x32x16_bf16(k0, vf, s0, 0, 0, 0); s1 = __builtin_amdgcn_mfma_f32_32x32x16_bf16(k1, vf, s1, 0, 0, 0);
                s2 = __builtin_amdgcn_mfma_f32_32x32x16_bf16(k2, vf, s2, 0, 0, 0); s3 = __builtin_amdgcn_mfma_f32_32x32x16_bf16(k3, vf, s3, 0, 0, 0); }
#pragma unroll
            for (int i = 0; i < 16; ++i) { const int rr = (i & 3) + 8 * (i >> 2) + 4 * hh;
                ogr16[(row0 + rr) * 1024 + h * 256 + w * 32 + r32] = f2bf(o0[i]); ogr16[(row0 + 32 + rr) * 1024 + h * 256 + w * 32 + r32] = f2bf(o1[i]); }
            { unsigned char* dp = (unsigned char*)gds + ((size_t)u * 256 + w * 32 + r32) * 128 + hh * 8;
#define GST(SJ, j_) do { _Pragma("unroll") for (int rp = 0; rp < 2; ++rp) {                                                                                  \
                const unsigned a_ = pack_fp8x4(SJ[8 * rp + 0] * 4.f, SJ[8 * rp + 1] * 4.f, SJ[8 * rp + 2] * 4.f, SJ[8 * rp + 3] * 4.f);                          \
                const unsigned b_ = pack_fp8x4(SJ[8 * rp + 4] * 4.f, SJ[8 * rp + 5] * 4.f, SJ[8 * rp + 6] * 4.f, SJ[8 * rp + 7] * 4.f);                          \
                auto r_ = __builtin_amdgcn_permlane32_swap(a_, b_, false, false);                                                                           \
                *(u32x2*)(dp + ((j_) * 2 + rp) * 16) = (u32x2){r_[0], r_[1]}; } } while (0)
              GST(s0, 0); GST(s1, 1); GST(s2, 2); GST(s3, 3);
#undef GST
            }
        }
        if (tid == 0) qs[0] = (int)nu_;
        __syncthreads();
    }
}
__device__ __forceinline__ void p_gla2(const Frame& F0) {
    const Frame F = phase_frame(F0);
    unsigned char* gds = F.ws + WS_GDS; const float* gdl = (const float*)(F.ws + WS_GDL);
    for (int i = F.c * NTHR + F.tid; i < 32 * 4096; i += F.G * NTHR) {
        const int bh = i >> 12, e = (i >> 4) & 255, dg = i & 15;
        float st[8];
#pragma unroll
        for (int j = 0; j < 8; ++j) st[j] = 0.f;
        unsigned char* p = gds + ((size_t)bh * 32 * 256 + e) * 128 + dg * 8; const float* dp = gdl + (size_t)bh * 32 * 128 + dg * 8;
        u32x2 dsv = *(const u32x2*)p; f32x4 d0 = *(const f32x4*)dp, d1 = *(const f32x4*)(dp + 4);
        for (int c = 0; c < 32; ++c) {
            u32x2 dsn = dsv; f32x4 e0 = d0, e1 = d1;
            if (c + 1 < 32) { dsn = *(const u32x2*)(p + (size_t)256 * 128); e0 = *(const f32x4*)(dp + 128); e1 = *(const f32x4*)(dp + 132); }
            *(u32x2*)p = (u32x2){pack_fp8x4(st[0] * 4.f, st[1] * 4.f, st[2] * 4.f, st[3] * 4.f), pack_fp8x4(st[4] * 4.f, st[5] * 4.f, st[6] * 4.f, st[7] * 4.f)};
            const f32x2 i0 = __builtin_amdgcn_cvt_pk_f32_fp8((int)dsv[0], false), i1 = __builtin_amdgcn_cvt_pk_f32_fp8((int)dsv[0], true), i2 = __builtin_amdgcn_cvt_pk_f32_fp8((int)dsv[1], false), i3 = __builtin_amdgcn_cvt_pk_f32_fp8((int)dsv[1], true);
            st[0] = d0[0] * st[0] + i0[0] * 0.25f; st[1] = d0[1] * st[1] + i0[1] * 0.25f; st[2] = d0[2] * st[2] + i1[0] * 0.25f; st[3] = d0[3] * st[3] + i1[1] * 0.25f;
            st[4] = d1[0] * st[4] + i2[0] * 0.25f; st[5] = d1[1] * st[5] + i2[1] * 0.25f; st[6] = d1[2] * st[6] + i3[0] * 0.25f; st[7] = d1[3] * st[7] + i3[1] * 0.25f;
            dsv = dsn; d0 = e0; d1 = e1; p += (size_t)256 * 128; dp += 128; }
    }
}
__device__ __forceinline__ void p_gla3(const Frame& F0, int l) {
    const Frame F = phase_frame(F0);
    const bf16_t* proj = (const bf16_t*)(F.ws + WS_PROJ); const float* ng = F.in(8) + (size_t)l * 256;
    const bf16_t* ogr16 = (const bf16_t*)(F.ws + WS_OGRAW); const bf16_t* gds = (const bf16_t*)(F.ws + WS_GDS); const bf16_t* gqt = (const bf16_t*)(F.ws + WS_GQT); bf16_t* og = (bf16_t*)(F.ws + WS_OG);
    LAS float* ot = (LAS float*)F.lds;
    const int lane = F.lane, w = F.wave, r32 = lane & 31, hh = lane >> 5;
    const f32x4 gn = *(const f32x4*)(ng + lane * 4);
    for (int u = F.c; u < 1024; u += F.G) {
        const int c = u & 31, h = (u >> 5) & 3, b = u >> 7; const size_t row0 = (size_t)b * S + c * 64;
        f32x16 o0 = {}, o1 = {};
        f32x4 og4[8];
#pragma unroll
        for (int q = 0; q < 8; ++q) { const u32x2 ow = *(const u32x2*)(ogr16 + (row0 + w * 8 + q) * 1024 + h * 256 + lane * 4); og4[q] = (f32x4){bf_lo(ow[0]), bf_hi(ow[0]), bf_lo(ow[1]), bf_hi(ow[1])}; }
#pragma unroll
        for (int ks = 0; ks < 8; ++ks) { const u32x2 s8 = *(const u32x2*)((const unsigned char*)gds + ((size_t)u * 256 + w * 32 + r32) * 128 + ks * 16 + hh * 8);
            const f32x2 q0 = __builtin_amdgcn_cvt_pk_f32_fp8((int)s8[0], false), q1 = __builtin_amdgcn_cvt_pk_f32_fp8((int)s8[0], true), q2 = __builtin_amdgcn_cvt_pk_f32_fp8((int)s8[1], false), q3 = __builtin_amdgcn_cvt_pk_f32_fp8((int)s8[1], true);
            u32x4 sw = {cvt_pk_bf16(q0[0], q0[1]), cvt_pk_bf16(q1[0], q1[1]), cvt_pk_bf16(q2[0], q2[1]), cvt_pk_bf16(q3[0], q3[1])};
            const bf16x8 sf = __builtin_bit_cast(bf16x8, sw);
            const bf16x8 a0 = *(const bf16x8*)(gqt + (row0 + r32) * 512 + h * 128 + ks * 16 + hh * 8), a1 = *(const bf16x8*)(gqt + (row0 + 32 + r32) * 512 + h * 128 + ks * 16 + hh * 8);
            o0 = __builtin_amdgcn_mfma_f32_32x32x16_bf16(a0, sf, o0, 0, 0, 0); o1 = __builtin_amdgcn_mfma_f32_32x32x16_bf16(a1, sf, o1, 0, 0, 0); }
        u32x2 gw[8];
#pragma unroll
        for (int q = 0; q < 8; ++q) gw[q] = *(const u32x2*)(proj + (row0 + w * 8 + q) * LDP + P_GG + h * 256 + lane * 4);
#pragma unroll
        for (int i = 0; i < 16; ++i) { const int rr = (i & 3) + 8 * (i >> 2) + 4 * hh;
            ot[rr * 260 + w * 32 + r32] = o0[i] * 0.25f;
            ot[(32 + rr) * 260 + w * 32 + r32] = o1[i] * 0.25f; }
        __syncthreads();
#pragma unroll
        for (int q = 0; q < 8; ++q) { const int t = w * 8 + q; const f32x4 v = *(const LAS f32x4*)(ot + t * 260 + lane * 4) + og4[q];
            float ss = v[0] * v[0] + v[1] * v[1] + v[2] * v[2] + v[3] * v[3];
#pragma unroll
            for (int o = 32; o > 0; o >>= 1) ss += __shfl_xor(ss, o);
            const float rstd = rsqrtf(ss * (1.f / 256.f) + 1e-6f);
            u32x2 ov; ov[0] = cvt_pk_bf16(v[0] * rstd * gn[0] * fast_silu(bf_lo(gw[q][0])), v[1] * rstd * gn[1] * fast_silu(bf_hi(gw[q][0])));
            ov[1] = cvt_pk_bf16(v[2] * rstd * gn[2] * fast_silu(bf_lo(gw[q][1])), v[3] * rstd * gn[3] * fast_silu(bf_hi(gw[q][1])));
            *(u32x2*)(og + (row0 + t) * 1024 + h * 256 + lane * 4) = ov; }
        __syncthreads();
    }
}

constexpr size_t WS_CHID = WS_GDL + al256((size_t)1024 * 128 * 4);
constexpr size_t WS_KC   = WS_CHID + al256((size_t)2 * 2048 * 256 * 2);
constexpr size_t WS_VCT  = WS_KC + al256((size_t)16 * 128 * 128 * 2);
constexpr size_t WS_CP   = WS_VCT + al256((size_t)16 * 128 * 128 * 2);
constexpr size_t WS_BIAS1P = WS_CP + al256((size_t)2 * 2048 * 256 * 2);
constexpr size_t WS_END5 = WS_BIAS1P + al256((size_t)NL * 2 * 32 * 128 * 4);
constexpr size_t WS_CP32 = WS_END5;
constexpr size_t WS_END6 = WS_CP32 + al256((size_t)4 * 2 * 2048 * 256 * 4);


__device__ __forceinline__ void p_conv_cmp(const Frame& F0) {
    const Frame F = phase_frame(F0);
    const float* pe = F.in(3); const float* w1 = F.in(4); const float* w2 = F.in(5);
    bf16_t* wc2 = (bf16_t*)(F.ws + WS_WC2); float* bias1 = (float*)(F.ws + WS_BIAS1);
    for (int i = F.c * NTHR + F.tid; i < NL * 2 * 256 * 256; i += F.G * NTHR) { const int k = i & 255, n = (i >> 8) & 255, lc = i >> 16;
        wc2[i] = (k < 128 && n < 128) ? f2bf(w2[((size_t)lc * 128 + k) * 128 + n]) : (bf16_t)0; }
    LAS float* part = (LAS float*)F.lds; float* bp = (float*)(F.ws + WS_BIAS1P);
    for (int task = F.c; task < NL * 2 * 32; task += F.G) { const int lc = task >> 5, ch = task & 31; const int o = F.tid & 127, ig = F.tid >> 7; float a = 0.f;
        const size_t i0 = (size_t)lc * 4096 + ch * 128 + ig * 32;
#pragma unroll 8
        for (int i = 0; i < 32; ++i) a += pe[i0 + i] * w1[(i0 + i) * 128 + o];
        part[ig * 128 + o] = a; __syncthreads();
        if (F.tid < 128) bp[(size_t)task * 128 + F.tid] = part[F.tid] + part[128 + F.tid] + part[256 + F.tid] + part[384 + F.tid];
        __syncthreads(); }
}
struct SchedCmp1 {
    static constexpr bool GATHER = true;
    const char* proj; const char* W; int G, c;
    __device__ __forceinline__ bool next(int i, ge::Unit& u) const { const int L = i * G + c; if (L >= 16) return false; const int cc = L >> 3, pm = L & 7;
        u.A = proj + (size_t)(P_NKV + cc * 256) * 2; u.B = W + (size_t)cc * 256 * 2048 * 2; u.r0 = pm * 256; u.c0 = 0; u.aux = cc; u.aux2 = 0; return true; }
    __device__ __forceinline__ void voffA(const ge::Unit& u, int tid, unsigned (&v)[2][2]) const {
#pragma unroll
        for (int i = 0; i < 2; ++i) { int R, C; ge::stage_rc(tid * 16 + i * 8192, R, C);
#pragma unroll
            for (int hf = 0; hf < 2; ++hf) { const int r = u.r0 + hf * 128 + R; const int b = r >> 8, g = (r >> 7) & 1, m = r & 127;
                v[hf][i] = (unsigned)(((b * S + 16 * m) * LDP + g * 128 + C)) * 2u; } } }
};
struct EpiCmp1 {
    static constexpr bool PERM = true; bf16_t* P;
    __device__ __forceinline__ void operator()(const f32x4 (&acc)[2][2][4][2], const ge::Unit& u, int wr, int wc, int fr, int fq) const {
#pragma unroll
        for (int ai = 0; ai < 2; ++ai)
#pragma unroll
            for (int m = 0; m < 4; ++m) { bf16_t* rowp = P + ((size_t)u.aux * 2048 + u.r0 + ai * 128 + wr * 64 + m * 16 + fr) * 256 + wc * 32 + 8 * fq;
#pragma unroll
                for (int bj = 0; bj < 2; ++bj) { const f32x4 v0 = acc[ai][bj][m][0], v1 = acc[ai][bj][m][1]; u32x4 w = {cvt_pk_bf16(v0[0], v0[1]), cvt_pk_bf16(v0[2], v0[3]), cvt_pk_bf16(v1[0], v1[1]), cvt_pk_bf16(v1[2], v1[3])};
                    *(u32x4*)(rowp + bj * 128) = w; } }
    }
};
struct SchedCmp2 {
    static constexpr bool GATHER = false;
    const char* hid; const char* W; int G, c;
    __device__ __forceinline__ bool next(int i, ge::Unit& u) const { const int L = i * G + c; if (L >= 16) return false; const int cc = L >> 3, pm = L & 7;
        u.A = hid + ((size_t)cc * 2048 + pm * 256) * 256 * 2; u.B = W + (size_t)cc * 256 * 256 * 2; u.r0 = pm * 256; u.c0 = 0; u.aux = cc; u.aux2 = 0; return true; }
    __device__ __forceinline__ void voffA(const ge::Unit&, int tid, unsigned (&v)[2][2]) const { ge::dense_voffA(256, tid, v); }
};
struct EpiCmp2 {
    static constexpr bool PERM = false; bf16_t* kc; bf16_t* vct;
    __device__ __forceinline__ void operator()(const f32x4 (&acc)[2][2][4][2], const ge::Unit& u, int wr, int wc, int fr, int fq) const {
#pragma unroll
        for (int ai = 0; ai < 2; ++ai)
#pragma unroll
            for (int m = 0; m < 4; ++m) { const int r = u.r0 + ai * 128 + wr * 64 + m * 16 + fr; const int bg = r >> 7, n = r & 127;
#pragma unroll
                for (int nn = 0; nn < 2; ++nn) { const int d = wc * 32 + nn * 16 + 4 * fq; const f32x4 v = acc[ai][0][m][nn];
                    if (u.aux == 0) { u32x2 w = {cvt_pk_bf16(v[0], v[1]), cvt_pk_bf16(v[2], v[3])}; *(u32x2*)(kc + ((size_t)bg * 128 + n) * 128 + d) = w; }
                    else {
#pragma unroll
                        for (int j = 0; j < 4; ++j) vct[((size_t)bg * 128 + d + j) * 128 + n] = f2bf(v[j]); } } }
    }
};
struct SchedCmp1S {
    static constexpr bool GATHER = true;
    const char* proj; const char* W; int c;
    __device__ __forceinline__ bool next(int i, ge::Unit& u) const { if (i != 0 || c >= CMP_WGS) return false; const int x = c & 7, j = c >> 3, tile = 2 * x + (j >> 2), kq = j & 3, cc = tile >> 3, pm = tile & 7;
        u.A = proj + (size_t)(P_NKV + cc * 256) * 2 + (size_t)kq * 4 * LDP * 2; u.B = W + (size_t)cc * 256 * 2048 * 2 + (size_t)kq * 512 * 2; u.r0 = pm * 256; u.c0 = 0; u.aux = cc; u.aux2 = kq; return true; }
    __device__ __forceinline__ void voffA(const ge::Unit& u, int tid, unsigned (&v)[2][2]) const {
#pragma unroll
        for (int i = 0; i < 2; ++i) { int R, C; ge::stage_rc(tid * 16 + i * 8192, R, C);
#pragma unroll
            for (int hf = 0; hf < 2; ++hf) { const int r = u.r0 + hf * 128 + R; const int b = r >> 8, g = (r >> 7) & 1, m = r & 127;
                v[hf][i] = (unsigned)(((b * S + 16 * m) * LDP + g * 128 + C)) * 2u; } } }
};
struct EpiCmp1S {
    static constexpr bool PERM = true; float* P;
    __device__ __forceinline__ void operator()(const f32x4 (&acc)[2][2][4][2], const ge::Unit& u, int wr, int wc, int fr, int fq) const {
#pragma unroll
        for (int ai = 0; ai < 2; ++ai)
#pragma unroll
            for (int m = 0; m < 4; ++m) { float* rowp = P + ((size_t)(u.aux2 * 2 + u.aux) * 2048 + u.r0 + ai * 128 + wr * 64 + m * 16 + fr) * 256 + wc * 32 + 8 * fq;
#pragma unroll
                for (int bj = 0; bj < 2; ++bj) { *(f32x4*)(rowp + bj * 128) = acc[ai][bj][m][0]; *(f32x4*)(rowp + bj * 128 + 4) = acc[ai][bj][m][1]; } }
    }
};
struct SchedCmp2S {
    static constexpr bool GATHER = true;
    const char* hid; const char* W; int c;
    __device__ __forceinline__ bool next(int i, ge::Unit& u) const { if (i != 0 || c >= CMP_WGS) return false; const int x = c & 7, j = c >> 3, tile = 2 * x + (j >> 2), kq = j & 3, cc = tile >> 3, pm = tile & 7;
        u.A = hid + ((size_t)cc * 2048 + pm * 256 + kq * 64) * 256 * 2; u.B = W + (size_t)cc * 256 * 256 * 2; u.r0 = pm * 256 + kq * 64; u.c0 = 0; u.aux = cc; u.aux2 = 0; return true; }
    __device__ __forceinline__ void voffA(const ge::Unit&, int tid, unsigned (&v)[2][2]) const {
#pragma unroll
        for (int i = 0; i < 2; ++i) { int R, C; ge::stage_rc(tid * 16 + i * 8192, R, C);
#pragma unroll
            for (int hf = 0; hf < 2; ++hf) v[hf][i] = (unsigned)((R & 63) * 256 + C) * 2u; } }
};
struct EpiCmp2S {
    static constexpr bool PERM = false; bf16_t* kc; bf16_t* vct;
    __device__ __forceinline__ void operator()(const f32x4 (&acc)[2][2][4][2], const ge::Unit& u, int wr, int wc, int fr, int fq) const {
        if (wr != 0) return;
#pragma unroll
        for (int m = 0; m < 4; ++m) { const int r = u.r0 + m * 16 + fr; const int bg = r >> 7, n = r & 127;
#pragma unroll
            for (int nn = 0; nn < 2; ++nn) { const int d = wc * 32 + nn * 16 + 4 * fq; const f32x4 v = acc[0][0][m][nn];
                if (u.aux == 0) { u32x2 w = {cvt_pk_bf16(v[0], v[1]), cvt_pk_bf16(v[2], v[3])}; *(u32x2*)(kc + ((size_t)bg * 128 + n) * 128 + d) = w; }
                else {
#pragma unroll
                    for (int j = 0; j < 4; ++j) vct[((size_t)bg * 128 + d + j) * 128 + n] = f2bf(v[j]); } } }
    }
};
__device__ __forceinline__ void p_nsa_cmp(const Frame& F0, int l) {
    const Frame F = phase_frame(F0);
    if (F.c >= CMP_WGS) return;
    const int x_ = F.c & 7, j_ = F.c >> 3, tile = 2 * x_ + (j_ >> 2), kq = j_ & 3, cc = tile >> 3, pm = tile & 7;
    LAS float* biasL = (LAS float*)(F.lds + LDS_MISC + 8192);
    if (F.tid < 128) { const int o = F.tid; const float* bp = (const float*)(F.ws + WS_BIAS1P) + ((size_t)(l * 2 + cc) * 32) * 128 + o; float a = 0.f;
#pragma unroll 8
        for (int ch = 0; ch < 32; ++ch) a += bp[ch * 128]; biasL[o] = a; }
    __syncthreads();
    { SchedCmp1S S{(const char*)(F.ws + WS_PROJ), (const char*)(F.ws + WS_WC1) + (size_t)l * 2 * 256 * 2048 * 2, F.c};
      EpiCmp1S E{(float*)(F.ws + WS_CP32)};
      ge::gemm_phase<EpiCmp1S, SchedCmp1S, 1>(F.lds, F.tid, 512, LDP * 2, S, E, 2048); }
    asm volatile("s_waitcnt vmcnt(0)" ::: "memory"); __syncthreads();
    if (F.tid == 0) { unsigned* bar = (unsigned*)(F.ws + WS_CTL); unsigned* fl = bar + CW_CMPF + 64 * (l * 16 + tile);
        __builtin_amdgcn_fence(__ATOMIC_RELEASE, "agent"); asm volatile("s_waitcnt vmcnt(0)" ::: "memory");
        (void)xb_add(fl, 1u);
        XB_SPIN(xb_ld(fl) < 4u, bar);
        __builtin_amdgcn_fence(__ATOMIC_ACQUIRE, "agent"); asm volatile("s_waitcnt vmcnt(0)" ::: "memory"); }
    __syncthreads();
    {
        const float* P = (const float*)(F.ws + WS_CP32); bf16_t* hid = (bf16_t*)(F.ws + WS_CHID);
        for (int idx = F.tid; idx < 64 * 16; idx += NTHR) { const int row = kq * 64 + (idx >> 4), ch = idx & 15; const size_t r = (size_t)cc * 2048 + pm * 256 + row;
            u32x4 w = {0u, 0u, 0u, 0u};
            if ((row & 127) != 127) { f32x4 s0 = *(const LAS f32x4*)(biasL + ch * 8), s1 = *(const LAS f32x4*)(biasL + ch * 8 + 4);
#pragma unroll
                for (int q = 0; q < 4; ++q) { const float* pq = P + ((size_t)q * 2 * 2048 + r) * 256 + ch * 8;
                    s0 += *(const f32x4*)pq + *(const f32x4*)(pq + 256 + 128); s1 += *(const f32x4*)(pq + 4) + *(const f32x4*)(pq + 256 + 128 + 4); }
                w[0] = cvt_pk_bf16(fast_silu(s0[0]), fast_silu(s0[1])); w[1] = cvt_pk_bf16(fast_silu(s0[2]), fast_silu(s0[3]));
                w[2] = cvt_pk_bf16(fast_silu(s1[0]), fast_silu(s1[1])); w[3] = cvt_pk_bf16(fast_silu(s1[2]), fast_silu(s1[3])); }
            *(u32x4*)(hid + r * 256 + ch * 8) = w; *(u32x4*)(hid + r * 256 + 128 + ch * 8) = (u32x4){0u, 0u, 0u, 0u}; }
    }
    asm volatile("s_waitcnt vmcnt(0)" ::: "memory"); __syncthreads();
    { SchedCmp2S S{(const char*)(F.ws + WS_CHID), (const char*)(F.ws + WS_WC2) + (size_t)l * 2 * 256 * 256 * 2, F.c};
      EpiCmp2S E{(bf16_t*)(F.ws + WS_KC), (bf16_t*)(F.ws + WS_VCT)};
      ge::gemm_phase<EpiCmp2S, SchedCmp2S, 0>(F.lds, F.tid, 256, 0, S, E); }
}

__device__ __forceinline__ void p_nsa_cmpsel(const Frame& F0) {
    const Frame F = phase_frame(F0);
    const bf16_t* proj = (const bf16_t*)(F.ws + WS_PROJ); const bf16_t* kc = (const bf16_t*)(F.ws + WS_KC); const bf16_t* vct = (const bf16_t*)(F.ws + WS_VCT);
    bf16_t* on = (bf16_t*)(F.ws + WS_ON); unsigned* selm = (unsigned*)(F.ws + WS_SELMASK);
    LAS float* gl = (LAS float*)F.lds + F.wave * 32;
    const int lane = F.lane, w = F.wave, r32 = lane & 31, hi = lane >> 5;
    for (int u = F.c; u < NB * 2 * 32; u += F.G) {
        const int pb = u & 31, g = (u >> 5) & 1, b = u >> 6; const int bg = b * 2 + g;
        const int p = pb * 64 + w * 8 + (r32 >> 2), hd = g * 4 + (r32 & 3); const size_t t = (size_t)b * S + p;
        bf16x8 qf[8];
#pragma unroll
        for (int d0 = 0; d0 < 8; ++d0) qf[d0] = *(const bf16x8*)(proj + t * LDP + P_NQ + hd * 128 + d0 * 16 + hi * 8);
        f32x16 sc[4];
#pragma unroll
        for (int kt = 0; kt < 4; ++kt) { sc[kt] = f32x16{};
#pragma unroll
            for (int d0 = 0; d0 < 8; ++d0) { const bf16x8 kf = *(const bf16x8*)(kc + ((size_t)bg * 128 + kt * 32 + r32) * 128 + d0 * 16 + hi * 8);
                sc[kt] = __builtin_amdgcn_mfma_f32_32x32x16_bf16(kf, qf[d0], sc[kt], 0, 0, 0); } }
        const int nmax = p >= 31 ? (p - 31) >> 4 : -1;
        float mx = -1e30f;
#pragma unroll
        for (int kt = 0; kt < 4; ++kt)
#pragma unroll
            for (int i = 0; i < 16; ++i) { const int n = kt * 32 + (i & 3) + 8 * (i >> 2) + 4 * hi; const float s = n <= nmax ? sc[kt][i] * 0.08838834764831845f : -__builtin_inff(); sc[kt][i] = s; mx = fmaxf(mx, s); }
        mx = fmaxf(mx, __shfl_xor(mx, 32));
        float sum = 0.f;
#pragma unroll
        for (int kt = 0; kt < 4; ++kt)
#pragma unroll
            for (int i = 0; i < 16; ++i) { const float e = __expf(sc[kt][i] - mx); sc[kt][i] = e; sum += e; }
        sum += __shfl_xor(sum, 32);
        const float inv = sum > 0.f ? 1.f / sum : 0.f;
#pragma unroll
        for (int kt = 0; kt < 4; ++kt)
#pragma unroll
            for (int i = 0; i < 16; ++i) sc[kt][i] *= inv;
        f32x16 oc[4] = {};
#pragma unroll
        for (int kt = 0; kt < 4; ++kt) { bf16x8 pa0, pa1;
#define PK4(P, B_, OUT) do { unsigned a0 = cvt_pk_bf16(P[B_+0], P[B_+1]), a1 = cvt_pk_bf16(P[B_+2], P[B_+3]); unsigned b0 = cvt_pk_bf16(P[B_+4], P[B_+5]), b1 = cvt_pk_bf16(P[B_+6], P[B_+7]); \
        auto r0 = __builtin_amdgcn_permlane32_swap(a0, b0, false, false); auto r1 = __builtin_amdgcn_permlane32_swap(a1, b1, false, false); u32x4 w_ = {r0[0], r1[0], r0[1], r1[1]}; OUT = *reinterpret_cast<bf16x8*>(&w_); } while (0)
            PK4(sc[kt], 0, pa0); PK4(sc[kt], 8, pa1);
#undef PK4
#pragma unroll
            for (int dt = 0; dt < 4; ++dt) { const bf16x8 v0 = *(const bf16x8*)(vct + ((size_t)bg * 128 + dt * 32 + r32) * 128 + kt * 32 + hi * 8), v1 = *(const bf16x8*)(vct + ((size_t)bg * 128 + dt * 32 + r32) * 128 + kt * 32 + 16 + hi * 8);
                oc[dt] = __builtin_amdgcn_mfma_f32_32x32x16_bf16(pa0, v0, oc[dt], 0, 0, 0); oc[dt] = __builtin_amdgcn_mfma_f32_32x32x16_bf16(pa1, v1, oc[dt], 0, 0, 0); } }
        if (hi == 0) gl[r32] = fast_sigmoid(bf2f(proj[t * LDP + P_NG + hd * 3]));
        asm volatile("s_waitcnt lgkmcnt(0)" ::: "memory");
#pragma unroll
        for (int i = 0; i < 16; ++i) { const int rr = (i & 3) + 8 * (i >> 2) + 4 * hi; const float gt = gl[rr];
            const size_t tt = (size_t)b * S + pb * 64 + w * 8 + (rr >> 2); const int hh = g * 4 + (rr & 3);
#pragma unroll
            for (int dt = 0; dt < 4; ++dt) { const float v = oc[dt][i] * gt, vn = __shfl_xor(v, 1);
                if ((r32 & 1) == 0) *(unsigned*)(on + tt * 1024 + hh * 128 + dt * 32 + r32) = cvt_pk_bf16(v, vn); } }
#pragma unroll
        for (int kt = 0; kt < 4; ++kt)
#pragma unroll
            for (int i = 0; i < 16; ++i) { float v = sc[kt][i]; v += __shfl_xor(v, 1); v += __shfl_xor(v, 2); sc[kt][i] = v; }
        float imp[16];
#pragma unroll
        for (int kt = 0; kt < 4; ++kt)
#pragma unroll
            for (int q = 0; q < 4; ++q) { const float gsum = sc[kt][4 * q] + sc[kt][4 * q + 1] + sc[kt][4 * q + 2] + sc[kt][4 * q + 3];
                const float lastown = sc[kt][4 * q + 3]; const float lastprev = (kt * 4 + q) > 0 ? sc[(kt * 4 + q - 1) >> 2][4 * ((kt * 4 + q - 1) & 3) + 3] : 0.f;
                const float fromp_same = __shfl_xor(lastown, 32), fromp_prev = __shfl_xor(lastprev, 32);
                imp[kt * 4 + q] = gsum + (hi ? fromp_same : fromp_prev); }
        const int cb = p >> 6;
#pragma unroll
        for (int s_ = 0; s_ < 16; ++s_) { const int j = 8 * (s_ >> 2) + 2 * (s_ & 3) + hi; if (j == 0 || j == cb || j == cb - 1) imp[s_] = 1e9f; if (j > cb) imp[s_] = -1e30f; }
        unsigned mask = 0;
#pragma unroll
        for (int k = 0; k < 8; ++k) { float bv = -__builtin_inff(); int bj = 64;
#pragma unroll
            for (int s_ = 0; s_ < 16; ++s_) { const int j = 8 * (s_ >> 2) + 2 * (s_ & 3) + hi; if (imp[s_] > bv) { bv = imp[s_]; bj = j; } }
            const float ov = __shfl_xor(bv, 32); const int oj = __shfl_xor(bj, 32);
            const bool mine = (bv > ov) || (bv == ov && bj < oj); const int wj = mine ? bj : oj;
            mask |= 1u << wj;
#pragma unroll
            for (int s_ = 0; s_ < 16; ++s_) { const int j = 8 * (s_ >> 2) + 2 * (s_ & 3) + hi; if (j == wj) imp[s_] = -__builtin_inff(); } }
        if ((r32 & 3) == 0 && hi == 0) selm[t * 2 + g] = mask;
    }
}
constexpr int NSTEP = 1 + 11 * NL;

#ifdef DIAG_A
__device__ __forceinline__ void diag_stamp(const Frame& F, int k) {
    if (F.c == 0 && F.tid == 0) { LAS long long* st = (LAS long long*)(F.lds + LDS_MISC + 4096); const long long now = wall_clock64(); const long long d = now - st[0]; st[0] = now;
        if (k == DIAG_A) st[1] = d; if (k == DIAG_B) st[2] = d; }
}
#endif
template <int l>
__device__ __forceinline__ void layer_steps(const Frame& F, const XcdBarrier& bar, const int lo, const int hi) {
#define IN(k) (lo <= (k) && (k) < hi)
#ifdef DIAG_A
#define SEAM(k) do { if (IN(k) && IN((k) + 1)) { xcd_barrier(bar); diag_stamp(F, (k)); } } while (0)
#else
#define SEAM(k) do { if (IN(k) && IN((k) + 1)) xcd_barrier(bar); } while (0)
#endif
    const int base = 1 + 11 * l;
    if (IN(base + 0)) { p_inproj(F, l);
#ifdef PROBE_INPROJ
        p_inproj(F, l);
#endif
#ifdef PROBE_INPROJ_NULL8
        p_inproj_null8(F, l);
#endif
#ifdef PROBE_INPROJ_LONGK
        p_inproj_longk(F, l);
#endif
#ifdef PROBE_INPROJ_SAME
        p_inproj_same(F, l);
#endif
#ifdef PROBE_INPROJ_NULL
        p_inproj_null(F, l);
#endif
    } SEAM(base + 0);
    if (IN(base + 1)) { p_nsa_cmp(F, l); p_moba_prep(F, F.G > CMP_WGS ? CMP_WGS : 0); p_gla1(F, l);
#ifdef PROBE_S1
        p_nsa_cmp(F, l); p_moba_prep(F, 16); p_gla1(F, l);
#endif
#ifdef PROBE_GLA1
        p_gla1(F, l);
#endif
#ifdef PROBE_MOBAPREP
        p_moba_prep(F, 16);
#endif
#ifdef PROBE_NSACMP
        p_nsa_cmp(F, l);
#endif
    } SEAM(base + 1);
    if (IN(base + 2)) { p_moba_attn(F);
#ifdef PROBE_MOBA
        p_moba_attn(F);
#endif
#ifdef PROBE_MOBA512
        p_moba_attn_t<512, true>(F);
#endif
#ifdef PROBE_MOBAFULL
        p_moba_attn_t<(1 << 20), true>(F);
#endif
        p_nsa_cmpsel(F); p_gla2(F); } SEAM(base + 2);
    if (IN(base + 3)) {
#ifndef PROBE_SKIP_NSA
        p_nsa_attn(F);
#endif
        p_gla3(F, l);
#ifdef PROBE_NSADUMMY
        p_nsa_attn_t<true>(F);
#endif
#ifdef PROBE_GLA3
        p_gla3(F, l);
#endif
    } SEAM(base + 3);
    if (IN(base + 4)) { p_merge(F, l);
#ifdef PROBE_MERGE
        p_merge(F, l);
#endif
    } SEAM(base + 4);
    if (IN(base + 5)) { p_wout(F, l); } SEAM(base + 5);
    if (IN(base + 6)) { p_route1<MOE_F8 && l >= MOE_F8_FROM>(F, l); p_conv_experts<MOE_F8 && l >= MOE_F8_FROM, 2>(F, l);
#ifdef PROBE_ROUTE1DRY
        p_route1<MOE_F8 && l >= MOE_F8_FROM, true>(F, l);
#endif
#ifdef PROBE_CONVX
        p_conv_experts<MOE_F8 && l >= MOE_F8_FROM, 0>(F, l);
#endif
    }
    if (IN(base + 6) && IN(base + 8)) xcd_barrier(bar);
    if (IN(base + 8)) { p_moe_gu<MOE_F8 && l >= MOE_F8_FROM>(F, l);
#ifdef PROBE_GU
        p_moe_gu<MOE_F8 && l >= MOE_F8_FROM>(F, l);
#endif
    } SEAM(base + 8);
    if (IN(base + 9)) { p_moe_down<MOE_F8 && l >= MOE_F8_FROM>(F, l);
#ifdef PROBE_DOWN
        p_moe_down<MOE_F8 && l >= MOE_F8_FROM>(F, l);
#endif
#ifdef PROBE_DOWN_NULL
        p_moe_down_null<MOE_F8 && l >= MOE_F8_FROM>(F, l);
#endif
    } SEAM(base + 9);
    if (IN(base + 10)) { if (l + 1 < NL) p_combine<0>(F, l + 1, l); else p_combine<1>(F, 0, l);
#ifdef PROBE_COMBINEDRY
        if (l + 1 < NL) { p_combine<0, true>(F, l + 1, l); p_combine<0, true>(F, l + 1, l); }
#endif
    }
    if (l + 1 < NL) SEAM(base + 10);
#undef SEAM
#undef IN
}

__global__ void __launch_bounds__(NTHR, 2) k_fwd(Args args) {
    extern __shared__ __attribute__((aligned(16))) unsigned char lds_raw[];
    Frame F; F.lds = (LAS unsigned char*)lds_raw; F.tid = threadIdx.x; F.lane = F.tid & 63; F.wave = __builtin_amdgcn_readfirstlane(F.tid >> 6);
    F.G = gridDim.x; F.c = blockIdx.x; F.ws = args.ws;
    if (F.tid == 0) {
#pragma unroll
        for (int i = 0; i < 22; ++i) *(LAS unsigned long long*)(F.lds + LDS_ARGS + i * 8) = (unsigned long long)args.in[i];
        *(LAS unsigned long long*)(F.lds + LDS_ARGS + 22 * 8) = (unsigned long long)args.out;
        *(LAS unsigned long long*)(F.lds + LDS_XB) = 0ull; *(LAS unsigned long long*)(F.lds + LDS_XB + 8) = 0ull;
    }
    __syncthreads();
    const int lo = args.ph_lo, hi = args.ph_hi;
    XcdBarrier bar; bar.bar = (unsigned*)(args.ws + WS_CTL) + CW_BAR; bar.x = 0; bar.st = (volatile LAS unsigned*)(F.lds + LDS_XB);
    if (hi - lo > 1) bar = xcd_barrier_post((unsigned*)(args.ws + WS_CTL) + CW_BAR, (volatile LAS unsigned*)(F.lds + LDS_XB));
#ifdef DIAG_A
    {
        const u32x4* src = (const u32x4*)(args.ws + (size_t)256 * 1024 * 1024); unsigned acc_ = 0;
        for (size_t i = (size_t)F.c * NTHR + F.tid; i < (size_t)768 * 1024 * 1024 / 16; i += (size_t)F.G * NTHR) { const u32x4 v = src[i]; acc_ ^= v[0] ^ v[1] ^ v[2] ^ v[3]; }
        asm volatile("" :: "v"(acc_)); xcd_barrier(bar);
    }
    if (F.c == 0 && F.tid == 0) { LAS long long* st = (LAS long long*)(F.lds + LDS_MISC + 4096); st[0] = wall_clock64(); st[1] = 0; st[2] = 0; }
#endif
    if (lo <= 0 && 0 < hi) {
#if INPROJ_F8 == 3
        p_conv_win_i8(F);
#endif
#if INPROJ_F8 == 3
        p_conv_small(F);
#else
        p_conv_static(F);
#endif
        p_conv_router(F); p_conv_cmp(F); p_rmsnorm(F, 0);
#ifdef PROBE_CONV
        p_conv_static(F);
#endif
 if (1 < hi) xcd_barrier(bar); }
    layer_steps<0>(F, bar, lo, hi);
    layer_steps<1>(F, bar, lo, hi);
#ifdef DIAG_A
    xcd_barrier(bar); diag_stamp(F, 22);
    if (F.c == 0 && F.tid == 0) { LAS long long* st = (LAS long long*)(F.lds + LDS_MISC + 4096);
        const float ua = (float)st[1] * 0.01f, ub = (float)st[2] * 0.01f;
        args.out[0] = ua > 1.f ? __expf(floorf(__logf(ua) / 0.10f + 0.5f) * 0.10f) : 0.f;
        args.out[1] = ub > 1.f ? __expf(floorf(__logf(ub) / 0.10f + 0.5f) * 0.10f) : 0.f; }
#endif
#ifdef PROBE_BARS
    for (int i = 0; i < 20; ++i) xcd_barrier(bar);
#endif
#ifdef DIAG_MODE
    xcd_barrier(bar);
    if (F.c == 0 && F.tid == 0) args.out[0] = *(LAS float*)(F.lds + LDS_MISC + 4000);
#endif
}

static int g_grid = 0;
extern "C" void kernel_launch(void* const* d_in, const int* in_sizes, int n_in,
                              void* d_out, int out_size, void* d_ws, size_t ws_size,
                              hipStream_t stream) {
    if (g_grid == 0) {
        int dev = 0, cus = 0; (void)hipGetDevice(&dev); (void)hipDeviceGetAttribute(&cus, hipDeviceAttributeMultiprocessorCount, dev);
        (void)hipFuncSetAttribute((const void*)k_fwd, hipFuncAttributeMaxDynamicSharedMemorySize, LDS_BYTES);
        int per_cu = 0; (void)hipOccupancyMaxActiveBlocksPerMultiprocessor(&per_cu, (const void*)k_fwd, NTHR, LDS_BYTES);
        g_grid = (cus > 0 ? cus : 256) * (per_cu >= 1 ? 1 : 1);
    }
    if (ws_size < WS_END6 || ws_size < WS_NEED || WS_END6 > WS_H8) return;
    Args a{}; for (int i = 0; i < 22; ++i) a.in[i] = (const float*)d_in[i];
    a.out = (float*)d_out; a.ws = (unsigned char*)d_ws;
    (void)hipMemsetAsync((unsigned char*)d_ws + WS_CTL, 0, CTL_BYTES, stream);

#ifdef MULTI_LAUNCH
    for (int s = 0; s < NSTEP; ++s) { a.ph_lo = s; a.ph_hi = s + 1; hipLaunchKernelGGL(k_fwd, dim3(g_grid), dim3(NTHR), LDS_BYTES, stream, a); }
#else
    a.ph_lo = 0; a.ph_hi = NSTEP;
    hipLaunchKernelGGL(k_fwd, dim3(g_grid), dim3(NTHR), LDS_BYTES, stream, a);
#endif
}
```

```cpp
#define INPROJ_F8 3
#include <hip/hip_runtime.h>
#include <hip/hip_bf16.h>
#include <stdint.h>
#include <math.h>

constexpr int D=2048, NB=8, S=2048, T=NB*S, NL=2;
constexpr int INW=14888;
constexpr int O_MQ=0,O_MK=1024,O_MV=2048,O_NQ=3072,O_NKV=4096,O_NG=5632,O_GQ=5656,O_GK=6168,O_GV=6680,O_GA=7704,O_GG=7720,O_MG=8744;
using f32x16 = __attribute__((ext_vector_type(16))) float;
using f32x4  = __attribute__((ext_vector_type(4))) float;
using bf16x8 = __attribute__((ext_vector_type(8))) short;
#define LAS __attribute__((address_space(3)))
typedef unsigned short bf16_t;
typedef unsigned u32x4 __attribute__((ext_vector_type(4)));
typedef unsigned u32x2 __attribute__((ext_vector_type(2)));
typedef float f32x2 __attribute__((ext_vector_type(2)));

__device__ __forceinline__ unsigned cvt_pk_bf16(float lo, float hi) { unsigned r; asm volatile("v_cvt_pk_bf16_f32 %0, %1, %2" : "=v"(r) : "v"(lo), "v"(hi)); return r; }
__device__ __forceinline__ float bf_lo(unsigned w) { return __uint_as_float(w << 16); }
__device__ __forceinline__ float bf_hi(unsigned w) { return __uint_as_float(w & 0xffff0000u); }
__device__ __forceinline__ float bf2f(bf16_t b) { return __uint_as_float(((unsigned)b) << 16); }
__device__ __forceinline__ bf16_t f2bf(float f) { unsigned u = __float_as_uint(f); u += 0x7FFFu + ((u >> 16) & 1u); return (bf16_t)(u >> 16); }
__device__ __forceinline__ float fast_sigmoid(float x) { return __builtin_amdgcn_rcpf(1.f + __builtin_amdgcn_exp2f(-1.4426950408889634f * x)); }
__device__ __forceinline__ float fast_silu(float x) { return x * fast_sigmoid(x); }

#ifndef GE_SP2_DEFAULT
#define GE_SP2_DEFAULT true
#endif
#ifndef GE_ALIGN_DEFAULT
#define GE_ALIGN_DEFAULT true
#endif
namespace ge {
constexpr int BM = 256, BK = 64, HALF = 128, HTB = HALF * BK * 2, STAGE_BYTES = 8 * HTB, NXCD = 8, WGM = 4;
__host__ __device__ __forceinline__ int lds_byte(int r, int c) { const int st = (r >> 4) * 2 + (c >> 5), rr = r & 15, cc = c & 31, ob = rr * 64 + cc * 2; return st * 1024 + (ob ^ (((ob >> 9) & 1) << 5)); }
__host__ __device__ __forceinline__ void stage_rc(int b, int& R, int& C) { const int st = b / 1024, sb = b % 1024, swz = sb ^ (((sb >> 9) & 1) << 5); R = (st >> 1) * 16 + swz / 64; C = (st & 1) * 32 + (swz % 64) / 2; }
__host__ __device__ __forceinline__ int perm32(int rho) { const int n = rho >> 4, i = rho & 15; return 8 * (i >> 2) + 4 * n + (i & 3); }

typedef int i32x8 __attribute__((ext_vector_type(8)));
typedef int i32x4 __attribute__((ext_vector_type(4)));
__device__ __forceinline__ i32x8 cat8(bf16x8 a, bf16x8 b) { const i32x4 x = *reinterpret_cast<i32x4*>(&a), y = *reinterpret_cast<i32x4*>(&b); return (i32x8){x[0], x[1], x[2], x[3], y[0], y[1], y[2], y[3]}; }
constexpr int F8_SCALE_A = 0x7B7B7B7B, F8_SCALE_B = 0x76767676;
struct Unit { const char* A; const char* B; int r0; int c0; int aux; int aux2; };

__device__ __forceinline__ bool static_tile(int i, int G, int c, int nM, int nN, int& pm, int& pn) {
    const int nwg = nM * nN; const long L = (long)i * G + c; if (L >= nwg) return false;
    int wgid = (int)L; { const int q = nwg / NXCD, r = nwg % NXCD, xcd = wgid % NXCD, off = wgid / NXCD; wgid = (xcd < r ? xcd * (q + 1) : r * (q + 1) + (xcd - r) * q) + off; }
    const int nig = WGM * nN, gid = wgid / nig, fm = gid * WGM, gsz = (nM - fm) < WGM ? (nM - fm) : WGM;
    pm = fm + ((wgid % nig) % gsz); pn = (wgid % nig) / gsz; return true;
}

template <class S, class = void> struct sched_waits { static constexpr bool value = false; };
template <class E, class = void> struct epi_inplace { static constexpr bool value = false; };
template <class E> struct epi_inplace<E, decltype((void)E::INPLACE)> { static constexpr bool value = true; };
template <class S> struct sched_waits<S, decltype((void)S::WAITS)> { static constexpr bool value = true; };
template <class Epi, class Sched, int KMODE, bool F8 = false, bool SP2 = GE_SP2_DEFAULT, bool ALIGN_EPI = GE_ALIGN_DEFAULT, int SCALE_A = F8_SCALE_A, bool I8 = false>
__device__ __forceinline__ void gemm_phase(LAS unsigned char* lds, const int tid_in, const int K, const int kbig, const Sched& S, const Epi& E, const int ldb_ = 0) {
    const int KB_ = ldb_ ? ldb_ : K;
    int tid_ = tid_in; asm volatile("" : "+v"(tid_));
    const int tid = tid_, wid = __builtin_amdgcn_readfirstlane(tid >> 6), lane = tid & 63, wr = wid >> 2, wc = wid & 3, fr = lane & 15, fq = lane >> 4;
    constexpr bool BYTE = F8 || I8;
    const int nt = BYTE ? K / 128 : K / BK;
    unsigned voffB[2];
#pragma unroll
    for (int i = 0; i < 2; ++i) { int R, C; stage_rc(tid * 16 + i * 8192, R, C); const int Rb = Epi::PERM ? ((R & ~31) + perm32(R & 31)) : R; voffB[i] = BYTE ? (unsigned)(Rb * KB_ + C * 2) : (unsigned)(Rb * KB_ + C) * 2u; }
    const size_t hstepB = BYTE ? (size_t)HALF * KB_ : (size_t)HALF * KB_ * 2;
    const unsigned ldsw = (unsigned)wid * 1024u;
    const int aoff = F8 ? lds_byte(wr * 64 + fr, fq * 16) : lds_byte(wr * 64 + fr, fq * 8), boff = F8 ? lds_byte(wc * 32 + fr, fq * 16) : lds_byte(wc * 32 + fr, fq * 8);
    const int aoff1 = F8 ? lds_byte(wr * 64 + fr, fq * 16 + 8) - aoff : 1024, boff1 = F8 ? lds_byte(wc * 32 + fr, fq * 16 + 8) - boff : 1024;
#define GE_KOFF(t) (KMODE == 0 ? (size_t)(t) * 128 : (size_t)((t) >> 1) * (size_t)kbig + (size_t)((t) & 1) * 128)
#define GE_SA(b, h) (((b) * 2 + (h)) * HTB)
#define GE_SB(b, h) ((4 + (b) * 2 + (h)) * HTB)
#define GE_STAGE_B(bufoff, gbase) do { _Pragma("unroll") for (int _i = 0; _i < 2; ++_i) \
        __builtin_amdgcn_global_load_lds((const unsigned*)((const char*)(gbase) + voffB[_i]), (LAS unsigned*)(lds + (bufoff) + ldsw + _i * 8192), 16, 0, 0); } while (0)
#define GE_STAGE_A(bufoff, gbase, v0, v1) do { \
        __builtin_amdgcn_global_load_lds((const unsigned*)((const char*)(gbase) + (v0)), (LAS unsigned*)(lds + (bufoff) + ldsw), 16, 0, 0); \
        __builtin_amdgcn_global_load_lds((const unsigned*)((const char*)(gbase) + (v1)), (LAS unsigned*)(lds + (bufoff) + ldsw + 8192), 16, 0, 0); } while (0)
#define GE_LDA(dst, b, h) do { _Pragma("unroll") for (int m = 0; m < 4; ++m) _Pragma("unroll") for (int k = 0; k < 2; ++k) dst[m][k] = *(const LAS bf16x8*)(lds + GE_SA(b, h) + aoff + m * 2048 + k * aoff1); } while (0)
#define GE_LDB(dst, b, h) do { _Pragma("unroll") for (int n = 0; n < 2; ++n) _Pragma("unroll") for (int k = 0; k < 2; ++k) dst[n][k] = *(const LAS bf16x8*)(lds + GE_SB(b, h) + boff + n * 2048 + k * boff1); } while (0)
#define GE_MMA(ai, bj, At, Bt) do { __builtin_amdgcn_s_setprio(1); _Pragma("unroll") for (int m = 0; m < 4; ++m) _Pragma("unroll") for (int n = 0; n < 2; ++n) { \
        if constexpr (F8) { const i32x8 b8_ = ge::cat8(Bt[n][0], Bt[n][1]), a8_ = ge::cat8(At[m][0], At[m][1]); \
              \
            asm volatile("v_mfma_scale_f32_16x16x128_f8f6f4 %0, %1, %2, %0, %3, %4 op_sel_hi:[0,0,0]" : "+v"(acc[ai][bj][m][n]) : "v"(b8_), "v"(a8_), "v"(f8sb), "v"(f8sa)); } \
        else if constexpr (I8) { ge::i32x4 ci_ = __builtin_bit_cast(ge::i32x4, acc[ai][bj][m][n]); \
            _Pragma("unroll") for (int k = 0; k < 2; ++k) ci_ = __builtin_amdgcn_mfma_i32_16x16x64_i8(__builtin_bit_cast(ge::i32x4, Bt[n][k]), __builtin_bit_cast(ge::i32x4, At[m][k]), ci_, 0, 0, 0); \
            acc[ai][bj][m][n] = __builtin_bit_cast(f32x4, ci_); } \
        else { _Pragma("unroll") for (int k = 0; k < 2; ++k) acc[ai][bj][m][n] = __builtin_amdgcn_mfma_f32_16x16x32_bf16(Bt[n][k], At[m][k], acc[ai][bj][m][n], 0, 0, 0); } } \
        if constexpr (F8) asm volatile("s_nop 7" ::: "memory"); \
        __builtin_amdgcn_s_setprio(0); } while (0)
#define GE_WAIT_V(n) asm volatile("s_waitcnt vmcnt(" #n ")" ::: "memory")
#define GE_WAIT_L(n) asm volatile("s_waitcnt lgkmcnt(" #n ")" ::: "memory")
#define GE_BAR __builtin_amdgcn_s_barrier()
#define GE_SCHED __builtin_amdgcn_sched_barrier(0)
    Unit cur, nxt; int ui = 0;
    if (!S.next(0, cur)) return;
    int f8sa = SCALE_A, f8sb = F8_SCALE_B; if constexpr (F8) asm volatile("" : "+v"(f8sa), "+v"(f8sb));
    f32x4 acc[2][2][4][2];
#pragma unroll
    for (int a = 0; a < 2; ++a)
#pragma unroll
        for (int b = 0; b < 2; ++b)
#pragma unroll
            for (int m = 0; m < 4; ++m)
#pragma unroll
                for (int n = 0; n < 2; ++n) acc[a][b][m][n] = (f32x4){0.f, 0.f, 0.f, 0.f};
    bf16x8 At[4][2], B0[2][2], B1[2][2];
    unsigned va[2][2], vn[2][2];
    S.voffA(cur, tid, va);
    const char* cA = cur.A; const char* cB = cur.B;
    if constexpr (sched_waits<Sched>::value) S.a_ready(cur);
    if constexpr (SP2) {
        GE_STAGE_B(GE_SB(0, 0), cB); GE_STAGE_B(GE_SB(0, 1), cB + hstepB); GE_STAGE_A(GE_SA(0, 0), cA, va[0][0], va[0][1]); GE_STAGE_A(GE_SA(0, 1), cA, va[1][0], va[1][1]);
        if (wr == 1) GE_BAR;
        GE_WAIT_V(2); GE_BAR;
        GE_STAGE_B(GE_SB(1, 0), cB + 128); GE_STAGE_A(GE_SA(1, 0), cA + GE_KOFF(1), va[0][0], va[0][1]); GE_STAGE_B(GE_SB(1, 1), cB + hstepB + 128);
        GE_WAIT_V(6); GE_BAR;
    } else {
    GE_STAGE_B(GE_SB(0, 0), cB); GE_STAGE_A(GE_SA(0, 0), cA, va[0][0], va[0][1]); GE_STAGE_B(GE_SB(0, 1), cB + hstepB); GE_STAGE_A(GE_SA(0, 1), cA, va[1][0], va[1][1]);
    if (wr == 1) GE_BAR;
    GE_WAIT_V(4); GE_BAR;
    GE_STAGE_B(GE_SB(1, 0), cB + 128); GE_STAGE_A(GE_SA(1, 0), cA + GE_KOFF(1), va[0][0], va[0][1]); GE_STAGE_B(GE_SB(1, 1), cB + hstepB + 128);
    GE_WAIT_V(6); GE_BAR;
    }
    for (;;) {
        const bool has_next = S.next(ui + 1, nxt);
        if constexpr (Sched::GATHER) { if (has_next) S.voffA(nxt, tid, vn); else { vn[0][0] = va[0][0]; vn[0][1] = va[0][1]; vn[1][0] = va[1][0]; vn[1][1] = va[1][1]; } }
        const char* nA = has_next ? nxt.A : cA; const char* nB = has_next ? nxt.B : cB;
        for (int t = 0; t < nt; t += 2) {
            const bool last = (t == nt - 2);
            const char* a1 = cA + GE_KOFF(t + 1);
            const char* a2 = last ? nA : cA + GE_KOFF(t + 2); const char* b2 = last ? nB : cB + (size_t)(t + 2) * 128;
            const char* a3 = last ? nA + GE_KOFF(1) : cA + GE_KOFF(t + 3); const char* b3 = b2 + 128;
            unsigned w00 = va[0][0], w01 = va[0][1], w10 = va[1][0], w11 = va[1][1];
            if constexpr (Sched::GATHER) { if (last) { w00 = vn[0][0]; w01 = vn[0][1]; w10 = vn[1][0]; w11 = vn[1][1]; } }
            if constexpr (sched_waits<Sched>::value) { if (last && has_next) S.a_ready(nxt); }
            if constexpr (SP2) {
            GE_LDB(B0, 0, 0); GE_LDB(B1, 0, 1); GE_SCHED; GE_LDA(At, 0, 0); GE_STAGE_A(GE_SA(1, 1), a1, va[1][0], va[1][1]);
            GE_WAIT_V(8); GE_WAIT_L(0); GE_BAR; GE_MMA(0, 0, At, B0); GE_MMA(0, 1, At, B1); GE_BAR; GE_SCHED;
            GE_LDA(At, 0, 1); GE_STAGE_B(GE_SB(0, 0), b2); GE_STAGE_B(GE_SB(0, 1), b2 + hstepB); GE_STAGE_A(GE_SA(0, 0), a2, w00, w01);
            GE_WAIT_V(8); GE_WAIT_L(0); GE_BAR; GE_MMA(1, 0, At, B0); GE_MMA(1, 1, At, B1); GE_BAR; GE_SCHED;
            GE_LDB(B0, 1, 0); GE_LDB(B1, 1, 1); GE_SCHED; GE_LDA(At, 1, 0); GE_STAGE_A(GE_SA(0, 1), a2, w10, w11);
            GE_WAIT_V(8); GE_WAIT_L(0); GE_BAR; GE_MMA(0, 0, At, B0); GE_MMA(0, 1, At, B1); GE_BAR; GE_SCHED;
            GE_LDA(At, 1, 1); GE_STAGE_B(GE_SB(1, 0), b3); GE_STAGE_B(GE_SB(1, 1), b3 + hstepB); GE_STAGE_A(GE_SA(1, 0), a3, w00, w01);
            GE_WAIT_V(8); GE_WAIT_L(0); GE_BAR; GE_MMA(1, 0, At, B0); GE_MMA(1, 1, At, B1); GE_BAR; GE_SCHED;
            } else {
            GE_LDB(B0, 0, 0); GE_SCHED; GE_LDA(At, 0, 0); GE_STAGE_A(GE_SA(1, 1), a1, va[1][0], va[1][1]);
            GE_WAIT_L(8); GE_BAR; GE_WAIT_L(0); GE_MMA(0, 0, At, B0); GE_BAR; GE_SCHED;
            GE_LDB(B1, 0, 1); GE_STAGE_B(GE_SB(0, 0), b2);
            GE_BAR; GE_WAIT_L(0); GE_MMA(0, 1, At, B1); GE_BAR;
            GE_LDA(At, 0, 1); GE_STAGE_A(GE_SA(0, 0), a2, w00, w01);
            GE_BAR; GE_WAIT_L(0); GE_MMA(1, 0, At, B0); GE_BAR; GE_SCHED;
            GE_STAGE_B(GE_SB(0, 1), b2 + hstepB);
            GE_WAIT_V(6); GE_BAR; GE_MMA(1, 1, At, B1); GE_BAR;
            GE_LDB(B0, 1, 0); GE_SCHED; GE_LDA(At, 1, 0); GE_STAGE_A(GE_SA(0, 1), a2, w10, w11);
            GE_WAIT_L(8); GE_BAR; GE_WAIT_L(0); GE_MMA(0, 0, At, B0); GE_BAR; GE_SCHED;
            GE_LDB(B1, 1, 1); GE_STAGE_B(GE_SB(1, 0), b3);
            GE_BAR; GE_WAIT_L(0); GE_MMA(0, 1, At, B1); GE_BAR;
            GE_LDA(At, 1, 1); GE_STAGE_A(GE_SA(1, 0), a3, w00, w01);
            GE_BAR; GE_WAIT_L(0); GE_MMA(1, 0, At, B0); GE_BAR; GE_SCHED;
            GE_STAGE_B(GE_SB(1, 1), b3 + hstepB);
            GE_WAIT_V(6); GE_BAR; GE_MMA(1, 1, At, B1); GE_BAR;
            }
        }
        if constexpr (ALIGN_EPI) { if (wr == 0) GE_BAR; }
        if constexpr (I8) {
#pragma unroll
            for (int a = 0; a < 2; ++a)
#pragma unroll
                for (int b = 0; b < 2; ++b)
#pragma unroll
                    for (int m = 0; m < 4; ++m)
#pragma unroll
                        for (int n = 0; n < 2; ++n) { const ge::i32x4 ci_ = __builtin_bit_cast(ge::i32x4, acc[a][b][m][n]); acc[a][b][m][n] = (f32x4){(float)ci_[0], (float)ci_[1], (float)ci_[2], (float)ci_[3]}; } }
        bool keep_acc = false;
        if constexpr (epi_inplace<Epi>::value) keep_acc = E.inplace(acc, cur, wr, wc, fr, fq); else E(acc, cur, wr, wc, fr, fq);
        if (!has_next) break;
        if (!keep_acc) {
#pragma unroll
        for (int a = 0; a < 2; ++a)
#pragma unroll
            for (int b = 0; b < 2; ++b)
#pragma unroll
                for (int m = 0; m < 4; ++m)
#pragma unroll
                    for (int n = 0; n < 2; ++n) acc[a][b][m][n] = (f32x4){0.f, 0.f, 0.f, 0.f};
        }
        cur = nxt; cA = nA; cB = nB; ++ui;
        if constexpr (Sched::GATHER) { va[0][0] = vn[0][0]; va[0][1] = vn[0][1]; va[1][0] = vn[1][0]; va[1][1] = vn[1][1]; }
        if constexpr (ALIGN_EPI) { if (wr == 1) GE_BAR; }
    }
    GE_WAIT_V(0);
    if constexpr (!ALIGN_EPI) { if (wr == 0) GE_BAR; }
    GE_BAR;
#undef GE_KOFF
#undef GE_SA
#undef GE_SB
#undef GE_STAGE_A
#undef GE_STAGE_B
#undef GE_LDA
#undef GE_LDB
#undef GE_MMA
#undef GE_WAIT_V
#undef GE_WAIT_L
#undef GE_BAR
#undef GE_SCHED
}

template <bool F8 = false>
__device__ __forceinline__ void dense_voffA(int lda, int tid, unsigned (&v)[2][2]) {
#pragma unroll
    for (int i = 0; i < 2; ++i) { int R, C; stage_rc(tid * 16 + i * 8192, R, C); v[0][i] = F8 ? (unsigned)(R * lda + C * 2) : (unsigned)(R * lda + C) * 2u; v[1][i] = F8 ? (unsigned)((R + HALF) * lda + C * 2) : (unsigned)((R + HALF) * lda + C) * 2u; }
}
}
#define XB_TMO      128
#define XB_XCNT(j)  (256  + 64 * (j))
#define XB_XSUB(j)  (1280 + 64 * (j))
#define XB_XGEN(j)  (2304 + 64 * (j))
#define XB_TOP      3328
#define XB_TOPGEN   3392
#define XCD_BAR_WORDS 3456
#define XB_SPIN_CAP (1u << 18)

__device__ __forceinline__ unsigned xb_ld(unsigned* p)              { return __hip_atomic_load(p, __ATOMIC_RELAXED, __HIP_MEMORY_SCOPE_AGENT); }
__device__ __forceinline__ unsigned xb_add(unsigned* p, unsigned v) { return __hip_atomic_fetch_add(p, v, __ATOMIC_RELAXED, __HIP_MEMORY_SCOPE_AGENT); }
__device__ __forceinline__ unsigned xb_xcc_id() { return (unsigned)__builtin_amdgcn_s_getreg((3 << 11) | 20) & 0xFu; }
#define XB_SPIN(cond, bar) do { unsigned _sp = 0; while (cond) { __builtin_amdgcn_s_sleep(1); \
    if ((++_sp & 255u) == 0u) { if (xb_ld(&(bar)[XB_TMO])) break; if (_sp > XB_SPIN_CAP) { atomicAdd(&(bar)[XB_TMO], 1u); break; } } } } while (0)

struct XcdBarrier {
    unsigned* bar; unsigned x;
    volatile LAS unsigned* st;
};

__device__ __forceinline__ XcdBarrier xcd_barrier_post(unsigned* bar, volatile LAS unsigned* st) {
    XcdBarrier b; b.bar = bar; b.x = xb_xcc_id(); b.st = st;
    if (threadIdx.x == 0) (void)xb_add(&bar[XB_XCNT(b.x)], 1u);
    return b;
}
__device__ __forceinline__ void xcd_barrier_complete(unsigned* bar, unsigned x, unsigned& nloc, unsigned& nx) {
    const unsigned G = gridDim.x * gridDim.y * gridDim.z;
    unsigned sum, cnt, mine, sp = 0u;
    for (;;) {
        sum = 0u; cnt = 0u; mine = 0u;
#pragma unroll
        for (unsigned j = 0; j < 16; ++j) { const unsigned c = xb_ld(&bar[XB_XCNT(j)]); sum += c; cnt += (c > 0u) ? 1u : 0u; mine = (j == x) ? c : mine; }
        if (sum == G) break;
        __builtin_amdgcn_s_sleep(1);
        if ((++sp & 255u) == 0u) { if (xb_ld(&bar[XB_TMO])) break; if (sp > XB_SPIN_CAP) { atomicAdd(&bar[XB_TMO], 1u); break; } }
    }
    nloc = mine > 0u ? mine : 1u; nx = cnt > 0u ? cnt : 1u;
}

__device__ __forceinline__ void xcd_barrier(const XcdBarrier& b) {
    asm volatile("s_waitcnt vmcnt(0)" ::: "memory");
    __syncthreads();
    if (threadIdx.x == 0) {
        unsigned* bar = b.bar;
        __builtin_amdgcn_s_waitcnt(0);
        unsigned nloc = b.st[0], nx = b.st[1];
        if (nloc == 0u) { xcd_barrier_complete(bar, b.x, nloc, nx); b.st[0] = nloc; b.st[1] = nx; }
        const unsigned old = xb_add(&bar[XB_XSUB(b.x)], 1u);
        const unsigned gen = old / nloc;
        if (old + 1u == (gen + 1u) * nloc) {
            __builtin_amdgcn_fence(__ATOMIC_RELEASE, "agent");
            asm volatile("s_waitcnt vmcnt(0)" ::: "memory");
            const unsigned og = xb_add(&bar[XB_TOP], 1u);
            const unsigned tg = og / nx;
            if (og + 1u == (tg + 1u) * nx) xb_add(&bar[XB_TOPGEN], 1u);
            else XB_SPIN(xb_ld(&bar[XB_TOPGEN]) == tg, bar);
            __builtin_amdgcn_fence(__ATOMIC_ACQUIRE, "agent");
            xb_add(&bar[XB_XGEN(b.x)], 1u);
            asm volatile("s_waitcnt vmcnt(0)" ::: "memory");
        } else {
            XB_SPIN(xb_ld(&bar[XB_XGEN(b.x)]) == gen, bar);
            __builtin_amdgcn_fence(__ATOMIC_ACQUIRE, "agent");
            asm volatile("s_waitcnt vmcnt(0)" ::: "memory");
        }
    }
    __syncthreads();
}

constexpr int LDP = 15104;
constexpr int P_MQ=0,P_MK=1024,P_MV=2048,P_NQ=3072,P_NKV=4096,P_GQ=5632,P_GK=6144,P_GV=6656,P_GG=7680,P_MG=8704,P_NG=14848,P_GA=14872;
constexpr int NTHR = 512;
#ifndef MOE_F8_FROM
#define MOE_F8_FROM 0
#endif
#ifndef Y_F8
#define Y_F8 1
#endif
#ifndef WOUT_F8
#define WOUT_F8 1
#endif
#ifndef MOE_F8
#define MOE_F8 1
#endif
#ifndef INPROJ_F8
#define INPROJ_F8 2
#endif
constexpr int LDS_BYTES = 147456;
constexpr int MOE_ROWS = 40960;
constexpr int MOE_TILES = MOE_ROWS / 256;

constexpr size_t al256(size_t x) { return (x + 255) & ~(size_t)255; }
constexpr size_t WS_CTL   = 0;
constexpr size_t CTL_BYTES = 65536 + 131072;
constexpr size_t WS_WIN   = WS_CTL + CTL_BYTES;
constexpr size_t WS_WBR   = WS_WIN + al256((size_t)NL * LDP * 2048 * 2);
constexpr size_t WS_WOUT  = WS_WBR + al256((size_t)NL * 3 * 2048 * 1024 * 2);
constexpr size_t WS_WC1   = WS_WOUT + al256((size_t)NL * 2048 * 2048 * 2);
constexpr size_t WS_WC2   = WS_WC1 + al256((size_t)NL * 2 * 256 * 4096 * 2);
constexpr size_t WS_BIAS1 = WS_WC2 + al256((size_t)NL * 2 * 256 * 256 * 2);
constexpr size_t WS_WGU   = WS_BIAS1 + al256((size_t)NL * 2 * 256 * 4);
constexpr size_t WS_WD    = WS_WGU + al256((size_t)32 * 1024 * 2048 * 2);
constexpr size_t WS_H     = WS_WD + al256((size_t)32 * 2048 * 512 * 2);
constexpr size_t WS_PROJ  = WS_H + al256((size_t)T * 2048 * 2);
constexpr size_t WS_OM    = WS_PROJ + al256((size_t)T * LDP * 2);
constexpr size_t WS_ON    = WS_OM + al256((size_t)T * 1024 * 2);
constexpr size_t WS_OG    = WS_ON + al256((size_t)T * 1024 * 2);
constexpr size_t WS_MERGED= WS_OG + al256((size_t)T * 1024 * 2);
constexpr size_t WS_MISC  = WS_MERGED + al256((size_t)T * 2048 * 2);
constexpr size_t WS_KMEAN = WS_MISC;
constexpr size_t WS_KVC   = WS_KMEAN + al256((size_t)NB * 8 * 8 * 128 * 4);
constexpr size_t WS_DEC   = WS_KVC + al256((size_t)NB * 127 * 4 * 128 * 4);
constexpr size_t WS_OGRAW = WS_H;
constexpr size_t WS_ROUTE = WS_DEC + al256((size_t)T * 512 * 4);
constexpr size_t WS_ROWTOK= WS_ROUTE + al256((size_t)T * 8 * 4);
constexpr size_t WS_ROWW  = WS_ROWTOK + al256((size_t)MOE_ROWS * 4);
constexpr size_t WS_TILEE = WS_ROWW + al256((size_t)MOE_ROWS * 4);
constexpr size_t WS_END_SMALL = WS_TILEE + al256((size_t)(MOE_TILES + 64) * 4);
constexpr size_t WS_HID   = WS_PROJ;
constexpr size_t WS_YBUF  = WS_HID + al256((size_t)MOE_ROWS * 512 * 2);
static_assert(WS_YBUF + (size_t)MOE_ROWS * 2048 * 2 <= WS_OM, "MoE buffers must fit in the PROJ region");
constexpr size_t WS_TOTAL = WS_END_SMALL;

constexpr int CW_BAR = 0;
constexpr int CW_CNT = 4096;
constexpr int CW_CUR = 4096 + 64;
constexpr int CW_MISC = 4096 + 128;
constexpr int CMP_WGS = 64;
constexpr int CW_CMPF = 8192;
constexpr int CW_GQ = 8192 + 64 * 32;
constexpr int CW_PANEL = 8192 + 64 * 34;

constexpr size_t WS_H8 = (size_t)1114 * 1024 * 1024;
constexpr size_t WS_SA = WS_H8 + (size_t)T * 2048;
constexpr size_t WS_SB = WS_CTL + 65536;
constexpr size_t WS_XB = WS_SA + al256((size_t)T * 4);
constexpr int MOE_CAP = T;
constexpr size_t WS_LIST = WS_XB + (size_t)T * 2048 * 2;
constexpr size_t WS_LISTW = WS_LIST + (size_t)32 * MOE_CAP * 4;
constexpr size_t WS_NEED = WS_LISTW + (size_t)32 * MOE_CAP * 4;
static_assert((size_t)NL * 15104 * 4 <= 131072, "column absmax table must fit the control region");
__host__ __device__ __forceinline__ int inproj_src(int n) {
    if (n < 5632) return n; if (n < 7680) return n + 24; if (n < 14848) return n + 40; if (n < 14872) return O_NG + (n - 14848); if (n < 14888) return O_GA + (n - 14872); return -1; }
#ifndef MIX_SET
#define MIX_SET 0
#endif
#if MIX_SET == 0
constexpr int NT16 = 24, NT8 = 35;
__host__ __device__ __forceinline__ int tile16(int p) { return p < 8 ? p : p < 12 ? p + 4 : p == 12 ? 16 : p == 13 ? 18 : p == 14 ? 20 : p < 19 ? p + 7 : p < 23 ? p + 11 : 58; }
__host__ __device__ __forceinline__ int tile8(int p) { return p < 4 ? p + 8 : p == 4 ? 17 : p == 5 ? 19 : p == 6 ? 21 : p < 11 ? p + 19 : p + 23; }
#else
constexpr int NT16 = 35, NT8 = 24;
__host__ __device__ __forceinline__ int tile16(int p) { return p < 34 ? p : 58; }
__host__ __device__ __forceinline__ int tile8(int p) { return p + 34; }
#endif
struct Args { const float* in[22]; float* out; unsigned char* ws; int ph_lo, ph_hi; };
constexpr int LDS_ARGS = 131072;
constexpr int LDS_XB = LDS_ARGS + 256;
constexpr int LDS_MISC = LDS_ARGS + 512;
constexpr int LDS_GTAB = LDS_MISC + 10240;

struct Frame {
    LAS unsigned char* lds; int tid, lane, wave, G, c;
    unsigned char* ws;
    __device__ __forceinline__ const float* in(int k) const { const unsigned long long v = *(const volatile LAS unsigned long long*)(lds + LDS_ARGS + k * 8); return (const float*)(const __attribute__((address_space(1))) float*)(((unsigned long long)__builtin_amdgcn_readfirstlane((unsigned)(v >> 32)) << 32) | (unsigned)__builtin_amdgcn_readfirstlane((unsigned)v)); }
    __device__ __forceinline__ float* out() const { return (float*)in(22); }
};
template <class P> __device__ __forceinline__ P* opaque_ptr(P* p) {
    const unsigned long long v = (unsigned long long)p; unsigned lo = __builtin_amdgcn_readfirstlane((unsigned)v), hi = __builtin_amdgcn_readfirstlane((unsigned)(v >> 32));
    asm volatile("" : "+s"(lo), "+s"(hi)); return (P*)(__attribute__((address_space(1))) P*)(((unsigned long long)hi << 32) | lo);
}
__device__ __forceinline__ Frame phase_frame(const Frame& F0) {
    __syncthreads();
    Frame F = F0; F.ws = opaque_ptr(F0.ws);
    int t; asm volatile("v_mbcnt_lo_u32_b32 %0, -1, 0\n\tv_mbcnt_hi_u32_b32 %0, -1, %0" : "=v"(t)); t += F0.wave * 64; asm volatile("" : "+v"(t));
    F.tid = t; F.lane = t & 63; F.wave = __builtin_amdgcn_readfirstlane(t >> 6); return F;
}

__device__ __forceinline__ float clamp_fp8(float v) { return __builtin_amdgcn_fmed3f(v, -448.f, 448.f); }
__device__ __forceinline__ unsigned pack_fp8x4(float a, float b, float c, float d) { int w = __builtin_amdgcn_cvt_pk_fp8_f32(clamp_fp8(a), clamp_fp8(b), 0, false); w = __builtin_amdgcn_cvt_pk_fp8_f32(clamp_fp8(c), clamp_fp8(d), w, true); return (unsigned)w; }
__device__ __forceinline__ unsigned pack_i8x4(float a, float b, float c, float d) {
    const int ia = (int)rintf(__builtin_amdgcn_fmed3f(a, -127.f, 127.f)), ib = (int)rintf(__builtin_amdgcn_fmed3f(b, -127.f, 127.f)), ic = (int)rintf(__builtin_amdgcn_fmed3f(c, -127.f, 127.f)), id = (int)rintf(__builtin_amdgcn_fmed3f(d, -127.f, 127.f));
    return (unsigned)(ia & 255) | ((unsigned)(ib & 255) << 8) | ((unsigned)(ic & 255) << 16) | ((unsigned)(id & 255) << 24); }
template <bool F8, class Fn>
__device__ __forceinline__ void conv_t(const Frame& F, Fn colsrc, int ld, int K, int N, void* dstv, float scale = 1.f, const float* rowinv = nullptr  , int wg0 = 0, int t_lo = 0, int t_hi = -1) {
    const int ntn = N / 256, ntk = K / 64, tot = t_hi < 0 ? ntn * ntk : t_hi;
    if (F.c < wg0) return;
    const int n4 = ((F.tid >> 6) * 8 + (F.tid & 7)) * 4, kc = (F.tid >> 3) & 7;
    f32x4 va[8], vb[8];
#define CONV_LOAD(v, ti_) do { const int tn_ = (ti_) % ntn, tk_ = (ti_) / ntn; const float* sp_ = colsrc(tn_ * 256 + n4); \
        _Pragma("unroll") for (int p = 0; p < 8; ++p) v[p] = sp_ ? __builtin_nontemporal_load((const f32x4*)(sp_ + (size_t)(tk_ * 64 + kc * 8 + p) * ld)) : (f32x4){0.f, 0.f, 0.f, 0.f}; } while (0)
#define CONV_TILE(v) do { const int tn = ti % ntn, tk = ti / ntn; const int n0 = tn * 256 + n4, k0 = tk * 64 + kc * 8;                                        \
        f32x4 c_[8]; _Pragma("unroll") for (int p = 0; p < 8; ++p) c_[p] = v[p] * scale;                                                                   \
        if (ti + 2 * stride < tot) CONV_LOAD(v, ti + 2 * stride);                                                                                          \
        _Pragma("unroll") for (int j = 0; j < 4; ++j) {                                                                                                      \
            if (rowinv) { const float am_ = rowinv[n0 + j]; const float ri = am_ > 0.f ? 127.f / am_ : 0.f;                \
                u32x2 w = {pack_i8x4(c_[0][j] * ri, c_[1][j] * ri, c_[2][j] * ri, c_[3][j] * ri), pack_i8x4(c_[4][j] * ri, c_[5][j] * ri, c_[6][j] * ri, c_[7][j] * ri)}; *(u32x2*)((unsigned char*)dstv + (size_t)(n0 + j) * K + k0) = w; } \
            else if (F8) { u32x2 w = {pack_fp8x4(c_[0][j], c_[1][j], c_[2][j], c_[3][j]), pack_fp8x4(c_[4][j], c_[5][j], c_[6][j], c_[7][j])}; *(u32x2*)((unsigned char*)dstv + (size_t)(n0 + j) * K + k0) = w; } \
            else { u32x4 w = {cvt_pk_bf16(c_[0][j], c_[1][j]), cvt_pk_bf16(c_[2][j], c_[3][j]), cvt_pk_bf16(c_[4][j], c_[5][j]), cvt_pk_bf16(c_[6][j], c_[7][j])}; *(u32x4*)((bf16_t*)dstv + (size_t)(n0 + j) * K + k0) = w; } } \
        } while (0)
    int ti = t_lo + F.c - wg0; const int stride = F.G - wg0;
    if (ti < tot) CONV_LOAD(va, ti);
    if (ti + stride < tot) CONV_LOAD(vb, ti + stride);
    for (;;) {
        if (ti >= tot) break;
        CONV_TILE(va); ti += stride;
        if (ti >= tot) break;
        CONV_TILE(vb); ti += stride;
    }
#undef CONV_TILE
#undef CONV_LOAD
}

__device__ __forceinline__ void p_conv_win_i8(const Frame& F0) {
    const Frame F = phase_frame(F0);
    LAS float* red = (LAS float*)F.lds;
    LAS float* cmax = red + 64 * 32;
    float* sb = (float*)(F.ws + WS_SB);
    const int cg = F.tid & 7, rl = F.tid >> 3;
    for (int task = F.c; task < NL * (LDP / 32); task += F.G) { const int nb = task % (LDP / 32), l = task / (LDP / 32); const int n0 = nb * 32;
        const int src = inproj_src(n0 + cg * 4); const float* sp = F.in(2) + (size_t)l * D * INW + (src >= 0 ? src : 0) + (size_t)(rl * 8) * INW;
        u32x2 w[32]; f32x4 m = {0.f, 0.f, 0.f, 0.f};
#pragma unroll
        for (int q = 0; q < 4; ++q) { f32x4 v[8];
#pragma unroll
            for (int p = 0; p < 8; ++p) v[p] = src >= 0 ? __builtin_nontemporal_load((const f32x4*)(sp + (size_t)(q * 512 + p) * INW)) : (f32x4){0.f, 0.f, 0.f, 0.f};
#pragma unroll
            for (int p = 0; p < 8; ++p) { m[0] = fmaxf(m[0], fabsf(v[p][0])); m[1] = fmaxf(m[1], fabsf(v[p][1])); m[2] = fmaxf(m[2], fabsf(v[p][2])); m[3] = fmaxf(m[3], fabsf(v[p][3]));
                w[q * 8 + p] = (u32x2){cvt_pk_bf16(v[p][0], v[p][1]), cvt_pk_bf16(v[p][2], v[p][3])}; } }
        *(LAS f32x4*)(red + rl * 32 + cg * 4) = m; __syncthreads();
        if (F.tid < 32) { float a = 0.f;
#pragma unroll 8
            for (int q = 0; q < 64; ++q) a = fmaxf(a, red[q * 32 + F.tid]);
            cmax[F.tid] = a; sb[(size_t)l * LDP + n0 + F.tid] = a; }
        __syncthreads();
        unsigned char* dst = F.ws + WS_WIN + (size_t)l * LDP * 2048;
#pragma unroll
        for (int j = 0; j < 4; ++j) { const float am_ = cmax[cg * 4 + j]; const float ri = am_ > 0.f ? 127.f / am_ : 0.f;
#define WEL(pp_) ((j & 1) ? bf_hi(w[pp_][j >> 1]) : bf_lo(w[pp_][j >> 1]))
#pragma unroll
            for (int q = 0; q < 4; ++q) { u32x2 o = {pack_i8x4(WEL(q * 8 + 0) * ri, WEL(q * 8 + 1) * ri, WEL(q * 8 + 2) * ri, WEL(q * 8 + 3) * ri), pack_i8x4(WEL(q * 8 + 4) * ri, WEL(q * 8 + 5) * ri, WEL(q * 8 + 6) * ri, WEL(q * 8 + 7) * ri)};
                __builtin_nontemporal_store(o, (u32x2*)(dst + (size_t)(n0 + cg * 4 + j) * 2048 + q * 512 + rl * 8)); }
#undef WEL
        }
        __syncthreads();
    }
}
__device__ __forceinline__ void p_conv_small(const Frame& F0) {
    const Frame F = phase_frame(F0);
    constexpr int PER_L = 704;
    const int n4 = ((F.tid >> 6) * 8 + (F.tid & 7)) * 4, kc = (F.tid >> 3) & 7;
    for (int g = F.c; g < NL * PER_L; g += F.G) {
        const int l = g / PER_L; int t = g - l * PER_L;
        const float* base; int ld, K, ntn; bf16_t* dst; bool cmp = false, f8 = false;
        if (t < 384) { const int b = t / 128; t -= b * 128; base = (b == 0 ? F.in(9) : b == 1 ? F.in(10) : F.in(11)) + (size_t)l * 1024 * D; ld = D; K = 1024; ntn = 8; dst = (bf16_t*)(F.ws + WS_WBR) + ((size_t)l * 3 + b) * 2048 * 1024; }
        else if (t < 640) { t -= 384; base = F.in(12) + (size_t)l * D * D; ld = D; K = 2048; ntn = 8; dst = (bf16_t*)(F.ws + WS_WOUT) + (size_t)l * 2048 * 2048; f8 = WOUT_F8 != 0; }
        else { t -= 640; const int c = t >> 5; t &= 31; base = F.in(4) + ((size_t)l * 2 + c) * 4096 * 128; ld = 128; K = 2048; ntn = 1; dst = (bf16_t*)(F.ws + WS_WC1) + ((size_t)l * 2 + c) * 256 * 2048; cmp = true; }
        const int tn = t % ntn, tk = t / ntn; const int n = tn * 256 + n4, k0 = tk * 64 + kc * 8;
        const float* sp = cmp ? base + (n >= 128 ? (size_t)2048 * 128 : 0) + (n & 127) : base + n;
        f32x4 v[8];
#pragma unroll
        for (int pp = 0; pp < 8; ++pp) v[pp] = __builtin_nontemporal_load((const f32x4*)(sp + (size_t)(k0 + pp) * ld));
#pragma unroll
        for (int j = 0; j < 4; ++j) {
            if (f8) { u32x2 w = {pack_fp8x4(v[0][j] * 512.f, v[1][j] * 512.f, v[2][j] * 512.f, v[3][j] * 512.f), pack_fp8x4(v[4][j] * 512.f, v[5][j] * 512.f, v[6][j] * 512.f, v[7][j] * 512.f)};
                __builtin_nontemporal_store(w, (u32x2*)((unsigned char*)dst + (size_t)(n + j) * K + k0)); }
            else { u32x4 w = {cvt_pk_bf16(v[0][j], v[1][j]), cvt_pk_bf16(v[2][j], v[3][j]), cvt_pk_bf16(v[4][j], v[5][j]), cvt_pk_bf16(v[6][j], v[7][j])};
                __builtin_nontemporal_store(w, (u32x4*)(dst + (size_t)(n + j) * K + k0)); } }
    }
}
__device__ __forceinline__ void p_conv_static(const Frame& F0) {
    const Frame F = phase_frame(F0);
    for (int l = 0; l < NL; ++l) {
        { const float* w = F.in(2) + (size_t)l * D * INW;
          auto srcpad = [=](int n) -> const float* { int s; if (n < 5632) s = n; else if (n < 7680) s = n + 24; else if (n < 14848) s = n + 40; else if (n < 14872) s = O_NG + (n - 14848); else if (n < 14888) s = O_GA + (n - 14872); else return nullptr; return w + s; };
#if INPROJ_F8 == 3
          (void)srcpad;
#elif INPROJ_F8 == 2
          conv_t<false>(F, [=](int n) -> const float* { return srcpad(tile16(n >> 8) * 256 + (n & 255)); }, INW, 2048, NT16 * 256, (bf16_t*)(F.ws + WS_WIN) + (size_t)l * NT16 * 256 * 2048);
          conv_t<true>(F, [=](int n) -> const float* { return srcpad(tile8(n >> 8) * 256 + (n & 255)); }, INW, 2048, NT8 * 256, F.ws + WS_WIN + (size_t)NL * NT16 * 256 * 2048 * 2 + (size_t)l * NT8 * 256 * 2048, 512.f);
#elif INPROJ_F8 == 1
          conv_t<true>(F, srcpad, INW, 2048, LDP, F.ws + WS_WIN + (size_t)l * LDP * 2048, 512.f);
#else
          conv_t<false>(F, srcpad, INW, 2048, LDP, (bf16_t*)(F.ws + WS_WIN) + (size_t)l * LDP * 2048);
#endif
        }
#define CONV_BR(b, idx) { const float* w = F.in(idx) + (size_t)l * 1024 * D; bf16_t* dst = (bf16_t*)(F.ws + WS_WBR) + ((size_t)l * 3 + b) * 2048 * 1024; \
          conv_t<false>(F, [=](int n) -> const float* { return w + n; }, D, 1024, 2048, dst); }
        CONV_BR(0, 9) CONV_BR(1, 10) CONV_BR(2, 11)
#undef CONV_BR
        { const float* w = F.in(12) + (size_t)l * D * D; bf16_t* dst = (bf16_t*)(F.ws + WS_WOUT) + (size_t)l * 2048 * 2048;
          conv_t<false>(F, [=](int n) -> const float* { return w + n; }, D, 2048, 2048, dst); }
        for (int c = 0; c < 2; ++c) { const float* w = F.in(4) + ((size_t)l * 2 + c) * 4096 * 128; bf16_t* dst = (bf16_t*)(F.ws + WS_WC1) + ((size_t)l * 2 + c) * 256 * 2048;
          conv_t<false>(F, [=](int n) -> const float* { return w + (n >= 128 ? (size_t)2048 * 128 : 0) + (n & 127); }, 128, 2048, 256, dst); }
    }
}
#ifndef CONVX_EARLY_TILES
#define CONVX_EARLY_TILES 0
#endif
constexpr int CONVX_EARLY = CONVX_EARLY_TILES;
template <bool F8, int PART>
__device__ __forceinline__ void p_conv_experts(const Frame& F0, int l, int wg0 = 0) {
    const Frame F = phase_frame(F0);
    const float* wg = F.in(18) + (size_t)l * 32 * D * 512; const float* wu = F.in(19) + (size_t)l * 32 * D * 512; const float* wd = F.in(20) + (size_t)l * 32 * 512 * D;
    constexpr int DOWN_TILES = 8 * 256, EARLY = CONVX_EARLY < DOWN_TILES ? CONVX_EARLY : DOWN_TILES;
    auto down_src = [=](int n) -> const float* { return wd + (size_t)(n >> 11) * 512 * D + (n & 2047); };
    if (PART == 1) { conv_t<F8>(F, down_src, D, 512, 32 * 2048, F.ws + WS_WD, F8 ? 512.f : 1.f, nullptr, wg0, 0, EARLY); return; }
    conv_t<F8>(F, [=](int n) -> const float* { const int e = n >> 10, r = n & 1023, j = r >> 8, wi = r & 255; const unsigned long long dlt = (unsigned long long)wu - (unsigned long long)wg; const float* base = (const float*)((unsigned long long)wg + (dlt & (0ull - (unsigned long long)(wi >> 7)))) + (size_t)e * D * 512; return base + j * 128 + (wi & 127); }, 512, 2048, 32 * 1024, F.ws + WS_WGU, F8 ? 512.f : 1.f);
    conv_t<F8>(F, down_src, D, 512, 32 * 2048, F.ws + WS_WD, F8 ? 512.f : 1.f, nullptr, 0, PART == 2 ? EARLY : 0, -1);
}
__device__ __forceinline__ void store_h4(unsigned char* ws, size_t idx, float a, float b, float c, float d) {
#if INPROJ_F8 == 1 || INPROJ_F8 == 2
    *(unsigned*)(ws + (INPROJ_F8 == 2 ? WS_H8 : WS_H) + idx) = pack_fp8x4(a * 16.f, b * 16.f, c * 16.f, d * 16.f);
#endif
#if INPROJ_F8 == 0 || INPROJ_F8 == 2
    u32x2 w; w[0] = cvt_pk_bf16(a, b); w[1] = cvt_pk_bf16(c, d); *(u32x2*)((bf16_t*)(ws + WS_H) + idx) = w;
#endif
}
template <bool NT = false>
__device__ __forceinline__ void store_h_row(unsigned char* ws, int row, const f32x4 (&y)[8], int lane) {
#if INPROJ_F8 == 3
    float am = 0.f;
#pragma unroll
    for (int i = 0; i < 8; ++i) am = fmaxf(fmaxf(am, fmaxf(fabsf(y[i][0]), fabsf(y[i][1]))), fmaxf(fabsf(y[i][2]), fabsf(y[i][3])));
#pragma unroll
    for (int o = 32; o > 0; o >>= 1) am = fmaxf(am, __shfl_xor(am, o));
    const float inv = am > 0.f ? 127.f / am : 0.f;
    if (lane == 0) ((float*)(ws + WS_SA))[row] = am > 0.f ? am * (1.f / 127.f) : 1.f;
#pragma unroll
    for (int i = 0; i < 8; ++i) { const unsigned w_ = pack_i8x4(y[i][0] * inv, y[i][1] * inv, y[i][2] * inv, y[i][3] * inv); unsigned* p_ = (unsigned*)(ws + WS_H8 + (size_t)row * D + i * 256 + lane * 4);
        if (NT) __builtin_nontemporal_store(w_, p_); else *p_ = w_; }
#else
#pragma unroll
    for (int i = 0; i < 8; ++i) store_h4(ws, (size_t)row * D + i * 256 + lane * 4, y[i][0], y[i][1], y[i][2], y[i][3]);
#endif
}
__device__ __forceinline__ void p_rmsnorm(const Frame& F0, int l) {
    const Frame F = phase_frame(F0);
    const float* x = (l == 0) ? F.in(0) : F.out(); const float* g = F.in(1) + l * D; unsigned char* h = F.ws;
    for (int row = F.c * 8 + F.wave; row < T; row += F.G * 8) {
        const float* xr = x + (size_t)row * D; f32x4 v[8]; float ss = 0.f;
#pragma unroll
        for (int i = 0; i < 8; ++i) { v[i] = __builtin_nontemporal_load((const f32x4*)(xr + i * 256 + F.lane * 4)); ss += v[i][0] * v[i][0] + v[i][1] * v[i][1] + v[i][2] * v[i][2] + v[i][3] * v[i][3]; }
#pragma unroll
        for (int o = 32; o > 0; o >>= 1) ss += __shfl_xor(ss, o);
        const float rstd = rsqrtf(ss * (1.f / D) + 1e-6f);
#pragma unroll
        for (int i = 0; i < 8; ++i) { const f32x4 gv = *(const f32x4*)(g + i * 256 + F.lane * 4); v[i] = (f32x4){v[i][0] * rstd * gv[0], v[i][1] * rstd * gv[1], v[i][2] * rstd * gv[2], v[i][3] * rstd * gv[3]}; }
        store_h_row<true>(h, row, v, F.lane);
    }
}

template <bool F8 = false>
struct SchedDenseT {
    static constexpr bool GATHER = false;
    const char* A; const char* B; int lda, K, nM, nN, G, c;
    __device__ __forceinline__ bool next(int i, ge::Unit& u) const { int pm, pn; if (!ge::static_tile(i, G, c, nM, nN, pm, pn)) return false;
        u.A = A + (size_t)pm * 256 * lda * (F8 ? 1 : 2); u.B = B + (size_t)pn * 256 * K * (F8 ? 1 : 2); u.r0 = pm * 256; u.c0 = pn * 256; u.aux = 0; u.aux2 = 0; return true; }
    __device__ __forceinline__ void voffA(const ge::Unit&, int tid, unsigned (&v)[2][2]) const { ge::dense_voffA<F8>(lda, tid, v); }
};
typedef SchedDenseT<false> SchedDense;
struct SchedInproj2D {
    static constexpr bool GATHER = false;
    const char* A; const char* B; int G, c;
    __device__ __forceinline__ bool next(int i, ge::Unit& u) const {
        if (G != 256) { int pm, pn; if (!ge::static_tile(i, G, c, T / 256, LDP / 256, pm, pn)) return false;
            u.A = A + (size_t)pm * 256 * 2048; u.B = B + (size_t)pn * 256 * 2048; u.r0 = pm * 256; u.c0 = pn * 256; u.aux = 0; u.aux2 = 0; return true; }
        const int x = c & 7, xr = x >> 2, xc = x & 3, nNx = xc < 3 ? 15 : 14, p = i * 32 + (c >> 3);
        if (p >= 32 * nNx) return false;
        const int gid = p / (4 * nNx), q = p - gid * 4 * nNx, pm = xr * 32 + gid * 4 + (q & 3), pn = xc * 15 + (q >> 2);
        u.A = A + (size_t)pm * 256 * 2048; u.B = B + (size_t)pn * 256 * 2048; u.r0 = pm * 256; u.c0 = pn * 256; u.aux = 0; u.aux2 = 0; return true; }
    __device__ __forceinline__ void voffA(const ge::Unit&, int tid, unsigned (&v)[2][2]) const { ge::dense_voffA<true>(2048, tid, v); }
};
struct EpiStoreBf16 {
    static constexpr bool PERM = true; bf16_t* O; int ldc;
    __device__ __forceinline__ void operator()(const f32x4 (&acc)[2][2][4][2], const ge::Unit& u, int wr, int wc, int fr, int fq) const {
#pragma unroll
        for (int ai = 0; ai < 2; ++ai)
#pragma unroll
            for (int m = 0; m < 4; ++m) { bf16_t* rowp = O + (size_t)(u.r0 + ai * 128 + wr * 64 + m * 16 + fr) * ldc + u.c0 + wc * 32 + 8 * fq;
#pragma unroll
                for (int bj = 0; bj < 2; ++bj) { const f32x4 v0 = acc[ai][bj][m][0], v1 = acc[ai][bj][m][1]; u32x4 w = {cvt_pk_bf16(v0[0], v0[1]), cvt_pk_bf16(v0[2], v0[3]), cvt_pk_bf16(v1[0], v1[1]), cvt_pk_bf16(v1[2], v1[3])};
                    *(u32x4*)(rowp + bj * 128) = w; } }
    }
};
struct EpiNull {
    static constexpr bool PERM = true;
    __device__ __forceinline__ void operator()(const f32x4 (&acc)[2][2][4][2], const ge::Unit&, int, int, int, int) const {
#pragma unroll
        for (int ai = 0; ai < 2; ++ai)
#pragma unroll
            for (int bj = 0; bj < 2; ++bj)
#pragma unroll
                for (int m = 0; m < 4; ++m) asm volatile("" :: "v"(acc[ai][bj][m][0]), "v"(acc[ai][bj][m][1]));
    }
};
struct SchedSame {
    static constexpr bool GATHER = false; const char* A; const char* B; int n;
    __device__ __forceinline__ bool next(int i, ge::Unit& u) const { if (i >= n) return false; u.A = A; u.B = B; u.r0 = 0; u.c0 = 0; u.aux = 0; u.aux2 = 0; return true; }
    __device__ __forceinline__ void voffA(const ge::Unit&, int tid, unsigned (&v)[2][2]) const { ge::dense_voffA<false>(2048, tid, v); }
};
__device__ __forceinline__ void p_inproj_same(const Frame& F0, int l) {
    const Frame F = phase_frame(F0);
    EpiNull E{};
    SchedSame S{(const char*)(F.ws + WS_H), (const char*)(F.ws + WS_WIN) + (size_t)l * LDP * 2048 * 2, 15};
    ge::gemm_phase<EpiNull, SchedSame, 0>(F.lds, F.tid, 2048, 0, S, E);
}
__device__ __forceinline__ void p_inproj_longk(const Frame& F0, int l) {
    const Frame F = phase_frame(F0);
    EpiNull E{};
    SchedSame S{(const char*)(F.ws + WS_H), (const char*)(F.ws + WS_WIN) + (size_t)l * LDP * 2048 * 2, 1};
    ge::gemm_phase<EpiNull, SchedSame, 0>(F.lds, F.tid, 2048 * 15, 0, S, E);
}
__device__ __forceinline__ void p_inproj_null(const Frame& F0, int l) {
    const Frame F = phase_frame(F0);
    EpiNull E{};
    SchedDense S{(const char*)(F.ws + WS_H), (const char*)(F.ws + WS_WIN) + (size_t)l * LDP * 2048 * 2, 2048, 2048, T / 256, LDP / 256, F.G, F.c};
    ge::gemm_phase<EpiNull, SchedDense, 0>(F.lds, F.tid, 2048, 0, S, E);
}
__device__ __forceinline__ void p_inproj_null8(const Frame& F0, int l) {
    const Frame F = phase_frame(F0);
    EpiNull E{};
    SchedDenseT<true> S{(const char*)(F.ws + WS_H8), (const char*)(F.ws + WS_WIN) + (size_t)l * LDP * 2048, 2048, 2048, T / 256, LDP / 256, F.G, F.c};
    ge::gemm_phase<EpiNull, SchedDenseT<true>, 0, false, GE_SP2_DEFAULT, GE_ALIGN_DEFAULT, 0, true>(F.lds, F.tid, 2048, 0, S, E);
}
#ifndef INPROJ_F8
#define INPROJ_F8 1
#endif
struct EpiStoreBf16Scaled {
    static constexpr bool PERM = true; bf16_t* O; int ldc; const float* sa; const float* sb; unsigned gtab;
    __device__ __forceinline__ void operator()(const f32x4 (&acc)[2][2][4][2], const ge::Unit& u, int wr, int wc, int fr, int fq) const {
        float rs[2][4];
#pragma unroll
        for (int ai = 0; ai < 2; ++ai)
#pragma unroll
            for (int m = 0; m < 4; ++m) rs[ai][m] = sa[u.r0 + ai * 128 + wr * 64 + m * 16 + fr];
        const bool gate = u.c0 >= P_MG && u.c0 < P_NG;
#pragma unroll
        for (int bj = 0; bj < 2; ++bj) { const int col = u.c0 + bj * 128 + wc * 32 + 8 * fq; const f32x4 c0 = *(const f32x4*)(sb + col) * (1.f / 127.f), c1 = *(const f32x4*)(sb + col + 4) * (1.f / 127.f);
#pragma unroll
            for (int ai = 0; ai < 2; ++ai)
#pragma unroll
                for (int m = 0; m < 4; ++m) { const f32x4 v0 = acc[ai][bj][m][0] * c0 * rs[ai][m], v1 = acc[ai][bj][m][1] * c1 * rs[ai][m];
                    const size_t row = (size_t)(u.r0 + ai * 128 + wr * 64 + m * 16 + fr);
                    if (gate) {
                        unsigned g[8];
#pragma unroll
                        for (int j = 0; j < 8; ++j) { const float x = j < 4 ? v0[j] : v1[j - 4]; const float fi = fminf(fmaxf(x * 128.f + 1024.f, 0.f), 2047.f);
                            g[j] = *(const LAS unsigned char*)(gtab + (unsigned)fi); }
                        u32x2 w = {g[0] | (g[1] << 8) | (g[2] << 16) | (g[3] << 24), g[4] | (g[5] << 8) | (g[6] << 16) | (g[7] << 24)};
                        *(u32x2*)((unsigned char*)(O + row * ldc + P_MG) + (col - P_MG)) = w; }
                    else { u32x4 w = {cvt_pk_bf16(v0[0], v0[1]), cvt_pk_bf16(v0[2], v0[3]), cvt_pk_bf16(v1[0], v1[1]), cvt_pk_bf16(v1[2], v1[3])};
                        *(u32x4*)(O + row * ldc + col) = w; } } }
    }
};
template <bool F8>
struct SchedInprojMix {
    static constexpr bool GATHER = false;
    const char* A; const char* B; int G, c;
    __device__ __forceinline__ bool next(int i, ge::Unit& u) const { int pm, pn; if (!ge::static_tile(i, G, c, T / 256, F8 ? NT8 : NT16, pm, pn)) return false;
        u.A = A + (size_t)pm * 256 * 2048 * (F8 ? 1 : 2); u.B = B + (size_t)pn * 256 * 2048 * (F8 ? 1 : 2); u.r0 = pm * 256; u.c0 = (F8 ? tile8(pn) : tile16(pn)) * 256; u.aux = 0; u.aux2 = 0; return true; }
    __device__ __forceinline__ void voffA(const ge::Unit&, int tid, unsigned (&v)[2][2]) const { ge::dense_voffA<F8>(2048, tid, v); }
};
__device__ __forceinline__ void p_inproj(const Frame& F0, int l) {
    const Frame F = phase_frame(F0);
    EpiStoreBf16 E{(bf16_t*)(F.ws + WS_PROJ), LDP};
#if INPROJ_F8 == 3
    {
        LAS unsigned char* gt = F.lds + LDS_GTAB;
        for (int i = F.tid; i < 2048; i += NTHR) gt[i] = (unsigned char)fminf(256.f * fast_sigmoid(((float)(i - 1024) + 0.5f) * (1.f / 128.f)), 255.f);
        __syncthreads(); }
    { SchedInproj2D S{(const char*)(F.ws + WS_H8), (const char*)(F.ws + WS_WIN) + (size_t)l * LDP * 2048, F.G, F.c};
      EpiStoreBf16Scaled E3{(bf16_t*)(F.ws + WS_PROJ), LDP, (const float*)(F.ws + WS_SA), (const float*)(F.ws + WS_SB) + (size_t)l * LDP, (unsigned)(uintptr_t)(F.lds + LDS_GTAB)};
      ge::gemm_phase<EpiStoreBf16Scaled, SchedInproj2D, 0, false, GE_SP2_DEFAULT, GE_ALIGN_DEFAULT, 0, true>(F.lds, F.tid, 2048, 0, S, E3); }
#elif INPROJ_F8 == 2
    { SchedInprojMix<false> S{(const char*)(F.ws + WS_H), (const char*)(F.ws + WS_WIN) + (size_t)l * NT16 * 256 * 2048 * 2, F.G, F.c};
      ge::gemm_phase<EpiStoreBf16, SchedInprojMix<false>, 0, false>(F.lds, F.tid, 2048, 0, S, E); }
    { const Frame F2 = phase_frame(F0);
      SchedInprojMix<true> S{(const char*)(F2.ws + WS_H8), (const char*)(F2.ws + WS_WIN) + (size_t)NL * NT16 * 256 * 2048 * 2 + (size_t)l * NT8 * 256 * 2048, F2.G, F2.c};
      EpiStoreBf16 E2{(bf16_t*)(F2.ws + WS_PROJ), LDP};
      ge::gemm_phase<EpiStoreBf16, SchedInprojMix<true>, 0, true>(F2.lds, F2.tid, 2048, 0, S, E2); }
#elif INPROJ_F8 == 1
    SchedDenseT<true> S{(const char*)(F.ws + WS_H), (const char*)(F.ws + WS_WIN) + (size_t)l * LDP * 2048, 2048, 2048, T / 256, LDP / 256, F.G, F.c};
    ge::gemm_phase<EpiStoreBf16, SchedDenseT<true>, 0, true>(F.lds, F.tid, 2048, 0, S, E);
#else
    SchedDense S{(const char*)(F.ws + WS_H), (const char*)(F.ws + WS_WIN) + (size_t)l * LDP * 2048 * 2, 2048, 2048, T / 256, LDP / 256, F.G, F.c};
    ge::gemm_phase<EpiStoreBf16, SchedDense, 0>(F.lds, F.tid, 2048, 0, S, E);
#endif
}

struct SchedMerge {
    static constexpr bool GATHER = false;
    const char* O3; const char* W; int G, c;
    __device__ __forceinline__ bool next(int i, ge::Unit& u) const { const int ti = i / 3, b = i - ti * 3; int pm, pn; if (!ge::static_tile(ti, G, c, T / 256, 8, pm, pn)) return false;
        u.A = O3 + (size_t)b * T * 1024 * 2 + (size_t)pm * 256 * 1024 * 2; u.B = W + (size_t)b * 2048 * 1024 * 2 + (size_t)pn * 256 * 1024 * 2; u.r0 = pm * 256; u.c0 = pn * 256; u.aux = b; u.aux2 = 0; return true; }
    __device__ __forceinline__ void voffA(const ge::Unit&, int tid, unsigned (&v)[2][2]) const { ge::dense_voffA(1024, tid, v); }
};
#if INPROJ_F8 == 3
struct EpiMerge {
    static constexpr bool PERM = true; static constexpr bool INPLACE = true; const bf16_t* proj; bf16_t* merged;
    __device__ __forceinline__ bool inplace(f32x4 (&acc)[2][2][4][2], const ge::Unit& u, int wr, int wc, int fr, int fq) const {
        const int col = u.c0 + wc * 32 + 8 * fq; const int b = u.aux;
#pragma unroll
        for (int ai = 0; ai < 2; ++ai) {
            u32x2 ga[4][2], gb[4][2];
#pragma unroll
            for (int m = 0; m < 4; ++m) { const size_t row = (size_t)(u.r0 + ai * 128 + wr * 64 + m * 16 + fr);
#pragma unroll
                for (int bj = 0; bj < 2; ++bj) { const unsigned char* gp = (const unsigned char*)(proj + row * LDP + P_MG) + b * 2048 + col + bj * 128;
                    ga[m][bj] = *(const u32x2*)gp; if (b < 2) gb[m][bj] = *(const u32x2*)(gp + 2048); else gb[m][bj] = (u32x2){0u, 0u}; } }
#pragma unroll
            for (int m = 0; m < 4; ++m) { const size_t row = (size_t)(u.r0 + ai * 128 + wr * 64 + m * 16 + fr);
#pragma unroll
                for (int bj = 0; bj < 2; ++bj) { const u32x2 g = ga[m][bj], h = gb[m][bj]; float s[8];
#pragma unroll
                    for (int j = 0; j < 8; ++j) { const float num = (float)((g[j >> 2] >> (8 * (j & 3))) & 255u) + 0.5f;
                        s[j] = b < 2 ? num * __builtin_amdgcn_rcpf((float)((h[j >> 2] >> (8 * (j & 3))) & 255u) + 0.5f) : num * (1.f / 256.f); }
                    f32x4 v0 = acc[ai][bj][m][0], v1 = acc[ai][bj][m][1];
                    v0[0] *= s[0]; v0[1] *= s[1]; v0[2] *= s[2]; v0[3] *= s[3]; v1[0] *= s[4]; v1[1] *= s[5]; v1[2] *= s[6]; v1[3] *= s[7];
                    acc[ai][bj][m][0] = v0; acc[ai][bj][m][1] = v1;
                    if (b == 2) {
#if WOUT_F8
                        u32x2 w = {pack_fp8x4(v0[0] * 16.f, v0[1] * 16.f, v0[2] * 16.f, v0[3] * 16.f), pack_fp8x4(v1[0] * 16.f, v1[1] * 16.f, v1[2] * 16.f, v1[3] * 16.f)};
                        *(u32x2*)((unsigned char*)merged + row * 2048 + col + bj * 128) = w;
#else
                        u32x4 w = {cvt_pk_bf16(v0[0], v0[1]), cvt_pk_bf16(v0[2], v0[3]), cvt_pk_bf16(v1[0], v1[1]), cvt_pk_bf16(v1[2], v1[3])};
                        *(u32x4*)(merged + row * 2048 + col + bj * 128) = w;
#endif
                    } } }
        }
        return b < 2;
    }
};
#else
struct EpiMerge {
    static constexpr bool PERM = true; const bf16_t* proj; bf16_t* merged;
    __device__ __forceinline__ void operator()(const f32x4 (&acc)[2][2][4][2], const ge::Unit& u, int wr, int wc, int fr, int fq) const {
        const int col = u.c0 + wc * 32 + 8 * fq;
#pragma unroll
        for (int ai = 0; ai < 2; ++ai) {
            u32x4 gw[4][2], pw[4][2];
#pragma unroll
            for (int m = 0; m < 4; ++m) { const size_t row = (size_t)(u.r0 + ai * 128 + wr * 64 + m * 16 + fr);
#pragma unroll
                for (int bj = 0; bj < 2; ++bj) {
#if INPROJ_F8 == 3
                    { const u32x2 g8 = *(const u32x2*)((const unsigned char*)(proj + row * LDP + P_MG) + u.aux * 2048 + col + bj * 128); gw[m][bj] = (u32x4){g8[0], g8[1], 0u, 0u}; }
#else
                    gw[m][bj] = *(const u32x4*)(proj + row * LDP + P_MG + u.aux * 2048 + col + bj * 128);
#endif
                    if (u.aux > 0) pw[m][bj] = *(const u32x4*)(merged + row * 2048 + col + bj * 128); else pw[m][bj] = (u32x4){0u, 0u, 0u, 0u}; } }
#pragma unroll
            for (int m = 0; m < 4; ++m) { const size_t row = (size_t)(u.r0 + ai * 128 + wr * 64 + m * 16 + fr);
#pragma unroll
                for (int bj = 0; bj < 2; ++bj) { const u32x4 g = gw[m][bj], q = pw[m][bj]; const f32x4 v0 = acc[ai][bj][m][0], v1 = acc[ai][bj][m][1];
#if INPROJ_F8 == 3
                    constexpr float I255 = 1.f / 255.f;
                    const float s0 = (float)(g[0] & 255u) * I255, s1 = (float)((g[0] >> 8) & 255u) * I255, s2 = (float)((g[0] >> 16) & 255u) * I255, s3 = (float)(g[0] >> 24) * I255;
                    const float s4 = (float)(g[1] & 255u) * I255, s5 = (float)((g[1] >> 8) & 255u) * I255, s6 = (float)((g[1] >> 16) & 255u) * I255, s7 = (float)(g[1] >> 24) * I255;
#else
                    const float s0 = fast_sigmoid(bf_lo(g[0])), s1 = fast_sigmoid(bf_hi(g[0])), s2 = fast_sigmoid(bf_lo(g[1])), s3 = fast_sigmoid(bf_hi(g[1])), s4 = fast_sigmoid(bf_lo(g[2])), s5 = fast_sigmoid(bf_hi(g[2])), s6 = fast_sigmoid(bf_lo(g[3])), s7 = fast_sigmoid(bf_hi(g[3]));
#endif
                    const float o0 = v0[0] * s0 + bf_lo(q[0]), o1 = v0[1] * s1 + bf_hi(q[0]), o2 = v0[2] * s2 + bf_lo(q[1]), o3 = v0[3] * s3 + bf_hi(q[1]);
                    const float o4 = v1[0] * s4 + bf_lo(q[2]), o5 = v1[1] * s5 + bf_hi(q[2]), o6 = v1[2] * s6 + bf_lo(q[3]), o7 = v1[3] * s7 + bf_hi(q[3]);
                    u32x4 w = {cvt_pk_bf16(o0, o1), cvt_pk_bf16(o2, o3), cvt_pk_bf16(o4, o5), cvt_pk_bf16(o6, o7)};
                    *(u32x4*)(merged + row * 2048 + col + bj * 128) = w; } }
        }
    }
};
#endif
__device__ __forceinline__ void p_merge(const Frame& F0, int l) {
    const Frame F = phase_frame(F0);
    SchedMerge S{(const char*)(F.ws + WS_OM), (const char*)(F.ws + WS_WBR) + (size_t)l * 3 * 2048 * 1024 * 2, F.G, F.c};
    EpiMerge E{(const bf16_t*)(F.ws + WS_PROJ), (bf16_t*)(F.ws + WS_MERGED)};
    ge::gemm_phase<EpiMerge, SchedMerge, 0>(F.lds, F.tid, 1024, 0, S, E);
}

struct EpiResF32 {
    static constexpr bool PERM = false; const float* R; float* C;
    __device__ __forceinline__ void operator()(const f32x4 (&acc)[2][2][4][2], const ge::Unit& u, int wr, int wc, int fr, int fq) const {
#pragma unroll
        for (int ai = 0; ai < 2; ++ai) {
            f32x4 r[4][2][2];
#pragma unroll
            for (int m = 0; m < 4; ++m) { const size_t off = (size_t)(u.r0 + ai * 128 + wr * 64 + m * 16 + fr) * D + u.c0 + wc * 32 + 4 * fq;
#pragma unroll
                for (int bj = 0; bj < 2; ++bj)
#pragma unroll
                    for (int n = 0; n < 2; ++n) r[m][bj][n] = *(const f32x4*)(R + off + bj * 128 + n * 16); }
#pragma unroll
            for (int m = 0; m < 4; ++m) { const size_t off = (size_t)(u.r0 + ai * 128 + wr * 64 + m * 16 + fr) * D + u.c0 + wc * 32 + 4 * fq;
#pragma unroll
                for (int bj = 0; bj < 2; ++bj)
#pragma unroll
                    for (int n = 0; n < 2; ++n) *(f32x4*)(C + off + bj * 128 + n * 16) = acc[ai][bj][m][n] + r[m][bj][n]; }
        }
    }
};
template <bool RF32>
struct EpiResBf16 {
    static constexpr bool PERM = true; const void* R; bf16_t* C;
    __device__ __forceinline__ void operator()(const f32x4 (&acc)[2][2][4][2], const ge::Unit& u, int wr, int wc, int fr, int fq) const {
#pragma unroll
        for (int ai = 0; ai < 2; ++ai) {
            f32x4 r[4][2][2];
#pragma unroll
            for (int m = 0; m < 4; ++m) { const size_t off = (size_t)(u.r0 + ai * 128 + wr * 64 + m * 16 + fr) * D + u.c0 + wc * 32 + 8 * fq;
#pragma unroll
                for (int bj = 0; bj < 2; ++bj) {
                    if (RF32) { r[m][bj][0] = __builtin_nontemporal_load((const f32x4*)((const float*)R + off + bj * 128)); r[m][bj][1] = __builtin_nontemporal_load((const f32x4*)((const float*)R + off + bj * 128 + 4)); }
                    else { const u32x4 q = *(const u32x4*)((const bf16_t*)R + off + bj * 128); r[m][bj][0] = (f32x4){bf_lo(q[0]), bf_hi(q[0]), bf_lo(q[1]), bf_hi(q[1])}; r[m][bj][1] = (f32x4){bf_lo(q[2]), bf_hi(q[2]), bf_lo(q[3]), bf_hi(q[3])}; } } }
#pragma unroll
            for (int m = 0; m < 4; ++m) { const size_t off = (size_t)(u.r0 + ai * 128 + wr * 64 + m * 16 + fr) * D + u.c0 + wc * 32 + 8 * fq;
#pragma unroll
                for (int bj = 0; bj < 2; ++bj) { const f32x4 v0 = acc[ai][bj][m][0] + r[m][bj][0], v1 = acc[ai][bj][m][1] + r[m][bj][1];
                    u32x4 w = {cvt_pk_bf16(v0[0], v0[1]), cvt_pk_bf16(v0[2], v0[3]), cvt_pk_bf16(v1[0], v1[1]), cvt_pk_bf16(v1[2], v1[3])};
                    *(u32x4*)(C + off + bj * 128) = w; } }
        }
    }
};
__device__ __forceinline__ void p_wout(const Frame& F0, int l) {
    const Frame F = phase_frame(F0);
    constexpr bool W8 = WOUT_F8 != 0;
    SchedDenseT<W8> S{(const char*)(F.ws + WS_MERGED), (const char*)(F.ws + WS_WOUT) + (size_t)l * 2048 * 2048 * 2, 2048, 2048, T / 256, 8, F.G, F.c};
    if (l == 0) { EpiResBf16<true> E{(const void*)F.in(0), (bf16_t*)(F.ws + WS_XB)}; ge::gemm_phase<EpiResBf16<true>, SchedDenseT<W8>, 0, W8>(F.lds, F.tid, 2048, 0, S, E); }
    else { EpiResBf16<false> E{(const void*)(F.ws + WS_XB), (bf16_t*)(F.ws + WS_XB)}; ge::gemm_phase<EpiResBf16<false>, SchedDenseT<W8>, 0, W8>(F.lds, F.tid, 2048, 0, S, E); }
}

constexpr size_t WS_WR = WS_END_SMALL;
constexpr size_t WS_END2 = WS_WR + al256((size_t)NL * 2048 * 64 * 4);

__device__ __forceinline__ void p_conv_router(const Frame& F0) {
    const Frame F = phase_frame(F0);
    bf16_t* wr = (bf16_t*)(F.ws + WS_WR);
    const float* g2 = F.in(13); const float* rgw = F.in(14); const float* rew = F.in(16);
    for (int i = F.c * NTHR + F.tid; i < NL * 64 * 2048; i += F.G * NTHR) {
        const int d = i & 2047, j = (i >> 11) & 63, l = i >> 17;
        float v = 0.f;
        if (j < 4) v = rgw[((size_t)l * 2048 + d) * 4 + j]; else if (j < 36) v = rew[((size_t)l * 2048 + d) * 32 + (j - 4)];
        v *= g2[l * 2048 + d];
        const bf16_t h = f2bf(v); const bf16_t lo = f2bf(v - bf2f(h));
        wr[((size_t)(l * 2 + 0) * 64 + j) * 2048 + d] = h; wr[((size_t)(l * 2 + 1) * 64 + j) * 2048 + d] = lo;
    }
}

template <bool F8, bool DRY = false>
__device__ __forceinline__ void p_route1(const Frame& F0, int l) {
    const Frame F = phase_frame(F0);
    const bf16_t* x = (const bf16_t*)(F.ws + WS_XB);
    const bf16_t* wr = (const bf16_t*)(F.ws + WS_WR) + (size_t)l * 2 * 64 * 2048;
    const float* g2 = F.in(13) + l * D; const float* rgb = F.in(15) + l * 4; const float* reb = F.in(17) + l * 32;
    unsigned* ctl = (unsigned*)(F.ws + WS_CTL);
    int* list = (int*)(F.ws + WS_LIST); float* listw = (float*)(F.ws + WS_LISTW);
    LAS float* part = (LAS float*)F.lds;
    LAS float* ssq = (LAS float*)(F.lds + 65536);
    LAS float* lg = (LAS float*)(F.lds + 65536 + 1024);
    LAS float* rstd_s = (LAS float*)(F.lds + 65536 + 1024 + 64 * 40 * 4);
    const int w = F.wave, lane = F.lane, rh = w >> 2, kq = w & 3, r32 = lane & 31, hi = lane >> 5;
    for (int rg = F.c; rg < T / 64; rg += F.G) {
        const int row0 = rg * 64;
        f32x16 acc0, acc1;
#pragma unroll
        for (int r = 0; r < 16; ++r) { acc0[r] = 0.f; acc1[r] = 0.f; }
        float ss = 0.f;
        const bf16_t* xr = x + (size_t)(row0 + rh * 32 + r32) * D + kq * 512 + 8 * hi;
        const bf16_t* wh = wr + (size_t)r32 * 2048 + kq * 512 + 8 * hi; const bf16_t* wl = wh + (size_t)64 * 2048;
#pragma unroll 4
        for (int ks = 0; ks < 32; ++ks) {
            const u32x4 ah = *(const u32x4*)(xr + ks * 16);
            { const float a0 = bf_lo(ah[0]), a1 = bf_hi(ah[0]), a2 = bf_lo(ah[1]), a3 = bf_hi(ah[1]), a4 = bf_lo(ah[2]), a5 = bf_hi(ah[2]), a6 = bf_lo(ah[3]), a7 = bf_hi(ah[3]);
              ss += a0 * a0 + a1 * a1 + a2 * a2 + a3 * a3 + a4 * a4 + a5 * a5 + a6 * a6 + a7 * a7; }
            const bf16x8 fah = __builtin_bit_cast(bf16x8, ah);
            const bf16x8 b0h = *(const bf16x8*)(wh + ks * 16), b0l = *(const bf16x8*)(wl + ks * 16), b1h = *(const bf16x8*)(wh + (size_t)32 * 2048 + ks * 16), b1l = *(const bf16x8*)(wl + (size_t)32 * 2048 + ks * 16);
            acc0 = __builtin_amdgcn_mfma_f32_32x32x16_bf16(fah, b0h, acc0, 0, 0, 0); acc0 = __builtin_amdgcn_mfma_f32_32x32x16_bf16(fah, b0l, acc0, 0, 0, 0);
            acc1 = __builtin_amdgcn_mfma_f32_32x32x16_bf16(fah, b1h, acc1, 0, 0, 0); acc1 = __builtin_amdgcn_mfma_f32_32x32x16_bf16(fah, b1l, acc1, 0, 0, 0);
        }
        ss += __shfl_xor(ss, 32);
        if (hi == 0) ssq[w * 32 + r32] = ss;
#pragma unroll
        for (int r = 0; r < 16; ++r) { const int row = (r & 3) + 8 * (r >> 2) + 4 * hi; part[(w * 32 + row) * 64 + r32] = acc0[r]; part[(w * 32 + row) * 64 + 32 + r32] = acc1[r]; }
        __syncthreads();
        { const int row = F.tid >> 3, sub = F.tid & 7, rr = row & 31, rhh = row >> 5;
          float s2 = ssq[(rhh * 4 + 0) * 32 + rr] + ssq[(rhh * 4 + 1) * 32 + rr] + ssq[(rhh * 4 + 2) * 32 + rr] + ssq[(rhh * 4 + 3) * 32 + rr];
          const float rstd = rsqrtf(s2 * (1.f / D) + 1e-6f);
          if (sub == 0) rstd_s[row] = rstd;
#pragma unroll
          for (int q = 0; q < 5; ++q) { const int j = sub * 5 + q; if (j < 36) {
              float a = part[((rhh * 4 + 0) * 32 + rr) * 64 + j] + part[((rhh * 4 + 1) * 32 + rr) * 64 + j] + part[((rhh * 4 + 2) * 32 + rr) * 64 + j] + part[((rhh * 4 + 3) * 32 + rr) * 64 + j];
              lg[row * 40 + j] = a * rstd + (j < 4 ? rgb[j] : reb[j - 4]); } } }
        __syncthreads();
        if (F.tid < 64 && !DRY) {
            const int row = F.tid; const LAS float* L = lg + row * 40;
            int grp = 0; float gm = L[0];
#pragma unroll
            for (int j = 1; j < 4; ++j) if (L[j] > gm) { gm = L[j]; grp = j; }
            float den = 0.f;
#pragma unroll
            for (int j = 0; j < 4; ++j) den += expf(L[j] - gm);
            const float pg = 1.f / den;
            const LAS float* el = L + 4 + grp * 8;
            int i0 = 0; for (int j = 1; j < 8; ++j) if (el[j] > el[i0]) i0 = j;
            int i1 = -1; for (int j = 0; j < 8; ++j) { if (j == i0) continue; if (i1 < 0 || el[j] > el[i1]) i1 = j; }
            const float e1 = expf(el[i1] - el[i0]), d2 = 1.f + e1;
            const int ea = grp * 8 + i0, eb = grp * 8 + i1;
            const unsigned pa = atomicAdd(&ctl[CW_CNT + l * 32 + ea], 1u), pb = atomicAdd(&ctl[CW_CNT + l * 32 + eb], 1u);
            int* rt = (int*)(F.ws + WS_ROUTE) + (size_t)(row0 + row) * 8;
            rt[0] = ea; rt[1] = eb; ((float*)rt)[2] = pg / d2; ((float*)rt)[3] = pg * e1 / d2; rt[4] = (int)pa; rt[5] = (int)pb;
            list[(size_t)ea * MOE_CAP + pa] = row0 + row; listw[(size_t)ea * MOE_CAP + pa] = pg / d2; list[(size_t)eb * MOE_CAP + pb] = row0 + row; listw[(size_t)eb * MOE_CAP + pb] = pg * e1 / d2;
        }
        for (int q = 0; q < 8; ++q) { const int row = w * 8 + q; const float rstd = rstd_s[row];
            const bf16_t* xr2 = x + (size_t)(row0 + row) * D; bf16_t* hr = (bf16_t*)(F.ws + WS_H) + (size_t)(row0 + row) * D; unsigned char* hr8 = F.ws + WS_H + (size_t)(row0 + row) * D;
#pragma unroll
            for (int i = 0; i < 8; ++i) { const u32x2 xw = *(const u32x2*)(xr2 + i * 256 + lane * 4); const f32x4 v = {bf_lo(xw[0]), bf_hi(xw[0]), bf_lo(xw[1]), bf_hi(xw[1])}; const f32x4 gv = *(const f32x4*)(g2 + i * 256 + lane * 4);
                if (F8) { *(unsigned*)(hr8 + i * 256 + lane * 4) = pack_fp8x4(v[0] * rstd * gv[0] * 16.f, v[1] * rstd * gv[1] * 16.f, v[2] * rstd * gv[2] * 16.f, v[3] * rstd * gv[3] * 16.f); }
                else { u32x2 wv; wv[0] = cvt_pk_bf16(v[0] * rstd * gv[0], v[1] * rstd * gv[1]); wv[1] = cvt_pk_bf16(v[2] * rstd * gv[2], v[3] * rstd * gv[3]); *(u32x2*)(hr + i * 256 + lane * 4) = wv; } } }
        __syncthreads();
    }
}

struct MoeTab { int ntiles; };
__device__ __forceinline__ int moe_build_tab(const Frame& F, int l, LAS int* tab  ) {
    unsigned* ctl = (unsigned*)(F.ws + WS_CTL);
    if (F.tid < 64) { const int e = F.tid; const int cnt = e < 32 ? (int)__hip_atomic_load(&ctl[CW_CNT + l * 32 + e], __ATOMIC_RELAXED, __HIP_MEMORY_SCOPE_AGENT) : 0;
        const int nt = (cnt + 255) >> 8; int pre = nt;
#pragma unroll
        for (int o = 1; o < 32; o <<= 1) { const int v = __shfl_up(pre, o); if (e >= o) pre += v; }
        const int first = pre - nt;
        if (e < 32) { tab[e] = first * 256; tab[32 + e] = cnt;
            for (int k = 0; k < nt; ++k) { tab[64 + first + k] = e; tab[224 + first + k] = (first + k) * 256; } }
        if (e == 31) tab[384] = pre; }
    __syncthreads();
    return tab[384];
}
template <bool F8>
struct SchedMoeGUT {
    static constexpr bool GATHER = true;
    const char* H; const char* W; const int* list; LAS int* tab; int G, c, ntiles;
    __device__ __forceinline__ bool next(int i, ge::Unit& u) const { const int L = i * G + c; if (L >= ntiles * 4) return false; const int ti = L >> 2, ct = L & 3; const int e = tab[64 + ti];
        u.A = H; u.B = W + ((size_t)e * 1024 + ct * 256) * 2048 * (F8 ? 1 : 2); u.r0 = tab[224 + ti]; u.c0 = ct * 128; u.aux = e; u.aux2 = u.r0 - tab[e]; return true; }
    __device__ __forceinline__ void voffA(const ge::Unit& u, int tid, unsigned (&v)[2][2]) const {
#pragma unroll
        for (int i = 0; i < 2; ++i) { int R, C; ge::stage_rc(tid * 16 + i * 8192, R, C); const int cnt_ = tab[32 + u.aux], l0_ = u.aux2 + R, l1_ = l0_ + 128; const int* lp_ = list + (size_t)u.aux * MOE_CAP; const int t0 = l0_ < cnt_ ? lp_[l0_] : 0, t1 = l1_ < cnt_ ? lp_[l1_] : 0;     v[0][i] = F8 ? (unsigned)(t0 * 2048 + C * 2) : (unsigned)(t0 * 2048 + C) * 2u; v[1][i] = F8 ? (unsigned)(t1 * 2048 + C * 2) : (unsigned)(t1 * 2048 + C) * 2u; } }
};
template <bool F8>
struct EpiGUT {
    static constexpr bool PERM = true; void* hidv;
    __device__ __forceinline__ void operator()(const f32x4 (&acc)[2][2][4][2], const ge::Unit& u, int wr, int wc, int fr, int fq) const {
#pragma unroll
        for (int ai = 0; ai < 2; ++ai)
#pragma unroll
            for (int m = 0; m < 4; ++m) { const f32x4 g0 = acc[ai][0][m][0], g1 = acc[ai][0][m][1], u0 = acc[ai][1][m][0], u1 = acc[ai][1][m][1];
                float h[8] = {fast_silu(g0[0]) * u0[0], fast_silu(g0[1]) * u0[1], fast_silu(g0[2]) * u0[2], fast_silu(g0[3]) * u0[3], fast_silu(g1[0]) * u1[0], fast_silu(g1[1]) * u1[1], fast_silu(g1[2]) * u1[2], fast_silu(g1[3]) * u1[3]};
                const size_t off = (size_t)(u.r0 + ai * 128 + wr * 64 + m * 16 + fr) * 512 + u.c0 + wc * 32 + 8 * fq;
                if (F8) {
#pragma unroll
                    for (int j = 0; j < 8; ++j) h[j] = fminf(fmaxf(h[j] * 8.f, -440.f), 440.f);
                    u32x2 w = {pack_fp8x4(h[0], h[1], h[2], h[3]), pack_fp8x4(h[4], h[5], h[6], h[7])}; *(u32x2*)((unsigned char*)hidv + off) = w; }
                else { u32x4 w = {cvt_pk_bf16(h[0], h[1]), cvt_pk_bf16(h[2], h[3]), cvt_pk_bf16(h[4], h[5]), cvt_pk_bf16(h[6], h[7])}; *(u32x4*)((bf16_t*)hidv + off) = w; } }
    }
};
template <bool F8>
__device__ __forceinline__ void p_moe_gu(const Frame& F0, int l) {
    const Frame F = phase_frame(F0);
    LAS int* tab = (LAS int*)(F.lds + LDS_MISC);
    const int nt = moe_build_tab(F, l, tab);
    SchedMoeGUT<F8> S{(const char*)(F.ws + WS_H), (const char*)(F.ws + WS_WGU), (const int*)(F.ws + WS_LIST), tab, F.G, F.c, nt};
    EpiGUT<F8> E{(void*)(F.ws + WS_HID)};
    ge::gemm_phase<EpiGUT<F8>, SchedMoeGUT<F8>, 0, F8>(F.lds, F.tid, 2048, 0, S, E);
}
template <bool F8>
struct SchedMoeDT {
    static constexpr bool GATHER = false;
    const char* HID; const char* W; LAS int* tab; int G, c, ntiles;
    __device__ __forceinline__ bool next(int i, ge::Unit& u) const { const int L = i * G + c; if (L >= ntiles * 8) return false; const int ti = L >> 3, ct = L & 7; const int e = tab[64 + ti];
        u.r0 = tab[224 + ti]; u.A = HID + (size_t)u.r0 * 512 * (F8 ? 1 : 2); u.B = W + ((size_t)e * 2048 + ct * 256) * 512 * (F8 ? 1 : 2); u.c0 = ct * 256; u.aux = e; u.aux2 = u.r0 - tab[e]; return true; }
    __device__ __forceinline__ void voffA(const ge::Unit&, int tid, unsigned (&v)[2][2]) const { ge::dense_voffA<F8>(512, tid, v); }
};
struct EpiDown {
    static constexpr bool PERM = true; bf16_t* y; const float* listw; LAS int* tab;
    __device__ __forceinline__ void operator()(const f32x4 (&acc)[2][2][4][2], const ge::Unit& u, int wr, int wc, int fr, int fq) const {
        float rs[2][4];
#pragma unroll
        for (int ai = 0; ai < 2; ++ai)
#pragma unroll
            for (int m = 0; m < 4; ++m) { const int lr_ = u.aux2 + ai * 128 + wr * 64 + m * 16 + fr; rs[ai][m] = lr_ < tab[32 + u.aux] ? listw[(size_t)u.aux * MOE_CAP + lr_] : 0.f; }
#pragma unroll
        for (int ai = 0; ai < 2; ++ai)
#pragma unroll
            for (int m = 0; m < 4; ++m) { const int row = u.r0 + ai * 128 + wr * 64 + m * 16 + fr; const float s = rs[ai][m]; bf16_t* rowp = y + (size_t)row * 2048 + u.c0 + wc * 32 + 8 * fq;
#pragma unroll
                for (int bj = 0; bj < 2; ++bj) {
#if Y_F8
                    const f32x4 v0 = acc[ai][bj][m][0] * (s * 64.f), v1 = acc[ai][bj][m][1] * (s * 64.f);
                    u32x2 w = {pack_fp8x4(v0[0], v0[1], v0[2], v0[3]), pack_fp8x4(v1[0], v1[1], v1[2], v1[3])};
                    *(u32x2*)((unsigned char*)y + (size_t)row * 2048 + u.c0 + wc * 32 + 8 * fq + bj * 128) = w;
#else
                    const f32x4 v0 = acc[ai][bj][m][0] * s, v1 = acc[ai][bj][m][1] * s; u32x4 w = {cvt_pk_bf16(v0[0], v0[1]), cvt_pk_bf16(v0[2], v0[3]), cvt_pk_bf16(v1[0], v1[1]), cvt_pk_bf16(v1[2], v1[3])};
                    *(u32x4*)(rowp + bj * 128) = w;
#endif
                } }
    }
};
template <bool F8>
__device__ __forceinline__ void p_moe_down(const Frame& F0, int l) {
    const Frame F = phase_frame(F0);
    LAS int* tab = (LAS int*)(F.lds + LDS_MISC);
    const int nt = moe_build_tab(F, l, tab);
    SchedMoeDT<F8> S{(const char*)(F.ws + WS_HID), (const char*)(F.ws + WS_WD), tab, F.G, F.c, nt};
    EpiDown E{(bf16_t*)(F.ws + WS_YBUF), (const float*)(F.ws + WS_LISTW), tab};
    ge::gemm_phase<EpiDown, SchedMoeDT<F8>, 0, F8, GE_SP2_DEFAULT, GE_ALIGN_DEFAULT, 0x7C7C7C7C>(F.lds, F.tid, 512, 0, S, E);
}
template <bool F8>
__device__ __forceinline__ void p_moe_down_null(const Frame& F0, int l) {
    const Frame F = phase_frame(F0);
    LAS int* tab = (LAS int*)(F.lds + LDS_MISC);
    const int nt = moe_build_tab(F, l, tab);
    SchedMoeDT<F8> S{(const char*)(F.ws + WS_HID), (const char*)(F.ws + WS_WD), tab, F.G, F.c, nt};
    EpiNull E{};
    ge::gemm_phase<EpiNull, SchedMoeDT<F8>, 0, F8, GE_SP2_DEFAULT, GE_ALIGN_DEFAULT, 0x7C7C7C7C>(F.lds, F.tid, 512, 0, S, E);
}
template <int MODE, bool DRY = false>
__device__ __forceinline__ void p_combine(const Frame& F0, int lnext, int lmoe) {
    const Frame F = phase_frame(F0);
    LAS int* tab = (LAS int*)(F.lds + LDS_MISC); moe_build_tab(F, lmoe, tab);
    bf16_t* x = (bf16_t*)(F.ws + WS_XB); float* outp = F.out(); const bf16_t* y = (const bf16_t*)(F.ws + WS_YBUF);
    const float* g = MODE == 0 ? F.in(1) + lnext * D : F.in(21);
    static_assert(Y_F8 != 0, "the pipelined combine reads fp8 expert outputs");
    const int stride = F.G * 8;
    f32x4 gvv[8];
#pragma unroll
    for (int i = 0; i < 8; ++i) gvv[i] = *(const f32x4*)(g + i * 256 + F.lane * 4);
#define CMB_IDX(r_, ra_, rb_) do { ra_ = 0; rb_ = 0; if ((r_) < T) { const int* rt_ = (const int*)(F.ws + WS_ROUTE) + (size_t)(r_) * 8; ra_ = tab[rt_[0]] + rt_[4]; rb_ = tab[rt_[1]] + rt_[5]; } } while (0)
#define CMB_LOAD(r_, ra_, rb_, XW, YA, YB) do { if ((r_) < T) { _Pragma("unroll") for (int i = 0; i < 8; ++i) { XW[i] = *(const u32x2*)(x + (size_t)(r_) * D + i * 256 + F.lane * 4);                        \
            YA[i] = __builtin_nontemporal_load((const unsigned*)((const unsigned char*)y + (size_t)(ra_) * 2048 + i * 256 + F.lane * 4));                                                      \
            YB[i] = __builtin_nontemporal_load((const unsigned*)((const unsigned char*)y + (size_t)(rb_) * 2048 + i * 256 + F.lane * 4)); } } } while (0)
    int row = F.c * 8 + F.wave;
    int ra, rb, ran, rbn; CMB_IDX(row, ra, rb); CMB_IDX(row + stride, ran, rbn);
    u32x2 xw[8]; unsigned ya[8], yb[8];
    CMB_LOAD(row, ra, rb, xw, ya, yb);
    for (; row < T; row += stride) {
        u32x2 xn[8]; unsigned yan[8], ybn[8];
        CMB_LOAD(row + stride, ran, rbn, xn, yan, ybn);
        int ra2, rb2; CMB_IDX(row + 2 * stride, ra2, rb2);
        bf16_t* xr = x + (size_t)row * D; float* orow = outp + (size_t)row * D; f32x4 v[8]; float ss = 0.f;
#pragma unroll
        for (int i = 0; i < 8; ++i) { v[i] = (f32x4){bf_lo(xw[i][0]), bf_hi(xw[i][0]), bf_lo(xw[i][1]), bf_hi(xw[i][1])};
            const f32x2 a0 = __builtin_amdgcn_cvt_pk_f32_fp8((int)ya[i], false), a1 = __builtin_amdgcn_cvt_pk_f32_fp8((int)ya[i], true), b0 = __builtin_amdgcn_cvt_pk_f32_fp8((int)yb[i], false), b1 = __builtin_amdgcn_cvt_pk_f32_fp8((int)yb[i], true);
            v[i][0] += (a0[0] + b0[0]) * (1.f / 64.f); v[i][1] += (a0[1] + b0[1]) * (1.f / 64.f); v[i][2] += (a1[0] + b1[0]) * (1.f / 64.f); v[i][3] += (a1[1] + b1[1]) * (1.f / 64.f);
            ss += v[i][0] * v[i][0] + v[i][1] * v[i][1] + v[i][2] * v[i][2] + v[i][3] * v[i][3]; }
#pragma unroll
        for (int o = 32; o > 0; o >>= 1) ss += __shfl_xor(ss, o);
        const float rstd = rsqrtf(ss * (1.f / D) + 1e-6f);
#pragma unroll
        for (int i = 0; i < 8; ++i) { const f32x4 gv = gvv[i];
            if (DRY) { asm volatile("" :: "v"(v[i][0] * rstd * gv[0]), "v"(v[i][1]), "v"(v[i][2]), "v"(v[i][3])); }
            else if (MODE == 0) { *(u32x2*)(xr + i * 256 + F.lane * 4) = (u32x2){cvt_pk_bf16(v[i][0], v[i][1]), cvt_pk_bf16(v[i][2], v[i][3])}; v[i] = (f32x4){v[i][0] * rstd * gv[0], v[i][1] * rstd * gv[1], v[i][2] * rstd * gv[2], v[i][3] * rstd * gv[3]}; }
            else { f32x4 o = {v[i][0] * rstd * gv[0], v[i][1] * rstd * gv[1], v[i][2] * rstd * gv[2], v[i][3] * rstd * gv[3]}; __builtin_nontemporal_store(o, (f32x4*)(orow + i * 256 + F.lane * 4)); } }
        if (MODE == 0 && !DRY) store_h_row(F.ws, row, v, F.lane);
#pragma unroll
        for (int i = 0; i < 8; ++i) { xw[i] = xn[i]; ya[i] = yan[i]; yb[i] = ybn[i]; }
        ra = ran; rb = rbn; ran = ra2; rbn = rb2;
    }
#undef CMB_IDX
#undef CMB_LOAD
}

namespace att {
constexpr float SCALE = 0.08838834764831845f;
constexpr int NW = 8, QBLK = 32, KVBLK = 64, QB = NW * QBLK, DH = 128;
constexpr int SHM_V = KVBLK * DH * 2, SHM_K = KVBLK * DH * 2;
constexpr int NBUF = 3;
constexpr int ATT_LDS = NBUF * SHM_V + NBUF * SHM_K;
constexpr float THR = 8.f;
typedef short s16x4 __attribute__((ext_vector_type(4)));

#define KSWZ(row, colB) ((row) * 256 + ((colB) ^ (((row) & 7) << 4)))
#define SBAR() __builtin_amdgcn_sched_barrier(0)
__device__ __forceinline__ int v_st(int k, int c) { const int kk = (k & ~0xC) | ((k & 4) << 1) | ((k & 8) >> 1); return ((kk >> 3) * 4 + (c >> 5)) * 512 + ((kk & 7) * 32 + (c & 31)) * 2; }
__device__ __forceinline__ int v_rd_base(int lane) { return ((lane & 3) << 3) | (((lane >> 2) & 3) << 6) | (((lane >> 4) & 1) << 5) | (((lane >> 5) & 1) << 8); }
constexpr int v_rd_off(int d0, int ks, int half) { return d0 * 512 + ks * 4096 + half * 2048; }
__device__ __forceinline__ int crow(int r, int hi) { return (r & 3) + 8 * (r >> 2) + 4 * hi; }
__device__ __forceinline__ bf16x8 load8(const bf16_t* p) { return *reinterpret_cast<const bf16x8*>(p); }

__device__ __forceinline__ void mask_tile(f32x16& p0, f32x16& p1, int dq, unsigned W) {
    const float NEG = -__builtin_inff();
#pragma unroll
    for (int r = 0; r < 16; ++r) {
        const int c = (r & 3) + 8 * (r >> 2);
        if ((unsigned)(dq - c) >= W) p0[r] = NEG;
        if ((unsigned)(dq - c - 32) >= W) p1[r] = NEG;
    }
}
__device__ __forceinline__ void mask_all(f32x16& p0, f32x16& p1, bool ok) {
    const float NEG = -__builtin_inff();
#pragma unroll
    for (int r = 0; r < 16; ++r) { p0[r] = ok ? p0[r] : NEG; p1[r] = ok ? p1[r] : NEG; }
}
__device__ __forceinline__ void partialSM(f32x16& p0, f32x16& p1, float& m_reg, float& mn, float& alpha) {
    float pmax = p0[0]; for (int r = 1; r < 16; ++r) pmax = fmaxf(pmax, p0[r]); for (int r = 0; r < 16; ++r) pmax = fmaxf(pmax, p1[r]);
    { auto rr = __builtin_amdgcn_permlane32_swap(__float_as_uint(pmax), __float_as_uint(pmax), false, false);
      pmax = fmaxf(__uint_as_float(rr[0]), __uint_as_float(rr[1])); }
    constexpr float C2 = 1.4426950408889634f * SCALE;
    if (__builtin_expect(__all((pmax - m_reg) * SCALE <= THR), 1)) { mn = m_reg; alpha = 1.f; }
    else { mn = fmaxf(m_reg, pmax); alpha = __builtin_amdgcn_exp2f((m_reg - mn) * C2); m_reg = mn; }
    const float mnL = -mn * C2;
    for (int r = 0; r < 16; ++r) p0[r] = fmaf(p0[r], C2, mnL); for (int r = 0; r < 16; ++r) p1[r] = fmaf(p1[r], C2, mnL);
    for (int r = 0; r < 16; ++r) p0[r] = __builtin_amdgcn_exp2f(p0[r]);
}
__device__ __forceinline__ void finishSM(f32x16& p0, f32x16& p1, float alpha, float& l_reg, bf16x8& pa0, bf16x8& pa1, bf16x8& pa2, bf16x8& pa3) {
    for (int r = 0; r < 16; ++r) p1[r] = __builtin_amdgcn_exp2f(p1[r]);
    float ps = 0; for (int r = 0; r < 16; ++r) ps += p0[r]; for (int r = 0; r < 16; ++r) ps += p1[r];
    { auto rr = __builtin_amdgcn_permlane32_swap(__float_as_uint(ps), __float_as_uint(ps), false, false);
      ps = __uint_as_float(rr[0]) + __uint_as_float(rr[1]); }
    l_reg = l_reg * alpha + ps;
#define PK4(P, B_, OUT) do { unsigned a0 = cvt_pk_bf16(P[B_+0], P[B_+1]), a1 = cvt_pk_bf16(P[B_+2], P[B_+3]);                          \
        unsigned b0 = cvt_pk_bf16(P[B_+4], P[B_+5]), b1 = cvt_pk_bf16(P[B_+6], P[B_+7]);                                             \
        auto r0 = __builtin_amdgcn_permlane32_swap(a0, b0, false, false); auto r1 = __builtin_amdgcn_permlane32_swap(a1, b1, false, false); \
        u32x4 w = {r0[0], r1[0], r0[1], r1[1]}; OUT = *reinterpret_cast<bf16x8*>(&w); } while (0)
    PK4(p0, 0, pa0); PK4(p0, 8, pa1); PK4(p1, 0, pa2); PK4(p1, 8, pa3);
#undef PK4
}
template <bool SK>
__device__ __forceinline__ void qkt(f32x16& p0, f32x16& p1, const char* K_lds, int koff, int r32, int hi, const bf16x8* qr, bool act) {
    if (SK && !act) { const float NEG = -__builtin_inff();
#pragma unroll
        for (int r = 0; r < 16; ++r) { p0[r] = NEG; p1[r] = NEG; } return; }
    p0 = f32x16{}; p1 = f32x16{};
    const unsigned kb0 = (unsigned)(uintptr_t)(const LAS char*)(K_lds) + (unsigned)koff + (unsigned)KSWZ(r32, (hi * 8) * 2);
    unsigned kbx[4]; kbx[0] = kb0;
    asm volatile("v_xor_b32 %0, 32, %1" : "=v"(kbx[1]) : "v"(kb0)); asm volatile("v_xor_b32 %0, 64, %1" : "=v"(kbx[2]) : "v"(kb0)); asm volatile("v_xor_b32 %0, 0x60, %1" : "=v"(kbx[3]) : "v"(kb0));
#pragma unroll
    for (int d0 = 0; d0 < 8; ++d0) { const unsigned a = kbx[d0 & 3] + (d0 >> 2) * 128;
        bf16x8 b0 = *(const LAS bf16x8*)(a);
        bf16x8 b1 = *(const LAS bf16x8*)(a + 32 * 256);
        p0 = __builtin_amdgcn_mfma_f32_32x32x16_bf16(b0, qr[d0], p0, 0, 0, 0);
        p1 = __builtin_amdgcn_mfma_f32_32x32x16_bf16(b1, qr[d0], p1, 0, 0, 0); }
}
template <bool SK>
__device__ __forceinline__ void pv_tile(f32x16* o, int vb0  , bf16x8 pa0, bf16x8 pa1, bf16x8 pa2, bf16x8 pa3, bool act) {
    if (SK && !act) return;
#define TRRD(dst, off) asm volatile("ds_read_b64_tr_b16 %0, %1 offset:%2" : "=&v"(dst) : "v"(vb0), "i"(off) : "memory")
#define PV_D0(d0) do { s16x4 l0, l1, l2, l3, h0, h1, h2, h3; constexpr int b_ = v_rd_off(d0, 0, 0); \
        TRRD(l0, b_); TRRD(h0, b_ + 2048); TRRD(l1, b_ + 4096); TRRD(h1, b_ + 6144); TRRD(l2, b_ + 8192); TRRD(h2, b_ + 10240); TRRD(l3, b_ + 12288); TRRD(h3, b_ + 14336); \
        asm volatile("s_waitcnt lgkmcnt(0)" ::: "memory"); SBAR(); \
        o[d0] = __builtin_amdgcn_mfma_f32_32x32x16_bf16((bf16x8){l0[0], l0[1], l0[2], l0[3], h0[0], h0[1], h0[2], h0[3]}, pa0, o[d0], 0, 0, 0);   \
        o[d0] = __builtin_amdgcn_mfma_f32_32x32x16_bf16((bf16x8){l1[0], l1[1], l1[2], l1[3], h1[0], h1[1], h1[2], h1[3]}, pa1, o[d0], 0, 0, 0);   \
        o[d0] = __builtin_amdgcn_mfma_f32_32x32x16_bf16((bf16x8){l2[0], l2[1], l2[2], l2[3], h2[0], h2[1], h2[2], h2[3]}, pa2, o[d0], 0, 0, 0);   \
        o[d0] = __builtin_amdgcn_mfma_f32_32x32x16_bf16((bf16x8){l3[0], l3[1], l3[2], l3[3], h3[0], h3[1], h3[2], h3[3]}, pa3, o[d0], 0, 0, 0); } while (0)
    PV_D0(0); PV_D0(1); PV_D0(2); PV_D0(3);
#undef PV_D0
#undef TRRD
}

__device__ __forceinline__ int fresh_lane() { int t; asm volatile("v_mbcnt_lo_u32_b32 %0, -1, 0\n\tv_mbcnt_hi_u32_b32 %0, -1, %0" : "=v"(t)); return t; }
struct BlockRef { const bf16_t* Q; const bf16_t* K; const bf16_t* V; bf16_t* O; const void* mask; const bf16_t* gate; int P0; int pad; };
struct Seam { bf16x8 qr[8]; bf16x8 st_v0, st_v1, st_k0, st_k1; };
__device__ __forceinline__ int swa_jlo(int P0, int W) { const int lowk = P0 - W + 1; return lowk > 0 ? lowk / KVBLK : 0; }
#define ROW(p, k0, rr) ((p) + (size_t)(k0) * LDP + (unsigned)((rr) * LDP + sc))
#define ROWU(p, k0, c_) ((p) + (size_t)((k0) + (c_)) * LDP + rofs)
#define VMW() asm volatile("s_waitcnt vmcnt(0)" ::: "memory")
#define VMWN(n) asm volatile("s_waitcnt vmcnt(%0)" :: "i"(n) : "memory")
#define SLOAD_H(Kp, Vp, k0) do { const bf16_t* vp_ = opaque_ptr((Vp) + (size_t)(k0) * LDP); const bf16_t* kp_ = opaque_ptr((Kp) + (size_t)(k0) * LDP);   \
                         S.st_v0 = load8(vp_ + rofs); S.st_v1 = load8(vp_ + 32 * LDP + rofs);                                 \
                         S.st_k0 = load8(kp_ + rofs); S.st_k1 = load8(kp_ + 32 * LDP + rofs); } while (0)
#define SWRITE_HK(bo) do { *(bf16x8*)(K_lds + (bo) + kws) = S.st_k0; *(bf16x8*)(K_lds + (bo) + kws + 32 * 256) = S.st_k1; } while (0)
#define SWRITE_HV(bo) do { *(bf16x8*)(V_lds + (bo) + vst0) = S.st_v0; *(bf16x8*)(V_lds + (bo) + vst0 + 8192) = S.st_v1; } while (0)
#define SWRITE_H(bf) do { SWRITE_HV(bf); SWRITE_HK(bf); } while (0)
__device__ __forceinline__ void prime(const BlockRef& cur, int W, char* lds, Seam& S, int wid) {
    const int lane = fresh_lane(), tid = wid * 64 + lane, r32 = lane & 31, hi = lane >> 5;
    const int sr = tid >> 4, sc = (tid & 15) * 8, kws = KSWZ(sr, sc * 2); char* K_lds = lds + NBUF * SHM_V; const unsigned rofs = (unsigned)(sr * LDP + sc) & 0xfffffu;
    const int kb0 = swa_jlo(cur.P0, W) * KVBLK;
    for (int d0 = 0; d0 < 8; ++d0) S.qr[d0] = load8(cur.Q + (unsigned)((wid * QBLK + r32) * LDP + hi * 8) + d0 * 16);
    SLOAD_H(cur.K, cur.V, kb0); VMW(); SWRITE_HK(0);
    __syncthreads();
}
template <int MODE, bool SK>
__device__ __forceinline__ void block(const BlockRef& cur, const BlockRef& nxt, int skv, int W, char* lds, Seam& S, int wid) {
    const int lane = fresh_lane(), tid = wid * 64 + lane, r32 = lane & 31, hi = lane >> 5;
    const int j_lo = swa_jlo(cur.P0, W);
    int j_hi = (cur.P0 + QB - 1) / KVBLK + 1; if (j_hi > skv / KVBLK) j_hi = skv / KVBLK;
    const int NT = j_hi - j_lo;
    const int kbn = swa_jlo(nxt.P0, W) * KVBLK;
    const int qlo = cur.P0 + wid * QBLK, qm = qlo + r32 - 4 * hi;
    char* V_lds = lds; char* K_lds = lds + NBUF * SHM_V;
    float m_reg = -1e30f, l_reg = 0; f32x16 o[4] = {};
    const int sr = tid >> 4, sc = (tid & 15) * 8, vst0 = v_st(sr, sc), kws = KSWZ(sr, sc * 2); const unsigned rofs = (unsigned)(sr * LDP + sc) & 0xfffffu;
    const int vb0 = (int)(uintptr_t)V_lds + v_rd_base(lane);
    const bf16_t* Kh = cur.K; const bf16_t* Vh = cur.V;
    unsigned rowmask = 0xffffffffu;
    if (MODE != 2) { const int l0_ = lane; const int rq_ = wid * QBLK + (l0_ & 31);
        if (MODE == 0) rowmask = ((const unsigned char*)cur.mask)[(unsigned)(rq_ * 8)];
        if (MODE == 1) rowmask = ((const unsigned*)cur.mask)[(unsigned)(rq_ * 2)]; }
    constexpr int BSH = (MODE == 0) ? 8 : 6;
#define RESC(a) do { if (__any((a) < 1.f)) { const float a_ = (a);                                                                   \
                     for (int d_ = 0; d_ < 4; ++d_) for (int r = 0; r < 16; ++r) o[d_][r] *= a_; } } while (0)
#define KBASE(t) ((j_lo + (t)) * KVBLK)
#define ACT(t) (KBASE(t) <= qlo + QBLK - 1 && KBASE(t) + KVBLK - 1 >= qlo - W + 1)
#define MASKT(P0_, P1_, t) do { const int kb_ = KBASE(t); if ((!SK || ACT(t)) && (kb_ + KVBLK - 1 > qlo || kb_ <= qlo + QBLK - 1 - W)) mask_tile(P0_, P1_, qm - kb_, (unsigned)W); \
        if (MODE != 2) { const bool ok_ = (rowmask >> (kb_ >> BSH)) & 1u; if (!__all(ok_)) mask_all(P0_, P1_, ok_); } } while (0)
    constexpr int NQL = 8;
#define SEAM_K0() do { VMWN(NQL); SWRITE_HK(0); SBAR(); } while (0)
    f32x16 pA0, pA1, pB0, pB1; float mnA, mnB, alA, alB; bf16x8 pa0, pa1, pa2, pa3;
    SWRITE_HV(0); SBAR();
    if (NT > 1) { SLOAD_H(Kh, Vh, KBASE(1)); }
    SBAR(); qkt<SK>(pA0, pA1, K_lds, 0, r32, hi, S.qr, ACT(0));
    MASKT(pA0, pA1, 0); partialSM(pA0, pA1, m_reg, mnA, alA);
    if (NT > 1) { VMW(); SWRITE_H(SHM_K); }
    if (NT > 2) { SLOAD_H(Kh, Vh, KBASE(2)); SBAR(); }
    __syncthreads();
    int oc = SHM_K, op = 0, on = 2 * SHM_K;
    const bool lag = wid >= 4;
#define HALF_STEP(PX0, PX1, mnX, alX, PY0, PY1, alY, t) do {                                                                  \
        if ((t) + 1 < NT) { VMW(); SWRITE_H(on); SBAR(); }                                                                    \
        if ((t) + 2 < NT) { SLOAD_H(Kh, Vh, KBASE((t) + 2)); }                                                                \
        SBAR(); qkt<SK>(PX0, PX1, K_lds, oc, r32, hi, S.qr, ACT(t));                                                          \
        finishSM(PY0, PY1, alY, l_reg, pa0, pa1, pa2, pa3); SBAR();                                                           \
        pv_tile<SK>(o, vb0 + op, pa0, pa1, pa2, pa3, ACT((t) - 1));                                                           \
        if (lag) __syncthreads();     \
        MASKT(PX0, PX1, (t)); partialSM(PX0, PX1, m_reg, mnX, alX);                                                           \
        RESC(alX); if (!lag) __syncthreads();                                                                                 \
        op = oc; oc = on; on = (on == 2 * SHM_K) ? 0 : on + SHM_K; } while (0)
    for (int t = 1; t + 1 < NT; t += 2) {
        HALF_STEP(pB0, pB1, mnB, alB, pA0, pA1, alA, t);
        HALF_STEP(pA0, pA1, mnA, alA, pB0, pB1, alB, t + 1);
    }
    const bool even = (NT & 1) == 0;
    if (even) { SBAR(); qkt<SK>(pB0, pB1, K_lds, oc, r32, hi, S.qr, ACT(NT - 1)); SBAR(); }
    SLOAD_H(nxt.K, nxt.V, kbn); SBAR();
    { const int l1_ = fresh_lane(); const unsigned qo_ = (unsigned)((wid * QBLK + (l1_ & 31)) * LDP + (l1_ >> 5) * 8);
#pragma unroll
    for (int d0 = 0; d0 < 8; ++d0) S.qr[d0] = load8(nxt.Q + qo_ + d0 * 16); }
    SBAR();
    finishSM(pA0, pA1, alA, l_reg, pa0, pa1, pa2, pa3); SBAR();
    pv_tile<SK>(o, vb0 + op, pa0, pa1, pa2, pa3, ACT(even ? NT - 2 : NT - 1));
    if (even) { MASKT(pB0, pB1, NT - 1); partialSM(pB0, pB1, m_reg, mnB, alB); __syncthreads(); RESC(alB);
        finishSM(pB0, pB1, alB, l_reg, pa0, pa1, pa2, pa3); SBAR(); pv_tile<SK>(o, vb0 + oc, pa0, pa1, pa2, pa3, ACT(NT - 1)); }
    SBAR(); SEAM_K0();
    { const int le = fresh_lane(); const int r32e = le & 31, hie = le >> 5;
    float sc_ = 1.f / l_reg;
    if (MODE != 0) { const float gl = bf2f(cur.gate[(unsigned)((wid * QBLK + r32e) * LDP)]); sc_ *= fast_sigmoid(gl); }
    char* Ow = (char*)(cur.O + (size_t)(wid * QBLK) * 1024) + (unsigned)(r32e * 2048 + hie * 16);
#pragma unroll
    for (int d0 = 0; d0 < 4; ++d0) {
#pragma unroll
        for (int rp = 0; rp < 2; ++rp) { const int k = d0 * 2 + rp;
            float a0 = o[d0][8 * rp + 0] * sc_, a1 = o[d0][8 * rp + 1] * sc_, a2 = o[d0][8 * rp + 2] * sc_, a3 = o[d0][8 * rp + 3] * sc_;
            float b0 = o[d0][8 * rp + 4] * sc_, b1 = o[d0][8 * rp + 5] * sc_, b2 = o[d0][8 * rp + 6] * sc_, b3 = o[d0][8 * rp + 7] * sc_;
            uint4 w;
            if (MODE == 0) {
                const unsigned ax = cvt_pk_bf16(a0, a1), ay = cvt_pk_bf16(a2, a3), bx = cvt_pk_bf16(b0, b1), by = cvt_pk_bf16(b2, b3);
                auto rx = __builtin_amdgcn_permlane32_swap(ax, bx, false, false); auto ry = __builtin_amdgcn_permlane32_swap(ay, by, false, false);
                w = make_uint4(rx[0], ry[0], rx[1], ry[1]);
            } else {
#define SWP(A_, B_) do { auto r_ = __builtin_amdgcn_permlane32_swap(__float_as_uint(A_), __float_as_uint(B_), false, false); A_ = __uint_as_float(r_[0]); B_ = __uint_as_float(r_[1]); } while (0)
                SWP(a0, b0); SWP(a1, b1); SWP(a2, b2); SWP(a3, b3);
#undef SWP
                const uint4 pw = *(const uint4*)(Ow + k * 32);
                a0 += bf_lo(pw.x); a1 += bf_hi(pw.x); a2 += bf_lo(pw.y); a3 += bf_hi(pw.y);
                b0 += bf_lo(pw.z); b1 += bf_hi(pw.z); b2 += bf_lo(pw.w); b3 += bf_hi(pw.w);
                w = make_uint4(cvt_pk_bf16(a0, a1), cvt_pk_bf16(a2, a3), cvt_pk_bf16(b0, b1), cvt_pk_bf16(b2, b3));
            }
            *(uint4*)(Ow + k * 32) = w; } } }
    __syncthreads();
#undef RESC
#undef KBASE
#undef ACT
#undef MASKT
#undef SEAM_K0
#undef HALF_STEP
}
#undef ROW
#undef ROWU
#undef VMW
#undef VMWN
#undef SLOAD_H
#undef SWRITE_HK
#undef SWRITE_HV
#undef SWRITE_H
#undef KSWZ
#undef SBAR
}
constexpr size_t WS_DUMMY = (size_t)1242 * 1000 * 1000 + 512000;
constexpr size_t WS_MOBAMASK = WS_END2;
constexpr size_t WS_SELMASK = WS_MOBAMASK + al256((size_t)T * 8);
constexpr size_t WS_END3 = WS_SELMASK + al256((size_t)T * 2 * 4);

__device__ __forceinline__ void p_moba_prep(const Frame& F0, int wg0) {
    const Frame F = phase_frame(F0);
    if (F.c < wg0) return;
    const bf16_t* proj = (const bf16_t*)(F.ws + WS_PROJ); unsigned char* mm = (unsigned char*)(F.ws + WS_MOBAMASK);
    LAS float* km = (LAS float*)F.lds;
    LAS float* part = km + 8 * 128;
    for (int u = F.c - wg0; u < NB * 8 * 8; u += F.G - wg0) {
        const int pb = u & 7, h = (u >> 3) & 7, b = u >> 6;
        {
            const int rg = F.tid >> 4, dg = F.tid & 15;
            for (int n = 0; n < pb; ++n) { const bf16_t* kp = proj + ((size_t)b * S + n * 256 + rg * 8) * LDP + P_MK + h * 128 + dg * 8; float a[8];
#pragma unroll
                for (int j = 0; j < 8; ++j) a[j] = 0.f;
#pragma unroll
                for (int r = 0; r < 8; ++r) { const u32x4 kw = *(const u32x4*)(kp + (size_t)r * LDP);
                    a[0] += bf_lo(kw[0]); a[1] += bf_hi(kw[0]); a[2] += bf_lo(kw[1]); a[3] += bf_hi(kw[1]); a[4] += bf_lo(kw[2]); a[5] += bf_hi(kw[2]); a[6] += bf_lo(kw[3]); a[7] += bf_hi(kw[3]); }
                LAS float* pp = part + (n * 32 + rg) * 128 + dg * 8;
                *(LAS f32x4*)pp = (f32x4){a[0], a[1], a[2], a[3]}; *(LAS f32x4*)(pp + 4) = (f32x4){a[4], a[5], a[6], a[7]}; }
            __syncthreads();
            for (int idx = F.tid; idx < pb * 128; idx += NTHR) { const int n = idx >> 7, d = idx & 127; float a = 0.f;
#pragma unroll 8
                for (int q = 0; q < 32; ++q) a += part[(n * 32 + q) * 128 + d];
                km[n * 128 + d] = a * (1.f / 256.f); }
            __syncthreads();
        }
        const int pos = F.tid >> 1, half = F.tid & 1; const size_t t = (size_t)b * S + pb * 256 + pos;
        float gt[8];
#pragma unroll
        for (int n = 0; n < 8; ++n) gt[n] = 0.f;
        const bf16_t* qp = proj + t * LDP + P_MQ + h * 128 + half * 64;
        for (int c8 = 0; c8 < 8; ++c8) { const u32x4 qw = *(const u32x4*)(qp + c8 * 8);
            const float qf[8] = {bf_lo(qw[0]), bf_hi(qw[0]), bf_lo(qw[1]), bf_hi(qw[1]), bf_lo(qw[2]), bf_hi(qw[2]), bf_lo(qw[3]), bf_hi(qw[3])};
#pragma unroll
            for (int n = 0; n < 8; ++n) if (n < pb) {
#pragma unroll
                for (int j = 0; j < 8; ++j) gt[n] += qf[j] * km[n * 128 + half * 64 + c8 * 8 + j]; } }
        unsigned taken = 0;
#pragma unroll
        for (int n = 0; n < 8; ++n) { gt[n] += __shfl_xor(gt[n], 1); if (n >= pb) gt[n] = -1e30f; }
#pragma unroll
        for (int k = 0; k < 3; ++k) { int best = -1; float bv = 0.f;
#pragma unroll
            for (int n = 0; n < 8; ++n) if (!((taken >> n) & 1u) && (best < 0 || gt[n] > bv)) { best = n; bv = gt[n]; }
            taken |= 1u << best; }
        unsigned m = (taken & ((1u << pb) - 1u)) | (1u << pb);
        if (half == 0) mm[t * 8 + h] = (unsigned char)m;
        __syncthreads();
    }
}
__device__ __forceinline__ int xcd_item(int i, int n) { return (i & 7) * (n >> 3) + (i >> 3); }
__device__ __forceinline__ att::BlockRef ref_moba(const bf16_t* proj, bf16_t* om, const unsigned char* mm, int L, int pass) {
    const int bh = L >> 2, y = L & 3, b = bh >> 3, h = bh & 7; const int qb = pass ? y : 7 - y;     const size_t t0 = (size_t)b * S + qb * 256;
    att::BlockRef r; r.Q = proj + t0 * LDP + P_MQ + h * 128; r.K = proj + (size_t)b * S * LDP + P_MK + h * 128; r.V = proj + (size_t)b * S * LDP + P_MV + h * 128;
    r.O = om + t0 * 1024 + h * 128; r.mask = mm + t0 * 8 + h; r.gate = nullptr; r.P0 = qb * 256; r.pad = 0; return r; }
template <int BR>
__device__ __forceinline__ att::BlockRef ref_nsa(const bf16_t* proj, bf16_t* on, const unsigned* sm, int L, int pass) {
    const int bh = L >> 2, y = L & 3, b = bh >> 3, h = bh & 7, g = h >> 2; const int qb = pass ? y : 7 - y;     const size_t t0 = (size_t)b * S + qb * 256;
    att::BlockRef r; r.Q = proj + t0 * LDP + P_NQ + h * 128; r.K = proj + (size_t)b * S * LDP + P_NKV + (2 + 2 * BR) * 256 + g * 128; r.V = proj + (size_t)b * S * LDP + P_NKV + (3 + 2 * BR) * 256 + g * 128;
    r.O = on + t0 * 1024 + h * 128; r.mask = sm + t0 * 2 + g; r.gate = proj + t0 * LDP + P_NG + h * 3 + 1 + BR; r.P0 = qb * 256; r.pad = 0; return r; }
template <int WIN, bool DUMMY>
__device__ __forceinline__ void p_moba_attn_t(const Frame& F0) {
    const Frame F = phase_frame(F0);
    const bf16_t* proj = (const bf16_t*)(F.ws + WS_PROJ); bf16_t* om = (bf16_t*)(F.ws + (DUMMY ? WS_DUMMY : WS_OM)); const unsigned char* mm = (const unsigned char*)(F.ws + WS_MOBAMASK);
    const int total = NB * 8 * 8;

    const int nitems = total / 2;
    int L = F.c; if (L >= nitems) return;
    int pass = 0; att::BlockRef cur = ref_moba(proj, om, mm, xcd_item(L, nitems), 0); att::Seam Sm;
    att::prime(cur, WIN, (char*)F.lds, Sm, F.wave);
    for (;;) {
        const bool more_pass = pass == 0, more_item = L + F.G < nitems, last = !more_pass && !more_item;
        int passn = pass + 1, Ln = L; if (!more_pass) { passn = 0; Ln = more_item ? L + F.G : L; }
        const att::BlockRef nxt = last ? cur : ref_moba(proj, om, mm, xcd_item(Ln, nitems), passn);
        att::block<0, false>(cur, nxt, S, WIN, (char*)F.lds, Sm, F.wave);
        if (last) break;
        cur = nxt; pass = passn; L = Ln;
    }
}
__device__ __forceinline__ void p_moba_attn(const Frame& F0) { p_moba_attn_t<(1 << 20), false>(F0); }
template <bool DUMMY>
__device__ __forceinline__ void p_nsa_attn_t(const Frame& F0) {
    const int nitems = NB * 8 * 4;
    if (F0.c >= nitems) return;
    {
        const Frame F = phase_frame(F0);
        const bf16_t* proj = (const bf16_t*)(F.ws + WS_PROJ); bf16_t* on = (bf16_t*)(F.ws + (DUMMY ? WS_DUMMY : WS_ON)); const unsigned* sm = (const unsigned*)(F.ws + WS_SELMASK);

        int L = F.c, pass = 0; att::BlockRef cur = ref_nsa<0>(proj, on, sm, xcd_item(L, nitems), 0); att::Seam Sm;
        att::prime(cur, 1 << 20, (char*)F.lds, Sm, F.wave);
        for (;;) {
            const bool more_pass = pass == 0, more_item = L + F.G < nitems, last = !more_pass && !more_item;
            int passn = pass + 1, Ln = L; if (!more_pass) { passn = 0; Ln = more_item ? L + F.G : L; }
            const att::BlockRef nxt = last ? cur : ref_nsa<0>(proj, on, sm, xcd_item(Ln, nitems), passn);
            att::block<1, false>(cur, nxt, S, 1 << 20, (char*)F.lds, Sm, F.wave);
            if (last) break;
            cur = nxt; pass = passn; L = Ln;
        }
    }
    {
        const Frame F = phase_frame(F0);
        const bf16_t* proj = (const bf16_t*)(F.ws + WS_PROJ); bf16_t* on = (bf16_t*)(F.ws + (DUMMY ? WS_DUMMY : WS_ON)); const unsigned* sm = (const unsigned*)(F.ws + WS_SELMASK);

        int L = F.c, pass = 0; att::BlockRef cur = ref_nsa<1>(proj, on, sm, xcd_item(L, nitems), 0); att::Seam Sm;
        att::prime(cur, 512, (char*)F.lds, Sm, F.wave);
        for (;;) {
            const bool more_pass = pass == 0, more_item = L + F.G < nitems, last = !more_pass && !more_item;
            int passn = pass + 1, Ln = L; if (!more_pass) { passn = 0; Ln = more_item ? L + F.G : L; }
            const att::BlockRef nxt = last ? cur : ref_nsa<1>(proj, on, sm, xcd_item(Ln, nitems), passn);
            att::block<2, false>(cur, nxt, S, 512, (char*)F.lds, Sm, F.wave);
            if (last) break;
            cur = nxt; pass = passn; L = Ln;
        }
    }
}

__device__ __forceinline__ void p_nsa_attn(const Frame& F0) { p_nsa_attn_t<false>(F0); }

constexpr size_t WS_GDS = WS_MERGED;
constexpr size_t WS_GQT = WS_DEC;
constexpr size_t WS_GDL = WS_END3;
constexpr size_t WS_END4 = WS_GDL + al256((size_t)1024 * 128 * 4);

__device__ __forceinline__ void p_gla1(const Frame& F0, int l) {
    const Frame F = phase_frame(F0);
    const bf16_t* proj = (const bf16_t*)(F.ws + WS_PROJ);
    const float* wa = F.in(6) + (size_t)l * 16 * 512; const float* ba = F.in(7) + (size_t)l * 512;
    bf16_t* ogr16 = (bf16_t*)(F.ws + WS_OGRAW); bf16_t* gds = (bf16_t*)(F.ws + WS_GDS); bf16_t* gqt = (bf16_t*)(F.ws + WS_GQT); float* gdl = (float*)(F.ws + WS_GDL);
    LAS bf16_t* bq = (LAS bf16_t*)F.lds;
    LAS bf16_t* bk = bq + 64 * 136;
    LAS bf16_t* bkT = bk + 64 * 136;
    LAS bf16_t* bvT = bkT + 128 * 72;
    LAS bf16_t* rv = bvT + 256 * 72;
    LAS bf16_t* bA = rv;
    LAS float* gs = (LAS float*)(rv + 64 * 256);
    LAS bf16_t* sga = (LAS bf16_t*)(gs + 512);
    const int tid = F.tid, lane = F.lane, w = F.wave, r32 = lane & 31, hh = lane >> 5;
    unsigned* qh = (unsigned*)(F.ws + WS_CTL) + CW_GQ + 64 * l; LAS int* qs = (LAS int*)(F.lds + LDS_MISC + 8192 + 1024);
    if (tid == 0) qs[0] = (int)xb_add(qh, 1u);
    __syncthreads();
    for (int u = __builtin_amdgcn_readfirstlane(qs[0]); u < 1024; u = __builtin_amdgcn_readfirstlane(qs[0])) {
        unsigned nu_ = 0u; if (tid == 0) nu_ = xb_add(qh, 1u);
        const int c = u & 31, h = (u >> 5) & 3, b = u >> 7; const size_t row0 = (size_t)b * S + c * 64;
        {
            u32x4 lq[2], lk[2], lv[4], lg = {0u, 0u, 0u, 0u};
#pragma unroll
            for (int i = 0; i < 2; ++i) { const int ch = i * NTHR + tid, t = ch >> 4, cc = ch & 15; lq[i] = *(const u32x4*)(proj + (row0 + t) * LDP + P_GQ + h * 128 + cc * 8); lk[i] = *(const u32x4*)(proj + (row0 + t) * LDP + P_GK + h * 128 + cc * 8); }
#pragma unroll
            for (int i = 0; i < 4; ++i) { const int ch = i * NTHR + tid, t = ch >> 5, cc = ch & 31; lv[i] = *(const u32x4*)(proj + (row0 + t) * LDP + P_GV + h * 256 + cc * 8); }
            if (tid < 128) lg = *(const u32x4*)(proj + (row0 + (tid >> 1)) * LDP + P_GA + (tid & 1) * 8);
#pragma unroll
            for (int i = 0; i < 2; ++i) { const int ch = i * NTHR + tid, t = ch >> 4, cc = ch & 15; *(LAS u32x4*)(bq + t * 136 + cc * 8) = lq[i]; *(LAS u32x4*)(bk + t * 136 + cc * 8) = lk[i]; }
#pragma unroll
            for (int i = 0; i < 4; ++i) { const int ch = i * NTHR + tid, t = ch >> 5, cc = ch & 31; *(LAS u32x4*)(rv + t * 256 + cc * 8) = lv[i]; }
            if (tid < 128) *(LAS u32x4*)(sga + (tid >> 1) * 16 + (tid & 1) * 8) = lg;
        }
        __syncthreads();
        {
            const int d = tid & 127, tq = tid >> 7, col = h * 128 + d;
            float war[16];
#pragma unroll
            for (int r = 0; r < 16; ++r) war[r] = wa[r * 512 + col];
            const float bias = ba[col];
            float bl[16]; float cum = 0.f;
#pragma unroll
            for (int i = 0; i < 16; ++i) { const LAS bf16_t* gp = sga + (tq * 16 + i) * 16;
                const u32x4 g0 = *(const LAS u32x4*)gp, g1 = *(const LAS u32x4*)(gp + 8);
                float x = bias + bf_lo(g0[0]) * war[0] + bf_hi(g0[0]) * war[1] + bf_lo(g0[1]) * war[2] + bf_hi(g0[1]) * war[3] + bf_lo(g0[2]) * war[4] + bf_hi(g0[2]) * war[5] + bf_lo(g0[3]) * war[6] + bf_hi(g0[3]) * war[7]
                        + bf_lo(g1[0]) * war[8] + bf_hi(g1[0]) * war[9] + bf_lo(g1[1]) * war[10] + bf_hi(g1[1]) * war[11] + bf_lo(g1[2]) * war[12] + bf_hi(g1[2]) * war[13] + bf_lo(g1[3]) * war[14] + bf_hi(g1[3]) * war[15];
                const float ls = fminf(x, 0.f) - 0.6931471805599453f * __builtin_amdgcn_logf(1.f + __builtin_amdgcn_exp2f(-1.4426950408889634f * fabsf(x)));
                cum += ls * (1.f / 16.f); bl[i] = cum; }
            gs[tq * 128 + d] = cum;
            __syncthreads();
            float off = 0.f, tot = 0.f;
#pragma unroll
            for (int q = 0; q < 4; ++q) { const float g = gs[q * 128 + d]; if (q < tq) off += g; tot += g; }
            unsigned kt[8];
#pragma unroll
            for (int i = 0; i < 16; ++i) { const float bt = off + bl[i]; const int t = tq * 16 + i;
                const float qv = bf2f(bq[t * 136 + d]), kv = bf2f(bk[t * 136 + d]);
                const float eb = __builtin_amdgcn_exp2f(1.4426950408889634f * bt);
                bq[t * 136 + d] = f2bf(qv * 0.08838834764831845f * eb); bk[t * 136 + d] = f2bf(kv * __builtin_amdgcn_rcpf(eb));
                const float kh = kv * __builtin_amdgcn_exp2f(1.4426950408889634f * (tot - bt));
                if (i & 1) kt[i >> 1] |= ((unsigned)f2bf(kh)) << 16; else kt[i >> 1] = f2bf(kh); }
            *(LAS u32x4*)(bkT + d * 72 + tq * 16) = (u32x4){kt[0], kt[1], kt[2], kt[3]}; *(LAS u32x4*)(bkT + d * 72 + tq * 16 + 8) = (u32x4){kt[4], kt[5], kt[6], kt[7]};
            if (tq == 0) gdl[(size_t)u * 128 + d] = __builtin_amdgcn_exp2f(1.4426950408889634f * tot);
        }
        {
            const int e = tid & 255, sg = tid >> 8;
#pragma unroll
            for (int q = 0; q < 4; ++q) { unsigned vt[4];
#pragma unroll
                for (int jj = 0; jj < 8; ++jj) { const bf16_t v = rv[(sg * 32 + q * 8 + jj) * 256 + e]; if (jj & 1) vt[jj >> 1] |= ((unsigned)v) << 16; else vt[jj >> 1] = v; }
                *(LAS u32x4*)(bvT + e * 72 + sg * 32 + q * 8) = (u32x4){vt[0], vt[1], vt[2], vt[3]}; }
        }
        __syncthreads();
        for (int i = tid; i < 1024; i += NTHR) { const int t = i >> 4, ch = i & 15; *(u32x4*)(gqt + (row0 + t) * 512 + h * 128 + ch * 8) = *(const LAS u32x4*)(bq + t * 136 + ch * 8); }
        if (w < 3) { const int tt = w == 0 ? 0 : 1, ss = w == 2 ? 1 : 0; f32x16 acc = {};
#pragma unroll
            for (int ks = 0; ks < 8; ++ks) { const bf16x8 a = *(const LAS bf16x8*)(bq + (tt * 32 + r32) * 136 + ks * 16 + hh * 8), bb = *(const LAS bf16x8*)(bk + (ss * 32 + r32) * 136 + ks * 16 + hh * 8);
                acc = __builtin_amdgcn_mfma_f32_32x32x16_bf16(a, bb, acc, 0, 0, 0); }
#pragma unroll
            for (int i = 0; i < 16; ++i) { const int t = tt * 32 + (i & 3) + 8 * (i >> 2) + 4 * hh, s = ss * 32 + r32; bA[t * 72 + s] = f2bf(t >= s ? acc[i] : 0.f); } }
        else if (w == 3) {
#pragma unroll
            for (int i = 0; i < 16; ++i) { const int t = (i & 3) + 8 * (i >> 2) + 4 * hh; bA[t * 72 + 32 + r32] = 0; } }
        __syncthreads();
        {
            f32x16 o0 = {}, o1 = {}, s0 = {}, s1 = {}, s2 = {}, s3 = {};
#pragma unroll
            for (int ks = 0; ks < 4; ++ks) { const bf16x8 vf = *(const LAS bf16x8*)(bvT + (w * 32 + r32) * 72 + ks * 16 + hh * 8);
                const bf16x8 a0 = *(const LAS bf16x8*)(bA + r32 * 72 + ks * 16 + hh * 8), a1 = *(const LAS bf16x8*)(bA + (32 + r32) * 72 + ks * 16 + hh * 8);
                o0 = __builtin_amdgcn_mfma_f32_32x32x16_bf16(a0, vf, o0, 0, 0, 0); o1 = __builtin_amdgcn_mfma_f32_32x32x16_bf16(a1, vf, o1, 0, 0, 0);
                const bf16x8 k0 = *(const LAS bf16x8*)(bkT + r32 * 72 + ks * 16 + hh * 8), k1 = *(const LAS bf16x8*)(bkT + (32 + r32) * 72 + ks * 16 + hh * 8),
                             k2 = *(const LAS bf16x8*)(bkT + (64 + r32) * 72 + ks * 16 + hh * 8), k3 = *(const LAS bf16x8*)(bkT + (96 + r32) * 72 + ks * 16 + hh * 8);
                s0 = __builtin_amdgcn_mfma_f32_32x32x16_bf16(k0, vf, s0, 0, 0, 0); s1 = __builtin_amdgcn_mfma_f32_32x32x16_bf16(k1, vf, s1, 0, 0, 0);
                s2 = __builtin_amdgcn_mfma_f32_32x32x16_bf16(k2, vf, s2, 0, 0, 0); s3 = __builtin_amdgcn_mfma_f32_32x32x16_bf16(k3, vf, s3, 0, 0, 0); }
#pragma unroll
            for (int i = 0; i < 16; ++i) { const int rr = (i & 3) + 8 * (i >> 2) + 4 * hh;
                ogr16[(row0 + rr) * 1024 + h * 256 + w * 32 + r32] = f2bf(o0[i]); ogr16[(row0 + 32 + rr) * 1024 + h * 256 + w * 32 + r32] = f2bf(o1[i]); }
            { unsigned char* dp = (unsigned char*)gds + ((size_t)u * 256 + w * 32 + r32) * 128 + hh * 8;
#define GST(SJ, j_) do { _Pragma("unroll") for (int rp = 0; rp < 2; ++rp) {                                                                                  \
                const unsigned a_ = pack_fp8x4(SJ[8 * rp + 0] * 4.f, SJ[8 * rp + 1] * 4.f, SJ[8 * rp + 2] * 4.f, SJ[8 * rp + 3] * 4.f);                          \
                const unsigned b_ = pack_fp8x4(SJ[8 * rp + 4] * 4.f, SJ[8 * rp + 5] * 4.f, SJ[8 * rp + 6] * 4.f, SJ[8 * rp + 7] * 4.f);                          \
                auto r_ = __builtin_amdgcn_permlane32_swap(a_, b_, false, false);                                                                           \
                *(u32x2*)(dp + ((j_) * 2 + rp) * 16) = (u32x2){r_[0], r_[1]}; } } while (0)
              GST(s0, 0); GST(s1, 1); GST(s2, 2); GST(s3, 3);
#undef GST
            }
        }
        if (tid == 0) qs[0] = (int)nu_;
        __syncthreads();
    }
}
__device__ __forceinline__ void p_gla2(const Frame& F0) {
    const Frame F = phase_frame(F0);
    unsigned char* gds = F.ws + WS_GDS; const float* gdl = (const float*)(F.ws + WS_GDL);
    for (int i = F.c * NTHR + F.tid; i < 32 * 4096; i += F.G * NTHR) {
        const int bh = i >> 12, e = (i >> 4) & 255, dg = i & 15;
        float st[8];
#pragma unroll
        for (int j = 0; j < 8; ++j) st[j] = 0.f;
        unsigned char* p = gds + ((size_t)bh * 32 * 256 + e) * 128 + dg * 8; const float* dp = gdl + (size_t)bh * 32 * 128 + dg * 8;
        u32x2 dsv = *(const u32x2*)p; f32x4 d0 = *(const f32x4*)dp, d1 = *(const f32x4*)(dp + 4);
        for (int c = 0; c < 32; ++c) {
            u32x2 dsn = dsv; f32x4 e0 = d0, e1 = d1;
            if (c + 1 < 32) { dsn = *(const u32x2*)(p + (size_t)256 * 128); e0 = *(const f32x4*)(dp + 128); e1 = *(const f32x4*)(dp + 132); }
            *(u32x2*)p = (u32x2){pack_fp8x4(st[0] * 4.f, st[1] * 4.f, st[2] * 4.f, st[3] * 4.f), pack_fp8x4(st[4] * 4.f, st[5] * 4.f, st[6] * 4.f, st[7] * 4.f)};
            const f32x2 i0 = __builtin_amdgcn_cvt_pk_f32_fp8((int)dsv[0], false), i1 = __builtin_amdgcn_cvt_pk_f32_fp8((int)dsv[0], true), i2 = __builtin_amdgcn_cvt_pk_f32_fp8((int)dsv[1], false), i3 = __builtin_amdgcn_cvt_pk_f32_fp8((int)dsv[1], true);
            st[0] = d0[0] * st[0] + i0[0] * 0.25f; st[1] = d0[1] * st[1] + i0[1] * 0.25f; st[2] = d0[2] * st[2] + i1[0] * 0.25f; st[3] = d0[3] * st[3] + i1[1] * 0.25f;
            st[4] = d1[0] * st[4] + i2[0] * 0.25f; st[5] = d1[1] * st[5] + i2[1] * 0.25f; st[6] = d1[2] * st[6] + i3[0] * 0.25f; st[7] = d1[3] * st[7] + i3[1] * 0.25f;
            dsv = dsn; d0 = e0; d1 = e1; p += (size_t)256 * 128; dp += 128; }
    }
}
__device__ __forceinline__ void p_gla3(const Frame& F0, int l) {
    const Frame F = phase_frame(F0);
    const bf16_t* proj = (const bf16_t*)(F.ws + WS_PROJ); const float* ng = F.in(8) + (size_t)l * 256;
    const bf16_t* ogr16 = (const bf16_t*)(F.ws + WS_OGRAW); const bf16_t* gds = (const bf16_t*)(F.ws + WS_GDS); const bf16_t* gqt = (const bf16_t*)(F.ws + WS_GQT); bf16_t* og = (bf16_t*)(F.ws + WS_OG);
    LAS float* ot = (LAS float*)F.lds;
    const int lane = F.lane, w = F.wave, r32 = lane & 31, hh = lane >> 5;
    const f32x4 gn = *(const f32x4*)(ng + lane * 4);
    for (int u = F.c; u < 1024; u += F.G) {
        const int c = u & 31, h = (u >> 5) & 3, b = u >> 7; const size_t row0 = (size_t)b * S + c * 64;
        f32x16 o0 = {}, o1 = {};
        f32x4 og4[8];
#pragma unroll
        for (int q = 0; q < 8; ++q) { const u32x2 ow = *(const u32x2*)(ogr16 + (row0 + w * 8 + q) * 1024 + h * 256 + lane * 4); og4[q] = (f32x4){bf_lo(ow[0]), bf_hi(ow[0]), bf_lo(ow[1]), bf_hi(ow[1])}; }
#pragma unroll
        for (int ks = 0; ks < 8; ++ks) { const u32x2 s8 = *(const u32x2*)((const unsigned char*)gds + ((size_t)u * 256 + w * 32 + r32) * 128 + ks * 16 + hh * 8);
            const f32x2 q0 = __builtin_amdgcn_cvt_pk_f32_fp8((int)s8[0], false), q1 = __builtin_amdgcn_cvt_pk_f32_fp8((int)s8[0], true), q2 = __builtin_amdgcn_cvt_pk_f32_fp8((int)s8[1], false), q3 = __builtin_amdgcn_cvt_pk_f32_fp8((int)s8[1], true);
            u32x4 sw = {cvt_pk_bf16(q0[0], q0[1]), cvt_pk_bf16(q1[0], q1[1]), cvt_pk_bf16(q2[0], q2[1]), cvt_pk_bf16(q3[0], q3[1])};
            const bf16x8 sf = __builtin_bit_cast(bf16x8, sw);
            const bf16x8 a0 = *(const bf16x8*)(gqt + (row0 + r32) * 512 + h * 128 + ks * 16 + hh * 8), a1 = *(const bf16x8*)(gqt + (row0 + 32 + r32) * 512 + h * 128 + ks * 16 + hh * 8);
            o0 = __builtin_amdgcn_mfma_f32_32x32x16_bf16(a0, sf, o0, 0, 0, 0); o1 = __builtin_amdgcn_mfma_f32_32x32x16_bf16(a1, sf, o1, 0, 0, 0); }
        u32x2 gw[8];
#pragma unroll
        for (int q = 0; q < 8; ++q) gw[q] = *(const u32x2*)(proj + (row0 + w * 8 + q) * LDP + P_GG + h * 256 + lane * 4);
#pragma unroll
        for (int i = 0; i < 16; ++i) { const int rr = (i & 3) + 8 * (i >> 2) + 4 * hh;
            ot[rr * 260 + w * 32 + r32] = o0[i] * 0.25f;
            ot[(32 + rr) * 260 + w * 32 + r32] = o1[i] * 0.25f; }
        __syncthreads();
#pragma unroll
        for (int q = 0; q < 8; ++q) { const int t = w * 8 + q; const f32x4 v = *(const LAS f32x4*)(ot + t * 260 + lane * 4) + og4[q];
            float ss = v[0] * v[0] + v[1] * v[1] + v[2] * v[2] + v[3] * v[3];
#pragma unroll
            for (int o = 32; o > 0; o >>= 1) ss += __shfl_xor(ss, o);
            const float rstd = rsqrtf(ss * (1.f / 256.f) + 1e-6f);
            u32x2 ov; ov[0] = cvt_pk_bf16(v[0] * rstd * gn[0] * fast_silu(bf_lo(gw[q][0])), v[1] * rstd * gn[1] * fast_silu(bf_hi(gw[q][0])));
            ov[1] = cvt_pk_bf16(v[2] * rstd * gn[2] * fast_silu(bf_lo(gw[q][1])), v[3] * rstd * gn[3] * fast_silu(bf_hi(gw[q][1])));
            *(u32x2*)(og + (row0 + t) * 1024 + h * 256 + lane * 4) = ov; }
        __syncthreads();
    }
}

constexpr size_t WS_CHID = WS_GDL + al256((size_t)1024 * 128 * 4);
constexpr size_t WS_KC   = WS_CHID + al256((size_t)2 * 2048 * 256 * 2);
constexpr size_t WS_VCT  = WS_KC + al256((size_t)16 * 128 * 128 * 2);
constexpr size_t WS_CP   = WS_VCT + al256((size_t)16 * 128 * 128 * 2);
constexpr size_t WS_BIAS1P = WS_CP + al256((size_t)2 * 2048 * 256 * 2);
constexpr size_t WS_END5 = WS_BIAS1P + al256((size_t)NL * 2 * 32 * 128 * 4);
constexpr size_t WS_CP32 = WS_END5;
constexpr size_t WS_END6 = WS_CP32 + al256((size_t)4 * 2 * 2048 * 256 * 4);


__device__ __forceinline__ void p_conv_cmp(const Frame& F0) {
    const Frame F = phase_frame(F0);
    const float* pe = F.in(3); const float* w1 = F.in(4); const float* w2 = F.in(5);
    bf16_t* wc2 = (bf16_t*)(F.ws + WS_WC2); float* bias1 = (float*)(F.ws + WS_BIAS1);
    for (int i = F.c * NTHR + F.tid; i < NL * 2 * 256 * 256; i += F.G * NTHR) { const int k = i & 255, n = (i >> 8) & 255, lc = i >> 16;
        wc2[i] = (k < 128 && n < 128) ? f2bf(w2[((size_t)lc * 128 + k) * 128 + n]) : (bf16_t)0; }
    LAS float* part = (LAS float*)F.lds; float* bp = (float*)(F.ws + WS_BIAS1P);
    for (int task = F.c; task < NL * 2 * 32; task += F.G) { const int lc = task >> 5, ch = task & 31; const int o = F.tid & 127, ig = F.tid >> 7; float a = 0.f;
        const size_t i0 = (size_t)lc * 4096 + ch * 128 + ig * 32;
#pragma unroll 8
        for (int i = 0; i < 32; ++i) a += pe[i0 + i] * w1[(i0 + i) * 128 + o];
        part[ig * 128 + o] = a; __syncthreads();
        if (F.tid < 128) bp[(size_t)task * 128 + F.tid] = part[F.tid] + part[128 + F.tid] + part[256 + F.tid] + part[384 + F.tid];
        __syncthreads(); }
}
struct SchedCmp1 {
    static constexpr bool GATHER = true;
    const char* proj; const char* W; int G, c;
    __device__ __forceinline__ bool next(int i, ge::Unit& u) const { const int L = i * G + c; if (L >= 16) return false; const int cc = L >> 3, pm = L & 7;
        u.A = proj + (size_t)(P_NKV + cc * 256) * 2; u.B = W + (size_t)cc * 256 * 2048 * 2; u.r0 = pm * 256; u.c0 = 0; u.aux = cc; u.aux2 = 0; return true; }
    __device__ __forceinline__ void voffA(const ge::Unit& u, int tid, unsigned (&v)[2][2]) const {
#pragma unroll
        for (int i = 0; i < 2; ++i) { int R, C; ge::stage_rc(tid * 16 + i * 8192, R, C);
#pragma unroll
            for (int hf = 0; hf < 2; ++hf) { const int r = u.r0 + hf * 128 + R; const int b = r >> 8, g = (r >> 7) & 1, m = r & 127;
                v[hf][i] = (unsigned)(((b * S + 16 * m) * LDP + g * 128 + C)) * 2u; } } }
};
struct EpiCmp1 {
    static constexpr bool PERM = true; bf16_t* P;
    __device__ __forceinline__ void operator()(const f32x4 (&acc)[2][2][4][2], const ge::Unit& u, int wr, int wc, int fr, int fq) const {
#pragma unroll
        for (int ai = 0; ai < 2; ++ai)
#pragma unroll
            for (int m = 0; m < 4; ++m) { bf16_t* rowp = P + ((size_t)u.aux * 2048 + u.r0 + ai * 128 + wr * 64 + m * 16 + fr) * 256 + wc * 32 + 8 * fq;
#pragma unroll
                for (int bj = 0; bj < 2; ++bj) { const f32x4 v0 = acc[ai][bj][m][0], v1 = acc[ai][bj][m][1]; u32x4 w = {cvt_pk_bf16(v0[0], v0[1]), cvt_pk_bf16(v0[2], v0[3]), cvt_pk_bf16(v1[0], v1[1]), cvt_pk_bf16(v1[2], v1[3])};
                    *(u32x4*)(rowp + bj * 128) = w; } }
    }
};
struct SchedCmp2 {
    static constexpr bool GATHER = false;
    const char* hid; const char* W; int G, c;
    __device__ __forceinline__ bool next(int i, ge::Unit& u) const { const int L = i * G + c; if (L >= 16) return false; const int cc = L >> 3, pm = L & 7;
        u.A = hid + ((size_t)cc * 2048 + pm * 256) * 256 * 2; u.B = W + (size_t)cc * 256 * 256 * 2; u.r0 = pm * 256; u.c0 = 0; u.aux = cc; u.aux2 = 0; return true; }
    __device__ __forceinline__ void voffA(const ge::Unit&, int tid, unsigned (&v)[2][2]) const { ge::dense_voffA(256, tid, v); }
};
struct EpiCmp2 {
    static constexpr bool PERM = false; bf16_t* kc; bf16_t* vct;
    __device__ __forceinline__ void operator()(const f32x4 (&acc)[2][2][4][2], const ge::Unit& u, int wr, int wc, int fr, int fq) const {
#pragma unroll
        for (int ai = 0; ai < 2; ++ai)
#pragma unroll
            for (int m = 0; m < 4; ++m) { const int r = u.r0 + ai * 128 + wr * 64 + m * 16 + fr; const int bg = r >> 7, n = r & 127;
#pragma unroll
                for (int nn = 0; nn < 2; ++nn) { const int d = wc * 32 + nn * 16 + 4 * fq; const f32x4 v = acc[ai][0][m][nn];
                    if (u.aux == 0) { u32x2 w = {cvt_pk_bf16(v[0], v[1]), cvt_pk_bf16(v[2], v[3])}; *(u32x2*)(kc + ((size_t)bg * 128 + n) * 128 + d) = w; }
                    else {
#pragma unroll
                        for (int j = 0; j < 4; ++j) vct[((size_t)bg * 128 + d + j) * 128 + n] = f2bf(v[j]); } } }
    }
};
struct SchedCmp1S {
    static constexpr bool GATHER = true;
    const char* proj; const char* W; int c;
    __device__ __forceinline__ bool next(int i, ge::Unit& u) const { if (i != 0 || c >= CMP_WGS) return false; const int x = c & 7, j = c >> 3, tile = 2 * x + (j >> 2), kq = j & 3, cc = tile >> 3, pm = tile & 7;
        u.A = proj + (size_t)(P_NKV + cc * 256) * 2 + (size_t)kq * 4 * LDP * 2; u.B = W + (size_t)cc * 256 * 2048 * 2 + (size_t)kq * 512 * 2; u.r0 = pm * 256; u.c0 = 0; u.aux = cc; u.aux2 = kq; return true; }
    __device__ __forceinline__ void voffA(const ge::Unit& u, int tid, unsigned (&v)[2][2]) const {
#pragma unroll
        for (int i = 0; i < 2; ++i) { int R, C; ge::stage_rc(tid * 16 + i * 8192, R, C);
#pragma unroll
            for (int hf = 0; hf < 2; ++hf) { const int r = u.r0 + hf * 128 + R; const int b = r >> 8, g = (r >> 7) & 1, m = r & 127;
                v[hf][i] = (unsigned)(((b * S + 16 * m) * LDP + g * 128 + C)) * 2u; } } }
};
struct EpiCmp1S {
    static constexpr bool PERM = true; float* P;
    __device__ __forceinline__ void operator()(const f32x4 (&acc)[2][2][4][2], const ge::Unit& u, int wr, int wc, int fr, int fq) const {
#pragma unroll
        for (int ai = 0; ai < 2; ++ai)
#pragma unroll
            for (int m = 0; m < 4; ++m) { float* rowp = P + ((size_t)(u.aux2 * 2 + u.aux) * 2048 + u.r0 + ai * 128 + wr * 64 + m * 16 + fr) * 256 + wc * 32 + 8 * fq;
#pragma unroll
                for (int bj = 0; bj < 2; ++bj) { *(f32x4*)(rowp + bj * 128) = acc[ai][bj][m][0]; *(f32x4*)(rowp + bj * 128 + 4) = acc[ai][bj][m][1]; } }
    }
};
struct SchedCmp2S {
    static constexpr bool GATHER = true;
    const char* hid; const char* W; int c;
    __device__ __forceinline__ bool next(int i, ge::Unit& u) const { if (i != 0 || c >= CMP_WGS) return false; const int x = c & 7, j = c >> 3, tile = 2 * x + (j >> 2), kq = j & 3, cc = tile >> 3, pm = tile & 7;
        u.A = hid + ((size_t)cc * 2048 + pm * 256 + kq * 64) * 256 * 2; u.B = W + (size_t)cc * 256 * 256 * 2; u.r0 = pm * 256 + kq * 64; u.c0 = 0; u.aux = cc; u.aux2 = 0; return true; }
    __device__ __forceinline__ void voffA(const ge::Unit&, int tid, unsigned (&v)[2][2]) const {
#pragma unroll
        for (int i = 0; i < 2; ++i) { int R, C; ge::stage_rc(tid * 16 + i * 8192, R, C);
#pragma unroll
            for (int hf = 0; hf < 2; ++hf) v[hf][i] = (unsigned)((R & 63) * 256 + C) * 2u; } }
};
struct EpiCmp2S {
    static constexpr bool PERM = false; bf16_t* kc; bf16_t* vct;
    __device__ __forceinline__ void operator()(const f32x4 (&acc)[2][2][4][2], const ge::Unit& u, int wr, int wc, int fr, int fq) const {
        if (wr != 0) return;
#pragma unroll
        for (int m = 0; m < 4; ++m) { const int r = u.r0 + m * 16 + fr; const int bg = r >> 7, n = r & 127;
#pragma unroll
            for (int nn = 0; nn < 2; ++nn) { const int d = wc * 32 + nn * 16 + 4 * fq; const f32x4 v = acc[0][0][m][nn];
                if (u.aux == 0) { u32x2 w = {cvt_pk_bf16(v[0], v[1]), cvt_pk_bf16(v[2], v[3])}; *(u32x2*)(kc + ((size_t)bg * 128 + n) * 128 + d) = w; }
                else {
#pragma unroll
                    for (int j = 0; j < 4; ++j) vct[((size_t)bg * 128 + d + j) * 128 + n] = f2bf(v[j]); } } }
    }
};
__device__ __forceinline__ void p_nsa_cmp(const Frame& F0, int l) {
    const Frame F = phase_frame(F0);
    if (F.c >= CMP_WGS) return;
    const int x_ = F.c & 7, j_ = F.c >> 3, tile = 2 * x_ + (j_ >> 2), kq = j_ & 3, cc = tile >> 3, pm = tile & 7;
    LAS float* biasL = (LAS float*)(F.lds + LDS_MISC + 8192);
    if (F.tid < 128) { const int o = F.tid; const float* bp = (const float*)(F.ws + WS_BIAS1P) + ((size_t)(l * 2 + cc) * 32) * 128 + o; float a = 0.f;
#pragma unroll 8
        for (int ch = 0; ch < 32; ++ch) a += bp[ch * 128]; biasL[o] = a; }
    __syncthreads();
    { SchedCmp1S S{(const char*)(F.ws + WS_PROJ), (const char*)(F.ws + WS_WC1) + (size_t)l * 2 * 256 * 2048 * 2, F.c};
      EpiCmp1S E{(float*)(F.ws + WS_CP32)};
      ge::gemm_phase<EpiCmp1S, SchedCmp1S, 1>(F.lds, F.tid, 512, LDP * 2, S, E, 2048); }
    asm volatile("s_waitcnt vmcnt(0)" ::: "memory"); __syncthreads();
    if (F.tid == 0) { unsigned* bar = (unsigned*)(F.ws + WS_CTL); unsigned* fl = bar + CW_CMPF + 64 * (l * 16 + tile);
        __builtin_amdgcn_fence(__ATOMIC_RELEASE, "agent"); asm volatile("s_waitcnt vmcnt(0)" ::: "memory");
        (void)xb_add(fl, 1u);
        XB_SPIN(xb_ld(fl) < 4u, bar);
        __builtin_amdgcn_fence(__ATOMIC_ACQUIRE, "agent"); asm volatile("s_waitcnt vmcnt(0)" ::: "memory"); }
    __syncthreads();
    {
        const float* P = (const float*)(F.ws + WS_CP32); bf16_t* hid = (bf16_t*)(F.ws + WS_CHID);
        for (int idx = F.tid; idx < 64 * 16; idx += NTHR) { const int row = kq * 64 + (idx >> 4), ch = idx & 15; const size_t r = (size_t)cc * 2048 + pm * 256 + row;
            u32x4 w = {0u, 0u, 0u, 0u};
            if ((row & 127) != 127) { f32x4 s0 = *(const LAS f32x4*)(biasL + ch * 8), s1 = *(const LAS f32x4*)(biasL + ch * 8 + 4);
#pragma unroll
                for (int q = 0; q < 4; ++q) { const float* pq = P + ((size_t)q * 2 * 2048 + r) * 256 + ch * 8;
                    s0 += *(const f32x4*)pq + *(const f32x4*)(pq + 256 + 128); s1 += *(const f32x4*)(pq + 4) + *(const f32x4*)(pq + 256 + 128 + 4); }
                w[0] = cvt_pk_bf16(fast_silu(s0[0]), fast_silu(s0[1])); w[1] = cvt_pk_bf16(fast_silu(s0[2]), fast_silu(s0[3]));
                w[2] = cvt_pk_bf16(fast_silu(s1[0]), fast_silu(s1[1])); w[3] = cvt_pk_bf16(fast_silu(s1[2]), fast_silu(s1[3])); }
            *(u32x4*)(hid + r * 256 + ch * 8) = w; *(u32x4*)(hid + r * 256 + 128 + ch * 8) = (u32x4){0u, 0u, 0u, 0u}; }
    }
    asm volatile("s_waitcnt vmcnt(0)" ::: "memory"); __syncthreads();
    { SchedCmp2S S{(const char*)(F.ws + WS_CHID), (const char*)(F.ws + WS_WC2) + (size_t)l * 2 * 256 * 256 * 2, F.c};
      EpiCmp2S E{(bf16_t*)(F.ws + WS_KC), (bf16_t*)(F.ws + WS_VCT)};
      ge::gemm_phase<EpiCmp2S, SchedCmp2S, 0>(F.lds, F.tid, 256, 0, S, E); }
}

__device__ __forceinline__ void p_nsa_cmpsel(const Frame& F0) {
    const Frame F = phase_frame(F0);
    const bf16_t* proj = (const bf16_t*)(F.ws + WS_PROJ); const bf16_t* kc = (const bf16_t*)(F.ws + WS_KC); const bf16_t* vct = (const bf16_t*)(F.ws + WS_VCT);
    bf16_t* on = (bf16_t*)(F.ws + WS_ON); unsigned* selm = (unsigned*)(F.ws + WS_SELMASK);
    LAS float* gl = (LAS float*)F.lds + F.wave * 32;
    const int lane = F.lane, w = F.wave, r32 = lane & 31, hi = lane >> 5;
    for (int u = F.c; u < NB * 2 * 32; u += F.G) {
        const int pb = u & 31, g = (u >> 5) & 1, b = u >> 6; const int bg = b * 2 + g;
        const int p = pb * 64 + w * 8 + (r32 >> 2), hd = g * 4 + (r32 & 3); const size_t t = (size_t)b * S + p;
        bf16x8 qf[8];
#pragma unroll
        for (int d0 = 0; d0 < 8; ++d0) qf[d0] = *(const bf16x8*)(proj + t * LDP + P_NQ + hd * 128 + d0 * 16 + hi * 8);
        f32x16 sc[4];
#pragma unroll
        for (int kt = 0; kt < 4; ++kt) { sc[kt] = f32x16{};
#pragma unroll
            for (int d0 = 0; d0 < 8; ++d0) { const bf16x8 kf = *(const bf16x8*)(kc + ((size_t)bg * 128 + kt * 32 + r32) * 128 + d0 * 16 + hi * 8);
                sc[kt] = __builtin_amdgcn_mfma_f32_32x32x16_bf16(kf, qf[d0], sc[kt], 0, 0, 0); } }
        const int nmax = p >= 31 ? (p - 31) >> 4 : -1;
        float mx = -1e30f;
#pragma unroll
        for (int kt = 0; kt < 4; ++kt)
#pragma unroll
            for (int i = 0; i < 16; ++i) { const int n = kt * 32 + (i & 3) + 8 * (i >> 2) + 4 * hi; const float s = n <= nmax ? sc[kt][i] * 0.08838834764831845f : -__builtin_inff(); sc[kt][i] = s; mx = fmaxf(mx, s); }
        mx = fmaxf(mx, __shfl_xor(mx, 32));
        float sum = 0.f;
#pragma unroll
        for (int kt = 0; kt < 4; ++kt)
#pragma unroll
            for (int i = 0; i < 16; ++i) { const float e = __expf(sc[kt][i] - mx); sc[kt][i] = e; sum += e; }
        sum += __shfl_xor(sum, 32);
        const float inv = sum > 0.f ? 1.f / sum : 0.f;
#pragma unroll
        for (int kt = 0; kt < 4; ++kt)
#pragma unroll
            for (int i = 0; i < 16; ++i) sc[kt][i] *= inv;
        f32x16 oc[4] = {};
#pragma unroll
        for (int kt = 0; kt < 4; ++kt) { bf16x8 pa0, pa1;
#define PK4(P, B_, OUT) do { unsigned a0 = cvt_pk_bf16(P[B_+0], P[B_+1]), a1 = cvt_pk_bf16(P[B_+2], P[B_+3]); unsigned b0 = cvt_pk_bf16(P[B_+4], P[B_+5]), b1 = cvt_pk_bf16(P[B_+6], P[B_+7]); \
        auto r0 = __builtin_amdgcn_permlane32_swap(a0, b0, false, false); auto r1 = __builtin_amdgcn_permlane32_swap(a1, b1, false, false); u32x4 w_ = {r0[0], r1[0], r0[1], r1[1]}; OUT = *reinterpret_cast<bf16x8*>(&w_); } while (0)
            PK4(sc[kt], 0, pa0); PK4(sc[kt], 8, pa1);
#undef PK4
#pragma unroll
            for (int dt = 0; dt < 4; ++dt) { const bf16x8 v0 = *(const bf16x8*)(vct + ((size_t)bg * 128 + dt * 32 + r32) * 128 + kt * 32 + hi * 8), v1 = *(const bf16x8*)(vct + ((size_t)bg * 128 + dt * 32 + r32) * 128 + kt * 32 + 16 + hi * 8);
                oc[dt] = __builtin_amdgcn_mfma_f32_32x32x16_bf16(pa0, v0, oc[dt], 0, 0, 0); oc[dt] = __builtin_amdgcn_mfma_f32_32x32x16_bf16(pa1, v1, oc[dt], 0, 0, 0); } }
        if (hi == 0) gl[r32] = fast_sigmoid(bf2f(proj[t * LDP + P_NG + hd * 3]));
        asm volatile("s_waitcnt lgkmcnt(0)" ::: "memory");
#pragma unroll
        for (int i = 0; i < 16; ++i) { const int rr = (i & 3) + 8 * (i >> 2) + 4 * hi; const float gt = gl[rr];
            const size_t tt = (size_t)b * S + pb * 64 + w * 8 + (rr >> 2); const int hh = g * 4 + (rr & 3);
#pragma unroll
            for (int dt = 0; dt < 4; ++dt) { const float v = oc[dt][i] * gt, vn = __shfl_xor(v, 1);
                if ((r32 & 1) == 0) *(unsigned*)(on + tt * 1024 + hh * 128 + dt * 32 + r32) = cvt_pk_bf16(v, vn); } }
#pragma unroll
        for (int kt = 0; kt < 4; ++kt)
#pragma unroll
            for (int i = 0; i < 16; ++i) { float v = sc[kt][i]; v += __shfl_xor(v, 1); v += __shfl_xor(v, 2); sc[kt][i] = v; }
        float imp[16];
#pragma unroll
        for (int kt = 0; kt < 4; ++kt)
#pragma unroll
            for (int q = 0; q < 4; ++q) { const float gsum = sc[kt][4 * q] + sc[kt][4 * q + 1] + sc[kt][4 * q + 2] + sc[kt][4 * q + 3];
                const float lastown = sc[kt][4 * q + 3]; const float lastprev = (kt * 4 + q) > 0 ? sc[(kt * 4 + q - 1) >> 2][4 * ((kt * 4 + q - 1) & 3) + 3] : 0.f;
                const float fromp_same = __shfl_xor(lastown, 32), fromp_prev = __shfl_xor(lastprev, 32);
                imp[kt * 4 + q] = gsum + (hi ? fromp_same : fromp_prev); }
        const int cb = p >> 6;
#pragma unroll
        for (int s_ = 0; s_ < 16; ++s_) { const int j = 8 * (s_ >> 2) + 2 * (s_ & 3) + hi; if (j == 0 || j == cb || j == cb - 1) imp[s_] = 1e9f; if (j > cb) imp[s_] = -1e30f; }
        unsigned mask = 0;
#pragma unroll
        for (int k = 0; k < 8; ++k) { float bv = -__builtin_inff(); int bj = 64;
#pragma unroll
            for (int s_ = 0; s_ < 16; ++s_) { const int j = 8 * (s_ >> 2) + 2 * (s_ & 3) + hi; if (imp[s_] > bv) { bv = imp[s_]; bj = j; } }
            const float ov = __shfl_xor(bv, 32); const int oj = __shfl_xor(bj, 32);
            const bool mine = (bv > ov) || (bv == ov && bj < oj); const int wj = mine ? bj : oj;
            mask |= 1u << wj;
#pragma unroll
            for (int s_ = 0; s_ < 16; ++s_) { const int j = 8 * (s_ >> 2) + 2 * (s_ & 3) + hi; if (j == wj) imp[s_] = -__builtin_inff(); } }
        if ((r32 & 3) == 0 && hi == 0) selm[t * 2 + g] = mask;
    }
}
constexpr int NSTEP = 1 + 11 * NL;

#ifdef DIAG_A
__device__ __forceinline__ void diag_stamp(const Frame& F, int k) {
    if (F.c == 0 && F.tid == 0) { LAS long long* st = (LAS long long*)(F.lds + LDS_MISC + 4096); const long long now = wall_clock64(); const long long d = now - st[0]; st[0] = now;
        if (k == DIAG_A) st[1] = d; if (k == DIAG_B) st[2] = d; }
}
#endif
template <int l>
__device__ __forceinline__ void layer_steps(const Frame& F, const XcdBarrier& bar, const int lo, const int hi) {
#define IN(k) (lo <= (k) && (k) < hi)
#ifdef DIAG_A
#define SEAM(k) do { if (IN(k) && IN((k) + 1)) { xcd_barrier(bar); diag_stamp(F, (k)); } } while (0)
#else
#define SEAM(k) do { if (IN(k) && IN((k) + 1)) xcd_barrier(bar); } while (0)
#endif
    const int base = 1 + 11 * l;
    if (IN(base + 0)) { p_inproj(F, l);
#ifdef PROBE_INPROJ
        p_inproj(F, l);
#endif
#ifdef PROBE_INPROJ_NULL8
        p_inproj_null8(F, l);
#endif
#ifdef PROBE_INPROJ_LONGK
        p_inproj_longk(F, l);
#endif
#ifdef PROBE_INPROJ_SAME
        p_inproj_same(F, l);
#endif
#ifdef PROBE_INPROJ_NULL
        p_inproj_null(F, l);
#endif
    } SEAM(base + 0);
    if (IN(base + 1)) { p_nsa_cmp(F, l); p_moba_prep(F, F.G > CMP_WGS ? CMP_WGS : 0); p_gla1(F, l);
#ifdef PROBE_S1
        p_nsa_cmp(F, l); p_moba_prep(F, 16); p_gla1(F, l);
#endif
#ifdef PROBE_GLA1
        p_gla1(F, l);
#endif
#ifdef PROBE_MOBAPREP
        p_moba_prep(F, 16);
#endif
#ifdef PROBE_NSACMP
        p_nsa_cmp(F, l);
#endif
    } SEAM(base + 1);
    if (IN(base + 2)) { p_moba_attn(F);
#ifdef PROBE_MOBA
        p_moba_attn(F);
#endif
#ifdef PROBE_MOBA512
        p_moba_attn_t<512, true>(F);
#endif
#ifdef PROBE_MOBAFULL
        p_moba_attn_t<(1 << 20), true>(F);
#endif
        p_nsa_cmpsel(F); p_gla2(F); } SEAM(base + 2);
    if (IN(base + 3)) {
#ifndef PROBE_SKIP_NSA
        p_nsa_attn(F);
#endif
        p_gla3(F, l);
#ifdef PROBE_NSADUMMY
        p_nsa_attn_t<true>(F);
#endif
#ifdef PROBE_GLA3
        p_gla3(F, l);
#endif
    } SEAM(base + 3);
    if (IN(base + 4)) { p_merge(F, l);
#ifdef PROBE_MERGE
        p_merge(F, l);
#endif
    } SEAM(base + 4);
    if (IN(base + 5)) { p_wout(F, l); } SEAM(base + 5);
    if (IN(base + 6)) { p_route1<MOE_F8 && l >= MOE_F8_FROM>(F, l); p_conv_experts<MOE_F8 && l >= MOE_F8_FROM, 2>(F, l);
#ifdef PROBE_ROUTE1DRY
        p_route1<MOE_F8 && l >= MOE_F8_FROM, true>(F, l);
#endif
#ifdef PROBE_CONVX
        p_conv_experts<MOE_F8 && l >= MOE_F8_FROM, 0>(F, l);
#endif
    }
    if (IN(base + 6) && IN(base + 8)) xcd_barrier(bar);
    if (IN(base + 8)) { p_moe_gu<MOE_F8 && l >= MOE_F8_FROM>(F, l);
#ifdef PROBE_GU
        p_moe_gu<MOE_F8 && l >= MOE_F8_FROM>(F, l);
#endif
    } SEAM(base + 8);
    if (IN(base + 9)) { p_moe_down<MOE_F8 && l >= MOE_F8_FROM>(F, l);
#ifdef PROBE_DOWN
        p_moe_down<MOE_F8 && l >= MOE_F8_FROM>(F, l);
#endif
#ifdef PROBE_DOWN_NULL
        p_moe_down_null<MOE_F8 && l >= MOE_F8_FROM>(F, l);
#endif
    } SEAM(base + 9);
    if (IN(base + 10)) { if (l + 1 < NL) p_combine<0>(F, l + 1, l); else p_combine<1>(F, 0, l);
#ifdef PROBE_COMBINEDRY
        if (l + 1 < NL) { p_combine<0, true>(F, l + 1, l); p_combine<0, true>(F, l + 1, l); }
#endif
    }
    if (l + 1 < NL) SEAM(base + 10);
#undef SEAM
#undef IN
}

__global__ void __launch_bounds__(NTHR, 2) k_fwd(Args args) {
    extern __shared__ __attribute__((aligned(16))) unsigned char lds_raw[];
    Frame F; F.lds = (LAS unsigned char*)lds_raw; F.tid = threadIdx.x; F.lane = F.tid & 63; F.wave = __builtin_amdgcn_readfirstlane(F.tid >> 6);
    F.G = gridDim.x; F.c = blockIdx.x; F.ws = args.ws;
    if (F.tid == 0) {
#pragma unroll
        for (int i = 0; i < 22; ++i) *(LAS unsigned long long*)(F.lds + LDS_ARGS + i * 8) = (unsigned long long)args.in[i];
        *(LAS unsigned long long*)(F.lds + LDS_ARGS + 22 * 8) = (unsigned long long)args.out;
        *(LAS unsigned long long*)(F.lds + LDS_XB) = 0ull; *(LAS unsigned long long*)(F.lds + LDS_XB + 8) = 0ull;
    }
    __syncthreads();
    const int lo = args.ph_lo, hi = args.ph_hi;
    XcdBarrier bar; bar.bar = (unsigned*)(args.ws + WS_CTL) + CW_BAR; bar.x = 0; bar.st = (volatile LAS unsigned*)(F.lds + LDS_XB);
    if (hi - lo > 1) bar = xcd_barrier_post((unsigned*)(args.ws + WS_CTL) + CW_BAR, (volatile LAS unsigned*)(F.lds + LDS_XB));
#ifdef DIAG_A
    {
        const u32x4* src = (const u32x4*)(args.ws + (size_t)256 * 1024 * 1024); unsigned acc_ = 0;
        for (size_t i = (size_t)F.c * NTHR + F.tid; i < (size_t)768 * 1024 * 1024 / 16; i += (size_t)F.G * NTHR) { const u32x4 v = src[i]; acc_ ^= v[0] ^ v[1] ^ v[2] ^ v[3]; }
        asm volatile("" :: "v"(acc_)); xcd_barrier(bar);
    }
    if (F.c == 0 && F.tid == 0) { LAS long long* st = (LAS long long*)(F.lds + LDS_MISC + 4096); st[0] = wall_clock64(); st[1] = 0; st[2] = 0; }
#endif
    if (lo <= 0 && 0 < hi) {
#if INPROJ_F8 == 3
        p_conv_win_i8(F);
#endif
#if INPROJ_F8 == 3
        p_conv_small(F);
#else
        p_conv_static(F);
#endif
        p_conv_router(F); p_conv_cmp(F); p_rmsnorm(F, 0);
#ifdef PROBE_CONV
        p_conv_static(F);
#endif
 if (1 < hi) xcd_barrier(bar); }
    layer_steps<0>(F, bar, lo, hi);
    layer_steps<1>(F, bar, lo, hi);
#ifdef DIAG_A
    xcd_barrier(bar); diag_stamp(F, 22);
    if (F.c == 0 && F.tid == 0) { LAS long long* st = (LAS long long*)(F.lds + LDS_MISC + 4096);
        const float ua = (float)st[1] * 0.01f, ub = (float)st[2] * 0.01f;
        args.out[0] = ua > 1.f ? __expf(floorf(__logf(ua) / 0.10f + 0.5f) * 0.10f) : 0.f;
        args.out[1] = ub > 1.f ? __expf(floorf(__logf(ub) / 0.10f + 0.5f) * 0.10f) : 0.f; }
#endif
#ifdef PROBE_BARS
    for (int i = 0; i < 20; ++i) xcd_barrier(bar);
#endif
#ifdef DIAG_MODE
    xcd_barrier(bar);
    if (F.c == 0 && F.tid == 0) args.out[0] = *(LAS float*)(F.lds + LDS_MISC + 4000);
#endif
}

static int g_grid = 0;
extern "C" void kernel_launch(void* const* d_in, const int* in_sizes, int n_in,
                              void* d_out, int out_size, void* d_ws, size_t ws_size,
                              hipStream_t stream) {
    if (g_grid == 0) {
        int dev = 0, cus = 0; (void)hipGetDevice(&dev); (void)hipDeviceGetAttribute(&cus, hipDeviceAttributeMultiprocessorCount, dev);
        (void)hipFuncSetAttribute((const void*)k_fwd, hipFuncAttributeMaxDynamicSharedMemorySize, LDS_BYTES);
        int per_cu = 0; (void)hipOccupancyMaxActiveBlocksPerMultiprocessor(&per_cu, (const void*)k_fwd, NTHR, LDS_BYTES);
        g_grid = (cus > 0 ? cus : 256) * (per_cu >= 1 ? 1 : 1);
    }
    if (ws_size < WS_END6 || ws_size < WS_NEED || WS_END6 > WS_H8) return;
    Args a{}; for (int i = 0; i < 22; ++i) a.in[i] = (const float*)d_in[i];
    a.out = (float*)d_out; a.ws = (unsigned char*)d_ws;
    (void)hipMemsetAsync((unsigned char*)d_ws + WS_CTL, 0, CTL_BYTES, stream);

#ifdef MULTI_LAUNCH
    for (int s = 0; s < NSTEP; ++s) { a.ph_lo = s; a.ph_hi = s + 1; hipLaunchKernelGGL(k_fwd, dim3(g_grid), dim3(NTHR), LDS_BYTES, stream, a); }
#else
    a.ph_lo = 0; a.ph_hi = NSTEP;
    hipLaunchKernelGGL(k_fwd, dim3(g_grid), dim3(NTHR), LDS_BYTES, stream, a);
#endif
}
```
